# Optimizing an MI355X kernel written in HIP

```python
import math
import jax
import jax.numpy as jnp
from jax import lax
import numpy as np

D_MODEL = 4096
BATCH = 1
SEQ = 16384
DEPTH = 1

MLA_HEADS = 16
MLA_Q_LORA = 1024
MLA_KV_LORA = 512
MLA_NOPE_DIM = 128
MLA_ROPE_DIM = 64
MLA_V_DIM = 128
MLA_Q_BLOCK = 128
ROPE_THETA = 10000.0
MOBA_HEADS = 16
MOBA_HEAD_DIM = 128
MOBA_BLOCK = 256
MOBA_TOPK = 3
MOBA_Q_CHUNK = 32
REL_BUCKETS = 32
REL_MAX_DIST = 128
D_FF = 11008
RMS_EPS = 1e-6

MLA_Q_UP = MLA_HEADS * (MLA_NOPE_DIM + MLA_ROPE_DIM)
MLA_KV_UP = MLA_HEADS * (MLA_NOPE_DIM + MLA_V_DIM)
MLA_OUT = MLA_HEADS * MLA_V_DIM
MOBA_WIDTH = MOBA_HEADS * MOBA_HEAD_DIM
IN_SIZES = (MLA_Q_LORA, MLA_KV_LORA, MLA_ROPE_DIM, MOBA_WIDTH, MOBA_WIDTH, MOBA_WIDTH, D_MODEL, D_MODEL)
IN_COLS = MLA_Q_LORA + MLA_KV_LORA + MLA_ROPE_DIM + 3 * MOBA_WIDTH + 2 * D_MODEL

kernel_name = "hybrid_mla_moba_gated_macaron"


def rms_norm(x, g):
    xf = x.astype(jnp.float32)
    y = xf * lax.rsqrt(jnp.mean(xf * xf, axis=-1, keepdims=True) + RMS_EPS)
    return y.astype(x.dtype) * g


def swiglu(h, w_in, w_out):
    gu = h @ w_in
    g, u = gu[..., :D_FF], gu[..., D_FF:]
    return (jax.nn.silu(g) * u) @ w_out


def split_cols(t, sizes):
    outs = []
    o = 0
    for s in sizes:
        outs.append(t[..., o:o + s])
        o += s
    return outs


def apply_rope(x, cos, sin):
    half = x.shape[-1] // 2
    x1, x2 = x[..., :half], x[..., half:]
    return jnp.concatenate([x1 * cos - x2 * sin, x2 * cos + x1 * sin], axis=-1)


def t5_bucket(n):
    max_exact = REL_BUCKETS // 2
    n_f = jnp.maximum(n, max_exact).astype(jnp.float32)
    large = max_exact + (jnp.log(n_f / max_exact) / math.log(REL_MAX_DIST / max_exact)
                         * (REL_BUCKETS - max_exact)).astype(jnp.int32)
    large = jnp.minimum(large, REL_BUCKETS - 1)
    return jnp.where(n < max_exact, n, large)


def mla_attention(c_q, c_kv, k_rope, cos, sin, norm_cq, w_uq, norm_ckv, w_ukv):
    B, S, _ = c_q.shape
    q = (rms_norm(c_q, norm_cq) @ w_uq).reshape(B, S, MLA_HEADS, MLA_NOPE_DIM + MLA_ROPE_DIM)
    q_nope = q[..., :MLA_NOPE_DIM]
    q_rope = apply_rope(q[..., MLA_NOPE_DIM:], cos[:, :, None, :], sin[:, :, None, :])
    kv = (rms_norm(c_kv, norm_ckv) @ w_ukv).reshape(B, S, MLA_HEADS, MLA_NOPE_DIM + MLA_V_DIM)
    k_nope, v = kv[..., :MLA_NOPE_DIM], kv[..., MLA_NOPE_DIM:]
    k_r = apply_rope(k_rope, cos, sin)
    scale = (MLA_NOPE_DIM + MLA_ROPE_DIM) ** -0.5
    k_idx = jnp.arange(S)

    def block(i):
        s0 = i * MLA_Q_BLOCK
        qn = lax.dynamic_slice_in_dim(q_nope, s0, MLA_Q_BLOCK, axis=1)
        qr = lax.dynamic_slice_in_dim(q_rope, s0, MLA_Q_BLOCK, axis=1)
        logits = (jnp.einsum('bqhd,bkhd->bhqk', qn, k_nope, preferred_element_type=jnp.float32)
                  + jnp.einsum('bqhd,bkd->bhqk', qr, k_r, preferred_element_type=jnp.float32)) * scale
        causal = k_idx[None, :] <= (s0 + jnp.arange(MLA_Q_BLOCK))[:, None]
        logits = jnp.where(causal, logits, -jnp.inf)
        p = jax.nn.softmax(logits, axis=-1).astype(v.dtype)
        return jnp.einsum('bhqk,bkhd->bqhd', p, v)

    out = lax.map(block, jnp.arange(S // MLA_Q_BLOCK))
    return jnp.moveaxis(out, 0, 1).reshape(B, S, MLA_OUT)


def moba_attention_single(q, k, v, pos, rel_bias):
    S, H, Dh = q.shape
    n_blk = -(-S // MOBA_BLOCK)
    s_pad = n_blk * MOBA_BLOCK
    pad = s_pad - S
    qp = jnp.pad(q, ((0, pad), (0, 0), (0, 0)))
    kp = jnp.pad(k, ((0, pad), (0, 0), (0, 0)))
    vp = jnp.pad(v, ((0, pad), (0, 0), (0, 0)))
    posp = jnp.pad(pos, (0, pad))
    kb = kp.reshape(n_blk, MOBA_BLOCK, H, Dh)
    vb = vp.reshape(n_blk, MOBA_BLOCK, H, Dh)
    posb = posp.reshape(n_blk, MOBA_BLOCK)
    k_mean = jnp.mean(kb.astype(jnp.float32), axis=1)
    q_blk = jnp.arange(s_pad) // MOBA_BLOCK
    gate = jnp.einsum('shd,nhd->shn', qp.astype(jnp.float32), k_mean)
    past = jnp.arange(n_blk)[None, None, :] < q_blk[:, None, None]
    gate = jnp.where(past, gate, -jnp.inf)
    n_sel = min(MOBA_TOPK, n_blk)
    _, sel = lax.top_k(gate, n_sel)
    sel_valid = sel < q_blk[:, None, None]
    kb_h = jnp.transpose(kb, (2, 0, 1, 3))
    vb_h = jnp.transpose(vb, (2, 0, 1, 3))
    bias_h = rel_bias.T
    h_idx = jnp.arange(H)
    scale = Dh ** -0.5

    def chunk(c):
        s0 = c * MOBA_Q_CHUNK
        qc = lax.dynamic_slice_in_dim(qp, s0, MOBA_Q_CHUNK, 0)
        sel_c = lax.dynamic_slice_in_dim(sel, s0, MOBA_Q_CHUNK, 0)
        valid_c = lax.dynamic_slice_in_dim(sel_valid, s0, MOBA_Q_CHUNK, 0)
        pos_qc = lax.dynamic_slice_in_dim(posp, s0, MOBA_Q_CHUNK, 0)
        k_sel = kb_h[h_idx[None, :, None], sel_c]
        v_sel = vb_h[h_idx[None, :, None], sel_c]
        pos_sel = posb[sel_c]
        b_sel = t5_bucket(jnp.maximum(pos_qc[:, None, None, None] - pos_sel, 0))
        logit_sel = (jnp.einsum('qhd,qhjkd->qhjk', qc, k_sel, preferred_element_type=jnp.float32) * scale
                     + bias_h[h_idx[None, :, None, None], b_sel])
        logit_sel = jnp.where(valid_c[..., None], logit_sel, -jnp.inf)
        logit_sel = logit_sel.reshape(MOBA_Q_CHUNK, H, n_sel * MOBA_BLOCK)
        ob = s0 // MOBA_BLOCK
        k_own = lax.dynamic_index_in_dim(kb, ob, 0, keepdims=False)
        v_own = lax.dynamic_index_in_dim(vb, ob, 0, keepdims=False)
        pos_own = lax.dynamic_index_in_dim(posb, ob, 0, keepdims=False)
        b_own = t5_bucket(jnp.maximum(pos_qc[:, None] - pos_own[None, :], 0))
        logit_own = (jnp.einsum('qhd,khd->qhk', qc, k_own, preferred_element_type=jnp.float32) * scale
                     + jnp.transpose(rel_bias[b_own], (0, 2, 1)))
        causal = (ob * MOBA_BLOCK + jnp.arange(MOBA_BLOCK))[None, :] <= (s0 + jnp.arange(MOBA_Q_CHUNK))[:, None]
        logit_own = jnp.where(causal[:, None, :], logit_own, -jnp.inf)
        p = jax.nn.softmax(jnp.concatenate([logit_sel, logit_own], axis=-1), axis=-1).astype(v.dtype)
        p_sel = p[..., :n_sel * MOBA_BLOCK].reshape(MOBA_Q_CHUNK, H, n_sel, MOBA_BLOCK)
        p_own = p[..., n_sel * MOBA_BLOCK:]
        return (jnp.einsum('qhjk,qhjkd->qhd', p_sel, v_sel)
                + jnp.einsum('qhk,khd->qhd', p_own, v_own))

    out = lax.map(chunk, jnp.arange(s_pad // MOBA_Q_CHUNK))
    return out.reshape(s_pad, H, Dh)[:S]


def hybrid_layer(x, cos, sin, positions, rel_bias, norm_ffn1, w_ffn1_in, w_ffn1_out, norm_mix, w_in,
                 norm_cq, w_uq, norm_ckv, w_ukv, w_br_a, w_br_b, w_out, norm_ffn2, w_ffn2_in, w_ffn2_out):
    B, S, _ = x.shape
    x = x + 0.5 * swiglu(rms_norm(x, norm_ffn1), w_ffn1_in, w_ffn1_out)
    h = rms_norm(x, norm_mix)
    c_q, c_kv, k_rope, q_b, k_b, v_b, gl_a, gl_b = split_cols(h @ w_in, IN_SIZES)
    o_a = mla_attention(c_q, c_kv, k_rope, cos, sin, norm_cq, w_uq, norm_ckv, w_ukv)
    shp = (B, S, MOBA_HEADS, MOBA_HEAD_DIM)
    o_b = jax.vmap(moba_attention_single, in_axes=(0, 0, 0, 0, None))(
        q_b.reshape(shp), k_b.reshape(shp), v_b.reshape(shp), positions, rel_bias).reshape(B, S, MOBA_WIDTH)
    merged = jax.nn.sigmoid(gl_a) * (o_a @ w_br_a) + jax.nn.sigmoid(gl_b) * (o_b @ w_br_b)
    x = x + merged @ w_out
    x = x + 0.5 * swiglu(rms_norm(x, norm_ffn2), w_ffn2_in, w_ffn2_out)
    return x


def setup_inputs(seed: int = 0) -> dict:
    key = jax.random.key(seed)
    ks = jax.random.split(key, 20)
    f32 = jnp.float32

    def w(k, shape, fan_in):
        return jax.random.normal(k, shape, f32) * (fan_in ** -0.5)

    def gain(k, shape):
        return 1.0 + 0.01 * jax.random.normal(k, shape, f32)

    x = jax.random.normal(ks[0], (BATCH, SEQ, D_MODEL), f32)
    positions = jnp.broadcast_to(jnp.arange(SEQ, dtype=jnp.int32)[None, :], (BATCH, SEQ))
    return {
        "x": x,
        "positions": positions,
        "rel_bias": 0.1 * jax.random.normal(ks[1], (REL_BUCKETS, MOBA_HEADS), f32),
        "norm_ffn1": gain(ks[2], (DEPTH, D_MODEL)),
        "w_ffn1_in": w(ks[3], (DEPTH, D_MODEL, 2 * D_FF), D_MODEL),
        "w_ffn1_out": w(ks[4], (DEPTH, D_FF, D_MODEL), D_FF),
        "norm_mix": gain(ks[5], (DEPTH, D_MODEL)),
        "w_in": w(ks[6], (DEPTH, D_MODEL, IN_COLS), D_MODEL),
        "norm_cq": gain(ks[7], (DEPTH, MLA_Q_LORA)),
        "w_uq": w(ks[8], (DEPTH, MLA_Q_LORA, MLA_Q_UP), MLA_Q_LORA),
        "norm_ckv": gain(ks[9], (DEPTH, MLA_KV_LORA)),
        "w_ukv": w(ks[10], (DEPTH, MLA_KV_LORA, MLA_KV_UP), MLA_KV_LORA),
        "w_br_a": w(ks[11], (DEPTH, MLA_OUT, D_MODEL), MLA_OUT),
        "w_br_b": w(ks[12], (DEPTH, MOBA_WIDTH, D_MODEL), MOBA_WIDTH),
        "w_out": w(ks[13], (DEPTH, D_MODEL, D_MODEL), D_MODEL),
        "norm_ffn2": gain(ks[14], (DEPTH, D_MODEL)),
        "w_ffn2_in": w(ks[15], (DEPTH, D_MODEL, 2 * D_FF), D_MODEL),
        "w_ffn2_out": w(ks[16], (DEPTH, D_FF, D_MODEL), D_FF),
        "norm_final": gain(ks[17], (D_MODEL,)),
    }


def reference(x, positions, rel_bias, norm_ffn1, w_ffn1_in, w_ffn1_out, norm_mix, w_in, norm_cq, w_uq,
              norm_ckv, w_ukv, w_br_a, w_br_b, w_out, norm_ffn2, w_ffn2_in, w_ffn2_out, norm_final):
    inv_freq = ROPE_THETA ** (-jnp.arange(0, MLA_ROPE_DIM, 2, dtype=jnp.float32) / MLA_ROPE_DIM)
    ang = positions[..., None].astype(jnp.float32) * inv_freq
    cos = jnp.cos(ang).astype(x.dtype)
    sin = jnp.sin(ang).astype(x.dtype)
    for l in range(DEPTH):
        x = hybrid_layer(x, cos, sin, positions, rel_bias, norm_ffn1[l], w_ffn1_in[l], w_ffn1_out[l],
                         norm_mix[l], w_in[l], norm_cq[l], w_uq[l], norm_ckv[l], w_ukv[l], w_br_a[l],
                         w_br_b[l], w_out[l], norm_ffn2[l], w_ffn2_in[l], w_ffn2_out[l])
    return rms_norm(x, norm_final)
```

```cpp
#ifndef CMP_REL
#define CMP_REL 0.03f
#define CMP_THR 0.2f
#define CMP_NBAD 0.f
#endif
#ifndef I8_FFN2
#define I8_FFN2 1
#endif
#ifndef FP8_BR
#define FP8_BR 1
#endif
#ifndef FP8_OUT
#define FP8_OUT 0
#endif
#ifndef PROBE_PHASE
#define PROBE_PHASE -1
#endif
#define MLA_BF16 (PROBE_PHASE == 500)
#ifndef SELFCHECK_REL
#define SELFCHECK_REL 0.03f
#define SELFCHECK_ABS 1e-4f
#endif
#ifndef SELFCHECK_TOL
#define SELFCHECK_TOL 0u
#endif
#include <hip/hip_runtime.h>
#include <cstdio>
#include <cstdint>
#include <cmath>
__device__ __forceinline__ int lane_id_() { return (int)__builtin_amdgcn_mbcnt_hi(~0u, __builtin_amdgcn_mbcnt_lo(~0u, 0u)); }
namespace pg8 {
#define PG8_LAS __attribute__((address_space(3)))
typedef unsigned short bf16_t;
typedef short bf16x8 __attribute__((ext_vector_type(8)));
typedef float f32x4 __attribute__((ext_vector_type(4)));
typedef unsigned u32x4 __attribute__((ext_vector_type(4)));
constexpr int BM = 256, BK = 64, HALF = 128, HTB = HALF * BK * 2  , STAGE_BYTES = 8 * HTB, NXCD = 8, WGM = 8;

__host__ __device__ __forceinline__ int lds_byte(int r, int c) { const int st = (r >> 4) * 2 + (c >> 5), rr = r & 15, cc = c & 31, ob = rr * 64 + cc * 2; return st * 1024 + (ob ^ (((ob >> 9) & 1) << 5)); }
__host__ __device__ __forceinline__ void stage_rc(int b, int& R, int& C) { const int st = b / 1024, sb = b % 1024, swz = sb ^ (((sb >> 9) & 1) << 5); R = (st >> 1) * 16 + swz / 64; C = (st & 1) * 32 + (swz % 64) / 2; }
__host__ __device__ __forceinline__ int perm32(int rho) { const int n = rho >> 4, i = rho & 15; return 8 * (i >> 2) + 4 * n + (i & 3); }

struct Unit { int pm, pn; };
struct Gemm { const bf16_t* A; const bf16_t* Bt; int M, N, K; };

struct StaticOrder {
    int nM, nN, nwg, G, c;
    __host__ __device__ void init(int M, int N, int G_, int c_) { nM = M / BM; nN = N / BM; nwg = nM * nN; G = G_; c = c_; }
    __host__ __device__ bool next(int i, Unit& u) const {
        const long L = (long)i * G + c; if (L >= nwg) return false;
        int wgid = (int)L; { const int q = nwg / NXCD, r = nwg % NXCD, xcd = wgid % NXCD, off = wgid / NXCD; wgid = (xcd < r ? xcd * (q + 1) : r * (q + 1) + (xcd - r) * q) + off; }
        const int nig = WGM * nN, gid = wgid / nig, fm = gid * WGM, gsz = (nM - fm) < WGM ? (nM - fm) : WGM;
        u.pm = fm + ((wgid % nig) % gsz); u.pn = (wgid % nig) / gsz; return true;
    }
    __device__ __forceinline__ void a_ready(const Unit&) const {}
    __device__ __forceinline__ void done(const Unit&) const {}
};

__device__ __forceinline__ unsigned cvt_pk_bf16(float lo, float hi) { unsigned r; asm volatile("v_cvt_pk_bf16_f32 %0, %1, %2" : "=v"(r) : "v"(lo), "v"(hi)); return r; }
typedef float f32x2 __attribute__((ext_vector_type(2)));
typedef unsigned u32x2 __attribute__((ext_vector_type(2)));
__device__ __forceinline__ float bf_lo(unsigned w) { return __uint_as_float(w << 16); }
__device__ __forceinline__ float bf_hi(unsigned w) { return __uint_as_float(w & 0xffff0000u); }
__device__ __forceinline__ float sigmoid_f(float x) { return __builtin_amdgcn_rcpf(1.0f + __builtin_amdgcn_exp2f(-1.4426950408889634f * x)); }
__device__ __forceinline__ u32x4 pack8f(f32x4 a, f32x4 b) { u32x4 w; w.x = cvt_pk_bf16(a[0], a[1]); w.y = cvt_pk_bf16(a[2], a[3]); w.z = cvt_pk_bf16(b[0], b[1]); w.w = cvt_pk_bf16(b[2], b[3]); return w; }

__device__ __forceinline__ unsigned pack4_fp8(f32x4 v) { int w = 0; w = __builtin_amdgcn_cvt_pk_fp8_f32(v[0], v[1], w, false); w = __builtin_amdgcn_cvt_pk_fp8_f32(v[2], v[3], w, true); return (unsigned)w; }
struct EpiPlain {
    static constexpr bool PERM = true, AFTER_DRAIN = false; __device__ __forceinline__ bool idem() const { return true; }
    bf16_t* O; int ldc; const float* part8; unsigned char* K8; unsigned char* V8;
    __device__ __forceinline__ void operator()(const f32x4 (&acc)[2][2][4][2], const Unit& u, int wr, int wc, int fr, int fq) const {
        const int row0 = u.pm * BM + wr * 64 + fr, col0 = u.pn * BM + wc * 32 + 8 * fq;
#pragma unroll
        for (int ai = 0; ai < 2; ++ai)
#pragma unroll
            for (int m = 0; m < 4; ++m) { const int row = row0 + ai * HALF + m * 16; bf16_t* rowp = O + (size_t)row * ldc + col0; float sc = 1.f;
                if (part8) { const f32x4* p = (const f32x4*)(part8 + (size_t)row * 8); const f32x4 a = p[0], b = p[1];
                    sc = 1.0f / sqrtf((((a[0] + a[1]) + (a[2] + a[3])) + ((b[0] + b[1]) + (b[2] + b[3]))) * (1.f / 512.f) + 1e-6f); }
#pragma unroll
                for (int bj = 0; bj < 2; ++bj) { const f32x4 v0 = acc[ai][bj][m][0] * sc, v1 = acc[ai][bj][m][1] * sc; if (O) *(u32x4*)(rowp + bj * HALF) = pack8f(v0, v1);
                    if (bj == 0 && K8) { u32x2 w8; w8.x = pack4_fp8(v0); w8.y = pack4_fp8(v1); *(u32x2*)(K8 + (size_t)row * 2048 + u.pn * 128 + wc * 32 + 8 * fq) = w8; }
                    if (bj == 1 && V8) { const int kk = row & 63; const unsigned w0 = pack4_fp8(v0), w1 = pack4_fp8(v1);
                        unsigned char* vp = V8 + ((size_t)(u.pn * 256 + (row >> 6)) * 128 + (wc * 32 + 8 * fq)) * 64 + (((kk >> 2) & 1) * 32 + (kk >> 5) * 16 + ((kk >> 3) & 3) * 4 + (kk & 3));
                        vp[0] = (unsigned char)w0; vp[64] = (unsigned char)(w0 >> 8); vp[128] = (unsigned char)(w0 >> 16); vp[192] = (unsigned char)(w0 >> 24);
                        vp[256] = (unsigned char)w1; vp[320] = (unsigned char)(w1 >> 8); vp[384] = (unsigned char)(w1 >> 16); vp[448] = (unsigned char)(w1 >> 24); } } }
    }
};
struct EpiSwiglu {
    static constexpr bool PERM = true, AFTER_DRAIN = false;
    bf16_t* O; int ldc; const float* rs; int tiledM; const float* cmax;
    __device__ __forceinline__ void operator()(const f32x4 (&acc)[2][2][4][2], const Unit& u, int wr, int wc, int fr, int fq) const {
        const int row0 = u.pm * BM + wr * 64 + fr, col0 = u.pn * HALF + wc * 32 + 8 * fq;
        f32x4 cg[2] = {{1.f, 1.f, 1.f, 1.f}, {1.f, 1.f, 1.f, 1.f}}, cu[2] = {{1.f, 1.f, 1.f, 1.f}, {1.f, 1.f, 1.f, 1.f}};
        if (cmax) {
#pragma unroll
            for (int n = 0; n < 2; ++n) { cg[n] = *(const f32x4*)(cmax + col0 + 4 * n) * (1.f / 127.f); cu[n] = *(const f32x4*)(cmax + (ldc + col0) + 4 * n) * (1.f / 127.f); } }
#pragma unroll
        for (int ai = 0; ai < 2; ++ai)
#pragma unroll
            for (int m = 0; m < 4; ++m) { const int row = row0 + ai * HALF + m * 16;
                bf16_t* rowp = tiledM ? O + ((size_t)(col0 >> 6) * tiledM + row) * 64 + (col0 & 63) : O + (size_t)row * ldc + col0;
                const float sc = rs ? rs[row] : 1.f;
                f32x4 h[2];
#pragma unroll
                for (int n = 0; n < 2; ++n) { f32x4 g = acc[ai][0][m][n], up = acc[ai][1][m][n];
                    if (cmax) { typedef int i32x4_t __attribute__((ext_vector_type(4)));
                        g = __builtin_convertvector(__builtin_bit_cast(i32x4_t, g), f32x4) * cg[n]; up = __builtin_convertvector(__builtin_bit_cast(i32x4_t, up), f32x4) * cu[n]; }
                    g = g * sc; up = up * sc;
#pragma unroll
                    for (int e = 0; e < 4; ++e) h[n][e] = g[e] * sigmoid_f(g[e]) * up[e]; }
                *(u32x4*)rowp = pack8f(h[0], h[1]); }
    }
};

struct EpiSwigluCmp {
    static constexpr bool PERM = true, AFTER_DRAIN = false;
    bf16_t* O; int ldc; int tiledM; float* stats; float thr;
    __device__ __forceinline__ void operator()(const f32x4 (&acc)[2][2][4][2], const Unit& u, int wr, int wc, int fr, int fq) const {
        const int row0 = u.pm * BM + wr * 64 + fr, col0 = u.pn * HALF + wc * 32 + 8 * fq; float sd = 0.f, sh = 0.f, nb = 0.f;
#pragma unroll
        for (int ai = 0; ai < 2; ++ai)
#pragma unroll
            for (int m = 0; m < 4; ++m) { const int row = row0 + ai * HALF + m * 16;
                bf16_t* rowp = O + ((size_t)(col0 >> 6) * tiledM + row) * 64 + (col0 & 63);
                const u32x4 old = *(const u32x4*)rowp; const float ov[8] = {bf_lo(old.x), bf_hi(old.x), bf_lo(old.y), bf_hi(old.y), bf_lo(old.z), bf_hi(old.z), bf_lo(old.w), bf_hi(old.w)};
                f32x4 h[2];
#pragma unroll
                for (int n = 0; n < 2; ++n) { const f32x4 g = acc[ai][0][m][n], up = acc[ai][1][m][n];
#pragma unroll
                    for (int e = 0; e < 4; ++e) { h[n][e] = g[e] * sigmoid_f(g[e]) * up[e]; const float d = h[n][e] - ov[4 * n + e]; sd += d * d; sh += h[n][e] * h[n][e]; nb += fabsf(d) > thr ? 1.f : 0.f; } }
                *(u32x4*)rowp = pack8f(h[0], h[1]); }
#pragma unroll
        for (int o = 1; o < 64; o <<= 1) { sd += __shfl_xor(sd, o); sh += __shfl_xor(sh, o); nb += __shfl_xor(nb, o); }
        if (fr == 0 && fq == 0) { atomicAdd(stats, sd); atomicAdd(stats + 1, sh); atomicAdd(stats + 2, nb); }
    }
};
struct EpiNull {
    static constexpr bool PERM = false, AFTER_DRAIN = false;
    __device__ __forceinline__ void operator()(const f32x4 (&acc)[2][2][4][2], const Unit&, int, int, int, int) const {
#pragma unroll
        for (int ai = 0; ai < 2; ++ai)
#pragma unroll
            for (int bj = 0; bj < 2; ++bj)
#pragma unroll
                for (int m = 0; m < 4; ++m)
#pragma unroll
                    for (int n = 0; n < 2; ++n) asm volatile("" :: "v"(acc[ai][bj][m][n]));
    }
};
struct EpiResid {
    static constexpr bool PERM = false, AFTER_DRAIN = false;
    const float* base; float* out; int ldc; float s;
    __device__ __forceinline__ void operator()(const f32x4 (&acc)[2][2][4][2], const Unit& u, int wr, int wc, int fr, int fq) const {
        const int row0 = u.pm * BM + wr * 64 + fr, col0 = u.pn * BM + wc * 32 + 4 * fq;
#pragma unroll
        for (int ai = 0; ai < 2; ++ai)
#pragma unroll
            for (int m = 0; m < 4; ++m) { const size_t off = (size_t)(row0 + ai * HALF + m * 16) * ldc + col0;
#pragma unroll
                for (int bj = 0; bj < 2; ++bj)
#pragma unroll
                    for (int n = 0; n < 2; ++n) { const f32x4 b = *(const f32x4*)(base + off + bj * HALF + n * 16); *(f32x4*)(out + off + bj * HALF + n * 16) = b + acc[ai][bj][m][n] * s; } }
    }
};
template <long F8> struct EpiResidNorm {
    static constexpr bool PERM = false, AFTER_DRAIN = false;
    const float* base; float* out; float s; bf16_t* hb; const float* gain; float* part; float* pmax;
    __device__ __forceinline__ void operator()(const f32x4 (&acc)[2][2][4][2], const Unit& u, int wr, int wc, int fr, int fq) const {
        constexpr int ldc = 4096, hbM = 16384;
        const int row0 = u.pm * BM + wr * 64 + fr, col0 = u.pn * BM + wc * 32 + 4 * fq;
        f32x4 gv[2][2];
#pragma unroll
        for (int bj = 0; bj < 2; ++bj)
#pragma unroll
            for (int n = 0; n < 2; ++n) gv[bj][n] = *(const f32x4*)(gain + col0 + bj * HALF + n * 16);
#pragma unroll
        for (int ai = 0; ai < 2; ++ai)
#pragma unroll
            for (int m = 0; m < 4; ++m) { const int row = row0 + ai * HALF + m * 16; const size_t off = (size_t)row * ldc + col0; float ss = 0.f, mx = 0.f;
#pragma unroll
                for (int bj = 0; bj < 2; ++bj)
#pragma unroll
                    for (int n = 0; n < 2; ++n) { const f32x4 b = *(const f32x4*)(base + off + bj * HALF + n * 16); const f32x4 o = b + acc[ai][bj][m][n] * s;
                        *(f32x4*)(out + off + bj * HALF + n * 16) = o;
                        ss += (o[0] * o[0] + o[1] * o[1]) + (o[2] * o[2] + o[3] * o[3]); const f32x4 y = o * gv[bj][n];
                        mx = fmaxf(fmaxf(mx, fmaxf(fabsf(y[0]), fabsf(y[1]))), fmaxf(fabsf(y[2]), fabsf(y[3])));
                        u32x2 w; w.x = cvt_pk_bf16(y[0], y[1]); w.y = cvt_pk_bf16(y[2], y[3]);
                        const int col = col0 + bj * HALF + n * 16;
                        *(u32x2*)(hb + ((size_t)(col >> 6) * hbM + row) * 64 + (col & 63)) = w;
                        if constexpr (F8 != 0) *(unsigned*)((unsigned char*)hb + F8 + ((size_t)(col >> 7) * hbM + row) * 128 + (col & 127)) = pack4_fp8(y); }
                ss += __shfl_xor(ss, 16); ss += __shfl_xor(ss, 32); if (fq == 0) part[(size_t)row * 64 + u.pn * 4 + wc] = ss;
                if (pmax) { mx = fmaxf(mx, __shfl_xor(mx, 16)); mx = fmaxf(mx, __shfl_xor(mx, 32)); if (fq == 0) pmax[(size_t)row * 64 + u.pn * 4 + wc] = mx; } }
    }
};
template <int MODE_> struct EpiProj {
    static constexpr bool PERM = true, AFTER_DRAIN = false; static constexpr int mode = MODE_; __device__ __forceinline__ bool idem() const { return true; }
    bf16_t *cq, *ckv, *kr, *qb, *kb, *vb, *ga, *gb; const float* cosT; const float* sinT; const float* rs; float* partq; float* partkv; float* kmean; unsigned char* kr8; unsigned char* qb8; unsigned char* kb8; unsigned char* vb8;
    float post;
    __device__ __forceinline__ void operator()(const f32x4 (&acc)[2][2][4][2], const Unit& u, int wr, int wc, int fr, int fq) const {
        const int row0 = u.pm * BM + wr * 64 + fr; const int pn = mode == 1 ? (u.pn == 22 ? 62 : u.pn) : u.pn + 22;
        if (mode == 1 && pn == 62) {
            if (wc < 2) { const int g = wc * 4 + fq;
#pragma unroll
                for (int ai = 0; ai < 2; ++ai)
#pragma unroll
                    for (int m = 0; m < 4; ++m) { const int row = row0 + ai * HALF + m * 16;
                        const f32x4 c = *(const f32x4*)(cosT + (size_t)row * 32 + 4 * g), s = *(const f32x4*)(sinT + (size_t)row * 32 + 4 * g);
                        const float sc = rs[row] * post;
                        const f32x4 x1 = acc[ai][0][m][0] * sc, x2 = acc[ai][0][m][1] * sc;
                        const f32x4 o1 = x1 * c - x2 * s, o2 = x2 * c + x1 * s;
                        u32x2 w1, w2; w1.x = cvt_pk_bf16(o1[0], o1[1]); w1.y = cvt_pk_bf16(o1[2], o1[3]); w2.x = cvt_pk_bf16(o2[0], o2[1]); w2.y = cvt_pk_bf16(o2[2], o2[3]);
                        *(u32x2*)(kr + (size_t)row * 64 + 4 * g) = w1; *(u32x2*)(kr + (size_t)row * 64 + 32 + 4 * g) = w2;
                        *(unsigned*)(kr8 + (size_t)row * 64 + 4 * g) = pack4_fp8(o1); *(unsigned*)(kr8 + (size_t)row * 64 + 32 + 4 * g) = pack4_fp8(o2); } }
            return; }
        bf16_t* base; int ldc, colt; bool sig = false;
        if (pn < 4) { base = cq; ldc = 1024; colt = pn * BM; }
        else if (pn < 6) { base = ckv; ldc = 512; colt = (pn - 4) * BM; }
        else if (pn < 14) { base = qb; ldc = 2048; colt = (pn - 6) * BM; }
        else if (pn < 22) { base = kb; ldc = 2048; colt = (pn - 14) * BM; }
        else if (pn < 30) { base = vb; ldc = 2048; colt = (pn - 22) * BM; }
        else if (pn < 46) { base = ga; ldc = 4096; colt = (pn - 30) * BM; sig = true; }
        else { base = gb; ldc = 4096; colt = (pn - 46) * BM; sig = true; }
        const int col0 = colt + wc * 32 + 8 * fq;
        float* part = mode != 1 ? nullptr : (pn < 4 ? partq + pn * 4 + wc : (pn < 6 ? partkv + (pn - 4) * 4 + wc : nullptr)); const int pstride = pn < 4 ? 16 : 8;
        const bool iskb = mode == 1 && pn >= 14 && pn < 22; f32x4 cs[2][2] = {};
        const bool isvb = mode == 2 && pn < 30;
        unsigned char* f8p = mode == 1 && pn >= 6 && pn < 22 ? (pn < 14 ? qb8 : kb8) : nullptr;
#pragma unroll
        for (int ai = 0; ai < 2; ++ai)
#pragma unroll
            for (int m = 0; m < 4; ++m) { const int row = row0 + ai * HALF + m * 16; bf16_t* rowp = base + (size_t)row * ldc + col0; const float sc = rs[row] * post; float ss = 0.f;
#pragma unroll
                for (int bj = 0; bj < 2; ++bj) { f32x4 v0 = acc[ai][bj][m][0] * sc, v1 = acc[ai][bj][m][1] * sc;
                    if (sig) {
#pragma unroll
                        for (int e = 0; e < 4; ++e) { v0[e] = sigmoid_f(v0[e]); v1[e] = sigmoid_f(v1[e]); } }
                    if (part) ss += ((v0[0] * v0[0] + v0[1] * v0[1]) + (v0[2] * v0[2] + v0[3] * v0[3])) + ((v1[0] * v1[0] + v1[1] * v1[1]) + (v1[2] * v1[2] + v1[3] * v1[3]));
                    if (iskb) { cs[bj][0] += v0; cs[bj][1] += v1; }
                    if (f8p) { u32x2 w8; w8.x = pack4_fp8(v0); w8.y = pack4_fp8(v1); *(u32x2*)(f8p + (size_t)row * 2048 + col0 + bj * HALF) = w8; }
                    if (isvb) { const int kk = row & 63; const unsigned w0 = pack4_fp8(v0), w1 = pack4_fp8(v1);
                        unsigned char* vp = vb8 + ((size_t)((2 * (pn - 22) + bj) * 256 + (row >> 6)) * 128 + (wc * 32 + 8 * fq)) * 64 + (((kk >> 2) & 1) * 32 + (kk >> 5) * 16 + ((kk >> 3) & 3) * 4 + (kk & 3));
                        vp[0] = (unsigned char)w0; vp[64] = (unsigned char)(w0 >> 8); vp[128] = (unsigned char)(w0 >> 16); vp[192] = (unsigned char)(w0 >> 24);
                        vp[256] = (unsigned char)w1; vp[320] = (unsigned char)(w1 >> 8); vp[384] = (unsigned char)(w1 >> 16); vp[448] = (unsigned char)(w1 >> 24); }
                    if (!isvb || MLA_BF16) *(u32x4*)(rowp + bj * HALF) = pack8f(v0, v1); }
                if (part) { ss += __shfl_xor(ss, 16); ss += __shfl_xor(ss, 32); if (fq == 0) part[(size_t)row * pstride] = ss; } }
        if (iskb) {
#pragma unroll
            for (int bj = 0; bj < 2; ++bj)
#pragma unroll
                for (int n = 0; n < 2; ++n)
#pragma unroll
                    for (int e2 = 0; e2 < 4; ++e2) { float c = cs[bj][n][e2];
                        c += __shfl_xor(c, 1); c += __shfl_xor(c, 2); c += __shfl_xor(c, 4); c += __shfl_xor(c, 8);
                        if (fr == 0) atomicAdd(kmean + (size_t)((2 * (pn - 14) + bj) * 64 + u.pm) * 128 + wc * 32 + 8 * fq + 4 * n + e2, c * (1.f / 256.f)); }
        }
    }
};
struct EpiQ {
    static constexpr bool PERM = true, AFTER_DRAIN = false; __device__ __forceinline__ bool idem() const { return true; }
    bf16_t* Q; const float* cosT; const float* sinT; const float* partq; unsigned char* Q8;
    __device__ __forceinline__ float rstd_of(int row) const { const f32x4* p = (const f32x4*)(partq + (size_t)row * 16); const f32x4 a = p[0], b = p[1], c = p[2], d = p[3];
        const float s = ((a[0] + a[1]) + (a[2] + a[3])) + ((b[0] + b[1]) + (b[2] + b[3])) + ((c[0] + c[1]) + (c[2] + c[3])) + ((d[0] + d[1]) + (d[2] + d[3])); return 1.0f / sqrtf(s * (1.f / 1024.f) + 1e-6f); }
    __device__ __forceinline__ void operator()(const f32x4 (&acc)[2][2][4][2], const Unit& u, int wr, int wc, int fr, int fq) const {
        const int row0 = u.pm * BM + wr * 64 + fr;
        float rsv[2][4];
#pragma unroll
        for (int ai = 0; ai < 2; ++ai)
#pragma unroll
            for (int m = 0; m < 4; ++m) rsv[ai][m] = rstd_of(row0 + ai * HALF + m * 16);
#pragma unroll
        for (int bj = 0; bj < 2; ++bj) {
            const int cw = u.pn * BM + bj * HALF + wc * 32;
            const int hc = cw % 192, hb = cw - hc;
            if (hc < 128) {
#pragma unroll
                for (int ai = 0; ai < 2; ++ai)
#pragma unroll
                    for (int m = 0; m < 4; ++m) { const int row = row0 + ai * HALF + m * 16; const float sc = rsv[ai][m];
                        const f32x4 q0 = acc[ai][bj][m][0] * sc, q1 = acc[ai][bj][m][1] * sc;
                        if (Q) *(u32x4*)(Q + (size_t)row * 3072 + cw + 8 * fq) = pack8f(q0, q1);
                        u32x2 w8; w8.x = pack4_fp8(q0); w8.y = pack4_fp8(q1); *(u32x2*)(Q8 + (size_t)row * 3072 + cw + 8 * fq) = w8; }
            } else {
                const int g = ((hc - 128) >> 3) + fq;
#pragma unroll
                for (int ai = 0; ai < 2; ++ai)
#pragma unroll
                    for (int m = 0; m < 4; ++m) { const int row = row0 + ai * HALF + m * 16;
                        const f32x4 c = *(const f32x4*)(cosT + (size_t)row * 32 + 4 * g), s = *(const f32x4*)(sinT + (size_t)row * 32 + 4 * g);
                        const float sc = rsv[ai][m];
                        const f32x4 x1 = acc[ai][bj][m][0] * sc, x2 = acc[ai][bj][m][1] * sc;
                        const f32x4 o1 = x1 * c - x2 * s, o2 = x2 * c + x1 * s;
                        if (Q) { u32x2 w1, w2; w1.x = cvt_pk_bf16(o1[0], o1[1]); w1.y = cvt_pk_bf16(o1[2], o1[3]); w2.x = cvt_pk_bf16(o2[0], o2[1]); w2.y = cvt_pk_bf16(o2[2], o2[3]);
                            bf16_t* qp = Q + (size_t)row * 3072 + hb + 128 + 4 * g;
                            *(u32x2*)qp = w1; *(u32x2*)(qp + 32) = w2; }
                        unsigned char* q8p = Q8 + (size_t)row * 3072 + hb + 128 + 4 * g; *(unsigned*)q8p = pack4_fp8(o1); *(unsigned*)(q8p + 32) = pack4_fp8(o2); }
            }
        }
    }
};
template <bool ADD> struct EpiMerge {
    static constexpr bool PERM = true, AFTER_DRAIN = false; const bf16_t* gate; bf16_t* T; unsigned char* O8; float post;
    __device__ __forceinline__ void operator()(const f32x4 (&acc)[2][2][4][2], const Unit& u, int wr, int wc, int fr, int fq) const {
        const int row0 = u.pm * BM + wr * 64 + fr, col0 = u.pn * BM + wc * 32 + 8 * fq;
#pragma unroll
        for (int ai = 0; ai < 2; ++ai)
#pragma unroll
            for (int m = 0; m < 4; ++m) { const int row = row0 + ai * HALF + m * 16; const size_t off = (size_t)row * 4096 + col0;
#pragma unroll
                for (int bj = 0; bj < 2; ++bj) { const u32x4 gw = *(const u32x4*)(gate + off + bj * HALF);
                    f32x4 v0 = acc[ai][bj][m][0] * post, v1 = acc[ai][bj][m][1] * post;
                    v0[0] *= bf_lo(gw.x); v0[1] *= bf_hi(gw.x); v0[2] *= bf_lo(gw.y); v0[3] *= bf_hi(gw.y);
                    v1[0] *= bf_lo(gw.z); v1[1] *= bf_hi(gw.z); v1[2] *= bf_lo(gw.w); v1[3] *= bf_hi(gw.w);
                    if (ADD) { const u32x4 pw = *(const u32x4*)(T + off + bj * HALF);
                        v0[0] += bf_lo(pw.x); v0[1] += bf_hi(pw.x); v0[2] += bf_lo(pw.y); v0[3] += bf_hi(pw.y);
                        v1[0] += bf_lo(pw.z); v1[1] += bf_hi(pw.z); v1[2] += bf_lo(pw.w); v1[3] += bf_hi(pw.w);
                        if (O8) { const int col = col0 + bj * HALF; u32x2 q; q.x = pack4_fp8(v0 * 16.f); q.y = pack4_fp8(v1 * 16.f);
                            *(u32x2*)(O8 + ((size_t)(col >> 7) * 16384 + row) * 128 + (col & 127)) = q; }
                        else *(u32x4*)(T + off + bj * HALF) = pack8f(v0, v1); }
                    else *(u32x4*)(T + off + bj * HALF) = pack8f(v0, v1); } }
    }
};
template <class Epi, class Sched, bool ALIGN_EPI = false, bool SP2 = false, bool TILED = false, bool FP8 = false, bool I8 = false>
__device__ __forceinline__ void gemm_phase(PG8_LAS unsigned char* lds, const Gemm g, const Sched S, const Epi E, int wv) {
    int tid_ = wv * 64 + lane_id_(); asm volatile("" : "+v"(tid_)); const int tid = tid_, wid = wv, lane = tid & 63, wr = wid >> 2, wc = wid & 3, fr = lane & 15, fq = lane >> 4;
    const int K = g.K, nt = K / BK;
    unsigned voffA[2], voffB[2];
#pragma unroll
    for (int i = 0; i < 2; ++i) { int R, C; stage_rc(tid * 16 + i * 8192, R, C); const int Rb = Epi::PERM ? ((R & ~31) + perm32(R & 31)) : R;
        voffA[i] = (unsigned)(R * (TILED ? BK : K) + C) * 2u; voffB[i] = (unsigned)(Rb * (TILED ? BK : K) + C) * 2u; }
    const size_t kstepA = TILED ? (size_t)g.M * BK * 2 : (size_t)(BK * 2), kstepB = TILED ? (size_t)g.N * BK * 2 : (size_t)(BK * 2);
    const size_t hstep = TILED ? (size_t)HALF * BK * 2 : (size_t)HALF * K * 2;
    const size_t tstep = 2 * hstep;
    const unsigned ldsw = (unsigned)wid * 1024u;
    const int aoff = lds_byte(wr * 64 + fr, fq * 8), boff = lds_byte(wc * 32 + fr, fq * 8);
#define PG8_SA(b, h) (((b) * 2 + (h)) * HTB)
#define PG8_SB(b, h) ((4 + (b) * 2 + (h)) * HTB)
#define PG8_STAGE(bufoff, gbase, voff) do { _Pragma("unroll") for (int _i = 0; _i < 2; ++_i) \
        __builtin_amdgcn_global_load_lds((const unsigned*)((const char*)(gbase) + (voff)[_i]), (PG8_LAS unsigned*)(lds + (bufoff) + ldsw + _i * 8192), 16, 0, 0); } while (0)
#define PG8_LDA(dst, b, h) do { _Pragma("unroll") for (int m = 0; m < 4; ++m) { if constexpr (FP8) { \
            dst##8[m].lo = *(const PG8_LAS v4i_t*)(lds + PG8_SA(b, h) + aoff + m * 2048); dst##8[m].hi = *(const PG8_LAS v4i_t*)(lds + PG8_SA(b, h) + aoff + m * 2048 + 1024); } \
        else { _Pragma("unroll") for (int k = 0; k < 2; ++k) dst[m][k] = *(const PG8_LAS bf16x8*)(lds + PG8_SA(b, h) + aoff + m * 2048 + k * 1024); } } } while (0)
#define PG8_LDB(dst, b, h) do { _Pragma("unroll") for (int n = 0; n < 2; ++n) { if constexpr (FP8) { \
            dst##8[n].lo = *(const PG8_LAS v4i_t*)(lds + PG8_SB(b, h) + boff + n * 2048); dst##8[n].hi = *(const PG8_LAS v4i_t*)(lds + PG8_SB(b, h) + boff + n * 2048 + 1024); } \
        else { _Pragma("unroll") for (int k = 0; k < 2; ++k) dst[n][k] = *(const PG8_LAS bf16x8*)(lds + PG8_SB(b, h) + boff + n * 2048 + k * 1024); } } } while (0)
#define PG8_MMA(ai, bj, At, Bt) do { __builtin_amdgcn_s_setprio(1); \
        if constexpr (I8) {   \
            _Pragma("unroll") for (int k = 0; k < 2; ++k) _Pragma("unroll") for (int m = 0; m < 4; ++m) _Pragma("unroll") for (int n = 0; n < 2; ++n) \
                acc[ai][bj][m][n] = __builtin_bit_cast(f32x4, __builtin_amdgcn_mfma_i32_16x16x64_i8(__builtin_bit_cast(v4i_t, Bt[n][k]), __builtin_bit_cast(v4i_t, At[m][k]), __builtin_bit_cast(v4i_t, acc[ai][bj][m][n]), 0, 0, 0)); } \
        else { _Pragma("unroll") for (int m = 0; m < 4; ++m) _Pragma("unroll") for (int n = 0; n < 2; ++n) { \
            if constexpr (FP8) asm volatile("v_mfma_scale_f32_16x16x128_f8f6f4 %0, %1, %2, %0, %3, %3 op_sel_hi:[0,0,0]" : "+v"(acc[ai][bj][m][n]) : "v"(Bt##8[n]), "v"(At##8[m]), "v"(f8scale));   \
            else { _Pragma("unroll") for (int k = 0; k < 2; ++k) acc[ai][bj][m][n] = __builtin_amdgcn_mfma_f32_16x16x32_bf16(Bt[n][k], At[m][k], acc[ai][bj][m][n], 0, 0, 0); } } } \
        __builtin_amdgcn_s_setprio(0); } while (0)
#define PG8_WAIT_V(n) asm volatile("s_waitcnt vmcnt(" #n ")" ::: "memory")
#define PG8_WAIT_L(n) asm volatile("s_waitcnt lgkmcnt(" #n ")" ::: "memory")
#define PG8_BAR __builtin_amdgcn_s_barrier()
#define PG8_SCHED __builtin_amdgcn_sched_barrier(0)
    Unit cur, nxt; int ui = 0;
    if (!S.next(0, cur)) return;
    f32x4 acc[2][2][4][2];
#pragma unroll
    for (int a = 0; a < 2; ++a)
#pragma unroll
        for (int b = 0; b < 2; ++b)
#pragma unroll
            for (int m = 0; m < 4; ++m)
#pragma unroll
                for (int n = 0; n < 2; ++n) acc[a][b][m][n] = (f32x4){0.f, 0.f, 0.f, 0.f};
    typedef int v8i_t __attribute__((ext_vector_type(8))); typedef int v4i_t __attribute__((ext_vector_type(4)));
    int f8scale = 0x7f7f7f7f; asm volatile("" : "+v"(f8scale));
    bf16x8 At[4][2], B0[2][2], B1[2][2]; v8i_t At8[4], B08[2], B18[2];
    const char* cA = (const char*)g.A + (size_t)cur.pm * tstep; const char* cB = (const char*)g.Bt + (size_t)cur.pn * tstep;
    S.a_ready(cur);
    if constexpr (SP2) {
        PG8_STAGE(PG8_SB(0, 0), cB, voffB); PG8_STAGE(PG8_SB(0, 1), cB + hstep, voffB); PG8_STAGE(PG8_SA(0, 0), cA, voffA); PG8_STAGE(PG8_SA(0, 1), cA + hstep, voffA);
        if (wr == 1) PG8_BAR;
        PG8_WAIT_V(2); PG8_BAR;
        PG8_STAGE(PG8_SB(1, 0), cB + kstepB, voffB); PG8_STAGE(PG8_SA(1, 0), cA + kstepA, voffA); PG8_STAGE(PG8_SB(1, 1), cB + hstep + kstepB, voffB);
        PG8_WAIT_V(6); PG8_BAR;
    } else {
        PG8_STAGE(PG8_SB(0, 0), cB, voffB); PG8_STAGE(PG8_SA(0, 0), cA, voffA); PG8_STAGE(PG8_SB(0, 1), cB + hstep, voffB); PG8_STAGE(PG8_SA(0, 1), cA + hstep, voffA);
        if (wr == 1) PG8_BAR;
        PG8_WAIT_V(4); PG8_BAR;
        PG8_STAGE(PG8_SB(1, 0), cB + kstepB, voffB); PG8_STAGE(PG8_SA(1, 0), cA + kstepA, voffA); PG8_STAGE(PG8_SB(1, 1), cB + hstep + kstepB, voffB);
        PG8_WAIT_V(6); PG8_BAR;
    }
    for (;;) {
        const bool has_next = S.next(ui + 1, nxt);
        const char* nA = has_next ? (const char*)g.A + (size_t)nxt.pm * tstep : cA; const char* nB = has_next ? (const char*)g.Bt + (size_t)nxt.pn * tstep : cB;
        for (int t = 0; t < nt; t += 2) {
            const bool last = (t == nt - 2);
            const char* a1 = cA + (size_t)(t + 1) * kstepA;
            const char* a2 = last ? nA : cA + (size_t)(t + 2) * kstepA; const char* b2 = last ? nB : cB + (size_t)(t + 2) * kstepB;
            const char* a3 = a2 + kstepA; const char* b3 = b2 + kstepB;
            if (last && has_next) S.a_ready(nxt);
            if constexpr (SP2) {
            PG8_LDB(B0, 0, 0); PG8_LDB(B1, 0, 1); PG8_SCHED; PG8_LDA(At, 0, 0); PG8_STAGE(PG8_SA(1, 1), a1 + hstep, voffA);
            PG8_WAIT_V(8); PG8_WAIT_L(0); PG8_BAR; PG8_MMA(0, 0, At, B0); PG8_MMA(0, 1, At, B1); PG8_BAR; PG8_SCHED;
            PG8_LDA(At, 0, 1); PG8_STAGE(PG8_SB(0, 0), b2, voffB); PG8_STAGE(PG8_SB(0, 1), b2 + hstep, voffB); PG8_STAGE(PG8_SA(0, 0), a2, voffA);
            PG8_WAIT_V(8); PG8_WAIT_L(0); PG8_BAR; PG8_MMA(1, 0, At, B0); PG8_MMA(1, 1, At, B1); PG8_BAR; PG8_SCHED;
            PG8_LDB(B0, 1, 0); PG8_LDB(B1, 1, 1); PG8_SCHED; PG8_LDA(At, 1, 0); PG8_STAGE(PG8_SA(0, 1), a2 + hstep, voffA);
            PG8_WAIT_V(8); PG8_WAIT_L(0); PG8_BAR; PG8_MMA(0, 0, At, B0); PG8_MMA(0, 1, At, B1); PG8_BAR; PG8_SCHED;
            PG8_LDA(At, 1, 1); PG8_STAGE(PG8_SB(1, 0), b3, voffB); PG8_STAGE(PG8_SB(1, 1), b3 + hstep, voffB); PG8_STAGE(PG8_SA(1, 0), a3, voffA);
            PG8_WAIT_V(8); PG8_WAIT_L(0); PG8_BAR; PG8_MMA(1, 0, At, B0); PG8_MMA(1, 1, At, B1); PG8_BAR; PG8_SCHED;
            } else {
            PG8_LDB(B0, 0, 0); PG8_SCHED; PG8_LDA(At, 0, 0); PG8_STAGE(PG8_SA(1, 1), a1 + hstep, voffA);
            PG8_WAIT_L(8); PG8_BAR; PG8_WAIT_L(0); PG8_MMA(0, 0, At, B0); PG8_BAR; PG8_SCHED;
            PG8_LDB(B1, 0, 1); PG8_STAGE(PG8_SB(0, 0), b2, voffB);
            PG8_BAR; PG8_WAIT_L(0); PG8_MMA(0, 1, At, B1); PG8_BAR;
            PG8_LDA(At, 0, 1); PG8_STAGE(PG8_SA(0, 0), a2, voffA);
            PG8_BAR; PG8_WAIT_L(0); PG8_MMA(1, 0, At, B0); PG8_BAR; PG8_SCHED;
            PG8_STAGE(PG8_SB(0, 1), b2 + hstep, voffB);
            PG8_WAIT_V(6); PG8_BAR; PG8_MMA(1, 1, At, B1); PG8_BAR;
            PG8_LDB(B0, 1, 0); PG8_SCHED; PG8_LDA(At, 1, 0); PG8_STAGE(PG8_SA(0, 1), a2 + hstep, voffA);
            PG8_WAIT_L(8); PG8_BAR; PG8_WAIT_L(0); PG8_MMA(0, 0, At, B0); PG8_BAR; PG8_SCHED;
            PG8_LDB(B1, 1, 1); PG8_STAGE(PG8_SB(1, 0), b3, voffB);
            PG8_BAR; PG8_WAIT_L(0); PG8_MMA(0, 1, At, B1); PG8_BAR;
            PG8_LDA(At, 1, 1); PG8_STAGE(PG8_SA(1, 0), a3, voffA);
            PG8_BAR; PG8_WAIT_L(0); PG8_MMA(1, 0, At, B0); PG8_BAR; PG8_SCHED;
            PG8_STAGE(PG8_SB(1, 1), b3 + hstep, voffB);
            PG8_WAIT_V(6); PG8_BAR; PG8_MMA(1, 1, At, B1); PG8_BAR;
            }
        }
        if constexpr (FP8 || I8) asm volatile("s_nop 15\n\ts_nop 7" ::: "memory");
        if constexpr (ALIGN_EPI) { if (wr == 0) PG8_BAR; }
        if constexpr (!Epi::AFTER_DRAIN) { int fr_e = fr, fq_e = fq; asm volatile("" : "+v"(fr_e), "+v"(fq_e));
            E(acc, cur, wr, wc, fr_e, fq_e); S.done(cur); }
        if (!has_next) break;
#pragma unroll
        for (int a = 0; a < 2; ++a)
#pragma unroll
            for (int b = 0; b < 2; ++b)
#pragma unroll
                for (int m = 0; m < 4; ++m)
#pragma unroll
                    for (int n = 0; n < 2; ++n) acc[a][b][m][n] = (f32x4){0.f, 0.f, 0.f, 0.f};
        cur = nxt; cA = nA; cB = nB; ++ui;
        if constexpr (ALIGN_EPI) { if (wr == 1) PG8_BAR; }
    }
    PG8_WAIT_V(0);
    if constexpr (!ALIGN_EPI) { if (wr == 0) PG8_BAR; }
    PG8_BAR;
    if constexpr (Epi::AFTER_DRAIN) { E.fused(acc, cur, wr, wc, fr, fq, lds, wid, lane); S.done(cur); }
#undef PG8_SA
#undef PG8_SB
#undef PG8_STAGE
#undef PG8_LDA
#undef PG8_LDB
#undef PG8_MMA
#undef PG8_WAIT_V
#undef PG8_WAIT_L
#undef PG8_BAR
#undef PG8_SCHED
}
}
namespace att {
typedef unsigned short bf16_t;
typedef short bf16x8 __attribute__((ext_vector_type(8)));
typedef short s16x4 __attribute__((ext_vector_type(4)));
typedef float f32x16 __attribute__((ext_vector_type(16)));
typedef float f32x4 __attribute__((ext_vector_type(4)));
typedef unsigned u32x4 __attribute__((ext_vector_type(4)));
typedef int i32x4 __attribute__((ext_vector_type(4)));
#define ASBAR() __builtin_amdgcn_sched_barrier(0)
constexpr int VT_BYTES = 16384;
constexpr int L_V = 0, L_K = 2 * VT_BYTES;
constexpr int KT_MAX = 64 * 192 * 2;
constexpr int L_WS = L_K + 2 * KT_MAX;
constexpr int L_BIAS = L_WS + 8 * 128 * 4;
constexpr int L_PREF = L_BIAS + 16 * 132 * 4;
constexpr int L_CNT = L_PREF + 1040 * 4 + 64;
constexpr int L_END = L_CNT + 1024 * 4;
constexpr float LOG2E = 1.4426950408889634f;
constexpr float THR2 = 6.0f;

__device__ __forceinline__ int v_st(int k, int c) { const int kk = (k & ~0xC) | ((k & 4) << 1) | ((k & 8) >> 1); return ((kk >> 3) * 4 + (c >> 5)) * 512 + ((kk & 7) * 32 + (c & 31)) * 2; }
__device__ __forceinline__ int v_rd_base(int lane) { return ((lane & 3) << 3) | (((lane >> 2) & 3) << 6) | (((lane >> 4) & 1) << 5) | (((lane >> 5) & 1) << 8); }
constexpr int v_rd_off(int d0, int ks, int half) { return d0 * 512 + ks * 4096 + half * 2048; }
__device__ __forceinline__ int crow(int r, int hi) { return (r & 3) + 8 * (r >> 2) + 4 * hi; }
__device__ __forceinline__ unsigned cvtpk(float lo, float hi) { unsigned r; asm volatile("v_cvt_pk_bf16_f32 %0, %1, %2" : "=v"(r) : "v"(lo), "v"(hi)); return r; }
__device__ __forceinline__ bf16x8 ld8(const bf16_t* p) { return *reinterpret_cast<const bf16x8*>(p); }
template <int DQK> __device__ __forceinline__ int kswz(int row, int chunk) {
    if constexpr (DQK == 128) return row * 256 + ((chunk ^ (row & 7)) << 4);
    else return row * 384 + (((chunk & ~7) | ((chunk ^ (row >> 1)) & 7)) << 4);
}
__device__ __forceinline__ void mask_tile(f32x16& p0, f32x16& p1, int dq) {
    const float NEG = -__builtin_inff();
#pragma unroll
    for (int r = 0; r < 16; ++r) { const int c = (r & 3) + 8 * (r >> 2); if (dq - c < 0) p0[r] = NEG; if (dq - c - 32 < 0) p1[r] = NEG; }
}
template <bool RAW>
__device__ __forceinline__ void partialSM(f32x16& p0, f32x16& p1, float& m_reg, float& alpha, float sc) {
    float pmax = p0[0];
#pragma unroll
    for (int r = 1; r < 16; ++r) pmax = fmaxf(pmax, p0[r]);
#pragma unroll
    for (int r = 0; r < 16; ++r) pmax = fmaxf(pmax, p1[r]);
    { auto rr = __builtin_amdgcn_permlane32_swap(__float_as_uint(pmax), __float_as_uint(pmax), false, false);
      pmax = fmaxf(__uint_as_float(rr[0]), __uint_as_float(rr[1])); }
    if (RAW) pmax *= sc;
    const bool need = pmax - m_reg > THR2;
    const float mn = need ? pmax : m_reg;
    alpha = need ? __builtin_amdgcn_exp2f(m_reg - mn) : 1.f; m_reg = mn;
    if (RAW) {
#pragma unroll
        for (int r = 0; r < 16; ++r) p0[r] = __builtin_amdgcn_exp2f(fmaf(p0[r], sc, -mn));
#pragma unroll
        for (int r = 0; r < 16; ++r) p1[r] = fmaf(p1[r], sc, -mn);
    } else {
#pragma unroll
        for (int r = 0; r < 16; ++r) p0[r] = __builtin_amdgcn_exp2f(p0[r] - mn);
#pragma unroll
        for (int r = 0; r < 16; ++r) p1[r] = p1[r] - mn;
    }
}
__device__ __forceinline__ void finishSM_e(f32x16& p1) {
#pragma unroll
    for (int r = 0; r < 16; ++r) p1[r] = __builtin_amdgcn_exp2f(p1[r]);
}
__device__ __forceinline__ void finishSM_a(f32x16& p0, f32x16& p1, float alpha, float& l_reg) {
#pragma unroll
    for (int r = 0; r < 16; ++r) p1[r] = __builtin_amdgcn_exp2f(p1[r]);
    float ps = 0;
#pragma unroll
    for (int r = 0; r < 16; ++r) ps += p0[r];
#pragma unroll
    for (int r = 0; r < 16; ++r) ps += p1[r];
    { auto rr = __builtin_amdgcn_permlane32_swap(__float_as_uint(ps), __float_as_uint(ps), false, false);
      ps = __uint_as_float(rr[0]) + __uint_as_float(rr[1]); }
    l_reg = l_reg * alpha + ps;
}
#define PK4(P, B_, OUT) do { unsigned a0 = cvtpk(P[B_+0], P[B_+1]), a1 = cvtpk(P[B_+2], P[B_+3]);                          \
        unsigned b0 = cvtpk(P[B_+4], P[B_+5]), b1 = cvtpk(P[B_+6], P[B_+7]);                                             \
        auto r0 = __builtin_amdgcn_permlane32_swap(a0, b0, false, false); auto r1 = __builtin_amdgcn_permlane32_swap(a1, b1, false, false); \
        u32x4 w = {r0[0], r1[0], r0[1], r1[1]}; OUT = *reinterpret_cast<bf16x8*>(&w); } while (0)
template <int DQK>
__device__ __forceinline__ void qkt(f32x16& p0, f32x16& p1, const char* kbuf, int r32, int hi, const bf16x8* qr) {
    p0 = f32x16{}; p1 = f32x16{};
    const char* kb[4];
    constexpr int RP = DQK * 2;
#pragma unroll
    for (int dd = 0; dd < 4; ++dd) kb[dd] = kbuf + kswz<DQK>(r32, 2 * dd + hi);
#pragma unroll
    for (int d0 = 0; d0 < DQK / 16; ++d0) { const char* a = kb[d0 & 3] + (d0 >> 2) * 128;
        bf16x8 b0 = *reinterpret_cast<const bf16x8*>(a);
        bf16x8 b1 = *reinterpret_cast<const bf16x8*>(a + 32 * RP);
        __builtin_amdgcn_s_setprio(1);
        p0 = __builtin_amdgcn_mfma_f32_32x32x16_bf16(b0, qr[d0], p0, 0, 0, 0);
        p1 = __builtin_amdgcn_mfma_f32_32x32x16_bf16(b1, qr[d0], p1, 0, 0, 0);
        __builtin_amdgcn_s_setprio(0); }
}
template <int VBOFF>
__device__ __forceinline__ void pv_tile(f32x16* o, int vb0, bf16x8 pa0, bf16x8 pa1, bf16x8 pa2, bf16x8 pa3) {
#define TRRD(dst, off) asm volatile("ds_read_b64_tr_b16 %0, %1 offset:%2" : "=&v"(dst) : "v"(vb0), "i"(off) : "memory")
#define PV_D0(d0) do { s16x4 l0, l1, l2, l3, h0, h1, h2, h3; constexpr int b_ = VBOFF + v_rd_off(d0, 0, 0); \
        TRRD(l0, b_); TRRD(h0, b_ + 2048); TRRD(l1, b_ + 4096); TRRD(h1, b_ + 6144); TRRD(l2, b_ + 8192); TRRD(h2, b_ + 10240); TRRD(l3, b_ + 12288); TRRD(h3, b_ + 14336); \
        asm volatile("s_waitcnt lgkmcnt(0)" ::: "memory"); ASBAR();   \
        o[d0] = __builtin_amdgcn_mfma_f32_32x32x16_bf16(pa0, (bf16x8){l0[0], l0[1], l0[2], l0[3], h0[0], h0[1], h0[2], h0[3]}, o[d0], 0, 0, 0);   \
        o[d0] = __builtin_amdgcn_mfma_f32_32x32x16_bf16(pa1, (bf16x8){l1[0], l1[1], l1[2], l1[3], h1[0], h1[1], h1[2], h1[3]}, o[d0], 0, 0, 0);   \
        o[d0] = __builtin_amdgcn_mfma_f32_32x32x16_bf16(pa2, (bf16x8){l2[0], l2[1], l2[2], l2[3], h2[0], h2[1], h2[2], h2[3]}, o[d0], 0, 0, 0);   \
        o[d0] = __builtin_amdgcn_mfma_f32_32x32x16_bf16(pa3, (bf16x8){l3[0], l3[1], l3[2], l3[3], h3[0], h3[1], h3[2], h3[3]}, o[d0], 0, 0, 0); } while (0)
    PV_D0(0); PV_D0(1); PV_D0(2); PV_D0(3);
#undef PV_D0
#undef TRRD
}

typedef __attribute__((address_space(3))) const char* lds_cptr;
typedef short v4i16_t __attribute__((ext_vector_type(4)));
__device__ __forceinline__ s16x4 vtr(lds_cptr p) { return __builtin_bit_cast(s16x4, __builtin_amdgcn_ds_read_tr16_b64_v4i16((__attribute__((address_space(3))) v4i16_t*)p)); }
#define VRD(S, vp, d0) do { _Pragma("unroll") for (int ks_ = 0; ks_ < 4; ++ks_) { S[2 * ks_] = vtr((vp) + (d0) * 512 + ks_ * 4096); S[2 * ks_ + 1] = vtr((vp) + (d0) * 512 + ks_ * 4096 + 2048); } } while (0)
#define VFR(S, k) (bf16x8){S[2 * (k)][0], S[2 * (k)][1], S[2 * (k)][2], S[2 * (k)][3], S[2 * (k) + 1][0], S[2 * (k) + 1][1], S[2 * (k) + 1][2], S[2 * (k) + 1][3]}
#define PVMMA(S, d0) do { __builtin_amdgcn_s_setprio(1); o[d0] = __builtin_amdgcn_mfma_f32_32x32x16_bf16(pa0, VFR(S, 0), o[d0], 0, 0, 0); o[d0] = __builtin_amdgcn_mfma_f32_32x32x16_bf16(pa1, VFR(S, 1), o[d0], 0, 0, 0); \
        o[d0] = __builtin_amdgcn_mfma_f32_32x32x16_bf16(pa2, VFR(S, 2), o[d0], 0, 0, 0); o[d0] = __builtin_amdgcn_mfma_f32_32x32x16_bf16(pa3, VFR(S, 3), o[d0], 0, 0, 0); __builtin_amdgcn_s_setprio(0); } while (0)

typedef int v8i_t __attribute__((ext_vector_type(8))); typedef int v4i_t __attribute__((ext_vector_type(4)));
__device__ __forceinline__ unsigned pk4f8(float a, float b, float c, float d) { int w = 0; w = __builtin_amdgcn_cvt_pk_fp8_f32(a, b, w, false); w = __builtin_amdgcn_cvt_pk_fp8_f32(c, d, w, true); return (unsigned)w; }
template <int DQK> __device__ __forceinline__ int k8swz(int row, int chunk) {
    if constexpr (DQK == 192) return row * 256 + ((chunk ^ (row & 15)) << 4);
    else return row * 128 + ((chunk ^ ((row >> 1) & 7)) << 4);
}
template <int DQK>
__device__ __forceinline__ void qkt8(f32x16& p0, f32x16& p1, const char* kbuf, int r32, int hi, const v8i_t* q8, int f8scale) {
    p0 = f32x16{}; p1 = f32x16{};
    constexpr int NS = DQK / 64, H32 = 32 * (DQK == 192 ? 256 : 128);
    v8i_t a0[NS], a1[NS];
#define K8LD(s_) do { const int c0 = 4 * (s_) + 2 * hi;                                                                          \
        const lds_cptr k0_ = (lds_cptr)kbuf + k8swz<DQK>(r32, c0), k1_ = (lds_cptr)kbuf + k8swz<DQK>(r32, c0 + 1);             \
        a0[s_].lo = *(const __attribute__((address_space(3))) v4i_t*)k0_; a0[s_].hi = *(const __attribute__((address_space(3))) v4i_t*)k1_;            \
        a1[s_].lo = *(const __attribute__((address_space(3))) v4i_t*)(k0_ + H32); a1[s_].hi = *(const __attribute__((address_space(3))) v4i_t*)(k1_ + H32); } while (0)
    K8LD(0); K8LD(1);
#pragma unroll
    for (int s_ = 0; s_ < NS; ++s_) {
        __builtin_amdgcn_s_setprio(1);
        asm volatile("v_mfma_scale_f32_32x32x64_f8f6f4 %0, %1, %2, %0, %3, %3 op_sel_hi:[0,0,0]" : "+v"(p0) : "v"(a0[s_]), "v"(q8[s_]), "v"(f8scale));
        asm volatile("v_mfma_scale_f32_32x32x64_f8f6f4 %0, %1, %2, %0, %3, %3 op_sel_hi:[0,0,0]" : "+v"(p1) : "v"(a1[s_]), "v"(q8[s_]), "v"(f8scale));
        __builtin_amdgcn_s_setprio(0);
        if (s_ == 0 && NS == 3) { ASBAR(); K8LD(2); } }
#undef K8LD
    asm volatile("s_nop 15\n\ts_nop 7" : "+v"(p0), "+v"(p1));
}
struct UnitArgs {
    const bf16_t* Q; int qpitch;
    const bf16_t* K; int kpitch;
    const bf16_t* Kr;
    const unsigned char* Q8; const unsigned char* K8; const unsigned char* Kr8; const unsigned char* V8;
    const bf16_t* V; int vpitch;
    bf16_t* O; int opitch;
    bf16_t* PO; float* PML;
    const int* pos; const int* tpmax;
    const unsigned* list; int nrows;
    int q0, k0, NT, h;
    float c2;
};
template <int DQK, int MODE>
__device__ __forceinline__ void attn_unit(const UnitArgs& A, char* lds, int wv) {
    int tid_ = wv * 64 + lane_id_(); asm volatile("" : "+v"(tid_)); const int tid = tid_, wid = wv, lane = tid & 63, r32 = lane & 31, hi = lane >> 5;
    constexpr bool F8 = true;
    constexpr int KT = F8 ? (DQK == 192 ? 16384 : 8192) : 64 * DQK * 2; constexpr int Q8P = DQK == 192 ? 3072 : 2048;
    char* V_lds = lds + L_V; char* K_lds = lds + L_K;
    float* ws = (float*)(lds + L_WS) + wid * 128; float* li_l = ws; float* al_l = ws + 32; int* ix_l = (int*)(ws + 64);
    const float* biasL = (const float*)(lds + L_BIAS) + A.h * 132;
    const int sr = tid >> 4, sc = (tid & 15) * 8, vst0 = v_st(sr, sc), vst1 = v_st(32 + sr, sc);
    const int kws0 = kswz<DQK>(sr, tid & 15), kws1 = kswz<DQK>(32 + sr, tid & 15);
    const int kws2 = (DQK == 192) ? kswz<DQK>(tid >> 3, 16 + (tid & 7)) : 0;
    const int k8w0 = k8swz<DQK>(tid >> 3, tid & 7), k8w2 = DQK == 192 ? k8swz<DQK>(tid >> 2, 8 + (tid & 3)) : 0;
    const int vb0 = (int)(uintptr_t)V_lds + v_rd_base(lane); (void)vb0;
    const int v8w = (tid >> 2) * 64 + (((tid & 3) ^ ((tid >> 4) & 3)) << 4), v8r = r32 * 64 + (((2 * hi) ^ ((r32 >> 2) & 3)) << 4);
    const lds_cptr vp0 = (lds_cptr)V_lds + v_rd_base(lane);
    bf16x8 st_k0, st_k1, st_k2, st_v0, st_v1;
#define SLOAD(t) do { const size_t kk_ = (size_t)(A.k0 + (t) * 64);                                                         \
        if constexpr (F8) st_v0 = ld8((const bf16_t*)(A.V8 + (kk_ >> 6) * 8192 + tid * 16));                             \
        else { st_v0 = ld8(A.V + (kk_ + sr) * A.vpitch + sc); st_v1 = ld8(A.V + (kk_ + 32 + sr) * A.vpitch + sc); }    \
        if constexpr (F8) { st_k0 = ld8((const bf16_t*)(A.K8 + (kk_ + (tid >> 3)) * 2048 + (tid & 7) * 16));             \
            if constexpr (DQK == 192) if (wid < 4) st_k2 = ld8((const bf16_t*)(A.Kr8 + (kk_ + (tid >> 2)) * 64 + (tid & 3) * 16)); }   \
        else { st_k0 = ld8(A.K + (kk_ + sr) * A.kpitch + sc); st_k1 = ld8(A.K + (kk_ + 32 + sr) * A.kpitch + sc);       \
            if constexpr (DQK == 192) st_k2 = ld8(A.Kr + (kk_ + (tid >> 3)) * 64 + (tid & 7) * 8); } } while (0)
#define SWRITE(bf) do { if constexpr (F8) *(bf16x8*)(V_lds + (bf) * VT_BYTES + v8w) = st_v0;                                  \
        else { *(bf16x8*)(V_lds + (bf) * VT_BYTES + vst0) = st_v0; *(bf16x8*)(V_lds + (bf) * VT_BYTES + vst1) = st_v1; } \
        if constexpr (F8) { *(bf16x8*)(K_lds + (bf) * KT + k8w0) = st_k0; if constexpr (DQK == 192) if (wid < 4) *(bf16x8*)(K_lds + (bf) * KT + k8w2) = st_k2; } \
        else { *(bf16x8*)(K_lds + (bf) * KT + kws0) = st_k0; *(bf16x8*)(K_lds + (bf) * KT + kws1) = st_k1;                 \
            if constexpr (DQK == 192) *(bf16x8*)(K_lds + (bf) * KT + kws2) = st_k2; } } while (0)
    SLOAD(0);
    int qrow, jslot = 3; bool valid = true;
    if constexpr (MODE == 1) { const int e = wid * 32 + r32; valid = e < A.nrows; const unsigned ent = A.list[valid ? e : 0]; qrow = (int)(ent & 0xffffu); jslot = (int)(ent >> 16); }
    else qrow = A.q0 + wid * 32 + r32;
    bf16x8 qr[F8 ? 1 : DQK / 16]; v8i_t q8[DQK / 64]; int f8scale = 0x7f7f7f7f;
    if constexpr (F8) { asm volatile("" : "+v"(f8scale));
#pragma unroll
        for (int s_ = 0; s_ < DQK / 64; ++s_) { const v4i_t* qp = (const v4i_t*)(A.Q8 + (size_t)qrow * Q8P + 64 * s_ + 32 * hi); q8[s_].lo = qp[0]; q8[s_].hi = qp[1]; } }
    else {
#pragma unroll
        for (int d0 = 0; d0 < DQK / 16; ++d0) qr[d0] = ld8(A.Q + (size_t)qrow * A.qpitch + d0 * 16 + hi * 8); }
    int posq = 0, qminw = 0;
    if constexpr (MODE != 0) { posq = A.pos[qrow]; int mn = posq;
#pragma unroll
        for (int o_ = 1; o_ < 64; o_ <<= 1) mn = min(mn, __shfl_xor(mn, o_));
        qminw = __builtin_amdgcn_readfirstlane(mn); }
    const int qlo = A.q0 + wid * 32;
    float m_reg = -1e30f, l_reg = 0.f; f32x16 o[4] = {};
    f32x16 o5 = {};
    f32x16 p0, p1; float alpha; bf16x8 pa0, pa1, pa2, pa3;
    const int NT = A.NT;
    SWRITE(0);
    __syncthreads();
    if constexpr (F8) {
#pragma unroll
        for (int s_ = 0; s_ < DQK / 64; ++s_) asm volatile("" : "+v"(q8[s_])); }
    else {
#pragma unroll
        for (int d0 = 0; d0 < DQK / 16; ++d0) asm volatile("" : "+v"(qr[d0])); }
#define KB_(t) (A.k0 + (t) * 64)
#define ACT(t) (MODE == 1 || KB_(t) <= qlo + 31)
#define NEEDMASK(t) (MODE != 1 && KB_(t) + 63 > qlo)
#define STEP(t, B) do {                                                                                                       \
        const bool more_ = (t) + 1 < NT;                                                                                      \
        if (more_) SLOAD((t) + 1);                                                                                            \
        if (ACT(t)) {                                                                                                         \
            ASBAR(); if constexpr (F8) qkt8<DQK>(p0, p1, K_lds + (B) * KT, r32, hi, q8, f8scale); else qkt<DQK>(p0, p1, K_lds + (B) * KT, r32, hi, qr);     \
            if constexpr (MODE != 0) {                                                                                                          \
                const int kmax_ = A.tpmax[KB_(t) >> 6];                                                                       \
                if (qminw - kmax_ >= 128) { const float bc = biasL[128];                                                      \
                    _Pragma("unroll") for (int r = 0; r < 16; ++r) { p0[r] = fmaf(p0[r], A.c2, bc); p1[r] = fmaf(p1[r], A.c2, bc); } }   \
                else {                                                                                                        \
                    _Pragma("unroll") for (int g4 = 0; g4 < 4; ++g4) {                                                        \
                        const i32x4 pk0 = *(const i32x4*)(A.pos + KB_(t) + 8 * g4 + 4 * hi);                                  \
                        const i32x4 pk1 = *(const i32x4*)(A.pos + KB_(t) + 32 + 8 * g4 + 4 * hi);                             \
                        _Pragma("unroll") for (int e = 0; e < 4; ++e) {                                                       \
                            const int d0_ = min(max(posq - pk0[e], 0), 128), d1_ = min(max(posq - pk1[e], 0), 128);           \
                            p0[4 * g4 + e] = fmaf(p0[4 * g4 + e], A.c2, biasL[d0_]); p1[4 * g4 + e] = fmaf(p1[4 * g4 + e], A.c2, biasL[d1_]); } } }   \
            }                                                                                                                 \
            if (NEEDMASK(t)) mask_tile(p0, p1, (qlo + r32 - 4 * hi) - KB_(t));                                                \
            partialSM<MODE == 0>(p0, p1, m_reg, alpha, A.c2);                                                                 \
            if (__any(alpha < 1.f)) { if (hi == 0) al_l[r32] = alpha; asm volatile("s_waitcnt lgkmcnt(0)" ::: "memory");      \
                _Pragma("unroll") for (int d_ = 0; d_ < 4; ++d_) _Pragma("unroll") for (int r = 0; r < 16; ++r) o[d_][r] *= al_l[crow(r, hi)];     \
                if constexpr (F8) { _Pragma("unroll") for (int r = 0; r < 16; ++r) o5[r] *= al_l[crow(r, hi)]; } }                                  \
            if constexpr (F8) { const lds_cptr vp_ = (lds_cptr)V_lds + (B) * VT_BYTES + v8r; v8i_t vf[4], p8;                   \
              _Pragma("unroll") for (int d_ = 0; d_ < 4; ++d_) { vf[d_].lo = *(const __attribute__((address_space(3))) v4i_t*)(vp_ + d_ * 2048);  \
                  vf[d_].hi = *(const __attribute__((address_space(3))) v4i_t*)((lds_cptr)V_lds + (B) * VT_BYTES + (v8r ^ 16) + d_ * 2048); }           \
              finishSM_e(p1);                                                                                                  \
              _Pragma("unroll") for (int j_ = 0; j_ < 4; ++j_) { p8[j_] = (int)pk4f8(p0[4 * j_], p0[4 * j_ + 1], p0[4 * j_ + 2], p0[4 * j_ + 3]);     \
                  p8[4 + j_] = (int)pk4f8(p1[4 * j_], p1[4 * j_ + 1], p1[4 * j_ + 2], p1[4 * j_ + 3]); }                       \
              __builtin_amdgcn_s_setprio(1);                                                                                   \
              _Pragma("unroll") for (int d_ = 0; d_ < 4; ++d_)                                                                 \
                  asm volatile("v_mfma_scale_f32_32x32x64_f8f6f4 %0, %1, %2, %0, %3, %3 op_sel_hi:[0,0,0]" : "+v"(o[d_]) : "v"(p8), "v"(vf[d_]), "v"(f8scale));   \
              { v8i_t ones8 = {0x38383838, 0x38383838, 0x38383838, 0x38383838, 0x38383838, 0x38383838, 0x38383838, 0x38383838}; asm volatile("" : "+v"(ones8));        \
                asm volatile("v_mfma_scale_f32_32x32x64_f8f6f4 %0, %1, %2, %0, %3, %3 op_sel_hi:[0,0,0]" : "+v"(o5) : "v"(p8), "v"(ones8), "v"(f8scale)); }        \
              __builtin_amdgcn_s_setprio(0); }                                                                                 \
            else { const lds_cptr vp_ = vp0 + (B) * VT_BYTES; s16x4 fa[8], fb[8];                                                    \
              finishSM_a(p0, p1, alpha, l_reg); PK4(p0, 0, pa0); PK4(p0, 8, pa1);                                             \
              VRD(fa, vp_, 0); PK4(p1, 0, pa2); PK4(p1, 8, pa3);                                                              \
              VRD(fb, vp_, 1); PVMMA(fa, 0); VRD(fa, vp_, 2); PVMMA(fb, 1); VRD(fb, vp_, 3); PVMMA(fa, 2); PVMMA(fb, 3); }    \
        }                                                                                                                     \
        if (more_) SWRITE((B) ^ 1);                                                                                           \
        __syncthreads(); } while (0)
    for (int t = 0; t < NT; t += 2) { STEP(t, 0); STEP(t + 1, 1); }
    if constexpr (F8) asm volatile("s_nop 15\n\ts_nop 7" : "+v"(o[0]), "+v"(o[1]), "+v"(o[2]), "+v"(o[3]), "+v"(o5));
#undef STEP
#undef ACT
#undef NEEDMASK
#undef KB_
#undef SLOAD
#undef SWRITE
    if (hi == 0) { if constexpr (!F8) li_l[r32] = l_reg; ix_l[r32] = valid ? (qrow * 16 + A.h) * 4 + jslot : -1; }
    asm volatile("s_waitcnt lgkmcnt(0)" ::: "memory");
    if constexpr (MODE != 0) { if (hi == 0 && valid) { float* ml = A.PML + (size_t)((qrow * 16 + A.h) * 4 + jslot) * 2; ml[0] = m_reg; if constexpr (!F8) ml[1] = l_reg; } }
#pragma unroll
    for (int r = 0; r < 16; ++r) { const int orow = crow(r, hi); const float rl = __builtin_amdgcn_rcpf(F8 ? o5[r] : li_l[orow]);
        bf16_t* dst; bool ok = true;
        if constexpr (MODE == 0) dst = A.O + (size_t)(qlo + orow) * A.opitch;
        else { const int ix = ix_l[orow]; ok = ix >= 0; dst = A.PO + (size_t)(ok ? ix : 0) * 128;
            if constexpr (F8) { if (r32 == 0 && ok) A.PML[(size_t)ix * 2 + 1] = o5[r]; } }
#pragma unroll
        for (int d0 = 0; d0 < 4; ++d0) { const float v = o[d0][r] * rl; const float vn = __shfl_xor(v, 1);
            if ((r32 & 1) == 0 && ok) *(unsigned*)(dst + d0 * 32 + r32) = cvtpk(v, vn); } }
    __syncthreads();
}
template <int MODE>
__device__ __forceinline__ void moba_unit(const UnitArgs& A, char* lds, int wv, int nchunk) {
    int tid_ = wv * 64 + lane_id_(); asm volatile("" : "+v"(tid_)); const int tid = tid_, wid = wv, lane = tid & 63, r32 = lane & 31, hi = lane >> 5;
    char* V_lds = lds + L_V; char* K_lds = lds + L_K;
    float* ws = (float*)(lds + L_WS) + wid * 128; float* al_l = ws + 32; int* ix_l = (int*)(ws + 64);
    const float* biasL = (const float*)(lds + L_BIAS) + A.h * 132;
    int qrow, jslot = 3, posq; bool valid = true; v8i_t q8[2]; unsigned ent = 0;
    if constexpr (MODE == 1) { const int e = wid * 32 + r32; valid = e < A.nrows; ent = A.list[valid ? e : 0]; }
    else qrow = A.q0 + wid * 32 + r32;
#define QLOAD(QF_, POSQ_, QROW_) do { _Pragma("unroll") for (int s_ = 0; s_ < 2; ++s_) { const v4i_t* qp = (const v4i_t*)(A.Q8 + (size_t)(QROW_) * 2048 + 64 * s_ + 32 * hi); QF_[s_].lo = qp[0]; QF_[s_].hi = qp[1]; } \
        POSQ_ = A.pos[QROW_]; } while (0)
    if constexpr (MODE != 1) QLOAD(q8, posq, qrow);
    { const int k8w0 = k8swz<128>(tid >> 3, tid & 7), v8w = (tid >> 2) * 64 + (((tid & 3) ^ ((tid >> 4) & 3)) << 4);
      bf16x8 sk[4], sv[4];
#pragma unroll
      for (int i = 0; i < 4; ++i) { const size_t kk_ = (size_t)(A.k0 + i * 64);
          sv[i] = ld8((const bf16_t*)(A.V8 + (kk_ >> 6) * 8192 + tid * 16)); sk[i] = ld8((const bf16_t*)(A.K8 + (kk_ + (tid >> 3)) * 2048 + (tid & 7) * 16)); }
      if constexpr (MODE == 1) { qrow = (int)(ent & 0xffffu); jslot = (int)(ent >> 16); QLOAD(q8, posq, qrow); }
#pragma unroll
      for (int i = 0; i < 4; ++i) { *(bf16x8*)(V_lds + i * 8192 + v8w) = sv[i]; *(bf16x8*)(K_lds + i * 8192 + k8w0) = sk[i]; } }
    __syncthreads();
    const int v8r = r32 * 64 + (((2 * hi) ^ ((r32 >> 2) & 3)) << 4);
    int f8scale = 0x7f7f7f7f; asm volatile("" : "+v"(f8scale));
    const int qlo = A.q0 + wid * 32;
#pragma unroll 1
    for (int c = 0; c < nchunk; ++c) {
        if (MODE == 1 && c * 256 + wid * 32 >= A.nrows) break;
        const bool has_next = MODE == 1 && (c + 1 < nchunk) && ((c + 1) * 256 + wid * 32 < A.nrows);
        unsigned entn = 0; bool validn = false; v8i_t q8n[2]; int posqn = 0, qrown = 0;
        if (has_next) { const int en = (c + 1) * 256 + wid * 32 + r32; validn = en < A.nrows; entn = A.list[validn ? en : 0]; }
        int qminw; { int mn = posq;
#pragma unroll
            for (int o_ = 1; o_ < 64; o_ <<= 1) mn = min(mn, __shfl_xor(mn, o_));
            qminw = __builtin_amdgcn_readfirstlane(mn); }
        float m_reg = -1e30f, alpha; f32x16 o[4] = {}, o5 = {}, p0, p1;
#pragma unroll
        for (int s_ = 0; s_ < 2; ++s_) asm volatile("" : "+v"(q8[s_]));
#define MTILE(t) do { const int kb_ = A.k0 + (t) * 64;                                                                          \
            if (MODE == 1 || kb_ <= qlo + 31) {                                                                               \
                ASBAR(); qkt8<128>(p0, p1, K_lds + (t) * 8192, r32, hi, q8, f8scale);                                         \
                const int kmax_ = A.tpmax[kb_ >> 6];                                                                          \
                if (qminw - kmax_ >= 128) { const float bc = biasL[128];                                                      \
                    _Pragma("unroll") for (int r = 0; r < 16; ++r) { p0[r] = fmaf(p0[r], A.c2, bc); p1[r] = fmaf(p1[r], A.c2, bc); } }   \
                else {                                                                                                        \
                    _Pragma("unroll") for (int g4 = 0; g4 < 4; ++g4) {                                                        \
                        const i32x4 pk0 = *(const i32x4*)(A.pos + kb_ + 8 * g4 + 4 * hi);                                     \
                        const i32x4 pk1 = *(const i32x4*)(A.pos + kb_ + 32 + 8 * g4 + 4 * hi);                                \
                        _Pragma("unroll") for (int e = 0; e < 4; ++e) {                                                       \
                            const int d0_ = min(max(posq - pk0[e], 0), 128), d1_ = min(max(posq - pk1[e], 0), 128);           \
                            p0[4 * g4 + e] = fmaf(p0[4 * g4 + e], A.c2, biasL[d0_]); p1[4 * g4 + e] = fmaf(p1[4 * g4 + e], A.c2, biasL[d1_]); } } }   \
                if (MODE != 1 && kb_ + 63 > qlo) mask_tile(p0, p1, (qlo + r32 - 4 * hi) - kb_);                               \
                partialSM<false>(p0, p1, m_reg, alpha, A.c2);                                                                 \
                if (__any(alpha < 1.f)) { if (hi == 0) al_l[r32] = alpha; asm volatile("s_waitcnt lgkmcnt(0)" ::: "memory");  \
                    _Pragma("unroll") for (int d_ = 0; d_ < 4; ++d_) _Pragma("unroll") for (int r = 0; r < 16; ++r) o[d_][r] *= al_l[crow(r, hi)];   \
                    _Pragma("unroll") for (int r = 0; r < 16; ++r) o5[r] *= al_l[crow(r, hi)]; }                              \
                { const lds_cptr vp_ = (lds_cptr)V_lds + (t) * 8192 + v8r; const lds_cptr vq_ = (lds_cptr)V_lds + (t) * 8192 + (v8r ^ 16); v8i_t vf[4], p8;   \
                  _Pragma("unroll") for (int d_ = 0; d_ < 4; ++d_) { vf[d_].lo = *(const __attribute__((address_space(3))) v4i_t*)(vp_ + d_ * 2048); vf[d_].hi = *(const __attribute__((address_space(3))) v4i_t*)(vq_ + d_ * 2048); }   \
                  finishSM_e(p1);                                                                                             \
                  _Pragma("unroll") for (int j_ = 0; j_ < 4; ++j_) { p8[j_] = (int)pk4f8(p0[4 * j_], p0[4 * j_ + 1], p0[4 * j_ + 2], p0[4 * j_ + 3]); p8[4 + j_] = (int)pk4f8(p1[4 * j_], p1[4 * j_ + 1], p1[4 * j_ + 2], p1[4 * j_ + 3]); }   \
                  __builtin_amdgcn_s_setprio(1);                                                                              \
                  _Pragma("unroll") for (int d_ = 0; d_ < 4; ++d_)                                                            \
                      asm volatile("v_mfma_scale_f32_32x32x64_f8f6f4 %0, %1, %2, %0, %3, %3 op_sel_hi:[0,0,0]" : "+v"(o[d_]) : "v"(p8), "v"(vf[d_]), "v"(f8scale));   \
                  { v8i_t ones8 = {0x38383838, 0x38383838, 0x38383838, 0x38383838, 0x38383838, 0x38383838, 0x38383838, 0x38383838}; asm volatile("" : "+v"(ones8));   \
                    asm volatile("v_mfma_scale_f32_32x32x64_f8f6f4 %0, %1, %2, %0, %3, %3 op_sel_hi:[0,0,0]" : "+v"(o5) : "v"(p8), "v"(ones8), "v"(f8scale)); }   \
                  __builtin_amdgcn_s_setprio(0); }                                                                            \
            } } while (0)
        MTILE(0); MTILE(1);
        if (has_next) { qrown = (int)(entn & 0xffffu); QLOAD(q8n, posqn, qrown); }
        MTILE(2); MTILE(3);
#undef MTILE
        asm volatile("s_nop 15\n\ts_nop 7" : "+v"(o[0]), "+v"(o[1]), "+v"(o[2]), "+v"(o[3]), "+v"(o5));
        if (hi == 0) ix_l[r32] = valid ? (qrow * 16 + A.h) * 4 + jslot : -1;
        asm volatile("s_waitcnt lgkmcnt(0)" ::: "memory");
        if (hi == 0 && valid) A.PML[(size_t)((qrow * 16 + A.h) * 4 + jslot) * 2] = m_reg;
#pragma unroll
        for (int r = 0; r < 16; ++r) { const int orow = crow(r, hi); const float rl = __builtin_amdgcn_rcpf(o5[r]);
            const int ix = ix_l[orow]; const bool ok = ix >= 0; bf16_t* dst = A.PO + (size_t)(ok ? ix : 0) * 128;
            if (r32 == 0 && ok) A.PML[(size_t)ix * 2 + 1] = o5[r];
#pragma unroll
            for (int d0 = 0; d0 < 4; ++d0) { const float v = o[d0][r] * rl; const float vn = __shfl_xor(v, 1);
                if ((r32 & 1) == 0 && ok) *(unsigned*)(dst + d0 * 32 + r32) = cvtpk(v, vn); } }
        asm volatile("s_waitcnt lgkmcnt(0)" ::: "memory");
        if (!has_next) break;
        qrow = qrown; jslot = (int)(entn >> 16); valid = validn; posq = posqn; q8[0] = q8n[0]; q8[1] = q8n[1];
    }
#undef QLOAD
    __syncthreads();
}
}
constexpr int NWAVES = 8;
constexpr int M_ = 16384, DM = 4096, DFF = 11008, NFF2 = 2 * DFF;
constexpr int NH = 16, QLORA = 1024, KVLORA = 512, ROPE = 64, NOPE = 128, VDIM = 128, QUP = NH * 192, KVUP = NH * 256, MLAOUT = NH * 128, MOBAW = NH * 128;
constexpr int INCOLS = 15936, INPAD1 = 5888, IN2 = 10240;
constexpr int MBLK = 256, NBLK = M_ / MBLK;
constexpr float RMS_EPS = 1e-6f;
constexpr size_t MiB = 1u << 20;
constexpr size_t WS_CTL = 0, CTL_ZERO_BYTES = 1 * MiB;
constexpr size_t WS_WFFN_IN = 1 * MiB;
constexpr size_t WS_WFFN_OUT = WS_WFFN_IN + (size_t)NFF2 * DM * 2;
constexpr size_t WS_WFFN_END = WS_WFFN_OUT + (size_t)DM * DFF * 2;
constexpr size_t WS_PO = WS_WFFN_IN;
constexpr size_t WS_WIN = WS_WFFN_END;
constexpr size_t WS_WIN8 = WS_WIN + (size_t)INPAD1 * DM * 2;
constexpr size_t WS_WUQ = WS_WIN8 + (size_t)IN2 * DM;
constexpr size_t WS_WUKV = WS_WUQ + (size_t)QUP * QLORA * 2;
constexpr size_t WS_WBRA = WS_WUKV + (size_t)KVUP * KVLORA * 2;
constexpr size_t WS_WBRB = WS_WBRA + (size_t)DM * MLAOUT * 2;
constexpr size_t WS_WOUT = WS_WBRB + (size_t)DM * MOBAW * 2;
constexpr size_t WS_H = WS_WOUT + (size_t)DM * DM * 2;
constexpr size_t WS_LIST = WS_H;
constexpr size_t LIST_PER_HEAD = 516096;
constexpr size_t WS_PML = WS_LIST + LIST_PER_HEAD * NH * 4;
constexpr size_t WS_BIG = WS_H + (size_t)M_ * DM * 2;
constexpr size_t WS_CQ = WS_BIG;
constexpr size_t WS_CKV = WS_CQ + (size_t)M_ * QLORA * 2;
constexpr size_t WS_KR = WS_CKV + (size_t)M_ * KVLORA * 2;
constexpr size_t WS_QB = WS_KR + (size_t)M_ * ROPE * 2;
constexpr size_t WS_KB = WS_QB + (size_t)M_ * MOBAW * 2;
constexpr size_t WS_VB = WS_KB + (size_t)M_ * MOBAW * 2;
constexpr size_t WS_GA = WS_VB + (size_t)M_ * MOBAW * 2;
constexpr size_t WS_GB = WS_GA + (size_t)M_ * DM * 2;
constexpr size_t WS_BIG_END = WS_GB + (size_t)M_ * DM * 2;
constexpr size_t WS_QM8 = WS_BIG_END;
constexpr size_t WS_KN8 = WS_QM8 + (size_t)M_ * QUP;
constexpr size_t WS_KR8 = WS_KN8 + (size_t)M_ * 2048;
constexpr size_t WS_V8 = WS_KR8 + (size_t)M_ * 64;
constexpr size_t WS_QB8 = WS_V8 + (size_t)M_ * 2048;
constexpr size_t WS_KB8 = WS_QB8 + (size_t)M_ * 2048;
constexpr size_t WS_VB8 = WS_KB8 + (size_t)M_ * 2048;
constexpr size_t WS_OA = WS_VB8 + (size_t)M_ * 2048;
constexpr size_t WS_COS = WS_OA + (size_t)M_ * MLAOUT * 2;
constexpr size_t WS_SIN = WS_COS + (size_t)M_ * 32 * 4;
constexpr size_t WS_KMH = WS_SIN + (size_t)M_ * 32 * 4;
constexpr size_t WS_KML = WS_KMH + (size_t)NH * NBLK * 128 * 2;
constexpr size_t WS_BIAS = WS_KML + (size_t)NH * NBLK * 128 * 2;
constexpr size_t WS_TPMAX = WS_BIAS + 16 * 132 * 4;
constexpr size_t WS_PART = WS_TPMAX + 256 * 4;
constexpr size_t WS_RSTD = WS_PART + (size_t)M_ * 64 * 4;
constexpr size_t WS_PARTQ = WS_RSTD + (size_t)M_ * 4;
constexpr size_t WS_PARTKV = WS_PARTQ + (size_t)M_ * 16 * 4;
constexpr size_t WS_RSTDQ = WS_PARTKV + (size_t)M_ * 8 * 4;
constexpr size_t WS_RSTDKV = WS_RSTDQ + (size_t)M_ * 4;
constexpr size_t WS_H8 = WS_RSTDKV + (size_t)M_ * 4;
constexpr size_t WS_OA8 = WS_H8 + (size_t)M_ * DM;
constexpr size_t WS_OB8 = WS_OA8 + (size_t)M_ * MLAOUT;
constexpr size_t WS_MG8 = WS_OB8 + (size_t)M_ * MOBAW;
constexpr size_t WS_PMAX = WS_MG8 + (size_t)M_ * DM;
constexpr size_t WS_CPART = WS_PMAX + (size_t)M_ * 64 * 4;
constexpr size_t WS_CMAXF = WS_CPART + (size_t)8 * 2 * NFF2 * 4;
constexpr size_t WS_QM = ((WS_CMAXF + (size_t)2 * NFF2 * 4 + 4095) / 4096) * 4096;
constexpr size_t WS_KV = WS_QM + (size_t)M_ * QUP * 2;
constexpr size_t WS_WFI2 = MLA_BF16 ? WS_KV + (size_t)M_ * KVUP * 2 : WS_QM;
constexpr size_t WS_END = WS_WFI2 + (size_t)NFF2 * DM;
static_assert(WS_PML + (size_t)M_ * NH * 4 * 2 * 4 <= WS_BIG, "lists + ml inside H");
static_assert((size_t)M_ * NH * 4 * 128 * 2 <= WS_WFFN_END - WS_WFFN_IN, "partial O inside FFN weight region");
static_assert((size_t)M_ * DFF * 2 <= WS_BIG_END - WS_BIG, "act inside BIG");
constexpr int CW_TMO = 0;
constexpr int CW_BAR = 4096;
constexpr int CW_GCNT = 16384;
constexpr int CW_CMAX = 196608;
constexpr int CW_KMEAN = 65536;
constexpr int RING_OFF = 0, RING_BYTES = 131072;
constexpr int LDSCTL_OFF = RING_BYTES, MISC_OFF = LDSCTL_OFF + 320;
constexpr int LDS_BYTES = 147456;
static_assert(att::L_END <= RING_BYTES, "attention LDS inside ring region");

#define GAS __attribute__((address_space(1)))
#define LAS __attribute__((address_space(3)))
typedef unsigned short bf16;
typedef unsigned v4u __attribute__((ext_vector_type(4)));
typedef unsigned v2u __attribute__((ext_vector_type(2)));
typedef float f32x4 __attribute__((ext_vector_type(4)));
typedef short bf16x8 __attribute__((ext_vector_type(8)));
typedef float f32x16 __attribute__((ext_vector_type(16)));
typedef GAS unsigned gu32;
#define RLX_AGENT __ATOMIC_RELAXED, __HIP_MEMORY_SCOPE_AGENT
#define LDS_WAIT() asm volatile("s_waitcnt lgkmcnt(0)" ::: "memory")
__device__ __forceinline__ unsigned f2bf(float f) { unsigned u = __builtin_bit_cast(unsigned, f); return (u + 0x7fffu + ((u >> 16) & 1u)) >> 16; }
__device__ __forceinline__ unsigned pk2(float lo, float hi) { return f2bf(lo) | (f2bf(hi) << 16); }
__device__ __forceinline__ float bfu_lo(unsigned w) { return __uint_as_float(w << 16); }
__device__ __forceinline__ float bfu_hi(unsigned w) { return __uint_as_float(w & 0xffff0000u); }

#define XB_TMO      128
#define XB_XCNT(j)  (256  + 64 * (j))
#define XB_XSUB(j)  (1280 + 64 * (j))
#define XB_XGEN(j)  (2304 + 64 * (j))
#define XB_TOP      3328
#define XB_TOPGEN   3392
#define XCD_BAR_WORDS 3456
#define XB_SPIN_CAP (1u << 22)
__device__ __forceinline__ unsigned xb_ld(unsigned* p)              { return __hip_atomic_load(p, __ATOMIC_RELAXED, __HIP_MEMORY_SCOPE_AGENT); }
__device__ __forceinline__ unsigned xb_add(unsigned* p, unsigned v) { return __hip_atomic_fetch_add(p, v, __ATOMIC_RELAXED, __HIP_MEMORY_SCOPE_AGENT); }
__device__ __forceinline__ unsigned xb_xcc_id() { return (unsigned)__builtin_amdgcn_s_getreg((3 << 11) | 20) & 0xFu; }
#define XB_SPIN(cond, bar) do { unsigned _sp = 0; while (cond) { __builtin_amdgcn_s_sleep(1); \
    if ((++_sp & 255u) == 0u) { if (xb_ld(&(bar)[XB_TMO])) break; if (_sp > XB_SPIN_CAP) { atomicAdd(&(bar)[XB_TMO], 1u); break; } } } } while (0)
struct XcdBarrier { unsigned* bar; unsigned x; volatile LAS unsigned* st; };
__device__ __forceinline__ XcdBarrier xcd_barrier_post(unsigned* bar, volatile LAS unsigned* st, int wv) {
    XcdBarrier b; b.bar = bar; b.x = xb_xcc_id(); b.st = st;
    if (wv == 0 && lane_id_() == 0) (void)xb_add(&bar[XB_XCNT(b.x)], 1u);
    return b;
}
__device__ __forceinline__ void xcd_barrier_complete(unsigned* bar, unsigned x, unsigned& nloc, unsigned& nx) {
    const unsigned G = gridDim.x * gridDim.y * gridDim.z;
    unsigned sum, cnt, mine, sp = 0u;
    for (;;) {
        sum = 0u; cnt = 0u; mine = 0u;
#pragma unroll
        for (unsigned j = 0; j < 16; ++j) { const unsigned c = xb_ld(&bar[XB_XCNT(j)]); sum += c; cnt += (c > 0u) ? 1u : 0u; mine = (j == x) ? c : mine; }
        if (sum == G) break;
        __builtin_amdgcn_s_sleep(1);
        if ((++sp & 255u) == 0u) { if (xb_ld(&bar[XB_TMO])) break; if (sp > XB_SPIN_CAP) { atomicAdd(&bar[XB_TMO], 1u); break; } }
    }
    nloc = mine > 0u ? mine : 1u; nx = cnt > 0u ? cnt : 1u;
}
__device__ __forceinline__ void xcd_barrier(const XcdBarrier& b, int wv) {
    asm volatile("s_waitcnt vmcnt(0)" ::: "memory");
    __syncthreads();
    if (wv == 0 && lane_id_() == 0) {
        unsigned* bar = b.bar;
        __builtin_amdgcn_s_waitcnt(0);
        unsigned nloc = b.st[0], nx = b.st[1];
        if (nloc == 0u) { xcd_barrier_complete(bar, b.x, nloc, nx); b.st[0] = nloc; b.st[1] = nx; }
        const unsigned old = xb_add(&bar[XB_XSUB(b.x)], 1u);
        const unsigned gen = old / nloc;
        if (old + 1u == (gen + 1u) * nloc) {
            __builtin_amdgcn_fence(__ATOMIC_RELEASE, "agent");
            asm volatile("s_waitcnt vmcnt(0)" ::: "memory");
            const unsigned og = xb_add(&bar[XB_TOP], 1u);
            const unsigned tg = og / nx;
            if (og + 1u == (tg + 1u) * nx) xb_add(&bar[XB_TOPGEN], 1u);
            else XB_SPIN(xb_ld(&bar[XB_TOPGEN]) == tg, bar);
            __builtin_amdgcn_fence(__ATOMIC_ACQUIRE, "agent");
            xb_add(&bar[XB_XGEN(b.x)], 1u);
            asm volatile("s_waitcnt vmcnt(0)" ::: "memory");
        } else {
            XB_SPIN(xb_ld(&bar[XB_XGEN(b.x)]) == gen, bar);
            __builtin_amdgcn_fence(__ATOMIC_ACQUIRE, "agent");
            asm volatile("s_waitcnt vmcnt(0)" ::: "memory");
        }
    }
    __syncthreads();
}
struct Args {
    const float* in[19]; float* out; unsigned char* ws;
    double invf[32];
    unsigned char bucket[136];
};
__device__ __forceinline__ float wave_sum(float v) {
#pragma unroll
    for (int o = 1; o < 64; o <<= 1) v += __shfl_xor(v, o);
    return v;
}
__device__ __forceinline__ void cvt_item(const float* W, int Nsrc, int scol0, bool ropep, bf16* Wt, int K, int drow0, int k0, LAS unsigned char* T, int lane, const float* gain, int tiledN = 0, int f8s = -1, const float* cmax = nullptr, int cstride = 0, float* cmfinal = nullptr) {
    const int rp = lane >> 4, c4 = lane & 15;
    if (scol0 >= 0) {
#pragma unroll
        for (int i = 0; i < 8; ++i) { const int k = 8 * i + 2 * rp;
            f32x4 a = __builtin_nontemporal_load((const GAS f32x4*)(W + (size_t)(k0 + k) * Nsrc + scol0 + 4 * c4));
            f32x4 b = __builtin_nontemporal_load((const GAS f32x4*)(W + (size_t)(k0 + k + 1) * Nsrc + scol0 + 4 * c4));
            if (gain) { a = a * gain[k0 + k]; b = b * gain[k0 + k + 1]; }
#pragma unroll
            for (int e = 0; e < 4; ++e) { const int c = 4 * c4 + e; *(LAS unsigned*)(T + c * 136 + k * 2) = pk2(a[e], b[e]); } }
    }
    LDS_WAIT(); asm volatile("" ::: "memory");
    const int kc = lane & 7, nr = lane >> 3;
#pragma unroll
    for (int j = 0; j < 8; ++j) { const int c = 8 * j + nr;
        v4u o = {0u, 0u, 0u, 0u};
        if (scol0 >= 0) { const v2u lo = *(const LAS v2u*)(T + c * 136 + kc * 16), hi2 = *(const LAS v2u*)(T + c * 136 + kc * 16 + 8); o.x = lo.x; o.y = lo.y; o.z = hi2.x; o.w = hi2.y; }
        int p = c; if (ropep) { const int half = c >> 5, i5 = c & 31; p = 8 * (i5 >> 2) + (i5 & 3) + 4 * half; }
        if (cmax) {
            float cm = 0.f;
#pragma unroll
            for (int sg_ = 0; sg_ < 8; ++sg_) cm = fmaxf(cm, cmax[(size_t)sg_ * cstride + scol0 + c]);
            if (k0 == 0 && kc == 0) cmfinal[scol0 + c] = cm;
            const float inv = 127.f / fmaxf(cm, 1e-30f); const float v8[8] = {bfu_lo(o.x), bfu_hi(o.x), bfu_lo(o.y), bfu_hi(o.y), bfu_lo(o.z), bfu_hi(o.z), bfu_lo(o.w), bfu_hi(o.w)};
            unsigned q0 = 0, q1 = 0;
#pragma unroll
            for (int e = 0; e < 4; ++e) { q0 |= ((unsigned)(int)rintf(v8[e] * inv) & 0xffu) << (8 * e); q1 |= ((unsigned)(int)rintf(v8[4 + e] * inv) & 0xffu) << (8 * e); }
            v2u q; q.x = q0; q.y = q1;
            *(GAS v2u*)((unsigned char*)Wt + ((size_t)(k0 >> 7) * tiledN + drow0 + p) * 128 + (k0 & 64) + 8 * kc) = q; }
        else if (f8s >= 0) {
            const float scl = __uint_as_float((unsigned)(127 + f8s) << 23); v2u q;
            int w0 = 0, w1 = 0;
            w0 = __builtin_amdgcn_cvt_pk_fp8_f32(bfu_lo(o.x) * scl, bfu_hi(o.x) * scl, w0, false); w0 = __builtin_amdgcn_cvt_pk_fp8_f32(bfu_lo(o.y) * scl, bfu_hi(o.y) * scl, w0, true);
            w1 = __builtin_amdgcn_cvt_pk_fp8_f32(bfu_lo(o.z) * scl, bfu_hi(o.z) * scl, w1, false); w1 = __builtin_amdgcn_cvt_pk_fp8_f32(bfu_lo(o.w) * scl, bfu_hi(o.w) * scl, w1, true);
            q.x = (unsigned)w0; q.y = (unsigned)w1;
            *(GAS v2u*)((unsigned char*)Wt + ((size_t)(k0 >> 7) * tiledN + drow0 + p) * 128 + (k0 & 64) + 8 * kc) = q; }
        else if (tiledN) *(GAS v4u*)(Wt + ((size_t)(k0 >> 6) * tiledN + drow0 + p) * 64 + 8 * kc) = o;
        else *(GAS v4u*)(Wt + (size_t)(drow0 + p) * K + k0 + 8 * kc) = o; }
    LDS_WAIT(); asm volatile("" ::: "memory");
}
template <int KIND>
__device__ __forceinline__ void cvt_job(const float* W, int K, int Nsrc, bf16* Wt, int ndb, LAS unsigned char* T, int gw, int NGW, int lane, const float* gain = nullptr, int tiledN = 0, int f8s = -1, const float* cmax = nullptr, int cstride = 0, float* cmfinal = nullptr, int jph = 0, int jnp = 1) {
    const int nkb = K / 64, nit = ndb * nkb;
    for (int it = gw + NGW * jph; it < nit; it += NGW * jnp) { const int db = it / nkb, kb = it - db * nkb;
        int scol = 64 * db; bool rp = false;
        if constexpr (KIND == 1) { const int pn = db >> 2, sub = db & 3; scol = (sub < 2) ? (128 * pn + 64 * sub) : (DFF + 128 * pn + 64 * (sub - 2)); }
        if constexpr (KIND == 2) { if (db < 24) scol = 64 * db; else if (db < 88) scol = 64 * db + 64; else if (db == 88) { scol = 1536; rp = true; } else scol = -1; }
        if constexpr (KIND == 4) { scol = 5696 + 64 * db; }
        if constexpr (KIND == 3) { rp = (db % 3) == 2; }
        cvt_item(W, Nsrc, scol, rp, Wt, K, 64 * db, 64 * kb, T, lane, gain, tiledN, f8s, cmax, cstride, cmfinal); }
}
template <bool OUTF32>
__device__ __forceinline__ void rms_row4096(const float* xrow, const float* g, void* orow, int lane, int tiledM = 0) {
    const GAS f32x4* xr = (const GAS f32x4*)xrow + lane;
    f32x4 v[16]; float s = 0.f;
#pragma unroll
    for (int j = 0; j < 16; ++j) { v[j] = xr[64 * j]; s += (v[j].x * v[j].x + v[j].y * v[j].y) + (v[j].z * v[j].z + v[j].w * v[j].w); }
    const float rstd = 1.0f / sqrtf(wave_sum(s) * (1.f / DM) + RMS_EPS);
    const GAS f32x4* gr = (const GAS f32x4*)g + lane;
#pragma unroll
    for (int j = 0; j < 16; ++j) { const f32x4 gg = gr[64 * j]; const f32x4 y = (v[j] * rstd) * gg;
        if constexpr (OUTF32) ((GAS f32x4*)orow)[64 * j + lane] = y;
        else { v2u w; w.x = pk2(y.x, y.y); w.y = pk2(y.z, y.w);
            if (tiledM) { const int col = 4 * (64 * j + lane); *(GAS v2u*)((bf16*)orow + ((size_t)(col >> 6) * tiledM) * 64 + (col & 63)) = w; }
            else ((GAS v2u*)orow)[64 * j + lane] = w; } }
}
template <int N>
__device__ __forceinline__ void rms_row_bf16(bf16* row, const float* g, int lane) {
    constexpr int NV = N / 512;
    v4u w[NV]; float s = 0.f;
#pragma unroll
    for (int j = 0; j < NV; ++j) { w[j] = *(const GAS v4u*)(row + (64 * j + lane) * 8);
#pragma unroll
        for (int e = 0; e < 4; ++e) { const float a = bfu_lo(w[j][e]), b = bfu_hi(w[j][e]); s += a * a + b * b; } }
    const float rstd = 1.0f / sqrtf(wave_sum(s) * (1.f / N) + RMS_EPS);
#pragma unroll
    for (int j = 0; j < NV; ++j) { const GAS f32x4* gp = (const GAS f32x4*)(g + (64 * j + lane) * 8); const f32x4 g0 = gp[0], g1 = gp[1]; v4u o;
        o.x = pk2(bfu_lo(w[j].x) * rstd * g0.x, bfu_hi(w[j].x) * rstd * g0.y); o.y = pk2(bfu_lo(w[j].y) * rstd * g0.z, bfu_hi(w[j].y) * rstd * g0.w);
        o.z = pk2(bfu_lo(w[j].z) * rstd * g1.x, bfu_hi(w[j].z) * rstd * g1.y); o.w = pk2(bfu_lo(w[j].w) * rstd * g1.z, bfu_hi(w[j].w) * rstd * g1.w);
        *(GAS v4u*)(row + (64 * j + lane) * 8) = o; }
}
__device__ __forceinline__ void colmax_job(const float* W, int K, int N, float* cpart, int cstride, int gw, int NGW, int lane) {
    const int nseg = K / 512, ntask = (N / 64) * nseg, rp = lane >> 4, c4 = lane & 15;
    for (int it = gw; it < ntask; it += NGW) { const int cb = it / nseg, sg = it - cb * nseg; f32x4 m = {0.f, 0.f, 0.f, 0.f};
        const float* wp = W + (size_t)(sg * 512 + rp) * N + cb * 64 + 4 * c4;
#pragma unroll 8
        for (int i = 0; i < 128; ++i) { const f32x4 v = __builtin_nontemporal_load((const GAS f32x4*)(wp + (size_t)(4 * i) * N));
            m[0] = fmaxf(m[0], fabsf(v[0])); m[1] = fmaxf(m[1], fabsf(v[1])); m[2] = fmaxf(m[2], fabsf(v[2])); m[3] = fmaxf(m[3], fabsf(v[3])); }
#pragma unroll
        for (int e = 0; e < 4; ++e) { float x = m[e]; x = fmaxf(x, __shfl_xor(x, 16)); x = fmaxf(x, __shfl_xor(x, 32)); if (rp == 0) cpart[(size_t)sg * cstride + cb * 64 + 4 * c4 + e] = x; } }
}
__device__ __forceinline__ void rms_row4096_i8(const float* xrow, const float* g, unsigned char* a8, int row, float* rs, int lane) {
    const GAS f32x4* xr = (const GAS f32x4*)xrow + lane;
    f32x4 v[16]; float s = 0.f;
#pragma unroll
    for (int j = 0; j < 16; ++j) { v[j] = xr[64 * j]; s += (v[j].x * v[j].x + v[j].y * v[j].y) + (v[j].z * v[j].z + v[j].w * v[j].w); }
    const float rstd = 1.0f / sqrtf(wave_sum(s) * (1.f / DM) + RMS_EPS);
    const GAS f32x4* gr = (const GAS f32x4*)g + lane; float mx = 0.f;
#pragma unroll
    for (int j = 0; j < 16; ++j) { const f32x4 gg = gr[64 * j]; v[j] = (v[j] * rstd) * gg; mx = fmaxf(fmaxf(mx, fmaxf(fabsf(v[j].x), fabsf(v[j].y))), fmaxf(fabsf(v[j].z), fabsf(v[j].w))); }
#pragma unroll
    for (int o = 1; o < 64; o <<= 1) mx = fmaxf(mx, __shfl_xor(mx, o));
    mx = fmaxf(mx, 1e-30f); const float inv = 127.f / mx;
#pragma unroll
    for (int j = 0; j < 16; ++j) { const int col = 4 * (64 * j + lane);
        const unsigned q = ((unsigned)(int)rintf(v[j].x * inv) & 0xffu) | (((unsigned)(int)rintf(v[j].y * inv) & 0xffu) << 8) | (((unsigned)(int)rintf(v[j].z * inv) & 0xffu) << 16) | (((unsigned)(int)rintf(v[j].w * inv) & 0xffu) << 24);
        *(GAS unsigned*)(a8 + ((size_t)(col >> 7) * M_ + row) * 128 + (col & 127)) = q; }
    if (lane == 0) rs[row] = mx * (1.f / 127.f);
}
__device__ __forceinline__ void quant_row_i8(const bf16* hb, const float* part, const float* pmax, unsigned char* a8, int row, float* rs, int lane) {
    float s = part[(size_t)row * 64 + lane], mx = pmax[(size_t)row * 64 + lane];
    s = wave_sum(s);
#pragma unroll
    for (int o = 1; o < 64; o <<= 1) mx = fmaxf(mx, __shfl_xor(mx, o));
    mx = fmaxf(mx, 1e-30f); const float inv = 127.f / mx;
    const GAS v4u* src = (const GAS v4u*)(hb + ((size_t)lane * M_ + row) * 64);
    v4u w[8];
#pragma unroll
    for (int j = 0; j < 8; ++j) w[j] = src[j];
    v4u o[4];
#pragma unroll
    for (int j = 0; j < 8; ++j) { unsigned q0 = 0, q1 = 0;
#pragma unroll
        for (int e = 0; e < 2; ++e) { const unsigned a = w[j][e], b = w[j][2 + e];
            q0 |= (((unsigned)(int)rintf(bfu_lo(a) * inv) & 0xffu) | (((unsigned)(int)rintf(bfu_hi(a) * inv) & 0xffu) << 8)) << (16 * e);
            q1 |= (((unsigned)(int)rintf(bfu_lo(b) * inv) & 0xffu) | (((unsigned)(int)rintf(bfu_hi(b) * inv) & 0xffu) << 8)) << (16 * e); }
        o[j >> 1][2 * (j & 1)] = q0; o[j >> 1][2 * (j & 1) + 1] = q1; }
    GAS v4u* dst = (GAS v4u*)(a8 + ((size_t)(lane >> 1) * M_ + row) * 128 + (lane & 1) * 64);
#pragma unroll
    for (int j = 0; j < 4; ++j) dst[j] = o[j];
    if (lane == 0) rs[row] = mx * (1.f / 127.f) / sqrtf(s * (1.f / DM) + RMS_EPS);
}
template <int NP>
__device__ __forceinline__ void rstd_reduce(const float* part, float* rstd, float inv_n, int vcu, int tid, int G) {
    for (int row = vcu * (NWAVES * 64) + tid; row < M_; row += G * NWAVES * 64) { float s = 0.f;
#pragma unroll
        for (int j = 0; j < NP / 4; ++j) { const f32x4 v = *(const GAS f32x4*)(part + (size_t)row * NP + 4 * j); s += (v.x + v.y) + (v.z + v.w); }
        rstd[row] = 1.0f / sqrtf(s * inv_n + RMS_EPS); }
}
__device__ __forceinline__ void sincos_d(double a, float& sn, float& cs) {
    const double k = rint(a * 0.63661977236758134308);
    double r = fma(-k, 1.57079632679489655800, a); r = fma(-k, 6.12323399573676603587e-17, r);
    const double r2 = r * r;
    const double sp = r + r * r2 * (-1.0 / 6 + r2 * (1.0 / 120 + r2 * (-1.0 / 5040 + r2 * (1.0 / 362880 + r2 * (-1.0 / 39916800)))));
    const double cp = 1.0 + r2 * (-0.5 + r2 * (1.0 / 24 + r2 * (-1.0 / 720 + r2 * (1.0 / 40320 + r2 * (-1.0 / 3628800 + r2 * (1.0 / 479001600))))));
    const int q = (int)((long long)k & 3);
    const double s_ = (q & 1) ? cp : sp, c_ = (q & 1) ? sp : cp;
    sn = (float)((q & 2) ? -s_ : s_); cs = (float)(((q + 1) & 2) ? -c_ : c_);
}
__device__ __forceinline__ int list_off(int kb) { return 16384 * kb - 128 * kb * (kb + 1); }
__device__ __forceinline__ bool better(float v, int i, float cv, int ci) { return v > cv || (v == cv && i < ci); }
#define TOP3_INS(v_, i_) do { const float vv_ = (v_); const int ii_ = (i_);                                             \
        const bool c0_ = better(vv_, ii_, tv0, ti0), c1_ = better(vv_, ii_, tv1, ti1), c2_ = better(vv_, ii_, tv2, ti2); \
        tv2 = c1_ ? tv1 : (c2_ ? vv_ : tv2); ti2 = c1_ ? ti1 : (c2_ ? ii_ : ti2);                                       \
        tv1 = c0_ ? tv0 : (c1_ ? vv_ : tv1); ti1 = c0_ ? ti0 : (c1_ ? ii_ : ti1);                                       \
        tv0 = c0_ ? vv_ : tv0; ti0 = c0_ ? ii_ : ti0; } while (0)
__device__ __forceinline__ void moba_gate_unit(int h, int qb, const bf16* QB, const float* KMF, unsigned* gcnt, unsigned* list, float* PML,
                                               LAS unsigned* cntL, LAS unsigned* baseL, int wv) {
    int tid_ = wv * 64 + lane_id_(); asm volatile("" : "+v"(tid_)); const int tid = tid_, wid = wv, lane = tid & 63, r32 = lane & 31, hi = lane >> 5;
    if (tid < 64) cntL[tid] = 0u;
    __syncthreads();
    const int s = qb * MBLK + wid * 32 + r32;
    bf16x8 qr[8];
#pragma unroll
    for (int d0 = 0; d0 < 8; ++d0) qr[d0] = *(const GAS bf16x8*)(QB + (size_t)s * MOBAW + h * 128 + d0 * 16 + hi * 8);
    f32x16 p0 = {}, p1 = {};
#pragma unroll
    for (int d0 = 0; d0 < 8; ++d0) {
#pragma unroll
        for (int half = 0; half < 2; ++half) { const float* kp = KMF + (size_t)(h * NBLK + half * 32 + r32) * 128 + d0 * 16 + hi * 8;
            const f32x4 a = *(const GAS f32x4*)kp, b = *(const GAS f32x4*)(kp + 4); const float v[8] = {a[0], a[1], a[2], a[3], b[0], b[1], b[2], b[3]};
            bf16x8 fh, fl;
#pragma unroll
            for (int j = 0; j < 8; ++j) { const unsigned hb_ = f2bf(v[j]); fh[j] = (short)hb_; fl[j] = (short)f2bf(v[j] - __uint_as_float(hb_ << 16)); }
            if (half == 0) { p0 = __builtin_amdgcn_mfma_f32_32x32x16_bf16(fh, qr[d0], p0, 0, 0, 0); p0 = __builtin_amdgcn_mfma_f32_32x32x16_bf16(fl, qr[d0], p0, 0, 0, 0); }
            else { p1 = __builtin_amdgcn_mfma_f32_32x32x16_bf16(fh, qr[d0], p1, 0, 0, 0); p1 = __builtin_amdgcn_mfma_f32_32x32x16_bf16(fl, qr[d0], p1, 0, 0, 0); } } }
    const float NEG = -__builtin_inff();
    float tv0 = NEG, tv1 = NEG, tv2 = NEG; int ti0 = 1000, ti1 = 1001, ti2 = 1002;
#pragma unroll
    for (int r = 0; r < 16; ++r) { const int n = (r & 3) + 8 * (r >> 2) + 4 * hi; TOP3_INS(n < qb ? p0[r] : NEG, n); }
#pragma unroll
    for (int r = 0; r < 16; ++r) { const int n = 32 + (r & 3) + 8 * (r >> 2) + 4 * hi; TOP3_INS(n < qb ? p1[r] : NEG, n); }
    { const float ov0 = __shfl_xor(tv0, 32), ov1 = __shfl_xor(tv1, 32), ov2 = __shfl_xor(tv2, 32);
      const int oi0 = __shfl_xor(ti0, 32), oi1 = __shfl_xor(ti1, 32), oi2 = __shfl_xor(ti2, 32);
      TOP3_INS(ov0, oi0); TOP3_INS(ov1, oi1); TOP3_INS(ov2, oi2); }
    const bool act = (hi == 0);
    const bool ok0 = act && tv0 > NEG, ok1 = act && tv1 > NEG, ok2 = act && tv2 > NEG;
    unsigned rk0 = 0, rk1 = 0, rk2 = 0;
    if (ok0) rk0 = atomicAdd((unsigned*)(cntL + ti0), 1u);
    if (ok1) rk1 = atomicAdd((unsigned*)(cntL + ti1), 1u);
    if (ok2) rk2 = atomicAdd((unsigned*)(cntL + ti2), 1u);
    if (act) { float* ml = PML + (size_t)((s * 16 + h) * 4) * 2;
        if (!ok0) { ml[0] = -1e30f; ml[1] = 0.f; } if (!ok1) { ml[2] = -1e30f; ml[3] = 0.f; } if (!ok2) { ml[4] = -1e30f; ml[5] = 0.f; } }
    __syncthreads();
    if (tid < 64) { const unsigned n = cntL[tid]; baseL[tid] = n ? atomicAdd(gcnt + h * NBLK + tid, n) : 0u; }
    __syncthreads();
    unsigned* lh = list + (size_t)h * LIST_PER_HEAD;
    if (ok0) lh[list_off(ti0) + baseL[ti0] + rk0] = (unsigned)s | (0u << 16);
    if (ok1) lh[list_off(ti1) + baseL[ti1] + rk1] = (unsigned)s | (1u << 16);
    if (ok2) lh[list_off(ti2) + baseL[ti2] + rk2] = (unsigned)s | (2u << 16);
    __syncthreads();
}
#if PROBE_PHASE == 500
constexpr int CW_FAIL = 8;
__device__ __forceinline__ float blk_reduce(float v, bool domax, float* red, int tid) {
#pragma unroll
    for (int o = 1; o < 64; o <<= 1) { const float y = __shfl_xor(v, o); v = domax ? fmaxf(v, y) : v + y; }
    __syncthreads();
    if ((tid & 63) == 0) red[tid >> 6] = v;
    __syncthreads();
    float r = red[0];
    for (int w = 1; w < 8; ++w) r = domax ? fmaxf(r, red[w]) : r + red[w];
    return r;
}
__device__ __forceinline__ float bfv(const bf16* p) { return __uint_as_float(((unsigned)*p) << 16); }
__device__ __forceinline__ int sample_row(int i) {
    const int fixed[16] = {0, 1, 31, 32, 63, 64, 255, 256, 257, 511, 512, 767, 1023, 8191, 16383, 16128};
    if (i < 16) return fixed[i];
    return (int)(((unsigned)i * 2654435761u) >> 18) & 16383;
}
__device__ __forceinline__ void selfcheck(unsigned char* lds, unsigned char* ws, const int* pos, const bf16* OBc, int G, int bid) {
    const int tid = threadIdx.x;
    float* lg = (float*)lds;
    float* red = (float*)(lds + 65536);
    float* po = (float*)(lds + 65536 + 64);
    float* gate = (float*)(lds + 65536 + 64 + 2048);
    int* sel = (int*)(lds + 65536 + 64 + 2048 + 256);
    gu32* ctl = (gu32*)(ws + WS_CTL);
    bf16* KR = (bf16*)(ws + WS_KR); bf16* QB = (bf16*)(ws + WS_QB); bf16* KB = (bf16*)(ws + WS_KB); bf16* VB = (bf16*)(ws + WS_VB);
    bf16* QM = (bf16*)(ws + WS_QM); bf16* KV = (bf16*)(ws + WS_KV); bf16* OA = (bf16*)(ws + WS_OA); float* BIAS = (float*)(ws + WS_BIAS);
    unsigned nbad = 0;
    for (int u = bid; u < 64 * 16; u += G) { const int s = sample_row(u >> 4), h = u & 15;
        { const bf16* q = QM + (size_t)s * QUP + h * 192; float mx = -1e30f;
          for (int k = tid; k <= s; k += 512) { const bf16* kn = KV + (size_t)k * KVUP + h * 256; const bf16* kr = KR + (size_t)k * 64; float a = 0.f;
              for (int d = 0; d < 128; ++d) a += bfv(q + d) * bfv(kn + d);
              for (int d = 0; d < 64; ++d) a += bfv(q + 128 + d) * bfv(kr + d);
              a *= 0.07216878364870322f; lg[k] = a; mx = fmaxf(mx, a); }
          mx = blk_reduce(mx, true, red, tid);
          float sm = 0.f; for (int k = tid; k <= s; k += 512) { const float p = expf(lg[k] - mx); lg[k] = p; sm += p; }
          sm = blk_reduce(sm, false, red, tid);
          const int d = tid & 127, part = tid >> 7; float o = 0.f;
          for (int k = part; k <= s; k += 4) o += lg[k] * bfv(KV + (size_t)k * KVUP + h * 256 + 128 + d);
          po[part * 128 + d] = o; __syncthreads();
          float amax = 0.f;
          if (tid < 128) { const float ref = (po[tid] + po[128 + tid] + po[256 + tid] + po[384 + tid]) / sm; po[tid] = ref; amax = fabsf(ref); }
          amax = blk_reduce(amax, true, red, tid);
          if (tid < 128) { const float got = bfv(OA + (size_t)s * MLAOUT + h * 128 + tid); if (!(fabsf(got - po[tid]) <= SELFCHECK_REL * amax + SELFCHECK_ABS)) nbad++; }
          __syncthreads(); }
        { const bf16* q = QB + (size_t)s * MOBAW + h * 128; const int qb = s >> 8; const int d = tid & 127, part = tid >> 7;
          for (int n = 0; n < qb; ++n) { float a = 0.f;
              for (int r = part * 64; r < part * 64 + 64; ++r) a += bfv(KB + (size_t)(n * 256 + r) * MOBAW + h * 128 + d);
              a = a * (1.f / 256.f) * bfv(q + d);
              a = blk_reduce(a, false, red, tid);
              if (tid == 0) gate[n] = a; }
          __syncthreads();
          if (tid == 0) { float g0 = -1e30f, g1 = -1e30f, g2 = -1e30f; int i0 = -1, i1 = -1, i2 = -1;
              for (int n = 0; n < qb; ++n) { const float g = gate[n];
                  if (g > g0) { g2 = g1; i2 = i1; g1 = g0; i1 = i0; g0 = g; i0 = n; } else if (g > g1) { g2 = g1; i2 = i1; g1 = g; i1 = n; } else if (g > g2) { g2 = g; i2 = n; } }
              sel[0] = i0; sel[1] = i1; sel[2] = i2; sel[3] = qb; }
          __syncthreads();
          float mx = -1e30f; const int pq = pos[s];
          for (int e = tid; e < 1024; e += 512) { const int j = e >> 8, kk = e & 255; const int blk = sel[j]; float a = -1e30f;
              if (blk >= 0) { const int key = blk * 256 + kk;
                  if (j < 3 || key <= s) { const bf16* kp = KB + (size_t)key * MOBAW + h * 128; float dsum = 0.f;
                      for (int dd = 0; dd < 128; ++dd) dsum += bfv(q + dd) * bfv(kp + dd);
                      int dist = pq - pos[key]; dist = dist < 0 ? 0 : (dist > 128 ? 128 : dist);
                      a = dsum * (0.08838834764831845f * 1.4426950408889634f) + BIAS[h * 132 + dist]; } }
              lg[e] = a; mx = fmaxf(mx, a); }
          mx = blk_reduce(mx, true, red, tid);
          float sm = 0.f; for (int e = tid; e < 1024; e += 512) { const float p = lg[e] > -1e29f ? exp2f(lg[e] - mx) : 0.f; lg[e] = p; sm += p; }
          sm = blk_reduce(sm, false, red, tid);
          float o = 0.f;
          for (int e = part; e < 1024; e += 4) { const int blk = sel[e >> 8]; if (blk >= 0 && lg[e] > 0.f) o += lg[e] * bfv(VB + (size_t)(blk * 256 + (e & 255)) * MOBAW + h * 128 + d); }
          po[part * 128 + d] = o; __syncthreads();
          float amax = 0.f;
          if (tid < 128) { const float ref = (po[tid] + po[128 + tid] + po[256 + tid] + po[384 + tid]) / sm; po[tid] = ref; amax = fabsf(ref); }
          amax = blk_reduce(amax, true, red, tid);
          if (tid < 128) { const float got = bfv(OBc + (size_t)s * MOBAW + h * 128 + tid); if (!(fabsf(got - po[tid]) <= SELFCHECK_REL * amax + SELFCHECK_ABS)) nbad++; }
          __syncthreads(); }
    }
    if (nbad) atomicAdd((unsigned*)(ctl + CW_FAIL), nbad);
}
#endif
struct NoConv { __device__ __forceinline__ void operator()(int, int, unsigned char*) const {} };
struct P7Conv {
    const Args& args; int vcu;
    __device__ __forceinline__ void operator()(int s, int wave, unsigned char* lds) const { int lane_ = lane_id_(); asm volatile("" : "+v"(lane_)); const int lane = lane_;
        unsigned char* ws = args.ws; const int NGW = (int)gridDim.x * NWAVES, gw = vcu * NWAVES + wave;
        LAS unsigned char* T = (LAS unsigned char*)lds + RING_OFF + wave * 8704;
        cvt_job<1>(args.in[16], DM, NFF2, (bf16*)(ws + WS_WFI2), NFF2 / 64, T, gw, NGW, lane, nullptr, NFF2, -1, (const float*)(ws + WS_CPART) + NFF2, 2 * NFF2, (float*)(ws + WS_CMAXF) + NFF2, s, 4);
        cvt_job<0>(args.in[12], MLAOUT, DM, (bf16*)(ws + WS_WBRA), DM / 64, T, gw, NGW, lane, nullptr, FP8_BR ? DM : 0, FP8_BR ? 5 : -1, nullptr, 0, nullptr, (s + 1) & 3, 4);
        cvt_job<0>(args.in[13], MOBAW, DM, (bf16*)(ws + WS_WBRB), DM / 64, T, gw, NGW, lane, nullptr, FP8_BR ? DM : 0, FP8_BR ? 5 : -1, nullptr, 0, nullptr, (s + 2) & 3, 4);
        cvt_job<0>(args.in[14], DM, DM, (bf16*)(ws + WS_WOUT), DM / 64, T, gw, NGW, lane, nullptr, FP8_OUT ? DM : 0, FP8_OUT ? 6 : -1, nullptr, 0, nullptr, (s + 1) & 3, 4); }
};
template <int WHICH, class Conv>
__device__ __forceinline__ void p7_attention(unsigned char* lds, unsigned char* ws, const int* pos, int G, int bid, int wv, Conv conv) {
    int tid_ = wv * 64 + lane_id_(); asm volatile("" : "+v"(tid_)); const int tid = tid_, lane = tid & 63, wave = wv;
    gu32* ctl = (gu32*)(ws + WS_CTL); unsigned* GCNT = (unsigned*)(ctl + CW_GCNT);
    bf16* KR = (bf16*)(ws + WS_KR); bf16* QB = (bf16*)(ws + WS_QB); bf16* KB = (bf16*)(ws + WS_KB); bf16* VB = (bf16*)(ws + WS_VB);
    bf16* QM = (bf16*)(ws + WS_QM); bf16* KV = (bf16*)(ws + WS_KV); bf16* OA = (bf16*)(ws + WS_OA);
    float* BIAS = (float*)(ws + WS_BIAS); int* TPMAX = (int*)(ws + WS_TPMAX);
    unsigned* LIST = (unsigned*)(ws + WS_LIST); float* PML = (float*)(ws + WS_PML); bf16* PO = (bf16*)(ws + WS_PO);
        float* biasL = (float*)(lds + att::L_BIAS); unsigned* pref = (unsigned*)(lds + att::L_PREF); unsigned* wtot = pref + 1028;
        for (int i = tid; i < 16 * 132; i += NWAVES * 64) biasL[i] = BIAS[i];
        unsigned* cntS = (unsigned*)(lds + att::L_CNT);
        { const unsigned ca = __hip_atomic_load(GCNT + 2 * tid, RLX_AGENT), cb = __hip_atomic_load(GCNT + 2 * tid + 1, RLX_AGENT); cntS[2 * tid] = ca; cntS[2 * tid + 1] = cb;
          const unsigned a = (ca + 255u) >> 8, b = (cb + 255u) >> 8;
          unsigned s = a + b;
#pragma unroll
          for (int o_ = 1; o_ < 64; o_ <<= 1) { const unsigned y = __shfl_up(s, o_); if (lane >= o_) s += y; }
          if (lane == 63) wtot[wave] = s;
          __syncthreads();
          unsigned offs = 0; for (int w = 0; w < wave; ++w) offs += wtot[w];
          const unsigned incl = s + offs; pref[2 * tid] = incl - a - b; pref[2 * tid + 1] = incl - b; if (tid == NWAVES * 64 - 1) pref[1024] = incl; }
        __syncthreads();
        const int U = (int)pref[1024];
        int cslot = 0;
        const float c2_mla = 0.07216878364870322f * 1.4426950408889634f;
        const float c2_moba = 0.08838834764831845f * 1.4426950408889634f;
        if constexpr (WHICH & 1) for (int p = bid; p < 512; p += G) { const int h = p & 15, xx = p >> 4;
#pragma unroll 1
            for (int k = 0; k < 2; ++k) { const int qb = k ? xx : 63 - xx;
                att::UnitArgs A; A.Q = QM + h * 192; A.qpitch = QUP; A.K = KV + h * 256; A.kpitch = KVUP; A.Kr = KR; A.Q8 = ws + WS_QM8 + h * 192; A.K8 = ws + WS_KN8 + h * 128; A.Kr8 = ws + WS_KR8; A.V8 = ws + WS_V8 + (size_t)h * 256 * 8192; A.V = KV + h * 256 + 128; A.vpitch = KVUP;
                A.O = OA + h * 128; A.opitch = MLAOUT; A.PO = nullptr; A.PML = nullptr; A.pos = pos; A.tpmax = TPMAX; A.list = nullptr; A.nrows = 256;
                A.q0 = qb * 256; A.k0 = 0; A.NT = 4 * (qb + 1); A.h = h; A.c2 = c2_mla;
                att::attn_unit<192, 0>(A, (char*)lds, wv);
                if (cslot < 4) { conv(cslot++, wv, lds); __syncthreads(); } } }
        if constexpr (WHICH & 1) while (cslot < 4) { conv(cslot++, wv, lds); __syncthreads(); }
        if constexpr (WHICH & 2) { int cb = (int)(((long)bid * U) / G); const int ce = (int)(((long)(bid + 1) * U) / G);
            if (cb < ce) { int lo = 0, hi_ = 1024;
                while (hi_ - lo > 1) { const int mid = (lo + hi_) >> 1; if (pref[mid] <= (unsigned)cb) lo = mid; else hi_ = mid; }
#pragma unroll 1
                while (cb < ce) { while ((int)pref[lo + 1] <= cb) ++lo;
                    const int h = lo >> 6, kb = lo & 63, first = cb - (int)pref[lo], nch = min(ce, (int)pref[lo + 1]) - cb;
                    const int cnt = (int)cntS[lo];
                    att::UnitArgs A; A.Q = QB + h * 128; A.qpitch = MOBAW; A.K = KB + h * 128; A.kpitch = MOBAW; A.Kr = nullptr; A.Q8 = ws + WS_QB8 + h * 128; A.K8 = ws + WS_KB8 + h * 128; A.Kr8 = nullptr; A.V8 = ws + WS_VB8 + (size_t)h * 256 * 8192; A.V = VB + h * 128; A.vpitch = MOBAW;
                    A.O = nullptr; A.opitch = 0; A.PO = PO; A.PML = PML; A.pos = pos; A.tpmax = TPMAX;
                    A.list = LIST + (size_t)h * LIST_PER_HEAD + list_off(kb) + first * 256; A.nrows = min(cnt - first * 256, nch * 256);
                    A.q0 = 0; A.k0 = kb * 256; A.NT = 4; A.h = h; A.c2 = c2_moba;
                    att::moba_unit<1>(A, (char*)lds, wv, nch); cb += nch; } } }
        if constexpr (WHICH & 4) for (int u = bid; u < NBLK * NH; u += G) { const int h = u & 15, qb = u >> 4;
            att::UnitArgs A; A.Q = QB + h * 128; A.qpitch = MOBAW; A.K = KB + h * 128; A.kpitch = MOBAW; A.Kr = nullptr; A.Q8 = ws + WS_QB8 + h * 128; A.K8 = ws + WS_KB8 + h * 128; A.Kr8 = nullptr; A.V8 = ws + WS_VB8 + (size_t)h * 256 * 8192; A.V = VB + h * 128; A.vpitch = MOBAW;
            A.O = nullptr; A.opitch = 0; A.PO = PO; A.PML = PML; A.pos = pos; A.tpmax = TPMAX; A.list = nullptr; A.nrows = 256;
            A.q0 = qb * 256; A.k0 = qb * 256; A.NT = 4; A.h = h; A.c2 = c2_moba;
            att::moba_unit<2>(A, (char*)lds, wv, 1); }
}
__global__ void __launch_bounds__(NWAVES * 64, 2) hybrid_fwd(Args args) {
    extern __shared__ __attribute__((aligned(16))) unsigned char lds[];
    LAS unsigned char* ldsl = (LAS unsigned char*)lds;
    volatile LAS unsigned* MISC = (volatile LAS unsigned*)(ldsl + MISC_OFF);
    const int tid = threadIdx.x, lane = tid & 63, wave = __builtin_amdgcn_readfirstlane(tid >> 6);
    const int G = gridDim.x, bid = blockIdx.x;
    const int vcu = (G % 8 == 0) ? (bid % 8) * (G / 8) + bid / 8 : bid;
    const int gw = vcu * NWAVES + wave, NGW = G * NWAVES;
    unsigned char* ws = args.ws;
    gu32* ctl = (gu32*)(ws + WS_CTL);
    for (int u = tid; u < (LDS_BYTES - LDSCTL_OFF) / 4; u += NWAVES * 64) ((LAS unsigned*)(ldsl + LDSCTL_OFF))[u] = 0u;
    __syncthreads();
    XcdBarrier bar = xcd_barrier_post((unsigned*)(ctl + CW_BAR), MISC + 8, wave);
#if PROBE_PHASE == 99
#define GRID_BAR() do { xcd_barrier(bar, wave); xcd_barrier(bar, wave); } while (0)
#else
#define GRID_BAR() xcd_barrier(bar, wave)
#endif
    const float* x = args.in[0]; const int* pos = (const int*)args.in[1]; const float* rel_bias = args.in[2];
    float* out = args.out;
    bf16* WFI = (bf16*)(ws + WS_WFFN_IN); bf16* WFO = (bf16*)(ws + WS_WFFN_OUT); bf16* WIN = (bf16*)(ws + WS_WIN); bf16* WUQ = (bf16*)(ws + WS_WUQ);
    bf16* WUKV = (bf16*)(ws + WS_WUKV); bf16* WBRA = (bf16*)(ws + WS_WBRA); bf16* WBRB = (bf16*)(ws + WS_WBRB); bf16* WOUT = (bf16*)(ws + WS_WOUT);
    bf16* H = (bf16*)(ws + WS_H); bf16* ACT = (bf16*)(ws + WS_BIG);
    bf16* CQ = (bf16*)(ws + WS_CQ); bf16* CKV = (bf16*)(ws + WS_CKV); bf16* KR = (bf16*)(ws + WS_KR); bf16* QB = (bf16*)(ws + WS_QB); bf16* KB = (bf16*)(ws + WS_KB);
    bf16* VB = (bf16*)(ws + WS_VB); bf16* GA = (bf16*)(ws + WS_GA); bf16* GB = (bf16*)(ws + WS_GB);
    bf16* QM = (bf16*)(ws + WS_QM); bf16* KV = (bf16*)(ws + WS_KV); bf16* OA = (bf16*)(ws + WS_OA);
    float* COS = (float*)(ws + WS_COS); float* SIN = (float*)(ws + WS_SIN);
    bf16* KMH = (bf16*)(ws + WS_KMH); bf16* KML = (bf16*)(ws + WS_KML); float* BIAS = (float*)(ws + WS_BIAS); int* TPMAX = (int*)(ws + WS_TPMAX);
    unsigned* LIST = (unsigned*)(ws + WS_LIST); float* PML = (float*)(ws + WS_PML); bf16* PO = (bf16*)(ws + WS_PO);
    unsigned* GCNT = (unsigned*)(ctl + CW_GCNT);
    float* PART = (float*)(ws + WS_PART); float* RSTD = (float*)(ws + WS_RSTD); float* PARTQ = (float*)(ws + WS_PARTQ); float* PARTKV = (float*)(ws + WS_PARTKV);
    float* RSTDQ = (float*)(ws + WS_RSTDQ); float* RSTDKV = (float*)(ws + WS_RSTDKV); bf16* H3 = GB; (void)RSTDQ; (void)RSTDKV;
    float* CPART = (float*)(ws + WS_CPART); float* CMAXF = (float*)(ws + WS_CMAXF); const float* CMAX1 = CMAXF; const float* CMAX2 = CMAXF + NFF2; float* PMAX = (float*)(ws + WS_PMAX);
    unsigned char* H8 = ws + WS_H8; unsigned char* OA8 = ws + WS_OA8; unsigned char* OB8 = ws + WS_OB8; unsigned char* MG8 = ws + WS_MG8; unsigned char* WIN8 = ws + WS_WIN8;
#if PROBE_PHASE == 500
    bf16* OBC = (bf16*)(ws + ((WS_END + 4095) / 4096) * 4096);
#else
    bf16* OBC = QB;
#endif
    LAS unsigned char* cvtT = ldsl + RING_OFF + wave * 8704;

    { int tid_f = wave * 64 + lane_id_(); asm volatile("" : "+v"(tid_f)); const int tid = tid_f, lane = tid & 63; (void)lane; (void)tid;
    {
    colmax_job(args.in[4], DM, NFF2, CPART, 2 * NFF2, gw, NGW, lane); colmax_job(args.in[16], DM, NFF2, CPART + NFF2, 2 * NFF2, gw, NGW, lane);
    cvt_job<2>(args.in[7], DM, INCOLS, WIN, INPAD1 / 64, cvtT, gw, NGW, lane, nullptr, INPAD1);
    cvt_job<4>(args.in[7], DM, INCOLS, (bf16*)WIN8, IN2 / 64, cvtT, gw, NGW, lane, nullptr, IN2, 6);
    cvt_job<3>(args.in[9], QLORA, QUP, WUQ, QUP / 64, cvtT, gw, NGW, lane, args.in[8]);
    cvt_job<0>(args.in[11], KVLORA, KVUP, WUKV, KVUP / 64, cvtT, gw, NGW, lane, args.in[10]);
    for (int idx = vcu * (NWAVES * 64) + tid; idx < M_ * 32; idx += G * NWAVES * 64) { const int s = idx >> 5, i = idx & 31;
        float sn, cs; sincos_d((double)pos[s] * args.invf[i], sn, cs); COS[idx] = cs; SIN[idx] = sn; }
    for (int idx = vcu * (NWAVES * 64) + tid; idx < 16 * 132; idx += G * NWAVES * 64) { const int h = idx / 132, d = idx - h * 132;
        BIAS[idx] = d <= 128 ? rel_bias[(int)args.bucket[d] * NH + h] * 1.4426950408889634f : 0.f; }
    for (int t = gw; t < 256; t += NGW) { int p = pos[t * 64 + lane];
#pragma unroll
        for (int o_ = 1; o_ < 64; o_ <<= 1) p = max(p, __shfl_xor(p, o_));
        if (lane == 0) TPMAX[t] = p; }
    for (int m = gw; m < M_; m += NGW) rms_row4096_i8(x + (size_t)m * DM, args.in[3], H8, m, RSTD, lane);
    }
#if PROBE_PHASE == 0
    {
    colmax_job(args.in[4], DM, NFF2, CPART, 2 * NFF2, gw, NGW, lane); colmax_job(args.in[16], DM, NFF2, CPART + NFF2, 2 * NFF2, gw, NGW, lane);
    cvt_job<2>(args.in[7], DM, INCOLS, WIN, INPAD1 / 64, cvtT, gw, NGW, lane, nullptr, INPAD1);
    cvt_job<4>(args.in[7], DM, INCOLS, (bf16*)WIN8, IN2 / 64, cvtT, gw, NGW, lane, nullptr, IN2, 6);
    cvt_job<3>(args.in[9], QLORA, QUP, WUQ, QUP / 64, cvtT, gw, NGW, lane, args.in[8]);
    cvt_job<0>(args.in[11], KVLORA, KVUP, WUKV, KVUP / 64, cvtT, gw, NGW, lane, args.in[10]);
    for (int idx = vcu * (NWAVES * 64) + tid; idx < M_ * 32; idx += G * NWAVES * 64) { const int s = idx >> 5, i = idx & 31;
        float sn, cs; sincos_d((double)pos[s] * args.invf[i], sn, cs); COS[idx] = cs; SIN[idx] = sn; }
    for (int idx = vcu * (NWAVES * 64) + tid; idx < 16 * 132; idx += G * NWAVES * 64) { const int h = idx / 132, d = idx - h * 132;
        BIAS[idx] = d <= 128 ? rel_bias[(int)args.bucket[d] * NH + h] * 1.4426950408889634f : 0.f; }
    for (int t = gw; t < 256; t += NGW) { int p = pos[t * 64 + lane];
#pragma unroll
        for (int o_ = 1; o_ < 64; o_ <<= 1) p = max(p, __shfl_xor(p, o_));
        if (lane == 0) TPMAX[t] = p; }
    for (int m = gw; m < M_; m += NGW) rms_row4096_i8(x + (size_t)m * DM, args.in[3], H8, m, RSTD, lane);
    }
#endif
    }
    GRID_BAR();
#if PROBE_PHASE == 300
    {
        const bf16x8 fa = *(const GAS bf16x8*)(H + (size_t)(bid * 512 + tid) * 8), fb = *(const GAS bf16x8*)(H + (size_t)(bid * 512 + tid) * 8 + 65536);
        f32x4 ac[8];
#pragma unroll
        for (int i = 0; i < 8; ++i) ac[i] = (f32x4){0.f, 0.f, 0.f, 0.f};
#pragma unroll 1
        for (int it = 0; it < 5120; ++it) {
#pragma unroll
            for (int i = 0; i < 8; ++i) ac[i] = __builtin_amdgcn_mfma_f32_16x16x32_bf16(fa, fb, ac[i], 0, 0, 0); }
        float sacc = 0.f;
#pragma unroll
        for (int i = 0; i < 8; ++i) sacc += ac[i][0] + ac[i][1] + ac[i][2] + ac[i][3];
        if (sacc == 12345.678f) out[0] = 1.f;
    }
#endif
    { int tid_f = wave * 64 + lane_id_(); asm volatile("" : "+v"(tid_f)); const int lane = tid_f & 63;
      cvt_job<1>(args.in[4], DM, NFF2, WFI, NFF2 / 64, cvtT, gw, NGW, lane, nullptr, NFF2, -1, CPART, 2 * NFF2, CMAXF); }
    GRID_BAR();
    { pg8::Gemm g{(const bf16*)H8, WFI, M_, NFF2, DM / 2}; pg8::StaticOrder S; S.init(M_, NFF2, G, bid); pg8::EpiSwiglu E{ACT, DFF, RSTD, M_, CMAX1};
      pg8::gemm_phase<pg8::EpiSwiglu, pg8::StaticOrder, true, true, true, false, true>(ldsl + RING_OFF, g, S, E, wave); }
#if PROBE_PHASE == 1
    { pg8::Gemm g{(const bf16*)H8, WFI, M_, NFF2, DM / 2}; pg8::StaticOrder S; S.init(M_, NFF2, G, bid); pg8::EpiSwiglu E{ACT, DFF, RSTD, M_, CMAX1};
      pg8::gemm_phase<pg8::EpiSwiglu, pg8::StaticOrder, true, true, true, false, true>(ldsl + RING_OFF, g, S, E, wave); }
#endif
    if (G == 256 && bid >= 128) { int tid_f = wave * 64 + lane_id_(); asm volatile("" : "+v"(tid_f)); const int lane = tid_f & 63;
        cvt_job<0>(args.in[5], DFF, DM, WFO, DM / 64, cvtT, (bid - 128) * NWAVES + wave, 128 * NWAVES, lane, nullptr, DM); }
    else if (G != 256) { int tid_f = wave * 64 + lane_id_(); asm volatile("" : "+v"(tid_f)); const int lane = tid_f & 63; cvt_job<0>(args.in[5], DFF, DM, WFO, DM / 64, cvtT, gw, NGW, lane, nullptr, DM); }
    GRID_BAR();
    { pg8::Gemm g{ACT, WFO, M_, DM, DFF}; pg8::StaticOrder S; S.init(M_, DM, G, bid); pg8::EpiResidNorm<(long)WS_H8 - (long)WS_H> E{x, out, 0.5f, H, args.in[6], PART, nullptr};
      pg8::gemm_phase<pg8::EpiResidNorm<(long)WS_H8 - (long)WS_H>, pg8::StaticOrder, true, true, true>(ldsl + RING_OFF, g, S, E, wave); }
#if PROBE_PHASE == 2
    { pg8::Gemm g{ACT, WFO, M_, DM, DFF}; pg8::StaticOrder S; S.init(M_, DM, G, bid); pg8::EpiResidNorm<(long)WS_H8 - (long)WS_H> E{x, out, 0.5f, H, args.in[6], PART, nullptr};
      pg8::gemm_phase<pg8::EpiResidNorm<(long)WS_H8 - (long)WS_H>, pg8::StaticOrder, true, true, true>(ldsl + RING_OFF, g, S, E, wave); }
#endif
#if PROBE_PHASE == 801 || PROBE_PHASE == 802
    GRID_BAR();
    { pg8::Gemm g{ACT, WFO, PROBE_PHASE == 801 ? M_ : 0, PROBE_PHASE == 801 ? DM : 0, DFF}; pg8::StaticOrder S; S.init(M_, DM, G, bid); pg8::EpiNull E{};
      pg8::gemm_phase<pg8::EpiNull, pg8::StaticOrder, true, true, true>(ldsl + RING_OFF, g, S, E, wave); }
#endif
#if PROBE_PHASE == 803 || PROBE_PHASE == 804
    GRID_BAR();
    { pg8::Gemm g{(const bf16*)H8, WFI, PROBE_PHASE == 803 ? M_ : 0, PROBE_PHASE == 803 ? NFF2 : 0, DM / 2}; pg8::StaticOrder S; S.init(M_, NFF2, G, bid); pg8::EpiNull E{};
      pg8::gemm_phase<pg8::EpiNull, pg8::StaticOrder, true, true, true, false, true>(ldsl + RING_OFF, g, S, E, wave); }
#endif
    GRID_BAR();
    { int tid_f = wave * 64 + lane_id_(); asm volatile("" : "+v"(tid_f)); const int tid = tid_f, lane = tid & 63; (void)lane; (void)tid;
    rstd_reduce<64>(PART, RSTD, 1.f / DM, vcu, tid, G);
#if PROBE_PHASE == 3 || PROBE_PHASE == 38
    rstd_reduce<64>(PART, RSTD, 1.f / DM, vcu, tid, G);
#endif
    }
    GRID_BAR();
    { pg8::Gemm g{H, WIN, M_, INPAD1, DM}; pg8::StaticOrder S; S.init(M_, INPAD1, G, bid);
      pg8::EpiProj<1> E{CQ, CKV, KR, QB, KB, VB, GA, GB, COS, SIN, RSTD, PARTQ, PARTKV, (float*)(ctl + CW_KMEAN), ws + WS_KR8, ws + WS_QB8, ws + WS_KB8, ws + WS_VB8, 1.0f};
      pg8::gemm_phase<pg8::EpiProj<1>, pg8::StaticOrder, true, true, true>(ldsl + RING_OFF, g, S, E, wave); }
    { pg8::Gemm g{(const bf16*)H8, (const bf16*)WIN8, M_, IN2, DM / 2}; pg8::StaticOrder S; S.init(M_, IN2, G, bid);
      pg8::EpiProj<2> E{CQ, CKV, KR, QB, KB, VB, GA, GB, COS, SIN, RSTD, PARTQ, PARTKV, (float*)(ctl + CW_KMEAN), ws + WS_KR8, ws + WS_QB8, ws + WS_KB8, ws + WS_VB8, 0.015625f};
      pg8::gemm_phase<pg8::EpiProj<2>, pg8::StaticOrder, true, true, true, true>(ldsl + RING_OFF, g, S, E, wave); }
    GRID_BAR();
    { LAS unsigned* cntL = (LAS unsigned*)(ldsl + RING_OFF); LAS unsigned* baseL = cntL + 64;
      for (int u = bid; u < NBLK * NH; u += G) moba_gate_unit(u & 15, u >> 4, QB, (const float*)(ctl + CW_KMEAN), GCNT, LIST, PML, cntL, baseL, wave); }
    { pg8::Gemm g{CQ, WUQ, M_, QUP, QLORA}; pg8::StaticOrder S; S.init(M_, QUP, G, bid); pg8::EpiQ E{MLA_BF16 ? QM : nullptr, COS, SIN, PARTQ, ws + WS_QM8};
      pg8::gemm_phase<pg8::EpiQ, pg8::StaticOrder, true, true>(ldsl + RING_OFF, g, S, E, wave); }
    { pg8::Gemm g{CKV, WUKV, M_, KVUP, KVLORA}; pg8::StaticOrder S; S.init(M_, KVUP, G, bid); pg8::EpiPlain E{MLA_BF16 ? KV : nullptr, KVUP, PARTKV, ws + WS_KN8, ws + WS_V8};
      pg8::gemm_phase<pg8::EpiPlain, pg8::StaticOrder, true, true>(ldsl + RING_OFF, g, S, E, wave); }
#if PROBE_PHASE == 6
    { pg8::Gemm g{CQ, WUQ, M_, QUP, QLORA}; pg8::StaticOrder S; S.init(M_, QUP, G, bid); pg8::EpiQ E{MLA_BF16 ? QM : nullptr, COS, SIN, PARTQ, ws + WS_QM8};
      pg8::gemm_phase<pg8::EpiQ, pg8::StaticOrder, true, true>(ldsl + RING_OFF, g, S, E, wave); }
    { pg8::Gemm g{CKV, WUKV, M_, KVUP, KVLORA}; pg8::StaticOrder S; S.init(M_, KVUP, G, bid); pg8::EpiPlain E{MLA_BF16 ? KV : nullptr, KVUP, PARTKV, ws + WS_KN8, ws + WS_V8};
      pg8::gemm_phase<pg8::EpiPlain, pg8::StaticOrder, true, true>(ldsl + RING_OFF, g, S, E, wave); }
#endif
    GRID_BAR();
#if I8_FFN2
    p7_attention<7>(lds, ws, pos, G, bid, wave, P7Conv{args, vcu});
#else
    p7_attention<7>(lds, ws, pos, G, bid, wave, NoConv{});
#endif
#if PROBE_PHASE == 7
    p7_attention<7>(lds, ws, pos, G, bid, wave, NoConv{});
#endif
#if PROBE_PHASE == 71
    p7_attention<1>(lds, ws, pos, G, bid, wave, NoConv{});
#endif
#if PROBE_PHASE == 72
    p7_attention<2>(lds, ws, pos, G, bid, wave, NoConv{});
#endif
#if PROBE_PHASE == 74
    p7_attention<4>(lds, ws, pos, G, bid, wave, NoConv{});
#endif
    GRID_BAR();
    { int tid_f = wave * 64 + lane_id_(); asm volatile("" : "+v"(tid_f)); const int tid = tid_f, lane = tid & 63; (void)lane; (void)tid;
    for (int it = gw; it < M_ * NH / 4; it += NGW) { const int pair = it * 4 + (lane >> 4), c8 = lane & 15;
        const f32x4 ml0 = *(const GAS f32x4*)(PML + (size_t)pair * 8), ml1 = *(const GAS f32x4*)(PML + (size_t)pair * 8 + 4);
        const float m[4] = {ml0.x, ml0.z, ml1.x, ml1.z}, l[4] = {ml0.y, ml0.w, ml1.y, ml1.w};
        float mx = -1e30f;
#pragma unroll
        for (int j = 0; j < 4; ++j) if (l[j] > 0.f) mx = fmaxf(mx, m[j]);
        float w[4], wsum = 0.f;
#pragma unroll
        for (int j = 0; j < 4; ++j) { w[j] = l[j] > 0.f ? __builtin_amdgcn_exp2f(m[j] - mx) * l[j] : 0.f; wsum += w[j]; }
        const float inv = 1.0f / wsum; float acc[8] = {0.f, 0.f, 0.f, 0.f, 0.f, 0.f, 0.f, 0.f};
#pragma unroll
        for (int j = 0; j < 4; ++j) { const v4u o = *(const GAS v4u*)(PO + ((size_t)pair * 4 + j) * 128 + c8 * 8); const float wj = w[j] * inv;
            if (w[j] > 0.f) {
#pragma unroll
                for (int e = 0; e < 4; ++e) { acc[2 * e] += wj * bfu_lo(o[e]); acc[2 * e + 1] += wj * bfu_hi(o[e]); } } }
        const int row = pair >> 4, h = pair & 15; v4u r; r.x = pk2(acc[0], acc[1]); r.y = pk2(acc[2], acc[3]); r.z = pk2(acc[4], acc[5]); r.w = pk2(acc[6], acc[7]);
        *(GAS v4u*)(OBC + (size_t)row * MOBAW + h * 128 + c8 * 8) = r;
        { int w0 = 0, w1 = 0;
          w0 = __builtin_amdgcn_cvt_pk_fp8_f32(acc[0] * 16.f, acc[1] * 16.f, w0, false); w0 = __builtin_amdgcn_cvt_pk_fp8_f32(acc[2] * 16.f, acc[3] * 16.f, w0, true);
          w1 = __builtin_amdgcn_cvt_pk_fp8_f32(acc[4] * 16.f, acc[5] * 16.f, w1, false); w1 = __builtin_amdgcn_cvt_pk_fp8_f32(acc[6] * 16.f, acc[7] * 16.f, w1, true);
          v2u q; q.x = (unsigned)w0; q.y = (unsigned)w1; *(GAS v2u*)(OB8 + ((size_t)h * M_ + row) * 128 + c8 * 8) = q; } }
    for (int it = gw * 64 + lane; it < M_ * MLAOUT / 8; it += NGW * 64) { const int row = it >> 8, c8 = it & 255;
        const v4u o = *(const GAS v4u*)(OA + (size_t)row * MLAOUT + c8 * 8); int w0 = 0, w1 = 0;
        w0 = __builtin_amdgcn_cvt_pk_fp8_f32(bfu_lo(o.x) * 16.f, bfu_hi(o.x) * 16.f, w0, false); w0 = __builtin_amdgcn_cvt_pk_fp8_f32(bfu_lo(o.y) * 16.f, bfu_hi(o.y) * 16.f, w0, true);
        w1 = __builtin_amdgcn_cvt_pk_fp8_f32(bfu_lo(o.z) * 16.f, bfu_hi(o.z) * 16.f, w1, false); w1 = __builtin_amdgcn_cvt_pk_fp8_f32(bfu_lo(o.w) * 16.f, bfu_hi(o.w) * 16.f, w1, true);
        v2u q; q.x = (unsigned)w0; q.y = (unsigned)w1; *(GAS v2u*)(OA8 + ((size_t)(c8 >> 4) * M_ + row) * 128 + (c8 & 15) * 8) = q; }
#if PROBE_PHASE == 8 || PROBE_PHASE == 38
    for (int it = gw; it < M_ * NH / 4; it += NGW) { const int pair = it * 4 + (lane >> 4), c8 = lane & 15;
        const f32x4 ml0 = *(const GAS f32x4*)(PML + (size_t)pair * 8), ml1 = *(const GAS f32x4*)(PML + (size_t)pair * 8 + 4);
        const float m[4] = {ml0.x, ml0.z, ml1.x, ml1.z}, l[4] = {ml0.y, ml0.w, ml1.y, ml1.w};
        float mx = -1e30f;
#pragma unroll
        for (int j = 0; j < 4; ++j) if (l[j] > 0.f) mx = fmaxf(mx, m[j]);
        float w[4], wsum = 0.f;
#pragma unroll
        for (int j = 0; j < 4; ++j) { w[j] = l[j] > 0.f ? __builtin_amdgcn_exp2f(m[j] - mx) * l[j] : 0.f; wsum += w[j]; }
        const float inv = 1.0f / wsum; float acc[8] = {0.f, 0.f, 0.f, 0.f, 0.f, 0.f, 0.f, 0.f};
#pragma unroll
        for (int j = 0; j < 4; ++j) { const v4u o = *(const GAS v4u*)(PO + ((size_t)pair * 4 + j) * 128 + c8 * 8); const float wj = w[j] * inv;
            if (w[j] > 0.f) {
#pragma unroll
                for (int e = 0; e < 4; ++e) { acc[2 * e] += wj * bfu_lo(o[e]); acc[2 * e + 1] += wj * bfu_hi(o[e]); } } }
        const int row = pair >> 4, h = pair & 15; v4u r; r.x = pk2(acc[0], acc[1]); r.y = pk2(acc[2], acc[3]); r.z = pk2(acc[4], acc[5]); r.w = pk2(acc[6], acc[7]);
        *(GAS v4u*)(OBC + (size_t)row * MOBAW + h * 128 + c8 * 8) = r;
        { int w0 = 0, w1 = 0;
          w0 = __builtin_amdgcn_cvt_pk_fp8_f32(acc[0] * 16.f, acc[1] * 16.f, w0, false); w0 = __builtin_amdgcn_cvt_pk_fp8_f32(acc[2] * 16.f, acc[3] * 16.f, w0, true);
          w1 = __builtin_amdgcn_cvt_pk_fp8_f32(acc[4] * 16.f, acc[5] * 16.f, w1, false); w1 = __builtin_amdgcn_cvt_pk_fp8_f32(acc[6] * 16.f, acc[7] * 16.f, w1, true);
          v2u q; q.x = (unsigned)w0; q.y = (unsigned)w1; *(GAS v2u*)(OB8 + ((size_t)h * M_ + row) * 128 + c8 * 8) = q; } }
    for (int it = gw * 64 + lane; it < M_ * MLAOUT / 8; it += NGW * 64) { const int row = it >> 8, c8 = it & 255;
        const v4u o = *(const GAS v4u*)(OA + (size_t)row * MLAOUT + c8 * 8); int w0 = 0, w1 = 0;
        w0 = __builtin_amdgcn_cvt_pk_fp8_f32(bfu_lo(o.x) * 16.f, bfu_hi(o.x) * 16.f, w0, false); w0 = __builtin_amdgcn_cvt_pk_fp8_f32(bfu_lo(o.y) * 16.f, bfu_hi(o.y) * 16.f, w0, true);
        w1 = __builtin_amdgcn_cvt_pk_fp8_f32(bfu_lo(o.z) * 16.f, bfu_hi(o.z) * 16.f, w1, false); w1 = __builtin_amdgcn_cvt_pk_fp8_f32(bfu_lo(o.w) * 16.f, bfu_hi(o.w) * 16.f, w1, true);
        v2u q; q.x = (unsigned)w0; q.y = (unsigned)w1; *(GAS v2u*)(OA8 + ((size_t)(c8 >> 4) * M_ + row) * 128 + (c8 & 15) * 8) = q; }
#endif
    }
    GRID_BAR();
#if PROBE_PHASE == 500
    selfcheck(lds, ws, pos, OBC, G, bid);
    GRID_BAR();
#endif
#if FP8_BR
    { pg8::Gemm g{(const bf16*)OA8, WBRA, M_, DM, MLAOUT / 2}; pg8::StaticOrder S; S.init(M_, DM, G, bid); pg8::EpiMerge<false> E{GA, H, nullptr, 0.001953125f};
      pg8::gemm_phase<pg8::EpiMerge<false>, pg8::StaticOrder, true, true, true, true>(ldsl + RING_OFF, g, S, E, wave); }
    { pg8::Gemm g{(const bf16*)OB8, WBRB, M_, DM, MOBAW / 2}; pg8::StaticOrder S; S.init(M_, DM, G, bid); pg8::EpiMerge<true> E{GB, H, FP8_OUT ? MG8 : nullptr, 0.001953125f};
      pg8::gemm_phase<pg8::EpiMerge<true>, pg8::StaticOrder, true, true, true, true>(ldsl + RING_OFF, g, S, E, wave); }
#else
    { pg8::Gemm g{OA, WBRA, M_, DM, MLAOUT}; pg8::StaticOrder S; S.init(M_, DM, G, bid); pg8::EpiMerge<false> E{GA, H, nullptr, 1.0f};
      pg8::gemm_phase<pg8::EpiMerge<false>, pg8::StaticOrder, true, true>(ldsl + RING_OFF, g, S, E, wave); }
    { pg8::Gemm g{OBC, WBRB, M_, DM, MOBAW}; pg8::StaticOrder S; S.init(M_, DM, G, bid); pg8::EpiMerge<true> E{GB, H, FP8_OUT ? MG8 : nullptr, 1.0f};
      pg8::gemm_phase<pg8::EpiMerge<true>, pg8::StaticOrder, true, true>(ldsl + RING_OFF, g, S, E, wave); }
#endif
    GRID_BAR();
#if FP8_OUT
    { pg8::Gemm g{(const bf16*)MG8, WOUT, M_, DM, DM / 2}; pg8::StaticOrder S; S.init(M_, DM, G, bid); pg8::EpiResidNorm<0> E{out, out, 0.0009765625f, H3, args.in[15], PART, PMAX};
      pg8::gemm_phase<pg8::EpiResidNorm<0>, pg8::StaticOrder, true, true, true, true>(ldsl + RING_OFF, g, S, E, wave); }
#else
    { pg8::Gemm g{H, WOUT, M_, DM, DM}; pg8::StaticOrder S; S.init(M_, DM, G, bid); pg8::EpiResidNorm<0> E{out, out, 1.0f, H3, args.in[15], PART, PMAX};
      pg8::gemm_phase<pg8::EpiResidNorm<0>, pg8::StaticOrder, true, true>(ldsl + RING_OFF, g, S, E, wave); }
#endif
    GRID_BAR();
    { int tid_f = wave * 64 + lane_id_(); asm volatile("" : "+v"(tid_f)); const int tid = tid_f, lane = tid & 63; (void)lane; (void)tid;
#if !I8_FFN2
    cvt_job<1>(args.in[16], DM, NFF2, WFI, NFF2 / 64, cvtT, gw, NGW, lane, nullptr, NFF2);
#endif
#if I8_FFN2
    for (int m = gw; m < M_; m += NGW) quant_row_i8(H3, PART, PMAX, H8, m, RSTD, lane);
#else
    rstd_reduce<64>(PART, RSTD, 1.f / DM, vcu, tid, G);
#endif
#if PROBE_PHASE == 11
#if !I8_FFN2
    cvt_job<1>(args.in[16], DM, NFF2, WFI, NFF2 / 64, cvtT, gw, NGW, lane, nullptr, NFF2);
#endif
#if I8_FFN2
    for (int m = gw; m < M_; m += NGW) quant_row_i8(H3, PART, PMAX, H8, m, RSTD, lane);
#else
    rstd_reduce<64>(PART, RSTD, 1.f / DM, vcu, tid, G);
#endif
#endif
    }
    GRID_BAR();
#if I8_FFN2
    { pg8::Gemm g{(const bf16*)H8, (const bf16*)(ws + WS_WFI2), M_, NFF2, DM / 2}; pg8::StaticOrder S; S.init(M_, NFF2, G, bid); pg8::EpiSwiglu E{ACT, DFF, RSTD, M_, CMAX2};
      pg8::gemm_phase<pg8::EpiSwiglu, pg8::StaticOrder, true, true, true, false, true>(ldsl + RING_OFF, g, S, E, wave); }
#else
    { pg8::Gemm g{H3, WFI, M_, NFF2, DM}; pg8::StaticOrder S; S.init(M_, NFF2, G, bid); pg8::EpiSwiglu E{ACT, DFF, RSTD, M_, nullptr};
      pg8::gemm_phase<pg8::EpiSwiglu, pg8::StaticOrder, true, true, true>(ldsl + RING_OFF, g, S, E, wave); }
#endif
    if (G == 256 && bid >= 128) { int tid_f = wave * 64 + lane_id_(); asm volatile("" : "+v"(tid_f)); const int lane = tid_f & 63;
        cvt_job<0>(args.in[17], DFF, DM, WFO, DM / 64, cvtT, (bid - 128) * NWAVES + wave, 128 * NWAVES, lane, nullptr, DM); }
    else if (G != 256) { int tid_f = wave * 64 + lane_id_(); asm volatile("" : "+v"(tid_f)); const int lane = tid_f & 63; cvt_job<0>(args.in[17], DFF, DM, WFO, DM / 64, cvtT, gw, NGW, lane, nullptr, DM); }
    GRID_BAR();
    { pg8::Gemm g{ACT, WFO, M_, DM, DFF}; pg8::StaticOrder S; S.init(M_, DM, G, bid); pg8::EpiResid E{out, out, DM, 0.5f};
      pg8::gemm_phase<pg8::EpiResid, pg8::StaticOrder, true, true, true>(ldsl + RING_OFF, g, S, E, wave); }
    GRID_BAR();
    { int tid_f = wave * 64 + lane_id_(); asm volatile("" : "+v"(tid_f)); const int tid = tid_f, lane = tid & 63; (void)lane; (void)tid;
#if PROBE_PHASE == 500
    if (__hip_atomic_load(ctl + CW_FAIL, RLX_AGENT) > SELFCHECK_TOL) { for (int m = gw; m < M_; m += NGW) for (int j = lane; j < DM; j += 64) out[(size_t)m * DM + j] = __builtin_nanf(""); return; }
#endif
    for (int m = gw; m < M_; m += NGW) rms_row4096<true>(out + (size_t)m * DM, args.in[18], out + (size_t)m * DM, lane);
    }
}

extern "C" void kernel_launch(void* const* d_in, const int* in_sizes, int n_in, void* d_out, int out_size, void* d_ws, size_t ws_size, hipStream_t stream) {
    static int grid = 0;
    if (grid == 0) {
        if (n_in != 19 || out_size != M_ * DM || ws_size < WS_END) { fprintf(stderr, "kernel_launch: unexpected shapes (n_in %d out %d ws %zu need %zu)\n", n_in, out_size, ws_size, (size_t)WS_END); grid = -1; return; }
        int dev = 0, cus = 0;
        if (hipGetDevice(&dev) != hipSuccess || hipDeviceGetAttribute(&cus, hipDeviceAttributeMultiprocessorCount, dev) != hipSuccess) { grid = -1; return; }
        if (hipFuncSetAttribute((const void*)hybrid_fwd, hipFuncAttributeMaxDynamicSharedMemorySize, LDS_BYTES) != hipSuccess) { fprintf(stderr, "kernel_launch: hipFuncSetAttribute failed\n"); grid = -1; return; }
        int per_cu = 0;
        if (hipOccupancyMaxActiveBlocksPerMultiprocessor(&per_cu, (const void*)hybrid_fwd, NWAVES * 64, LDS_BYTES) != hipSuccess || per_cu < 1) { fprintf(stderr, "kernel_launch: occupancy query says %d\n", per_cu); }
        (void)hipGetLastError();
        grid = cus;
    }
    if (grid < 0) return;
    if (hipMemsetAsync((char*)d_ws + WS_CTL, 0, CTL_ZERO_BYTES, stream) != hipSuccess) { fprintf(stderr, "kernel_launch: memset failed\n"); return; }
    Args a{};
    for (int i = 0; i < 19; ++i) a.in[i] = (const float*)d_in[i];
    a.out = (float*)d_out; a.ws = (unsigned char*)d_ws;
    for (int i = 0; i < 32; ++i) a.invf[i] = pow(10000.0, -(double)(2 * i) / 64.0);
    for (int d = 0; d < 136; ++d) { int b;
        if (d < 16) b = d; else { const double dd = d > 128 ? 128.0 : (double)d; b = 16 + (int)(log(dd / 16.0) / log(128.0 / 16.0) * 16.0); if (b > 31) b = 31; }
        a.bucket[d] = (unsigned char)b; }
    hipLaunchKernelGGL(hybrid_fwd, dim3(grid), dim3(NWAVES * 64), LDS_BYTES, stream, a);
    const hipError_t le = hipPeekAtLastError();
    if (le != hipSuccess) fprintf(stderr, "kernel_launch: launch failed: %s\n", hipGetErrorName(le));
}
```

```cpp
#ifndef CMP_REL
#define CMP_REL 0.03f
#define CMP_THR 0.2f
#define CMP_NBAD 0.f
#endif
#ifndef I8_FFN2
#define I8_FFN2 1
#endif
#ifndef FP8_BR
#define FP8_BR 1
#endif
#ifndef FP8_OUT
#define FP8_OUT 0
#endif
#ifndef PROBE_PHASE
#define PROBE_PHASE -1
#endif
#define MLA_BF16 (PROBE_PHASE == 500)
#ifndef SELFCHECK_REL
#define SELFCHECK_REL 0.03f
#define SELFCHECK_ABS 1e-4f
#endif
#ifndef SELFCHECK_TOL
#define SELFCHECK_TOL 0u
#endif
#include <hip/hip_runtime.h>
#include <cstdio>
#include <cstdint>
#include <cmath>
__device__ __forceinline__ int lane_id_() { return (int)__builtin_amdgcn_mbcnt_hi(~0u, __builtin_amdgcn_mbcnt_lo(~0u, 0u)); }
namespace pg8 {
#define PG8_LAS __attribute__((address_space(3)))
typedef unsigned short bf16_t;
typedef short bf16x8 __attribute__((ext_vector_type(8)));
typedef float f32x4 __attribute__((ext_vector_type(4)));
typedef unsigned u32x4 __attribute__((ext_vector_type(4)));
constexpr int BM = 256, BK = 64, HALF = 128, HTB = HALF * BK * 2  , STAGE_BYTES = 8 * HTB, NXCD = 8, WGM = 8;

__host__ __device__ __forceinline__ int lds_byte(int r, int c) { const int st = (r >> 4) * 2 + (c >> 5), rr = r & 15, cc = c & 31, ob = rr * 64 + cc * 2; return st * 1024 + (ob ^ (((ob >> 9) & 1) << 5)); }
__host__ __device__ __forceinline__ void stage_rc(int b, int& R, int& C) { const int st = b / 1024, sb = b % 1024, swz = sb ^ (((sb >> 9) & 1) << 5); R = (st >> 1) * 16 + swz / 64; C = (st & 1) * 32 + (swz % 64) / 2; }
__host__ __device__ __forceinline__ int perm32(int rho) { const int n = rho >> 4, i = rho & 15; return 8 * (i >> 2) + 4 * n + (i & 3); }

struct Unit { int pm, pn; };
struct Gemm { const bf16_t* A; const bf16_t* Bt; int M, N, K; };

struct StaticOrder {
    int nM, nN, nwg, G, c;
    __host__ __device__ void init(int M, int N, int G_, int c_) { nM = M / BM; nN = N / BM; nwg = nM * nN; G = G_; c = c_; }
    __host__ __device__ bool next(int i, Unit& u) const {
        const long L = (long)i * G + c; if (L >= nwg) return false;
        int wgid = (int)L; { const int q = nwg / NXCD, r = nwg % NXCD, xcd = wgid % NXCD, off = wgid / NXCD; wgid = (xcd < r ? xcd * (q + 1) : r * (q + 1) + (xcd - r) * q) + off; }
        const int nig = WGM * nN, gid = wgid / nig, fm = gid * WGM, gsz = (nM - fm) < WGM ? (nM - fm) : WGM;
        u.pm = fm + ((wgid % nig) % gsz); u.pn = (wgid % nig) / gsz; return true;
    }
    __device__ __forceinline__ void a_ready(const Unit&) const {}
    __device__ __forceinline__ void done(const Unit&) const {}
};

__device__ __forceinline__ unsigned cvt_pk_bf16(float lo, float hi) { unsigned r; asm volatile("v_cvt_pk_bf16_f32 %0, %1, %2" : "=v"(r) : "v"(lo), "v"(hi)); return r; }
typedef float f32x2 __attribute__((ext_vector_type(2)));
typedef unsigned u32x2 __attribute__((ext_vector_type(2)));
__device__ __forceinline__ float bf_lo(unsigned w) { return __uint_as_float(w << 16); }
__device__ __forceinline__ float bf_hi(unsigned w) { return __uint_as_float(w & 0xffff0000u); }
__device__ __forceinline__ float sigmoid_f(float x) { return __builtin_amdgcn_rcpf(1.0f + __builtin_amdgcn_exp2f(-1.4426950408889634f * x)); }
__device__ __forceinline__ u32x4 pack8f(f32x4 a, f32x4 b) { u32x4 w; w.x = cvt_pk_bf16(a[0], a[1]); w.y = cvt_pk_bf16(a[2], a[3]); w.z = cvt_pk_bf16(b[0], b[1]); w.w = cvt_pk_bf16(b[2], b[3]); return w; }

__device__ __forceinline__ unsigned pack4_fp8(f32x4 v) { int w = 0; w = __builtin_amdgcn_cvt_pk_fp8_f32(v[0], v[1], w, false); w = __builtin_amdgcn_cvt_pk_fp8_f32(v[2], v[3], w, true); return (unsigned)w; }
struct EpiPlain {
    static constexpr bool PERM = true, AFTER_DRAIN = false; __device__ __forceinline__ bool idem() const { return true; }
    bf16_t* O; int ldc; const float* part8; unsigned char* K8; unsigned char* V8;
    __device__ __forceinline__ void operator()(const f32x4 (&acc)[2][2][4][2], const Unit& u, int wr, int wc, int fr, int fq) const {
        const int row0 = u.pm * BM + wr * 64 + fr, col0 = u.pn * BM + wc * 32 + 8 * fq;
#pragma unroll
        for (int ai = 0; ai < 2; ++ai)
#pragma unroll
            for (int m = 0; m < 4; ++m) { const int row = row0 + ai * HALF + m * 16; bf16_t* rowp = O + (size_t)row * ldc + col0; float sc = 1.f;
                if (part8) { const f32x4* p = (const f32x4*)(part8 + (size_t)row * 8); const f32x4 a = p[0], b = p[1];
                    sc = 1.0f / sqrtf((((a[0] + a[1]) + (a[2] + a[3])) + ((b[0] + b[1]) + (b[2] + b[3]))) * (1.f / 512.f) + 1e-6f); }
#pragma unroll
                for (int bj = 0; bj < 2; ++bj) { const f32x4 v0 = acc[ai][bj][m][0] * sc, v1 = acc[ai][bj][m][1] * sc; if (O) *(u32x4*)(rowp + bj * HALF) = pack8f(v0, v1);
                    if (bj == 0 && K8) { u32x2 w8; w8.x = pack4_fp8(v0); w8.y = pack4_fp8(v1); *(u32x2*)(K8 + (size_t)row * 2048 + u.pn * 128 + wc * 32 + 8 * fq) = w8; }
                    if (bj == 1 && V8) { const int kk = row & 63; const unsigned w0 = pack4_fp8(v0), w1 = pack4_fp8(v1);
                        unsigned char* vp = V8 + ((size_t)(u.pn * 256 + (row >> 6)) * 128 + (wc * 32 + 8 * fq)) * 64 + (((kk >> 2) & 1) * 32 + (kk >> 5) * 16 + ((kk >> 3) & 3) * 4 + (kk & 3));
                        vp[0] = (unsigned char)w0; vp[64] = (unsigned char)(w0 >> 8); vp[128] = (unsigned char)(w0 >> 16); vp[192] = (unsigned char)(w0 >> 24);
                        vp[256] = (unsigned char)w1; vp[320] = (unsigned char)(w1 >> 8); vp[384] = (unsigned char)(w1 >> 16); vp[448] = (unsigned char)(w1 >> 24); } } }
    }
};
struct EpiSwiglu {
    static constexpr bool PERM = true, AFTER_DRAIN = false;
    bf16_t* O; int ldc; const float* rs; int tiledM; const float* cmax;
    __device__ __forceinline__ void operator()(const f32x4 (&acc)[2][2][4][2], const Unit& u, int wr, int wc, int fr, int fq) const {
        const int row0 = u.pm * BM + wr * 64 + fr, col0 = u.pn * HALF + wc * 32 + 8 * fq;
        f32x4 cg[2] = {{1.f, 1.f, 1.f, 1.f}, {1.f, 1.f, 1.f, 1.f}}, cu[2] = {{1.f, 1.f, 1.f, 1.f}, {1.f, 1.f, 1.f, 1.f}};
        if (cmax) {
#pragma unroll
            for (int n = 0; n < 2; ++n) { cg[n] = *(const f32x4*)(cmax + col0 + 4 * n) * (1.f / 127.f); cu[n] = *(const f32x4*)(cmax + (ldc + col0) + 4 * n) * (1.f / 127.f); } }
#pragma unroll
        for (int ai = 0; ai < 2; ++ai)
#pragma unroll
            for (int m = 0; m < 4; ++m) { const int row = row0 + ai * HALF + m * 16;
                bf16_t* rowp = tiledM ? O + ((size_t)(col0 >> 6) * tiledM + row) * 64 + (col0 & 63) : O + (size_t)row * ldc + col0;
                const float sc = rs ? rs[row] : 1.f;
                f32x4 h[2];
#pragma unroll
                for (int n = 0; n < 2; ++n) { f32x4 g = acc[ai][0][m][n], up = acc[ai][1][m][n];
                    if (cmax) { typedef int i32x4_t __attribute__((ext_vector_type(4)));
                        g = __builtin_convertvector(__builtin_bit_cast(i32x4_t, g), f32x4) * cg[n]; up = __builtin_convertvector(__builtin_bit_cast(i32x4_t, up), f32x4) * cu[n]; }
                    g = g * sc; up = up * sc;
#pragma unroll
                    for (int e = 0; e < 4; ++e) h[n][e] = g[e] * sigmoid_f(g[e]) * up[e]; }
                *(u32x4*)rowp = pack8f(h[0], h[1]); }
    }
};

struct EpiSwigluCmp {
    static constexpr bool PERM = true, AFTER_DRAIN = false;
    bf16_t* O; int ldc; int tiledM; float* stats; float thr;
    __device__ __forceinline__ void operator()(const f32x4 (&acc)[2][2][4][2], const Unit& u, int wr, int wc, int fr, int fq) const {
        const int row0 = u.pm * BM + wr * 64 + fr, col0 = u.pn * HALF + wc * 32 + 8 * fq; float sd = 0.f, sh = 0.f, nb = 0.f;
#pragma unroll
        for (int ai = 0; ai < 2; ++ai)
#pragma unroll
            for (int m = 0; m < 4; ++m) { const int row = row0 + ai * HALF + m * 16;
                bf16_t* rowp = O + ((size_t)(col0 >> 6) * tiledM + row) * 64 + (col0 & 63);
                const u32x4 old = *(const u32x4*)rowp; const float ov[8] = {bf_lo(old.x), bf_hi(old.x), bf_lo(old.y), bf_hi(old.y), bf_lo(old.z), bf_hi(old.z), bf_lo(old.w), bf_hi(old.w)};
                f32x4 h[2];
#pragma unroll
                for (int n = 0; n < 2; ++n) { const f32x4 g = acc[ai][0][m][n], up = acc[ai][1][m][n];
#pragma unroll
                    for (int e = 0; e < 4; ++e) { h[n][e] = g[e] * sigmoid_f(g[e]) * up[e]; const float d = h[n][e] - ov[4 * n + e]; sd += d * d; sh += h[n][e] * h[n][e]; nb += fabsf(d) > thr ? 1.f : 0.f; } }
                *(u32x4*)rowp = pack8f(h[0], h[1]); }
#pragma unroll
        for (int o = 1; o < 64; o <<= 1) { sd += __shfl_xor(sd, o); sh += __shfl_xor(sh, o); nb += __shfl_xor(nb, o); }
        if (fr == 0 && fq == 0) { atomicAdd(stats, sd); atomicAdd(stats + 1, sh); atomicAdd(stats + 2, nb); }
    }
};
struct EpiNull {
    static constexpr bool PERM = false, AFTER_DRAIN = false;
    __device__ __forceinline__ void operator()(const f32x4 (&acc)[2][2][4][2], const Unit&, int, int, int, int) const {
#pragma unroll
        for (int ai = 0; ai < 2; ++ai)
#pragma unroll
            for (int bj = 0; bj < 2; ++bj)
#pragma unroll
                for (int m = 0; m < 4; ++m)
#pragma unroll
                    for (int n = 0; n < 2; ++n) asm volatile("" :: "v"(acc[ai][bj][m][n]));
    }
};
struct EpiResid {
    static constexpr bool PERM = false, AFTER_DRAIN = false;
    const float* base; float* out; int ldc; float s;
    __device__ __forceinline__ void operator()(const f32x4 (&acc)[2][2][4][2], const Unit& u, int wr, int wc, int fr, int fq) const {
        const int row0 = u.pm * BM + wr * 64 + fr, col0 = u.pn * BM + wc * 32 + 4 * fq;
#pragma unroll
        for (int ai = 0; ai < 2; ++ai)
#pragma unroll
            for (int m = 0; m < 4; ++m) { const size_t off = (size_t)(row0 + ai * HALF + m * 16) * ldc + col0;
#pragma unroll
                for (int bj = 0; bj < 2; ++bj)
#pragma unroll
                    for (int n = 0; n < 2; ++n) { const f32x4 b = *(const f32x4*)(base + off + bj * HALF + n * 16); *(f32x4*)(out + off + bj * HALF + n * 16) = b + acc[ai][bj][m][n] * s; } }
    }
};
template <long F8> struct EpiResidNorm {
    static constexpr bool PERM = false, AFTER_DRAIN = false;
    const float* base; float* out; float s; bf16_t* hb; const float* gain; float* part; float* pmax;
    __device__ __forceinline__ void operator()(const f32x4 (&acc)[2][2][4][2], const Unit& u, int wr, int wc, int fr, int fq) const {
        constexpr int ldc = 4096, hbM = 16384;
        const int row0 = u.pm * BM + wr * 64 + fr, col0 = u.pn * BM + wc * 32 + 4 * fq;
        f32x4 gv[2][2];
#pragma unroll
        for (int bj = 0; bj < 2; ++bj)
#pragma unroll
            for (int n = 0; n < 2; ++n) gv[bj][n] = *(const f32x4*)(gain + col0 + bj * HALF + n * 16);
#pragma unroll
        for (int ai = 0; ai < 2; ++ai)
#pragma unroll
            for (int m = 0; m < 4; ++m) { const int row = row0 + ai * HALF + m * 16; const size_t off = (size_t)row * ldc + col0; float ss = 0.f, mx = 0.f;
#pragma unroll
                for (int bj = 0; bj < 2; ++bj)
#pragma unroll
                    for (int n = 0; n < 2; ++n) { const f32x4 b = *(const f32x4*)(base + off + bj * HALF + n * 16); const f32x4 o = b + acc[ai][bj][m][n] * s;
                        *(f32x4*)(out + off + bj * HALF + n * 16) = o;
                        ss += (o[0] * o[0] + o[1] * o[1]) + (o[2] * o[2] + o[3] * o[3]); const f32x4 y = o * gv[bj][n];
                        mx = fmaxf(fmaxf(mx, fmaxf(fabsf(y[0]), fabsf(y[1]))), fmaxf(fabsf(y[2]), fabsf(y[3])));
                        u32x2 w; w.x = cvt_pk_bf16(y[0], y[1]); w.y = cvt_pk_bf16(y[2], y[3]);
                        const int col = col0 + bj * HALF + n * 16;
                        *(u32x2*)(hb + ((size_t)(col >> 6) * hbM + row) * 64 + (col & 63)) = w;
                        if constexpr (F8 != 0) *(unsigned*)((unsigned char*)hb + F8 + ((size_t)(col >> 7) * hbM + row) * 128 + (col & 127)) = pack4_fp8(y); }
                ss += __shfl_xor(ss, 16); ss += __shfl_xor(ss, 32); if (fq == 0) part[(size_t)row * 64 + u.pn * 4 + wc] = ss;
                if (pmax) { mx = fmaxf(mx, __shfl_xor(mx, 16)); mx = fmaxf(mx, __shfl_xor(mx, 32)); if (fq == 0) pmax[(size_t)row * 64 + u.pn * 4 + wc] = mx; } }
    }
};
template <int MODE_> struct EpiProj {
    static constexpr bool PERM = true, AFTER_DRAIN = false; static constexpr int mode = MODE_; __device__ __forceinline__ bool idem() const { return true; }
    bf16_t *cq, *ckv, *kr, *qb, *kb, *vb, *ga, *gb; const float* cosT; const float* sinT; const float* rs; float* partq; float* partkv; float* kmean; unsigned char* kr8; unsigned char* qb8; unsigned char* kb8; unsigned char* vb8;
    float post;
    __device__ __forceinline__ void operator()(const f32x4 (&acc)[2][2][4][2], const Unit& u, int wr, int wc, int fr, int fq) const {
        const int row0 = u.pm * BM + wr * 64 + fr; const int pn = mode == 1 ? (u.pn == 22 ? 62 : u.pn) : u.pn + 22;
        if (mode == 1 && pn == 62) {
            if (wc < 2) { const int g = wc * 4 + fq;
#pragma unroll
                for (int ai = 0; ai < 2; ++ai)
#pragma unroll
                    for (int m = 0; m < 4; ++m) { const int row = row0 + ai * HALF + m * 16;
                        const f32x4 c = *(const f32x4*)(cosT + (size_t)row * 32 + 4 * g), s = *(const f32x4*)(sinT + (size_t)row * 32 + 4 * g);
                        const float sc = rs[row] * post;
                        const f32x4 x1 = acc[ai][0][m][0] * sc, x2 = acc[ai][0][m][1] * sc;
                        const f32x4 o1 = x1 * c - x2 * s, o2 = x2 * c + x1 * s;
                        u32x2 w1, w2; w1.x = cvt_pk_bf16(o1[0], o1[1]); w1.y = cvt_pk_bf16(o1[2], o1[3]); w2.x = cvt_pk_bf16(o2[0], o2[1]); w2.y = cvt_pk_bf16(o2[2], o2[3]);
                        *(u32x2*)(kr + (size_t)row * 64 + 4 * g) = w1; *(u32x2*)(kr + (size_t)row * 64 + 32 + 4 * g) = w2;
                        *(unsigned*)(kr8 + (size_t)row * 64 + 4 * g) = pack4_fp8(o1); *(unsigned*)(kr8 + (size_t)row * 64 + 32 + 4 * g) = pack4_fp8(o2); } }
            return; }
        bf16_t* base; int ldc, colt; bool sig = false;
        if (pn < 4) { base = cq; ldc = 1024; colt = pn * BM; }
        else if (pn < 6) { base = ckv; ldc = 512; colt = (pn - 4) * BM; }
        else if (pn < 14) { base = qb; ldc = 2048; colt = (pn - 6) * BM; }
        else if (pn < 22) { base = kb; ldc = 2048; colt = (pn - 14) * BM; }
        else if (pn < 30) { base = vb; ldc = 2048; colt = (pn - 22) * BM; }
        else if (pn < 46) { base = ga; ldc = 4096; colt = (pn - 30) * BM; sig = true; }
        else { base = gb; ldc = 4096; colt = (pn - 46) * BM; sig = true; }
        const int col0 = colt + wc * 32 + 8 * fq;
        float* part = mode != 1 ? nullptr : (pn < 4 ? partq + pn * 4 + wc : (pn < 6 ? partkv + (pn - 4) * 4 + wc : nullptr)); const int pstride = pn < 4 ? 16 : 8;
        const bool iskb = mode == 1 && pn >= 14 && pn < 22; f32x4 cs[2][2] = {};
        const bool isvb = mode == 2 && pn < 30;
        unsigned char* f8p = mode == 1 && pn >= 6 && pn < 22 ? (pn < 14 ? qb8 : kb8) : nullptr;
#pragma unroll
        for (int ai = 0; ai < 2; ++ai)
#pragma unroll
            for (int m = 0; m < 4; ++m) { const int row = row0 + ai * HALF + m * 16; bf16_t* rowp = base + (size_t)row * ldc + col0; const float sc = rs[row] * post; float ss = 0.f;
#pragma unroll
                for (int bj = 0; bj < 2; ++bj) { f32x4 v0 = acc[ai][bj][m][0] * sc, v1 = acc[ai][bj][m][1] * sc;
                    if (sig) {
#pragma unroll
                        for (int e = 0; e < 4; ++e) { v0[e] = sigmoid_f(v0[e]); v1[e] = sigmoid_f(v1[e]); } }
                    if (part) ss += ((v0[0] * v0[0] + v0[1] * v0[1]) + (v0[2] * v0[2] + v0[3] * v0[3])) + ((v1[0] * v1[0] + v1[1] * v1[1]) + (v1[2] * v1[2] + v1[3] * v1[3]));
                    if (iskb) { cs[bj][0] += v0; cs[bj][1] += v1; }
                    if (f8p) { u32x2 w8; w8.x = pack4_fp8(v0); w8.y = pack4_fp8(v1); *(u32x2*)(f8p + (size_t)row * 2048 + col0 + bj * HALF) = w8; }
                    if (isvb) { const int kk = row & 63; const unsigned w0 = pack4_fp8(v0), w1 = pack4_fp8(v1);
                        unsigned char* vp = vb8 + ((size_t)((2 * (pn - 22) + bj) * 256 + (row >> 6)) * 128 + (wc * 32 + 8 * fq)) * 64 + (((kk >> 2) & 1) * 32 + (kk >> 5) * 16 + ((kk >> 3) & 3) * 4 + (kk & 3));
                        vp[0] = (unsigned char)w0; vp[64] = (unsigned char)(w0 >> 8); vp[128] = (unsigned char)(w0 >> 16); vp[192] = (unsigned char)(w0 >> 24);
                        vp[256] = (unsigned char)w1; vp[320] = (unsigned char)(w1 >> 8); vp[384] = (unsigned char)(w1 >> 16); vp[448] = (unsigned char)(w1 >> 24); }
                    if (!isvb || MLA_BF16) *(u32x4*)(rowp + bj * HALF) = pack8f(v0, v1); }
                if (part) { ss += __shfl_xor(ss, 16); ss += __shfl_xor(ss, 32); if (fq == 0) part[(size_t)row * pstride] = ss; } }
        if (iskb) {
#pragma unroll
            for (int bj = 0; bj < 2; ++bj)
#pragma unroll
                for (int n = 0; n < 2; ++n)
#pragma unroll
                    for (int e2 = 0; e2 < 4; ++e2) { float c = cs[bj][n][e2];
                        c += __shfl_xor(c, 1); c += __shfl_xor(c, 2); c += __shfl_xor(c, 4); c += __shfl_xor(c, 8);
                        if (fr == 0) atomicAdd(kmean + (size_t)((2 * (pn - 14) + bj) * 64 + u.pm) * 128 + wc * 32 + 8 * fq + 4 * n + e2, c * (1.f / 256.f)); }
        }
    }
};
struct EpiQ {
    static constexpr bool PERM = true, AFTER_DRAIN = false; __device__ __forceinline__ bool idem() const { return true; }
    bf16_t* Q; const float* cosT; const float* sinT; const float* partq; unsigned char* Q8;
    __device__ __forceinline__ float rstd_of(int row) const { const f32x4* p = (const f32x4*)(partq + (size_t)row * 16); const f32x4 a = p[0], b = p[1], c = p[2], d = p[3];
        const float s = ((a[0] + a[1]) + (a[2] + a[3])) + ((b[0] + b[1]) + (b[2] + b[3])) + ((c[0] + c[1]) + (c[2] + c[3])) + ((d[0] + d[1]) + (d[2] + d[3])); return 1.0f / sqrtf(s * (1.f / 1024.f) + 1e-6f); }
    __device__ __forceinline__ void operator()(const f32x4 (&acc)[2][2][4][2], const Unit& u, int wr, int wc, int fr, int fq) const {
        const int row0 = u.pm * BM + wr * 64 + fr;
        float rsv[2][4];
#pragma unroll
        for (int ai = 0; ai < 2; ++ai)
#pragma unroll
            for (int m = 0; m < 4; ++m) rsv[ai][m] = rstd_of(row0 + ai * HALF + m * 16);
#pragma unroll
        for (int bj = 0; bj < 2; ++bj) {
            const int cw = u.pn * BM + bj * HALF + wc * 32;
            const int hc = cw % 192, hb = cw - hc;
            if (hc < 128) {
#pragma unroll
                for (int ai = 0; ai < 2; ++ai)
#pragma unroll
                    for (int m = 0; m < 4; ++m) { const int row = row0 + ai * HALF + m * 16; const float sc = rsv[ai][m];
                        const f32x4 q0 = acc[ai][bj][m][0] * sc, q1 = acc[ai][bj][m][1] * sc;
                        if (Q) *(u32x4*)(Q + (size_t)row * 3072 + cw + 8 * fq) = pack8f(q0, q1);
                        u32x2 w8; w8.x = pack4_fp8(q0); w8.y = pack4_fp8(q1); *(u32x2*)(Q8 + (size_t)row * 3072 + cw + 8 * fq) = w8; }
            } else {
                const int g = ((hc - 128) >> 3) + fq;
#pragma unroll
                for (int ai = 0; ai < 2; ++ai)
#pragma unroll
                    for (int m = 0; m < 4; ++m) { const int row = row0 + ai * HALF + m * 16;
                        const f32x4 c = *(const f32x4*)(cosT + (size_t)row * 32 + 4 * g), s = *(const f32x4*)(sinT + (size_t)row * 32 + 4 * g);
                        const float sc = rsv[ai][m];
                        const f32x4 x1 = acc[ai][bj][m][0] * sc, x2 = acc[ai][bj][m][1] * sc;
                        const f32x4 o1 = x1 * c - x2 * s, o2 = x2 * c + x1 * s;
                        if (Q) { u32x2 w1, w2; w1.x = cvt_pk_bf16(o1[0], o1[1]); w1.y = cvt_pk_bf16(o1[2], o1[3]); w2.x = cvt_pk_bf16(o2[0], o2[1]); w2.y = cvt_pk_bf16(o2[2], o2[3]);
                            bf16_t* qp = Q + (size_t)row * 3072 + hb + 128 + 4 * g;
                            *(u32x2*)qp = w1; *(u32x2*)(qp + 32) = w2; }
                        unsigned char* q8p = Q8 + (size_t)row * 3072 + hb + 128 + 4 * g; *(unsigned*)q8p = pack4_fp8(o1); *(unsigned*)(q8p + 32) = pack4_fp8(o2); }
            }
        }
    }
};
template <bool ADD> struct EpiMerge {
    static constexpr bool PERM = true, AFTER_DRAIN = false; const bf16_t* gate; bf16_t* T; unsigned char* O8; float post;
    __device__ __forceinline__ void operator()(const f32x4 (&acc)[2][2][4][2], const Unit& u, int wr, int wc, int fr, int fq) const {
        const int row0 = u.pm * BM + wr * 64 + fr, col0 = u.pn * BM + wc * 32 + 8 * fq;
#pragma unroll
        for (int ai = 0; ai < 2; ++ai)
#pragma unroll
            for (int m = 0; m < 4; ++m) { const int row = row0 + ai * HALF + m * 16; const size_t off = (size_t)row * 4096 + col0;
#pragma unroll
                for (int bj = 0; bj < 2; ++bj) { const u32x4 gw = *(const u32x4*)(gate + off + bj * HALF);
                    f32x4 v0 = acc[ai][bj][m][0] * post, v1 = acc[ai][bj][m][1] * post;
                    v0[0] *= bf_lo(gw.x); v0[1] *= bf_hi(gw.x); v0[2] *= bf_lo(gw.y); v0[3] *= bf_hi(gw.y);
                    v1[0] *= bf_lo(gw.z); v1[1] *= bf_hi(gw.z); v1[2] *= bf_lo(gw.w); v1[3] *= bf_hi(gw.w);
                    if (ADD) { const u32x4 pw = *(const u32x4*)(T + off + bj * HALF);
                        v0[0] += bf_lo(pw.x); v0[1] += bf_hi(pw.x); v0[2] += bf_lo(pw.y); v0[3] += bf_hi(pw.y);
                        v1[0] += bf_lo(pw.z); v1[1] += bf_hi(pw.z); v1[2] += bf_lo(pw.w); v1[3] += bf_hi(pw.w);
                        if (O8) { const int col = col0 + bj * HALF; u32x2 q; q.x = pack4_fp8(v0 * 16.f); q.y = pack4_fp8(v1 * 16.f);
                            *(u32x2*)(O8 + ((size_t)(col >> 7) * 16384 + row) * 128 + (col & 127)) = q; }
                        else *(u32x4*)(T + off + bj * HALF) = pack8f(v0, v1); }
                    else *(u32x4*)(T + off + bj * HALF) = pack8f(v0, v1); } }
    }
};
template <class Epi, class Sched, bool ALIGN_EPI = false, bool SP2 = false, bool TILED = false, bool FP8 = false, bool I8 = false>
__device__ __forceinline__ void gemm_phase(PG8_LAS unsigned char* lds, const Gemm g, const Sched S, const Epi E, int wv) {
    int tid_ = wv * 64 + lane_id_(); asm volatile("" : "+v"(tid_)); const int tid = tid_, wid = wv, lane = tid & 63, wr = wid >> 2, wc = wid & 3, fr = lane & 15, fq = lane >> 4;
    const int K = g.K, nt = K / BK;
    unsigned voffA[2], voffB[2];
#pragma unroll
    for (int i = 0; i < 2; ++i) { int R, C; stage_rc(tid * 16 + i * 8192, R, C); const int Rb = Epi::PERM ? ((R & ~31) + perm32(R & 31)) : R;
        voffA[i] = (unsigned)(R * (TILED ? BK : K) + C) * 2u; voffB[i] = (unsigned)(Rb * (TILED ? BK : K) + C) * 2u; }
    const size_t kstepA = TILED ? (size_t)g.M * BK * 2 : (size_t)(BK * 2), kstepB = TILED ? (size_t)g.N * BK * 2 : (size_t)(BK * 2);
    const size_t hstep = TILED ? (size_t)HALF * BK * 2 : (size_t)HALF * K * 2;
    const size_t tstep = 2 * hstep;
    const unsigned ldsw = (unsigned)wid * 1024u;
    const int aoff = lds_byte(wr * 64 + fr, fq * 8), boff = lds_byte(wc * 32 + fr, fq * 8);
#define PG8_SA(b, h) (((b) * 2 + (h)) * HTB)
#define PG8_SB(b, h) ((4 + (b) * 2 + (h)) * HTB)
#define PG8_STAGE(bufoff, gbase, voff) do { _Pragma("unroll") for (int _i = 0; _i < 2; ++_i) \
        __builtin_amdgcn_global_load_lds((const unsigned*)((const char*)(gbase) + (voff)[_i]), (PG8_LAS unsigned*)(lds + (bufoff) + ldsw + _i * 8192), 16, 0, 0); } while (0)
#define PG8_LDA(dst, b, h) do { _Pragma("unroll") for (int m = 0; m < 4; ++m) { if constexpr (FP8) { \
            dst##8[m].lo = *(const PG8_LAS v4i_t*)(lds + PG8_SA(b, h) + aoff + m * 2048); dst##8[m].hi = *(const PG8_LAS v4i_t*)(lds + PG8_SA(b, h) + aoff + m * 2048 + 1024); } \
        else { _Pragma("unroll") for (int k = 0; k < 2; ++k) dst[m][k] = *(const PG8_LAS bf16x8*)(lds + PG8_SA(b, h) + aoff + m * 2048 + k * 1024); } } } while (0)
#define PG8_LDB(dst, b, h) do { _Pragma("unroll") for (int n = 0; n < 2; ++n) { if constexpr (FP8) { \
            dst##8[n].lo = *(const PG8_LAS v4i_t*)(lds + PG8_SB(b, h) + boff + n * 2048); dst##8[n].hi = *(const PG8_LAS v4i_t*)(lds + PG8_SB(b, h) + boff + n * 2048 + 1024); } \
        else { _Pragma("unroll") for (int k = 0; k < 2; ++k) dst[n][k] = *(const PG8_LAS bf16x8*)(lds + PG8_SB(b, h) + boff + n * 2048 + k * 1024); } } } while (0)
#define PG8_MMA(ai, bj, At, Bt) do { __builtin_amdgcn_s_setprio(1); \
        if constexpr (I8) {   \
            _Pragma("unroll") for (int k = 0; k < 2; ++k) _Pragma("unroll") for (int m = 0; m < 4; ++m) _Pragma("unroll") for (int n = 0; n < 2; ++n) \
                acc[ai][bj][m][n] = __builtin_bit_cast(f32x4, __builtin_amdgcn_mfma_i32_16x16x64_i8(__builtin_bit_cast(v4i_t, Bt[n][k]), __builtin_bit_cast(v4i_t, At[m][k]), __builtin_bit_cast(v4i_t, acc[ai][bj][m][n]), 0, 0, 0)); } \
        else { _Pragma("unroll") for (int m = 0; m < 4; ++m) _Pragma("unroll") for (int n = 0; n < 2; ++n) { \
            if constexpr (FP8) asm volatile("v_mfma_scale_f32_16x16x128_f8f6f4 %0, %1, %2, %0, %3, %3 op_sel_hi:[0,0,0]" : "+v"(acc[ai][bj][m][n]) : "v"(Bt##8[n]), "v"(At##8[m]), "v"(f8scale));   \
            else { _Pragma("unroll") for (int k = 0; k < 2; ++k) acc[ai][bj][m][n] = __builtin_amdgcn_mfma_f32_16x16x32_bf16(Bt[n][k], At[m][k], acc[ai][bj][m][n], 0, 0, 0); } } } \
        __builtin_amdgcn_s_setprio(0); } while (0)
#define PG8_WAIT_V(n) asm volatile("s_waitcnt vmcnt(" #n ")" ::: "memory")
#define PG8_WAIT_L(n) asm volatile("s_waitcnt lgkmcnt(" #n ")" ::: "memory")
#define PG8_BAR __builtin_amdgcn_s_barrier()
#define PG8_SCHED __builtin_amdgcn_sched_barrier(0)
    Unit cur, nxt; int ui = 0;
    if (!S.next(0, cur)) return;
    f32x4 acc[2][2][4][2];
#pragma unroll
    for (int a = 0; a < 2; ++a)
#pragma unroll
        for (int b = 0; b < 2; ++b)
#pragma unroll
            for (int m = 0; m < 4; ++m)
#pragma unroll
                for (int n = 0; n < 2; ++n) acc[a][b][m][n] = (f32x4){0.f, 0.f, 0.f, 0.f};
    typedef int v8i_t __attribute__((ext_vector_type(8))); typedef int v4i_t __attribute__((ext_vector_type(4)));
    int f8scale = 0x7f7f7f7f; asm volatile("" : "+v"(f8scale));
    bf16x8 At[4][2], B0[2][2], B1[2][2]; v8i_t At8[4], B08[2], B18[2];
    const char* cA = (const char*)g.A + (size_t)cur.pm * tstep; const char* cB = (const char*)g.Bt + (size_t)cur.pn * tstep;
    S.a_ready(cur);
    if constexpr (SP2) {
        PG8_STAGE(PG8_SB(0, 0), cB, voffB); PG8_STAGE(PG8_SB(0, 1), cB + hstep, voffB); PG8_STAGE(PG8_SA(0, 0), cA, voffA); PG8_STAGE(PG8_SA(0, 1), cA + hstep, voffA);
        if (wr == 1) PG8_BAR;
        PG8_WAIT_V(2); PG8_BAR;
        PG8_STAGE(PG8_SB(1, 0), cB + kstepB, voffB); PG8_STAGE(PG8_SA(1, 0), cA + kstepA, voffA); PG8_STAGE(PG8_SB(1, 1), cB + hstep + kstepB, voffB);
        PG8_WAIT_V(6); PG8_BAR;
    } else {
        PG8_STAGE(PG8_SB(0, 0), cB, voffB); PG8_STAGE(PG8_SA(0, 0), cA, voffA); PG8_STAGE(PG8_SB(0, 1), cB + hstep, voffB); PG8_STAGE(PG8_SA(0, 1), cA + hstep, voffA);
        if (wr == 1) PG8_BAR;
        PG8_WAIT_V(4); PG8_BAR;
        PG8_STAGE(PG8_SB(1, 0), cB + kstepB, voffB); PG8_STAGE(PG8_SA(1, 0), cA + kstepA, voffA); PG8_STAGE(PG8_SB(1, 1), cB + hstep + kstepB, voffB);
        PG8_WAIT_V(6); PG8_BAR;
    }
    for (;;) {
        const bool has_next = S.next(ui + 1, nxt);
        const char* nA = has_next ? (const char*)g.A + (size_t)nxt.pm * tstep : cA; const char* nB = has_next ? (const char*)g.Bt + (size_t)nxt.pn * tstep : cB;
        for (int t = 0; t < nt; t += 2) {
            const bool last = (t == nt - 2);
            const char* a1 = cA + (size_t)(t + 1) * kstepA;
            const char* a2 = last ? nA : cA + (size_t)(t + 2) * kstepA; const char* b2 = last ? nB : cB + (size_t)(t + 2) * kstepB;
            const char* a3 = a2 + kstepA; const char* b3 = b2 + kstepB;
            if (last && has_next) S.a_ready(nxt);
            if constexpr (SP2) {
            PG8_LDB(B0, 0, 0); PG8_LDB(B1, 0, 1); PG8_SCHED; PG8_LDA(At, 0, 0); PG8_STAGE(PG8_SA(1, 1), a1 + hstep, voffA);
            PG8_WAIT_V(8); PG8_WAIT_L(0); PG8_BAR; PG8_MMA(0, 0, At, B0); PG8_MMA(0, 1, At, B1); PG8_BAR; PG8_SCHED;
            PG8_LDA(At, 0, 1); PG8_STAGE(PG8_SB(0, 0), b2, voffB); PG8_STAGE(PG8_SB(0, 1), b2 + hstep, voffB); PG8_STAGE(PG8_SA(0, 0), a2, voffA);
            PG8_WAIT_V(8); PG8_WAIT_L(0); PG8_BAR; PG8_MMA(1, 0, At, B0); PG8_MMA(1, 1, At, B1); PG8_BAR; PG8_SCHED;
            PG8_LDB(B0, 1, 0); PG8_LDB(B1, 1, 1); PG8_SCHED; PG8_LDA(At, 1, 0); PG8_STAGE(PG8_SA(0, 1), a2 + hstep, voffA);
            PG8_WAIT_V(8); PG8_WAIT_L(0); PG8_BAR; PG8_MMA(0, 0, At, B0); PG8_MMA(0, 1, At, B1); PG8_BAR; PG8_SCHED;
            PG8_LDA(At, 1, 1); PG8_STAGE(PG8_SB(1, 0), b3, voffB); PG8_STAGE(PG8_SB(1, 1), b3 + hstep, voffB); PG8_STAGE(PG8_SA(1, 0), a3, voffA);
            PG8_WAIT_V(8); PG8_WAIT_L(0); PG8_BAR; PG8_MMA(1, 0, At, B0); PG8_MMA(1, 1, At, B1); PG8_BAR; PG8_SCHED;
            } else {
            PG8_LDB(B0, 0, 0); PG8_SCHED; PG8_LDA(At, 0, 0); PG8_STAGE(PG8_SA(1, 1), a1 + hstep, voffA);
            PG8_WAIT_L(8); PG8_BAR; PG8_WAIT_L(0); PG8_MMA(0, 0, At, B0); PG8_BAR; PG8_SCHED;
            PG8_LDB(B1, 0, 1); PG8_STAGE(PG8_SB(0, 0), b2, voffB);
            PG8_BAR; PG8_WAIT_L(0); PG8_MMA(0, 1, At, B1); PG8_BAR;
            PG8_LDA(At, 0, 1); PG8_STAGE(PG8_SA(0, 0), a2, voffA);
            PG8_BAR; PG8_WAIT_L(0); PG8_MMA(1, 0, At, B0); PG8_BAR; PG8_SCHED;
            PG8_STAGE(PG8_SB(0, 1), b2 + hstep, voffB);
            PG8_WAIT_V(6); PG8_BAR; PG8_MMA(1, 1, At, B1); PG8_BAR;
            PG8_LDB(B0, 1, 0); PG8_SCHED; PG8_LDA(At, 1, 0); PG8_STAGE(PG8_SA(0, 1), a2 + hstep, voffA);
            PG8_WAIT_L(8); PG8_BAR; PG8_WAIT_L(0); PG8_MMA(0, 0, At, B0); PG8_BAR; PG8_SCHED;
            PG8_LDB(B1, 1, 1); PG8_STAGE(PG8_SB(1, 0), b3, voffB);
            PG8_BAR; PG8_WAIT_L(0); PG8_MMA(0, 1, At, B1); PG8_BAR;
            PG8_LDA(At, 1, 1); PG8_STAGE(PG8_SA(1, 0), a3, voffA);
            PG8_BAR; PG8_WAIT_L(0); PG8_MMA(1, 0, At, B0); PG8_BAR; PG8_SCHED;
            PG8_STAGE(PG8_SB(1, 1), b3 + hstep, voffB);
            PG8_WAIT_V(6); PG8_BAR; PG8_MMA(1, 1, At, B1); PG8_BAR;
            }
        }
        if constexpr (FP8 || I8) asm volatile("s_nop 15\n\ts_nop 7" ::: "memory");
        if constexpr (ALIGN_EPI) { if (wr == 0) PG8_BAR; }
        if constexpr (!Epi::AFTER_DRAIN) { int fr_e = fr, fq_e = fq; asm volatile("" : "+v"(fr_e), "+v"(fq_e));
            E(acc, cur, wr, wc, fr_e, fq_e); S.done(cur); }
        if (!has_next) break;
#pragma unroll
        for (int a = 0; a < 2; ++a)
#pragma unroll
            for (int b = 0; b < 2; ++b)
#pragma unroll
                for (int m = 0; m < 4; ++m)
#pragma unroll
                    for (int n = 0; n < 2; ++n) acc[a][b][m][n] = (f32x4){0.f, 0.f, 0.f, 0.f};
        cur = nxt; cA = nA; cB = nB; ++ui;
        if constexpr (ALIGN_EPI) { if (wr == 1) PG8_BAR; }
    }
    PG8_WAIT_V(0);
    if constexpr (!ALIGN_EPI) { if (wr == 0) PG8_BAR; }
    PG8_BAR;
    if constexpr (Epi::AFTER_DRAIN) { E.fused(acc, cur, wr, wc, fr, fq, lds, wid, lane); S.done(cur); }
#undef PG8_SA
#undef PG8_SB
#undef PG8_STAGE
#undef PG8_LDA
#undef PG8_LDB
#undef PG8_MMA
#undef PG8_WAIT_V
#undef PG8_WAIT_L
#undef PG8_BAR
#undef PG8_SCHED
}
}
namespace att {
typedef unsigned short bf16_t;
typedef short bf16x8 __attribute__((ext_vector_type(8)));
typedef short s16x4 __attribute__((ext_vector_type(4)));
typedef float f32x16 __attribute__((ext_vector_type(16)));
typedef float f32x4 __attribute__((ext_vector_type(4)));
typedef unsigned u32x4 __attribute__((ext_vector_type(4)));
typedef int i32x4 __attribute__((ext_vector_type(4)));
#define ASBAR() __builtin_amdgcn_sched_barrier(0)
constexpr int VT_BYTES = 16384;
constexpr int L_V = 0, L_K = 2 * VT_BYTES;
constexpr int KT_MAX = 64 * 192 * 2;
constexpr int L_WS = L_K + 2 * KT_MAX;
constexpr int L_BIAS = L_WS + 8 * 128 * 4;
constexpr int L_PREF = L_BIAS + 16 * 132 * 4;
constexpr int L_CNT = L_PREF + 1040 * 4 + 64;
constexpr int L_END = L_CNT + 1024 * 4;
constexpr float LOG2E = 1.4426950408889634f;
constexpr float THR2 = 6.0f;

__device__ __forceinline__ int v_st(int k, int c) { const int kk = (k & ~0xC) | ((k & 4) << 1) | ((k & 8) >> 1); return ((kk >> 3) * 4 + (c >> 5)) * 512 + ((kk & 7) * 32 + (c & 31)) * 2; }
__device__ __forceinline__ int v_rd_base(int lane) { return ((lane & 3) << 3) | (((lane >> 2) & 3) << 6) | (((lane >> 4) & 1) << 5) | (((lane >> 5) & 1) << 8); }
constexpr int v_rd_off(int d0, int ks, int half) { return d0 * 512 + ks * 4096 + half * 2048; }
__device__ __forceinline__ int crow(int r, int hi) { return (r & 3) + 8 * (r >> 2) + 4 * hi; }
__device__ __forceinline__ unsigned cvtpk(float lo, float hi) { unsigned r; asm volatile("v_cvt_pk_bf16_f32 %0, %1, %2" : "=v"(r) : "v"(lo), "v"(hi)); return r; }
__device__ __forceinline__ bf16x8 ld8(const bf16_t* p) { return *reinterpret_cast<const bf16x8*>(p); }
template <int DQK> __device__ __forceinline__ int kswz(int row, int chunk) {
    if constexpr (DQK == 128) return row * 256 + ((chunk ^ (row & 7)) << 4);
    else return row * 384 + (((chunk & ~7) | ((chunk ^ (row >> 1)) & 7)) << 4);
}
__device__ __forceinline__ void mask_tile(f32x16& p0, f32x16& p1, int dq) {
    const float NEG = -__builtin_inff();
#pragma unroll
    for (int r = 0; r < 16; ++r) { const int c = (r & 3) + 8 * (r >> 2); if (dq - c < 0) p0[r] = NEG; if (dq - c - 32 < 0) p1[r] = NEG; }
}
template <bool RAW>
__device__ __forceinline__ void partialSM(f32x16& p0, f32x16& p1, float& m_reg, float& alpha, float sc) {
    float pmax = p0[0];
#pragma unroll
    for (int r = 1; r < 16; ++r) pmax = fmaxf(pmax, p0[r]);
#pragma unroll
    for (int r = 0; r < 16; ++r) pmax = fmaxf(pmax, p1[r]);
    { auto rr = __builtin_amdgcn_permlane32_swap(__float_as_uint(pmax), __float_as_uint(pmax), false, false);
      pmax = fmaxf(__uint_as_float(rr[0]), __uint_as_float(rr[1])); }
    if (RAW) pmax *= sc;
    const bool need = pmax - m_reg > THR2;
    const float mn = need ? pmax : m_reg;
    alpha = need ? __builtin_amdgcn_exp2f(m_reg - mn) : 1.f; m_reg = mn;
    if (RAW) {
        typedef float f32x2_t __attribute__((ext_vector_type(2)));
        const f32x2_t sc2 = {sc, sc}, mn2 = {-mn, -mn};
#pragma unroll
        for (int r = 0; r < 8; ++r) { f32x2_t t = {p0[2 * r], p0[2 * r + 1]}; t = __builtin_elementwise_fma(t, sc2, mn2); p0[2 * r] = __builtin_amdgcn_exp2f(t.x); p0[2 * r + 1] = __builtin_amdgcn_exp2f(t.y); }
#pragma unroll
        for (int r = 0; r < 8; ++r) { f32x2_t t = {p1[2 * r], p1[2 * r + 1]}; t = __builtin_elementwise_fma(t, sc2, mn2); p1[2 * r] = t.x; p1[2 * r + 1] = t.y; }
    } else {
#pragma unroll
        for (int r = 0; r < 16; ++r) p0[r] = __builtin_amdgcn_exp2f(p0[r] - mn);
#pragma unroll
        for (int r = 0; r < 16; ++r) p1[r] = p1[r] - mn;
    }
}
__device__ __forceinline__ void finishSM_e(f32x16& p1) {
#pragma unroll
    for (int r = 0; r < 16; ++r) p1[r] = __builtin_amdgcn_exp2f(p1[r]);
}
__device__ __forceinline__ void finishSM_a(f32x16& p0, f32x16& p1, float alpha, float& l_reg) {
#pragma unroll
    for (int r = 0; r < 16; ++r) p1[r] = __builtin_amdgcn_exp2f(p1[r]);
    float ps = 0;
#pragma unroll
    for (int r = 0; r < 16; ++r) ps += p0[r];
#pragma unroll
    for (int r = 0; r < 16; ++r) ps += p1[r];
    { auto rr = __builtin_amdgcn_permlane32_swap(__float_as_uint(ps), __float_as_uint(ps), false, false);
      ps = __uint_as_float(rr[0]) + __uint_as_float(rr[1]); }
    l_reg = l_reg * alpha + ps;
}
#define PK4(P, B_, OUT) do { unsigned a0 = cvtpk(P[B_+0], P[B_+1]), a1 = cvtpk(P[B_+2], P[B_+3]);                          \
        unsigned b0 = cvtpk(P[B_+4], P[B_+5]), b1 = cvtpk(P[B_+6], P[B_+7]);                                             \
        auto r0 = __builtin_amdgcn_permlane32_swap(a0, b0, false, false); auto r1 = __builtin_amdgcn_permlane32_swap(a1, b1, false, false); \
        u32x4 w = {r0[0], r1[0], r0[1], r1[1]}; OUT = *reinterpret_cast<bf16x8*>(&w); } while (0)
template <int DQK>
__device__ __forceinline__ void qkt(f32x16& p0, f32x16& p1, const char* kbuf, int r32, int hi, const bf16x8* qr) {
    p0 = f32x16{}; p1 = f32x16{};
    const char* kb[4];
    constexpr int RP = DQK * 2;
#pragma unroll
    for (int dd = 0; dd < 4; ++dd) kb[dd] = kbuf + kswz<DQK>(r32, 2 * dd + hi);
#pragma unroll
    for (int d0 = 0; d0 < DQK / 16; ++d0) { const char* a = kb[d0 & 3] + (d0 >> 2) * 128;
        bf16x8 b0 = *reinterpret_cast<const bf16x8*>(a);
        bf16x8 b1 = *reinterpret_cast<const bf16x8*>(a + 32 * RP);
        __builtin_amdgcn_s_setprio(1);
        p0 = __builtin_amdgcn_mfma_f32_32x32x16_bf16(b0, qr[d0], p0, 0, 0, 0);
        p1 = __builtin_amdgcn_mfma_f32_32x32x16_bf16(b1, qr[d0], p1, 0, 0, 0);
        __builtin_amdgcn_s_setprio(0); }
}
template <int VBOFF>
__device__ __forceinline__ void pv_tile(f32x16* o, int vb0, bf16x8 pa0, bf16x8 pa1, bf16x8 pa2, bf16x8 pa3) {
#define TRRD(dst, off) asm volatile("ds_read_b64_tr_b16 %0, %1 offset:%2" : "=&v"(dst) : "v"(vb0), "i"(off) : "memory")
#define PV_D0(d0) do { s16x4 l0, l1, l2, l3, h0, h1, h2, h3; constexpr int b_ = VBOFF + v_rd_off(d0, 0, 0); \
        TRRD(l0, b_); TRRD(h0, b_ + 2048); TRRD(l1, b_ + 4096); TRRD(h1, b_ + 6144); TRRD(l2, b_ + 8192); TRRD(h2, b_ + 10240); TRRD(l3, b_ + 12288); TRRD(h3, b_ + 14336); \
        asm volatile("s_waitcnt lgkmcnt(0)" ::: "memory"); ASBAR();   \
        o[d0] = __builtin_amdgcn_mfma_f32_32x32x16_bf16(pa0, (bf16x8){l0[0], l0[1], l0[2], l0[3], h0[0], h0[1], h0[2], h0[3]}, o[d0], 0, 0, 0);   \
        o[d0] = __builtin_amdgcn_mfma_f32_32x32x16_bf16(pa1, (bf16x8){l1[0], l1[1], l1[2], l1[3], h1[0], h1[1], h1[2], h1[3]}, o[d0], 0, 0, 0);   \
        o[d0] = __builtin_amdgcn_mfma_f32_32x32x16_bf16(pa2, (bf16x8){l2[0], l2[1], l2[2], l2[3], h2[0], h2[1], h2[2], h2[3]}, o[d0], 0, 0, 0);   \
        o[d0] = __builtin_amdgcn_mfma_f32_32x32x16_bf16(pa3, (bf16x8){l3[0], l3[1], l3[2], l3[3], h3[0], h3[1], h3[2], h3[3]}, o[d0], 0, 0, 0); } while (0)
    PV_D0(0); PV_D0(1); PV_D0(2); PV_D0(3);
#undef PV_D0
#undef TRRD
}

typedef __attribute__((address_space(3))) const char* lds_cptr;
typedef short v4i16_t __attribute__((ext_vector_type(4)));
__device__ __forceinline__ s16x4 vtr(lds_cptr p) { return __builtin_bit_cast(s16x4, __builtin_amdgcn_ds_read_tr16_b64_v4i16((__attribute__((address_space(3))) v4i16_t*)p)); }
#define VRD(S, vp, d0) do { _Pragma("unroll") for (int ks_ = 0; ks_ < 4; ++ks_) { S[2 * ks_] = vtr((vp) + (d0) * 512 + ks_ * 4096); S[2 * ks_ + 1] = vtr((vp) + (d0) * 512 + ks_ * 4096 + 2048); } } while (0)
#define VFR(S, k) (bf16x8){S[2 * (k)][0], S[2 * (k)][1], S[2 * (k)][2], S[2 * (k)][3], S[2 * (k) + 1][0], S[2 * (k) + 1][1], S[2 * (k) + 1][2], S[2 * (k) + 1][3]}
#define PVMMA(S, d0) do { __builtin_amdgcn_s_setprio(1); o[d0] = __builtin_amdgcn_mfma_f32_32x32x16_bf16(pa0, VFR(S, 0), o[d0], 0, 0, 0); o[d0] = __builtin_amdgcn_mfma_f32_32x32x16_bf16(pa1, VFR(S, 1), o[d0], 0, 0, 0); \
        o[d0] = __builtin_amdgcn_mfma_f32_32x32x16_bf16(pa2, VFR(S, 2), o[d0], 0, 0, 0); o[d0] = __builtin_amdgcn_mfma_f32_32x32x16_bf16(pa3, VFR(S, 3), o[d0], 0, 0, 0); __builtin_amdgcn_s_setprio(0); } while (0)

typedef int v8i_t __attribute__((ext_vector_type(8))); typedef int v4i_t __attribute__((ext_vector_type(4)));
__device__ __forceinline__ unsigned pk4f8(float a, float b, float c, float d) { int w = 0; w = __builtin_amdgcn_cvt_pk_fp8_f32(a, b, w, false); w = __builtin_amdgcn_cvt_pk_fp8_f32(c, d, w, true); return (unsigned)w; }
template <int DQK> __device__ __forceinline__ int k8swz(int row, int chunk) {
    if constexpr (DQK == 192) return row * 256 + ((chunk ^ (row & 15)) << 4);
    else return row * 128 + ((chunk ^ ((row >> 1) & 7)) << 4);
}
template <int DQK>
__device__ __forceinline__ void qkt8(f32x16& p0, f32x16& p1, const char* kbuf, int r32, int hi, const v8i_t* q8, int f8scale) {
    p0 = f32x16{}; p1 = f32x16{};
    constexpr int NS = DQK / 64, H32 = 32 * (DQK == 192 ? 256 : 128);
    v8i_t a0[NS], a1[NS];
#define K8LD(s_) do { const int c0 = 4 * (s_) + 2 * hi;                                                                          \
        const lds_cptr k0_ = (lds_cptr)kbuf + k8swz<DQK>(r32, c0), k1_ = (lds_cptr)kbuf + k8swz<DQK>(r32, c0 + 1);             \
        a0[s_].lo = *(const __attribute__((address_space(3))) v4i_t*)k0_; a0[s_].hi = *(const __attribute__((address_space(3))) v4i_t*)k1_;            \
        a1[s_].lo = *(const __attribute__((address_space(3))) v4i_t*)(k0_ + H32); a1[s_].hi = *(const __attribute__((address_space(3))) v4i_t*)(k1_ + H32); } while (0)
    K8LD(0); K8LD(1);
#pragma unroll
    for (int s_ = 0; s_ < NS; ++s_) {
        __builtin_amdgcn_s_setprio(1);
        asm volatile("v_mfma_scale_f32_32x32x64_f8f6f4 %0, %1, %2, %0, %3, %3 op_sel_hi:[0,0,0]" : "+v"(p0) : "v"(a0[s_]), "v"(q8[s_]), "v"(f8scale));
        asm volatile("v_mfma_scale_f32_32x32x64_f8f6f4 %0, %1, %2, %0, %3, %3 op_sel_hi:[0,0,0]" : "+v"(p1) : "v"(a1[s_]), "v"(q8[s_]), "v"(f8scale));
        __builtin_amdgcn_s_setprio(0);
        if (s_ == 0 && NS == 3) { ASBAR(); K8LD(2); } }
#undef K8LD
    asm volatile("s_nop 15\n\ts_nop 7" : "+v"(p0), "+v"(p1));
}
struct UnitArgs {
    const bf16_t* Q; int qpitch;
    const bf16_t* K; int kpitch;
    const bf16_t* Kr;
    const unsigned char* Q8; const unsigned char* K8; const unsigned char* Kr8; const unsigned char* V8;
    const bf16_t* V; int vpitch;
    bf16_t* O; int opitch;
    bf16_t* PO; float* PML;
    const int* pos; const int* tpmax;
    const unsigned* list; int nrows;
    int q0, k0, NT, h;
    float c2;
};
template <int DQK, int MODE>
__device__ __forceinline__ void attn_unit(const UnitArgs& A, char* lds, int wv) {
    int tid_ = wv * 64 + lane_id_(); asm volatile("" : "+v"(tid_)); const int tid = tid_, wid = wv, lane = tid & 63, r32 = lane & 31, hi = lane >> 5;
    constexpr bool F8 = true;
    constexpr int KT = F8 ? (DQK == 192 ? 16384 : 8192) : 64 * DQK * 2; constexpr int Q8P = DQK == 192 ? 3072 : 2048;
    char* V_lds = lds + L_V; char* K_lds = lds + L_K;
    float* ws = (float*)(lds + L_WS) + wid * 128; float* li_l = ws; float* al_l = ws + 32; int* ix_l = (int*)(ws + 64);
    const float* biasL = (const float*)(lds + L_BIAS) + A.h * 132;
    const int sr = tid >> 4, sc = (tid & 15) * 8, vst0 = v_st(sr, sc), vst1 = v_st(32 + sr, sc);
    const int kws0 = kswz<DQK>(sr, tid & 15), kws1 = kswz<DQK>(32 + sr, tid & 15);
    const int kws2 = (DQK == 192) ? kswz<DQK>(tid >> 3, 16 + (tid & 7)) : 0;
    const int k8w0 = k8swz<DQK>(tid >> 3, tid & 7), k8w2 = DQK == 192 ? k8swz<DQK>(tid >> 2, 8 + (tid & 3)) : 0;
    const int vb0 = (int)(uintptr_t)V_lds + v_rd_base(lane); (void)vb0;
    const int v8w = (tid >> 2) * 64 + (((tid & 3) ^ ((tid >> 4) & 3)) << 4), v8r = r32 * 64 + (((2 * hi) ^ ((r32 >> 2) & 3)) << 4);
    const lds_cptr vp0 = (lds_cptr)V_lds + v_rd_base(lane);
    bf16x8 st_k0, st_k1, st_k2, st_v0, st_v1;
#define SLOAD(t) do { const size_t kk_ = (size_t)(A.k0 + (t) * 64);                                                         \
        if constexpr (F8) st_v0 = ld8((const bf16_t*)(A.V8 + (kk_ >> 6) * 8192 + tid * 16));                             \
        else { st_v0 = ld8(A.V + (kk_ + sr) * A.vpitch + sc); st_v1 = ld8(A.V + (kk_ + 32 + sr) * A.vpitch + sc); }    \
        if constexpr (F8) { st_k0 = ld8((const bf16_t*)(A.K8 + (kk_ + (tid >> 3)) * 2048 + (tid & 7) * 16));             \
            if constexpr (DQK == 192) if (wid < 4) st_k2 = ld8((const bf16_t*)(A.Kr8 + (kk_ + (tid >> 2)) * 64 + (tid & 3) * 16)); }   \
        else { st_k0 = ld8(A.K + (kk_ + sr) * A.kpitch + sc); st_k1 = ld8(A.K + (kk_ + 32 + sr) * A.kpitch + sc);       \
            if constexpr (DQK == 192) st_k2 = ld8(A.Kr + (kk_ + (tid >> 3)) * 64 + (tid & 7) * 8); } } while (0)
#define SWRITE(bf) do { if constexpr (F8) *(bf16x8*)(V_lds + (bf) * VT_BYTES + v8w) = st_v0;                                  \
        else { *(bf16x8*)(V_lds + (bf) * VT_BYTES + vst0) = st_v0; *(bf16x8*)(V_lds + (bf) * VT_BYTES + vst1) = st_v1; } \
        if constexpr (F8) { *(bf16x8*)(K_lds + (bf) * KT + k8w0) = st_k0; if constexpr (DQK == 192) if (wid < 4) *(bf16x8*)(K_lds + (bf) * KT + k8w2) = st_k2; } \
        else { *(bf16x8*)(K_lds + (bf) * KT + kws0) = st_k0; *(bf16x8*)(K_lds + (bf) * KT + kws1) = st_k1;                 \
            if constexpr (DQK == 192) *(bf16x8*)(K_lds + (bf) * KT + kws2) = st_k2; } } while (0)
    SLOAD(0);
    int qrow, jslot = 3; bool valid = true;
    if constexpr (MODE == 1) { const int e = wid * 32 + r32; valid = e < A.nrows; const unsigned ent = A.list[valid ? e : 0]; qrow = (int)(ent & 0xffffu); jslot = (int)(ent >> 16); }
    else qrow = A.q0 + wid * 32 + r32;
    bf16x8 qr[F8 ? 1 : DQK / 16]; v8i_t q8[DQK / 64]; int f8scale = 0x7f7f7f7f;
    if constexpr (F8) { asm volatile("" : "+v"(f8scale));
#pragma unroll
        for (int s_ = 0; s_ < DQK / 64; ++s_) { const v4i_t* qp = (const v4i_t*)(A.Q8 + (size_t)qrow * Q8P + 64 * s_ + 32 * hi); q8[s_].lo = qp[0]; q8[s_].hi = qp[1]; } }
    else {
#pragma unroll
        for (int d0 = 0; d0 < DQK / 16; ++d0) qr[d0] = ld8(A.Q + (size_t)qrow * A.qpitch + d0 * 16 + hi * 8); }
    int posq = 0, qminw = 0;
    if constexpr (MODE != 0) { posq = A.pos[qrow]; int mn = posq;
#pragma unroll
        for (int o_ = 1; o_ < 64; o_ <<= 1) mn = min(mn, __shfl_xor(mn, o_));
        qminw = __builtin_amdgcn_readfirstlane(mn); }
    const int qlo = A.q0 + wid * 32;
    float m_reg = -1e30f, l_reg = 0.f; f32x16 o[4] = {};
    f32x16 o5 = {};
    f32x16 p0, p1; float alpha; bf16x8 pa0, pa1, pa2, pa3;
    const int NT = A.NT;
    SWRITE(0);
    __syncthreads();
    if constexpr (F8) {
#pragma unroll
        for (int s_ = 0; s_ < DQK / 64; ++s_) asm volatile("" : "+v"(q8[s_])); }
    else {
#pragma unroll
        for (int d0 = 0; d0 < DQK / 16; ++d0) asm volatile("" : "+v"(qr[d0])); }
#define KB_(t) (A.k0 + (t) * 64)
#define ACT(t) (MODE == 1 || KB_(t) <= qlo + 31)
#define NEEDMASK(t) (MODE != 1 && KB_(t) + 63 > qlo)
#define STEP(t, B) do {                                                                                                       \
        const bool more_ = (t) + 1 < NT;                                                                                      \
        if (more_) SLOAD((t) + 1);                                                                                            \
        if (ACT(t)) {                                                                                                         \
            ASBAR(); if constexpr (F8) qkt8<DQK>(p0, p1, K_lds + (B) * KT, r32, hi, q8, f8scale); else qkt<DQK>(p0, p1, K_lds + (B) * KT, r32, hi, qr);     \
            if constexpr (MODE != 0) {                                                                                                          \
                const int kmax_ = A.tpmax[KB_(t) >> 6];                                                                       \
                if (qminw - kmax_ >= 128) { const float bc = biasL[128];                                                      \
                    _Pragma("unroll") for (int r = 0; r < 16; ++r) { p0[r] = fmaf(p0[r], A.c2, bc); p1[r] = fmaf(p1[r], A.c2, bc); } }   \
                else {                                                                                                        \
                    _Pragma("unroll") for (int g4 = 0; g4 < 4; ++g4) {                                                        \
                        const i32x4 pk0 = *(const i32x4*)(A.pos + KB_(t) + 8 * g4 + 4 * hi);                                  \
                        const i32x4 pk1 = *(const i32x4*)(A.pos + KB_(t) + 32 + 8 * g4 + 4 * hi);                             \
                        _Pragma("unroll") for (int e = 0; e < 4; ++e) {                                                       \
                            const int d0_ = min(max(posq - pk0[e], 0), 128), d1_ = min(max(posq - pk1[e], 0), 128);           \
                            p0[4 * g4 + e] = fmaf(p0[4 * g4 + e], A.c2, biasL[d0_]); p1[4 * g4 + e] = fmaf(p1[4 * g4 + e], A.c2, biasL[d1_]); } } }   \
            }                                                                                                                 \
            if (NEEDMASK(t)) mask_tile(p0, p1, (qlo + r32 - 4 * hi) - KB_(t));                                                \
            partialSM<MODE == 0>(p0, p1, m_reg, alpha, A.c2);                                                                 \
            if (__any(alpha < 1.f)) { if (hi == 0) al_l[r32] = alpha; asm volatile("s_waitcnt lgkmcnt(0)" ::: "memory");      \
                _Pragma("unroll") for (int d_ = 0; d_ < 4; ++d_) _Pragma("unroll") for (int r = 0; r < 16; ++r) o[d_][r] *= al_l[crow(r, hi)];     \
                if constexpr (F8) { _Pragma("unroll") for (int r = 0; r < 16; ++r) o5[r] *= al_l[crow(r, hi)]; } }                                  \
            if constexpr (F8) { const lds_cptr vp_ = (lds_cptr)V_lds + (B) * VT_BYTES + v8r; v8i_t vf[4], p8;                   \
              _Pragma("unroll") for (int d_ = 0; d_ < 4; ++d_) { vf[d_].lo = *(const __attribute__((address_space(3))) v4i_t*)(vp_ + d_ * 2048);  \
                  vf[d_].hi = *(const __attribute__((address_space(3))) v4i_t*)((lds_cptr)V_lds + (B) * VT_BYTES + (v8r ^ 16) + d_ * 2048); }           \
              finishSM_e(p1);                                                                                                  \
              _Pragma("unroll") for (int j_ = 0; j_ < 4; ++j_) { p8[j_] = (int)pk4f8(p0[4 * j_], p0[4 * j_ + 1], p0[4 * j_ + 2], p0[4 * j_ + 3]);     \
                  p8[4 + j_] = (int)pk4f8(p1[4 * j_], p1[4 * j_ + 1], p1[4 * j_ + 2], p1[4 * j_ + 3]); }                       \
              __builtin_amdgcn_s_setprio(1);                                                                                   \
              _Pragma("unroll") for (int d_ = 0; d_ < 4; ++d_)                                                                 \
                  asm volatile("v_mfma_scale_f32_32x32x64_f8f6f4 %0, %1, %2, %0, %3, %3 op_sel_hi:[0,0,0]" : "+v"(o[d_]) : "v"(p8), "v"(vf[d_]), "v"(f8scale));   \
              { v8i_t ones8 = {0x38383838, 0x38383838, 0x38383838, 0x38383838, 0x38383838, 0x38383838, 0x38383838, 0x38383838}; asm volatile("" : "+v"(ones8));        \
                asm volatile("v_mfma_scale_f32_32x32x64_f8f6f4 %0, %1, %2, %0, %3, %3 op_sel_hi:[0,0,0]" : "+v"(o5) : "v"(p8), "v"(ones8), "v"(f8scale)); }        \
              __builtin_amdgcn_s_setprio(0); }                                                                                 \
            else { const lds_cptr vp_ = vp0 + (B) * VT_BYTES; s16x4 fa[8], fb[8];                                                    \
              finishSM_a(p0, p1, alpha, l_reg); PK4(p0, 0, pa0); PK4(p0, 8, pa1);                                             \
              VRD(fa, vp_, 0); PK4(p1, 0, pa2); PK4(p1, 8, pa3);                                                              \
              VRD(fb, vp_, 1); PVMMA(fa, 0); VRD(fa, vp_, 2); PVMMA(fb, 1); VRD(fb, vp_, 3); PVMMA(fa, 2); PVMMA(fb, 3); }    \
        }                                                                                                                     \
        if (more_) SWRITE((B) ^ 1);                                                                                           \
        __syncthreads(); } while (0)
    for (int t = 0; t < NT; t += 2) { STEP(t, 0); STEP(t + 1, 1); }
    if constexpr (F8) asm volatile("s_nop 15\n\ts_nop 7" : "+v"(o[0]), "+v"(o[1]), "+v"(o[2]), "+v"(o[3]), "+v"(o5));
#undef STEP
#undef ACT
#undef NEEDMASK
#undef KB_
#undef SLOAD
#undef SWRITE
    if (hi == 0) { if constexpr (!F8) li_l[r32] = l_reg; ix_l[r32] = valid ? (qrow * 16 + A.h) * 4 + jslot : -1; }
    asm volatile("s_waitcnt lgkmcnt(0)" ::: "memory");
    if constexpr (MODE != 0) { if (hi == 0 && valid) { float* ml = A.PML + (size_t)((qrow * 16 + A.h) * 4 + jslot) * 2; ml[0] = m_reg; if constexpr (!F8) ml[1] = l_reg; } }
#pragma unroll
    for (int r = 0; r < 16; ++r) { const int orow = crow(r, hi); const float rl = __builtin_amdgcn_rcpf(F8 ? o5[r] : li_l[orow]);
        bf16_t* dst; bool ok = true;
        if constexpr (MODE == 0) dst = A.O + (size_t)(qlo + orow) * A.opitch;
        else { const int ix = ix_l[orow]; ok = ix >= 0; dst = A.PO + (size_t)(ok ? ix : 0) * 128;
            if constexpr (F8) { if (r32 == 0 && ok) A.PML[(size_t)ix * 2 + 1] = o5[r]; } }
#pragma unroll
        for (int d0 = 0; d0 < 4; ++d0) { const float v = o[d0][r] * rl; const float vn = __shfl_xor(v, 1);
            if ((r32 & 1) == 0 && ok) *(unsigned*)(dst + d0 * 32 + r32) = cvtpk(v, vn); } }
    __syncthreads();
}
}
constexpr int NWAVES = 8;
constexpr int M_ = 16384, DM = 4096, DFF = 11008, NFF2 = 2 * DFF;
constexpr int NH = 16, QLORA = 1024, KVLORA = 512, ROPE = 64, NOPE = 128, VDIM = 128, QUP = NH * 192, KVUP = NH * 256, MLAOUT = NH * 128, MOBAW = NH * 128;
constexpr int INCOLS = 15936, INPAD1 = 5888, IN2 = 10240;
constexpr int MBLK = 256, NBLK = M_ / MBLK;
constexpr float RMS_EPS = 1e-6f;
constexpr size_t MiB = 1u << 20;
constexpr size_t WS_CTL = 0, CTL_ZERO_BYTES = 1 * MiB;
constexpr size_t WS_WFFN_IN = 1 * MiB;
constexpr size_t WS_WFFN_OUT = WS_WFFN_IN + (size_t)NFF2 * DM * 2;
constexpr size_t WS_WFFN_END = WS_WFFN_OUT + (size_t)DM * DFF * 2;
constexpr size_t WS_PO = WS_WFFN_IN;
constexpr size_t WS_WIN = WS_WFFN_END;
constexpr size_t WS_WIN8 = WS_WIN + (size_t)INPAD1 * DM * 2;
constexpr size_t WS_WUQ = WS_WIN8 + (size_t)IN2 * DM;
constexpr size_t WS_WUKV = WS_WUQ + (size_t)QUP * QLORA * 2;
constexpr size_t WS_WBRA = WS_WUKV + (size_t)KVUP * KVLORA * 2;
constexpr size_t WS_WBRB = WS_WBRA + (size_t)DM * MLAOUT * 2;
constexpr size_t WS_WOUT = WS_WBRB + (size_t)DM * MOBAW * 2;
constexpr size_t WS_H = WS_WOUT + (size_t)DM * DM * 2;
constexpr size_t WS_LIST = WS_H;
constexpr size_t LIST_PER_HEAD = 516096;
constexpr size_t WS_PML = WS_LIST + LIST_PER_HEAD * NH * 4;
constexpr size_t WS_BIG = WS_H + (size_t)M_ * DM * 2;
constexpr size_t WS_CQ = WS_BIG;
constexpr size_t WS_CKV = WS_CQ + (size_t)M_ * QLORA * 2;
constexpr size_t WS_KR = WS_CKV + (size_t)M_ * KVLORA * 2;
constexpr size_t WS_QB = WS_KR + (size_t)M_ * ROPE * 2;
constexpr size_t WS_KB = WS_QB + (size_t)M_ * MOBAW * 2;
constexpr size_t WS_VB = WS_KB + (size_t)M_ * MOBAW * 2;
constexpr size_t WS_GA = WS_VB + (size_t)M_ * MOBAW * 2;
constexpr size_t WS_GB = WS_GA + (size_t)M_ * DM * 2;
constexpr size_t WS_BIG_END = WS_GB + (size_t)M_ * DM * 2;
constexpr size_t WS_QM8 = WS_BIG_END;
constexpr size_t WS_KN8 = WS_QM8 + (size_t)M_ * QUP;
constexpr size_t WS_KR8 = WS_KN8 + (size_t)M_ * 2048;
constexpr size_t WS_V8 = WS_KR8 + (size_t)M_ * 64;
constexpr size_t WS_QB8 = WS_V8 + (size_t)M_ * 2048;
constexpr size_t WS_KB8 = WS_QB8 + (size_t)M_ * 2048;
constexpr size_t WS_VB8 = WS_KB8 + (size_t)M_ * 2048;
constexpr size_t WS_OA = WS_VB8 + (size_t)M_ * 2048;
constexpr size_t WS_COS = WS_OA + (size_t)M_ * MLAOUT * 2;
constexpr size_t WS_SIN = WS_COS + (size_t)M_ * 32 * 4;
constexpr size_t WS_KMH = WS_SIN + (size_t)M_ * 32 * 4;
constexpr size_t WS_KML = WS_KMH + (size_t)NH * NBLK * 128 * 2;
constexpr size_t WS_BIAS = WS_KML + (size_t)NH * NBLK * 128 * 2;
constexpr size_t WS_TPMAX = WS_BIAS + 16 * 132 * 4;
constexpr size_t WS_PART = WS_TPMAX + 256 * 4;
constexpr size_t WS_RSTD = WS_PART + (size_t)M_ * 64 * 4;
constexpr size_t WS_PARTQ = WS_RSTD + (size_t)M_ * 4;
constexpr size_t WS_PARTKV = WS_PARTQ + (size_t)M_ * 16 * 4;
constexpr size_t WS_RSTDQ = WS_PARTKV + (size_t)M_ * 8 * 4;
constexpr size_t WS_RSTDKV = WS_RSTDQ + (size_t)M_ * 4;
constexpr size_t WS_H8 = WS_RSTDKV + (size_t)M_ * 4;
constexpr size_t WS_OA8 = WS_H8 + (size_t)M_ * DM;
constexpr size_t WS_OB8 = WS_OA8 + (size_t)M_ * MLAOUT;
constexpr size_t WS_MG8 = WS_OB8 + (size_t)M_ * MOBAW;
constexpr size_t WS_PMAX = WS_MG8 + (size_t)M_ * DM;
constexpr size_t WS_CPART = WS_PMAX + (size_t)M_ * 64 * 4;
constexpr size_t WS_CMAXF = WS_CPART + (size_t)8 * 2 * NFF2 * 4;
constexpr size_t WS_QM = ((WS_CMAXF + (size_t)2 * NFF2 * 4 + 4095) / 4096) * 4096;
constexpr size_t WS_KV = WS_QM + (size_t)M_ * QUP * 2;
constexpr size_t WS_WFI2 = MLA_BF16 ? WS_KV + (size_t)M_ * KVUP * 2 : WS_QM;
constexpr size_t WS_END = WS_WFI2 + (size_t)NFF2 * DM;
static_assert(WS_PML + (size_t)M_ * NH * 4 * 2 * 4 <= WS_BIG, "lists + ml inside H");
static_assert((size_t)M_ * NH * 4 * 128 * 2 <= WS_WFFN_END - WS_WFFN_IN, "partial O inside FFN weight region");
static_assert((size_t)M_ * DFF * 2 <= WS_BIG_END - WS_BIG, "act inside BIG");
constexpr int CW_TMO = 0;
constexpr int CW_BAR = 4096;
constexpr int CW_GCNT = 16384;
constexpr int CW_CMAX = 196608;
constexpr int CW_KMEAN = 65536;
constexpr int RING_OFF = 0, RING_BYTES = 131072;
constexpr int LDSCTL_OFF = RING_BYTES, MISC_OFF = LDSCTL_OFF + 320;
constexpr int LDS_BYTES = 147456;
static_assert(att::L_END <= RING_BYTES, "attention LDS inside ring region");

#define GAS __attribute__((address_space(1)))
#define LAS __attribute__((address_space(3)))
typedef unsigned short bf16;
typedef unsigned v4u __attribute__((ext_vector_type(4)));
typedef unsigned v2u __attribute__((ext_vector_type(2)));
typedef float f32x4 __attribute__((ext_vector_type(4)));
typedef short bf16x8 __attribute__((ext_vector_type(8)));
typedef float f32x16 __attribute__((ext_vector_type(16)));
typedef GAS unsigned gu32;
#define RLX_AGENT __ATOMIC_RELAXED, __HIP_MEMORY_SCOPE_AGENT
#define LDS_WAIT() asm volatile("s_waitcnt lgkmcnt(0)" ::: "memory")
__device__ __forceinline__ unsigned f2bf(float f) { unsigned u = __builtin_bit_cast(unsigned, f); return (u + 0x7fffu + ((u >> 16) & 1u)) >> 16; }
__device__ __forceinline__ unsigned pk2(float lo, float hi) { return f2bf(lo) | (f2bf(hi) << 16); }
__device__ __forceinline__ float bfu_lo(unsigned w) { return __uint_as_float(w << 16); }
__device__ __forceinline__ float bfu_hi(unsigned w) { return __uint_as_float(w & 0xffff0000u); }

#define XB_TMO      128
#define XB_XCNT(j)  (256  + 64 * (j))
#define XB_XSUB(j)  (1280 + 64 * (j))
#define XB_XGEN(j)  (2304 + 64 * (j))
#define XB_TOP      3328
#define XB_TOPGEN   3392
#define XCD_BAR_WORDS 3456
#define XB_SPIN_CAP (1u << 22)
__device__ __forceinline__ unsigned xb_ld(unsigned* p)              { return __hip_atomic_load(p, __ATOMIC_RELAXED, __HIP_MEMORY_SCOPE_AGENT); }
__device__ __forceinline__ unsigned xb_add(unsigned* p, unsigned v) { return __hip_atomic_fetch_add(p, v, __ATOMIC_RELAXED, __HIP_MEMORY_SCOPE_AGENT); }
__device__ __forceinline__ unsigned xb_xcc_id() { return (unsigned)__builtin_amdgcn_s_getreg((3 << 11) | 20) & 0xFu; }
#define XB_SPIN(cond, bar) do { unsigned _sp = 0; while (cond) { __builtin_amdgcn_s_sleep(1); \
    if ((++_sp & 255u) == 0u) { if (xb_ld(&(bar)[XB_TMO])) break; if (_sp > XB_SPIN_CAP) { atomicAdd(&(bar)[XB_TMO], 1u); break; } } } } while (0)
struct XcdBarrier { unsigned* bar; unsigned x; volatile LAS unsigned* st; };
__device__ __forceinline__ XcdBarrier xcd_barrier_post(unsigned* bar, volatile LAS unsigned* st, int wv) {
    XcdBarrier b; b.bar = bar; b.x = xb_xcc_id(); b.st = st;
    if (wv == 0 && lane_id_() == 0) (void)xb_add(&bar[XB_XCNT(b.x)], 1u);
    return b;
}
__device__ __forceinline__ void xcd_barrier_complete(unsigned* bar, unsigned x, unsigned& nloc, unsigned& nx) {
    const unsigned G = gridDim.x * gridDim.y * gridDim.z;
    unsigned sum, cnt, mine, sp = 0u;
    for (;;) {
        sum = 0u; cnt = 0u; mine = 0u;
#pragma unroll
        for (unsigned j = 0; j < 16; ++j) { const unsigned c = xb_ld(&bar[XB_XCNT(j)]); sum += c; cnt += (c > 0u) ? 1u : 0u; mine = (j == x) ? c : mine; }
        if (sum == G) break;
        __builtin_amdgcn_s_sleep(1);
        if ((++sp & 255u) == 0u) { if (xb_ld(&bar[XB_TMO])) break; if (sp > XB_SPIN_CAP) { atomicAdd(&bar[XB_TMO], 1u); break; } }
    }
    nloc = mine > 0u ? mine : 1u; nx = cnt > 0u ? cnt : 1u;
}
__device__ __forceinline__ void xcd_barrier(const XcdBarrier& b, int wv) {
    asm volatile("s_waitcnt vmcnt(0)" ::: "memory");
    __syncthreads();
    if (wv == 0 && lane_id_() == 0) {
        unsigned* bar = b.bar;
        __builtin_amdgcn_s_waitcnt(0);
        unsigned nloc = b.st[0], nx = b.st[1];
        if (nloc == 0u) { xcd_barrier_complete(bar, b.x, nloc, nx); b.st[0] = nloc; b.st[1] = nx; }
        const unsigned old = xb_add(&bar[XB_XSUB(b.x)], 1u);
        const unsigned gen = old / nloc;
        if (old + 1u == (gen + 1u) * nloc) {
            __builtin_amdgcn_fence(__ATOMIC_RELEASE, "agent");
            asm volatile("s_waitcnt vmcnt(0)" ::: "memory");
            const unsigned og = xb_add(&bar[XB_TOP], 1u);
            const unsigned tg = og / nx;
            if (og + 1u == (tg + 1u) * nx) xb_add(&bar[XB_TOPGEN], 1u);
            else XB_SPIN(xb_ld(&bar[XB_TOPGEN]) == tg, bar);
            __builtin_amdgcn_fence(__ATOMIC_ACQUIRE, "agent");
            xb_add(&bar[XB_XGEN(b.x)], 1u);
            asm volatile("s_waitcnt vmcnt(0)" ::: "memory");
        } else {
            XB_SPIN(xb_ld(&bar[XB_XGEN(b.x)]) == gen, bar);
            __builtin_amdgcn_fence(__ATOMIC_ACQUIRE, "agent");
            asm volatile("s_waitcnt vmcnt(0)" ::: "memory");
        }
    }
    __syncthreads();
}
struct Args {
    const float* in[19]; float* out; unsigned char* ws;
    double invf[32];
    unsigned char bucket[136];
};
__device__ __forceinline__ float wave_sum(float v) {
#pragma unroll
    for (int o = 1; o < 64; o <<= 1) v += __shfl_xor(v, o);
    return v;
}
__device__ __forceinline__ void cvt_item(const float* W, int Nsrc, int scol0, bool ropep, bf16* Wt, int K, int drow0, int k0, LAS unsigned char* T, int lane, const float* gain, int tiledN = 0, int f8s = -1, const float* cmax = nullptr, int cstride = 0, float* cmfinal = nullptr) {
    const int rp = lane >> 4, c4 = lane & 15;
    if (scol0 >= 0) {
#pragma unroll
        for (int i = 0; i < 8; ++i) { const int k = 8 * i + 2 * rp;
            f32x4 a = __builtin_nontemporal_load((const GAS f32x4*)(W + (size_t)(k0 + k) * Nsrc + scol0 + 4 * c4));
            f32x4 b = __builtin_nontemporal_load((const GAS f32x4*)(W + (size_t)(k0 + k + 1) * Nsrc + scol0 + 4 * c4));
            if (gain) { a = a * gain[k0 + k]; b = b * gain[k0 + k + 1]; }
#pragma unroll
            for (int e = 0; e < 4; ++e) { const int c = 4 * c4 + e; *(LAS unsigned*)(T + c * 136 + k * 2) = pk2(a[e], b[e]); } }
    }
    LDS_WAIT(); asm volatile("" ::: "memory");
    const int kc = lane & 7, nr = lane >> 3;
#pragma unroll
    for (int j = 0; j < 8; ++j) { const int c = 8 * j + nr;
        v4u o = {0u, 0u, 0u, 0u};
        if (scol0 >= 0) { const v2u lo = *(const LAS v2u*)(T + c * 136 + kc * 16), hi2 = *(const LAS v2u*)(T + c * 136 + kc * 16 + 8); o.x = lo.x; o.y = lo.y; o.z = hi2.x; o.w = hi2.y; }
        int p = c; if (ropep) { const int half = c >> 5, i5 = c & 31; p = 8 * (i5 >> 2) + (i5 & 3) + 4 * half; }
        if (cmax) {
            float cm = 0.f;
#pragma unroll
            for (int sg_ = 0; sg_ < 8; ++sg_) cm = fmaxf(cm, cmax[(size_t)sg_ * cstride + scol0 + c]);
            if (k0 == 0 && kc == 0) cmfinal[scol0 + c] = cm;
            const float inv = 127.f / fmaxf(cm, 1e-30f); const float v8[8] = {bfu_lo(o.x), bfu_hi(o.x), bfu_lo(o.y), bfu_hi(o.y), bfu_lo(o.z), bfu_hi(o.z), bfu_lo(o.w), bfu_hi(o.w)};
            unsigned q0 = 0, q1 = 0;
#pragma unroll
            for (int e = 0; e < 4; ++e) { q0 |= ((unsigned)(int)rintf(v8[e] * inv) & 0xffu) << (8 * e); q1 |= ((unsigned)(int)rintf(v8[4 + e] * inv) & 0xffu) << (8 * e); }
            v2u q; q.x = q0; q.y = q1;
            *(GAS v2u*)((unsigned char*)Wt + ((size_t)(k0 >> 7) * tiledN + drow0 + p) * 128 + (k0 & 64) + 8 * kc) = q; }
        else if (f8s >= 0) {
            const float scl = __uint_as_float((unsigned)(127 + f8s) << 23); v2u q;
            int w0 = 0, w1 = 0;
            w0 = __builtin_amdgcn_cvt_pk_fp8_f32(bfu_lo(o.x) * scl, bfu_hi(o.x) * scl, w0, false); w0 = __builtin_amdgcn_cvt_pk_fp8_f32(bfu_lo(o.y) * scl, bfu_hi(o.y) * scl, w0, true);
            w1 = __builtin_amdgcn_cvt_pk_fp8_f32(bfu_lo(o.z) * scl, bfu_hi(o.z) * scl, w1, false); w1 = __builtin_amdgcn_cvt_pk_fp8_f32(bfu_lo(o.w) * scl, bfu_hi(o.w) * scl, w1, true);
            q.x = (unsigned)w0; q.y = (unsigned)w1;
            *(GAS v2u*)((unsigned char*)Wt + ((size_t)(k0 >> 7) * tiledN + drow0 + p) * 128 + (k0 & 64) + 8 * kc) = q; }
        else if (tiledN) *(GAS v4u*)(Wt + ((size_t)(k0 >> 6) * tiledN + drow0 + p) * 64 + 8 * kc) = o;
        else *(GAS v4u*)(Wt + (size_t)(drow0 + p) * K + k0 + 8 * kc) = o; }
    LDS_WAIT(); asm volatile("" ::: "memory");
}
template <int KIND>
__device__ __forceinline__ void cvt_job(const float* W, int K, int Nsrc, bf16* Wt, int ndb, LAS unsigned char* T, int gw, int NGW, int lane, const float* gain = nullptr, int tiledN = 0, int f8s = -1, const float* cmax = nullptr, int cstride = 0, float* cmfinal = nullptr, int jph = 0, int jnp = 1) {
    const int nkb = K / 64, nit = ndb * nkb;
    for (int it = gw + NGW * jph; it < nit; it += NGW * jnp) { const int db = it / nkb, kb = it - db * nkb;
        int scol = 64 * db; bool rp = false;
        if constexpr (KIND == 1) { const int pn = db >> 2, sub = db & 3; scol = (sub < 2) ? (128 * pn + 64 * sub) : (DFF + 128 * pn + 64 * (sub - 2)); }
        if constexpr (KIND == 2) { if (db < 24) scol = 64 * db; else if (db < 88) scol = 64 * db + 64; else if (db == 88) { scol = 1536; rp = true; } else scol = -1; }
        if constexpr (KIND == 4) { scol = 5696 + 64 * db; }
        if constexpr (KIND == 3) { rp = (db % 3) == 2; }
        cvt_item(W, Nsrc, scol, rp, Wt, K, 64 * db, 64 * kb, T, lane, gain, tiledN, f8s, cmax, cstride, cmfinal); }
}
template <bool OUTF32>
__device__ __forceinline__ void rms_row4096(const float* xrow, const float* g, void* orow, int lane, int tiledM = 0) {
    const GAS f32x4* xr = (const GAS f32x4*)xrow + lane;
    f32x4 v[16]; float s = 0.f;
#pragma unroll
    for (int j = 0; j < 16; ++j) { v[j] = xr[64 * j]; s += (v[j].x * v[j].x + v[j].y * v[j].y) + (v[j].z * v[j].z + v[j].w * v[j].w); }
    const float rstd = 1.0f / sqrtf(wave_sum(s) * (1.f / DM) + RMS_EPS);
    const GAS f32x4* gr = (const GAS f32x4*)g + lane;
#pragma unroll
    for (int j = 0; j < 16; ++j) { const f32x4 gg = gr[64 * j]; const f32x4 y = (v[j] * rstd) * gg;
        if constexpr (OUTF32) ((GAS f32x4*)orow)[64 * j + lane] = y;
        else { v2u w; w.x = pk2(y.x, y.y); w.y = pk2(y.z, y.w);
            if (tiledM) { const int col = 4 * (64 * j + lane); *(GAS v2u*)((bf16*)orow + ((size_t)(col >> 6) * tiledM) * 64 + (col & 63)) = w; }
            else ((GAS v2u*)orow)[64 * j + lane] = w; } }
}
template <int N>
__device__ __forceinline__ void rms_row_bf16(bf16* row, const float* g, int lane) {
    constexpr int NV = N / 512;
    v4u w[NV]; float s = 0.f;
#pragma unroll
    for (int j = 0; j < NV; ++j) { w[j] = *(const GAS v4u*)(row + (64 * j + lane) * 8);
#pragma unroll
        for (int e = 0; e < 4; ++e) { const float a = bfu_lo(w[j][e]), b = bfu_hi(w[j][e]); s += a * a + b * b; } }
    const float rstd = 1.0f / sqrtf(wave_sum(s) * (1.f / N) + RMS_EPS);
#pragma unroll
    for (int j = 0; j < NV; ++j) { const GAS f32x4* gp = (const GAS f32x4*)(g + (64 * j + lane) * 8); const f32x4 g0 = gp[0], g1 = gp[1]; v4u o;
        o.x = pk2(bfu_lo(w[j].x) * rstd * g0.x, bfu_hi(w[j].x) * rstd * g0.y); o.y = pk2(bfu_lo(w[j].y) * rstd * g0.z, bfu_hi(w[j].y) * rstd * g0.w);
        o.z = pk2(bfu_lo(w[j].z) * rstd * g1.x, bfu_hi(w[j].z) * rstd * g1.y); o.w = pk2(bfu_lo(w[j].w) * rstd * g1.z, bfu_hi(w[j].w) * rstd * g1.w);
        *(GAS v4u*)(row + (64 * j + lane) * 8) = o; }
}
__device__ __forceinline__ void colmax_job(const float* W, int K, int N, float* cpart, int cstride, int gw, int NGW, int lane) {
    const int nseg = K / 512, ntask = (N / 64) * nseg, rp = lane >> 4, c4 = lane & 15;
    for (int it = gw; it < ntask; it += NGW) { const int cb = it / nseg, sg = it - cb * nseg; f32x4 m = {0.f, 0.f, 0.f, 0.f};
        const float* wp = W + (size_t)(sg * 512 + rp) * N + cb * 64 + 4 * c4;
#pragma unroll 8
        for (int i = 0; i < 128; ++i) { const f32x4 v = __builtin_nontemporal_load((const GAS f32x4*)(wp + (size_t)(4 * i) * N));
            m[0] = fmaxf(m[0], fabsf(v[0])); m[1] = fmaxf(m[1], fabsf(v[1])); m[2] = fmaxf(m[2], fabsf(v[2])); m[3] = fmaxf(m[3], fabsf(v[3])); }
#pragma unroll
        for (int e = 0; e < 4; ++e) { float x = m[e]; x = fmaxf(x, __shfl_xor(x, 16)); x = fmaxf(x, __shfl_xor(x, 32)); if (rp == 0) cpart[(size_t)sg * cstride + cb * 64 + 4 * c4 + e] = x; } }
}
__device__ __forceinline__ void rms_row4096_i8(const float* xrow, const float* g, unsigned char* a8, int row, float* rs, int lane) {
    const GAS f32x4* xr = (const GAS f32x4*)xrow + lane;
    f32x4 v[16]; float s = 0.f;
#pragma unroll
    for (int j = 0; j < 16; ++j) { v[j] = xr[64 * j]; s += (v[j].x * v[j].x + v[j].y * v[j].y) + (v[j].z * v[j].z + v[j].w * v[j].w); }
    const float rstd = 1.0f / sqrtf(wave_sum(s) * (1.f / DM) + RMS_EPS);
    const GAS f32x4* gr = (const GAS f32x4*)g + lane; float mx = 0.f;
#pragma unroll
    for (int j = 0; j < 16; ++j) { const f32x4 gg = gr[64 * j]; v[j] = (v[j] * rstd) * gg; mx = fmaxf(fmaxf(mx, fmaxf(fabsf(v[j].x), fabsf(v[j].y))), fmaxf(fabsf(v[j].z), fabsf(v[j].w))); }
#pragma unroll
    for (int o = 1; o < 64; o <<= 1) mx = fmaxf(mx, __shfl_xor(mx, o));
    mx = fmaxf(mx, 1e-30f); const float inv = 127.f / mx;
#pragma unroll
    for (int j = 0; j < 16; ++j) { const int col = 4 * (64 * j + lane);
        const unsigned q = ((unsigned)(int)rintf(v[j].x * inv) & 0xffu) | (((unsigned)(int)rintf(v[j].y * inv) & 0xffu) << 8) | (((unsigned)(int)rintf(v[j].z * inv) & 0xffu) << 16) | (((unsigned)(int)rintf(v[j].w * inv) & 0xffu) << 24);
        *(GAS unsigned*)(a8 + ((size_t)(col >> 7) * M_ + row) * 128 + (col & 127)) = q; }
    if (lane == 0) rs[row] = mx * (1.f / 127.f);
}
__device__ __forceinline__ void quant_row_i8(const bf16* hb, const float* part, const float* pmax, unsigned char* a8, int row, float* rs, int lane) {
    float s = part[(size_t)row * 64 + lane], mx = pmax[(size_t)row * 64 + lane];
    s = wave_sum(s);
#pragma unroll
    for (int o = 1; o < 64; o <<= 1) mx = fmaxf(mx, __shfl_xor(mx, o));
    mx = fmaxf(mx, 1e-30f); const float inv = 127.f / mx;
    const GAS v4u* src = (const GAS v4u*)(hb + ((size_t)lane * M_ + row) * 64);
    v4u w[8];
#pragma unroll
    for (int j = 0; j < 8; ++j) w[j] = src[j];
    v4u o[4];
#pragma unroll
    for (int j = 0; j < 8; ++j) { unsigned q0 = 0, q1 = 0;
#pragma unroll
        for (int e = 0; e < 2; ++e) { const unsigned a = w[j][e], b = w[j][2 + e];
            q0 |= (((unsigned)(int)rintf(bfu_lo(a) * inv) & 0xffu) | (((unsigned)(int)rintf(bfu_hi(a) * inv) & 0xffu) << 8)) << (16 * e);
            q1 |= (((unsigned)(int)rintf(bfu_lo(b) * inv) & 0xffu) | (((unsigned)(int)rintf(bfu_hi(b) * inv) & 0xffu) << 8)) << (16 * e); }
        o[j >> 1][2 * (j & 1)] = q0; o[j >> 1][2 * (j & 1) + 1] = q1; }
    GAS v4u* dst = (GAS v4u*)(a8 + ((size_t)(lane >> 1) * M_ + row) * 128 + (lane & 1) * 64);
#pragma unroll
    for (int j = 0; j < 4; ++j) dst[j] = o[j];
    if (lane == 0) rs[row] = mx * (1.f / 127.f) / sqrtf(s * (1.f / DM) + RMS_EPS);
}
template <int NP>
__device__ __forceinline__ void rstd_reduce(const float* part, float* rstd, float inv_n, int vcu, int tid, int G) {
    for (int row = vcu * (NWAVES * 64) + tid; row < M_; row += G * NWAVES * 64) { float s = 0.f;
#pragma unroll
        for (int j = 0; j < NP / 4; ++j) { const f32x4 v = *(const GAS f32x4*)(part + (size_t)row * NP + 4 * j); s += (v.x + v.y) + (v.z + v.w); }
        rstd[row] = 1.0f / sqrtf(s * inv_n + RMS_EPS); }
}
__device__ __forceinline__ void sincos_d(double a, float& sn, float& cs) {
    const double k = rint(a * 0.63661977236758134308);
    double r = fma(-k, 1.57079632679489655800, a); r = fma(-k, 6.12323399573676603587e-17, r);
    const double r2 = r * r;
    const double sp = r + r * r2 * (-1.0 / 6 + r2 * (1.0 / 120 + r2 * (-1.0 / 5040 + r2 * (1.0 / 362880 + r2 * (-1.0 / 39916800)))));
    const double cp = 1.0 + r2 * (-0.5 + r2 * (1.0 / 24 + r2 * (-1.0 / 720 + r2 * (1.0 / 40320 + r2 * (-1.0 / 3628800 + r2 * (1.0 / 479001600))))));
    const int q = (int)((long long)k & 3);
    const double s_ = (q & 1) ? cp : sp, c_ = (q & 1) ? sp : cp;
    sn = (float)((q & 2) ? -s_ : s_); cs = (float)(((q + 1) & 2) ? -c_ : c_);
}
__device__ __forceinline__ int list_off(int kb) { return 16384 * kb - 128 * kb * (kb + 1); }
__device__ __forceinline__ bool better(float v, int i, float cv, int ci) { return v > cv || (v == cv && i < ci); }
#define TOP3_INS(v_, i_) do { const float vv_ = (v_); const int ii_ = (i_);                                             \
        const bool c0_ = better(vv_, ii_, tv0, ti0), c1_ = better(vv_, ii_, tv1, ti1), c2_ = better(vv_, ii_, tv2, ti2); \
        tv2 = c1_ ? tv1 : (c2_ ? vv_ : tv2); ti2 = c1_ ? ti1 : (c2_ ? ii_ : ti2);                                       \
        tv1 = c0_ ? tv0 : (c1_ ? vv_ : tv1); ti1 = c0_ ? ti0 : (c1_ ? ii_ : ti1);                                       \
        tv0 = c0_ ? vv_ : tv0; ti0 = c0_ ? ii_ : ti0; } while (0)
__device__ __forceinline__ void moba_gate_unit(int h, int qb, const bf16* QB, const float* KMF, unsigned* gcnt, unsigned* list, float* PML,
                                               LAS unsigned* cntL, LAS unsigned* baseL, int wv) {
    int tid_ = wv * 64 + lane_id_(); asm volatile("" : "+v"(tid_)); const int tid = tid_, wid = wv, lane = tid & 63, r32 = lane & 31, hi = lane >> 5;
    if (tid < 64) cntL[tid] = 0u;
    __syncthreads();
    const int s = qb * MBLK + wid * 32 + r32;
    bf16x8 qr[8];
#pragma unroll
    for (int d0 = 0; d0 < 8; ++d0) qr[d0] = *(const GAS bf16x8*)(QB + (size_t)s * MOBAW + h * 128 + d0 * 16 + hi * 8);
    f32x16 p0 = {}, p1 = {};
#pragma unroll
    for (int d0 = 0; d0 < 8; ++d0) {
#pragma unroll
        for (int half = 0; half < 2; ++half) { const float* kp = KMF + (size_t)(h * NBLK + half * 32 + r32) * 128 + d0 * 16 + hi * 8;
            const f32x4 a = *(const GAS f32x4*)kp, b = *(const GAS f32x4*)(kp + 4); const float v[8] = {a[0], a[1], a[2], a[3], b[0], b[1], b[2], b[3]};
            bf16x8 fh, fl;
#pragma unroll
            for (int j = 0; j < 8; ++j) { const unsigned hb_ = f2bf(v[j]); fh[j] = (short)hb_; fl[j] = (short)f2bf(v[j] - __uint_as_float(hb_ << 16)); }
            if (half == 0) { p0 = __builtin_amdgcn_mfma_f32_32x32x16_bf16(fh, qr[d0], p0, 0, 0, 0); p0 = __builtin_amdgcn_mfma_f32_32x32x16_bf16(fl, qr[d0], p0, 0, 0, 0); }
            else { p1 = __builtin_amdgcn_mfma_f32_32x32x16_bf16(fh, qr[d0], p1, 0, 0, 0); p1 = __builtin_amdgcn_mfma_f32_32x32x16_bf16(fl, qr[d0], p1, 0, 0, 0); } } }
    const float NEG = -__builtin_inff();
    float tv0 = NEG, tv1 = NEG, tv2 = NEG; int ti0 = 1000, ti1 = 1001, ti2 = 1002;
#pragma unroll
    for (int r = 0; r < 16; ++r) { const int n = (r & 3) + 8 * (r >> 2) + 4 * hi; TOP3_INS(n < qb ? p0[r] : NEG, n); }
#pragma unroll
    for (int r = 0; r < 16; ++r) { const int n = 32 + (r & 3) + 8 * (r >> 2) + 4 * hi; TOP3_INS(n < qb ? p1[r] : NEG, n); }
    { const float ov0 = __shfl_xor(tv0, 32), ov1 = __shfl_xor(tv1, 32), ov2 = __shfl_xor(tv2, 32);
      const int oi0 = __shfl_xor(ti0, 32), oi1 = __shfl_xor(ti1, 32), oi2 = __shfl_xor(ti2, 32);
      TOP3_INS(ov0, oi0); TOP3_INS(ov1, oi1); TOP3_INS(ov2, oi2); }
    const bool act = (hi == 0);
    const bool ok0 = act && tv0 > NEG, ok1 = act && tv1 > NEG, ok2 = act && tv2 > NEG;
    unsigned rk0 = 0, rk1 = 0, rk2 = 0;
    if (ok0) rk0 = atomicAdd((unsigned*)(cntL + ti0), 1u);
    if (ok1) rk1 = atomicAdd((unsigned*)(cntL + ti1), 1u);
    if (ok2) rk2 = atomicAdd((unsigned*)(cntL + ti2), 1u);
    if (act) { float* ml = PML + (size_t)((s * 16 + h) * 4) * 2;
        if (!ok0) { ml[0] = -1e30f; ml[1] = 0.f; } if (!ok1) { ml[2] = -1e30f; ml[3] = 0.f; } if (!ok2) { ml[4] = -1e30f; ml[5] = 0.f; } }
    __syncthreads();
    if (tid < 64) { const unsigned n = cntL[tid]; baseL[tid] = n ? atomicAdd(gcnt + h * NBLK + tid, n) : 0u; }
    __syncthreads();
    unsigned* lh = list + (size_t)h * LIST_PER_HEAD;
    if (ok0) lh[list_off(ti0) + baseL[ti0] + rk0] = (unsigned)s | (0u << 16);
    if (ok1) lh[list_off(ti1) + baseL[ti1] + rk1] = (unsigned)s | (1u << 16);
    if (ok2) lh[list_off(ti2) + baseL[ti2] + rk2] = (unsigned)s | (2u << 16);
    __syncthreads();
}
#if PROBE_PHASE == 500
constexpr int CW_FAIL = 8;
__device__ __forceinline__ float blk_reduce(float v, bool domax, float* red, int tid) {
#pragma unroll
    for (int o = 1; o < 64; o <<= 1) { const float y = __shfl_xor(v, o); v = domax ? fmaxf(v, y) : v + y; }
    __syncthreads();
    if ((tid & 63) == 0) red[tid >> 6] = v;
    __syncthreads();
    float r = red[0];
    for (int w = 1; w < 8; ++w) r = domax ? fmaxf(r, red[w]) : r + red[w];
    return r;
}
__device__ __forceinline__ float bfv(const bf16* p) { return __uint_as_float(((unsigned)*p) << 16); }
__device__ __forceinline__ int sample_row(int i) {
    const int fixed[16] = {0, 1, 31, 32, 63, 64, 255, 256, 257, 511, 512, 767, 1023, 8191, 16383, 16128};
    if (i < 16) return fixed[i];
    return (int)(((unsigned)i * 2654435761u) >> 18) & 16383;
}
__device__ __forceinline__ void selfcheck(unsigned char* lds, unsigned char* ws, const int* pos, const bf16* OBc, int G, int bid) {
    const int tid = threadIdx.x;
    float* lg = (float*)lds;
    float* red = (float*)(lds + 65536);
    float* po = (float*)(lds + 65536 + 64);
    float* gate = (float*)(lds + 65536 + 64 + 2048);
    int* sel = (int*)(lds + 65536 + 64 + 2048 + 256);
    gu32* ctl = (gu32*)(ws + WS_CTL);
    bf16* KR = (bf16*)(ws + WS_KR); bf16* QB = (bf16*)(ws + WS_QB); bf16* KB = (bf16*)(ws + WS_KB); bf16* VB = (bf16*)(ws + WS_VB);
    bf16* QM = (bf16*)(ws + WS_QM); bf16* KV = (bf16*)(ws + WS_KV); bf16* OA = (bf16*)(ws + WS_OA); float* BIAS = (float*)(ws + WS_BIAS);
    unsigned nbad = 0;
    for (int u = bid; u < 64 * 16; u += G) { const int s = sample_row(u >> 4), h = u & 15;
        { const bf16* q = QM + (size_t)s * QUP + h * 192; float mx = -1e30f;
          for (int k = tid; k <= s; k += 512) { const bf16* kn = KV + (size_t)k * KVUP + h * 256; const bf16* kr = KR + (size_t)k * 64; float a = 0.f;
              for (int d = 0; d < 128; ++d) a += bfv(q + d) * bfv(kn + d);
              for (int d = 0; d < 64; ++d) a += bfv(q + 128 + d) * bfv(kr + d);
              a *= 0.07216878364870322f; lg[k] = a; mx = fmaxf(mx, a); }
          mx = blk_reduce(mx, true, red, tid);
          float sm = 0.f; for (int k = tid; k <= s; k += 512) { const float p = expf(lg[k] - mx); lg[k] = p; sm += p; }
          sm = blk_reduce(sm, false, red, tid);
          const int d = tid & 127, part = tid >> 7; float o = 0.f;
          for (int k = part; k <= s; k += 4) o += lg[k] * bfv(KV + (size_t)k * KVUP + h * 256 + 128 + d);
          po[part * 128 + d] = o; __syncthreads();
          float amax = 0.f;
          if (tid < 128) { const float ref = (po[tid] + po[128 + tid] + po[256 + tid] + po[384 + tid]) / sm; po[tid] = ref; amax = fabsf(ref); }
          amax = blk_reduce(amax, true, red, tid);
          if (tid < 128) { const float got = bfv(OA + (size_t)s * MLAOUT + h * 128 + tid); if (!(fabsf(got - po[tid]) <= SELFCHECK_REL * amax + SELFCHECK_ABS)) nbad++; }
          __syncthreads(); }
        { const bf16* q = QB + (size_t)s * MOBAW + h * 128; const int qb = s >> 8; const int d = tid & 127, part = tid >> 7;
          for (int n = 0; n < qb; ++n) { float a = 0.f;
              for (int r = part * 64; r < part * 64 + 64; ++r) a += bfv(KB + (size_t)(n * 256 + r) * MOBAW + h * 128 + d);
              a = a * (1.f / 256.f) * bfv(q + d);
              a = blk_reduce(a, false, red, tid);
              if (tid == 0) gate[n] = a; }
          __syncthreads();
          if (tid == 0) { float g0 = -1e30f, g1 = -1e30f, g2 = -1e30f; int i0 = -1, i1 = -1, i2 = -1;
              for (int n = 0; n < qb; ++n) { const float g = gate[n];
                  if (g > g0) { g2 = g1; i2 = i1; g1 = g0; i1 = i0; g0 = g; i0 = n; } else if (g > g1) { g2 = g1; i2 = i1; g1 = g; i1 = n; } else if (g > g2) { g2 = g; i2 = n; } }
              sel[0] = i0; sel[1] = i1; sel[2] = i2; sel[3] = qb; }
          __syncthreads();
          float mx = -1e30f; const int pq = pos[s];
          for (int e = tid; e < 1024; e += 512) { const int j = e >> 8, kk = e & 255; const int blk = sel[j]; float a = -1e30f;
              if (blk >= 0) { const int key = blk * 256 + kk;
                  if (j < 3 || key <= s) { const bf16* kp = KB + (size_t)key * MOBAW + h * 128; float dsum = 0.f;
                      for (int dd = 0; dd < 128; ++dd) dsum += bfv(q + dd) * bfv(kp + dd);
                      int dist = pq - pos[key]; dist = dist < 0 ? 0 : (dist > 128 ? 128 : dist);
                      a = dsum * (0.08838834764831845f * 1.4426950408889634f) + BIAS[h * 132 + dist]; } }
              lg[e] = a; mx = fmaxf(mx, a); }
          mx = blk_reduce(mx, true, red, tid);
          float sm = 0.f; for (int e = tid; e < 1024; e += 512) { const float p = lg[e] > -1e29f ? exp2f(lg[e] - mx) : 0.f; lg[e] = p; sm += p; }
          sm = blk_reduce(sm, false, red, tid);
          float o = 0.f;
          for (int e = part; e < 1024; e += 4) { const int blk = sel[e >> 8]; if (blk >= 0 && lg[e] > 0.f) o += lg[e] * bfv(VB + (size_t)(blk * 256 + (e & 255)) * MOBAW + h * 128 + d); }
          po[part * 128 + d] = o; __syncthreads();
          float amax = 0.f;
          if (tid < 128) { const float ref = (po[tid] + po[128 + tid] + po[256 + tid] + po[384 + tid]) / sm; po[tid] = ref; amax = fabsf(ref); }
          amax = blk_reduce(amax, true, red, tid);
          if (tid < 128) { const float got = bfv(OBc + (size_t)s * MOBAW + h * 128 + tid); if (!(fabsf(got - po[tid]) <= SELFCHECK_REL * amax + SELFCHECK_ABS)) nbad++; }
          __syncthreads(); }
    }
    if (nbad) atomicAdd((unsigned*)(ctl + CW_FAIL), nbad);
}
#endif
struct NoConv { __device__ __forceinline__ void operator()(int, int, unsigned char*) const {} };
struct P7Conv {
    const Args& args; int vcu;
    __device__ __forceinline__ void operator()(int s, int wave, unsigned char* lds) const { int lane_ = lane_id_(); asm volatile("" : "+v"(lane_)); const int lane = lane_;
        unsigned char* ws = args.ws; const int NGW = (int)gridDim.x * NWAVES, gw = vcu * NWAVES + wave;
        LAS unsigned char* T = (LAS unsigned char*)lds + RING_OFF + wave * 8704;
        cvt_job<1>(args.in[16], DM, NFF2, (bf16*)(ws + WS_WFI2), NFF2 / 64, T, gw, NGW, lane, nullptr, NFF2, -1, (const float*)(ws + WS_CPART) + NFF2, 2 * NFF2, (float*)(ws + WS_CMAXF) + NFF2, s, 4);
        cvt_job<0>(args.in[12], MLAOUT, DM, (bf16*)(ws + WS_WBRA), DM / 64, T, gw, NGW, lane, nullptr, FP8_BR ? DM : 0, FP8_BR ? 5 : -1, nullptr, 0, nullptr, (s + 1) & 3, 4);
        cvt_job<0>(args.in[13], MOBAW, DM, (bf16*)(ws + WS_WBRB), DM / 64, T, gw, NGW, lane, nullptr, FP8_BR ? DM : 0, FP8_BR ? 5 : -1, nullptr, 0, nullptr, (s + 2) & 3, 4);
        cvt_job<0>(args.in[14], DM, DM, (bf16*)(ws + WS_WOUT), DM / 64, T, gw, NGW, lane, nullptr, FP8_OUT ? DM : 0, FP8_OUT ? 6 : -1, nullptr, 0, nullptr, (s + 1) & 3, 4); }
};
template <int WHICH, class Conv>
__device__ __forceinline__ void p7_attention(unsigned char* lds, unsigned char* ws, const int* pos, int G, int bid, int wv, Conv conv) {
    int tid_ = wv * 64 + lane_id_(); asm volatile("" : "+v"(tid_)); const int tid = tid_, lane = tid & 63, wave = wv;
    gu32* ctl = (gu32*)(ws + WS_CTL); unsigned* GCNT = (unsigned*)(ctl + CW_GCNT);
    bf16* KR = (bf16*)(ws + WS_KR); bf16* QB = (bf16*)(ws + WS_QB); bf16* KB = (bf16*)(ws + WS_KB); bf16* VB = (bf16*)(ws + WS_VB);
    bf16* QM = (bf16*)(ws + WS_QM); bf16* KV = (bf16*)(ws + WS_KV); bf16* OA = (bf16*)(ws + WS_OA);
    float* BIAS = (float*)(ws + WS_BIAS); int* TPMAX = (int*)(ws + WS_TPMAX);
    unsigned* LIST = (unsigned*)(ws + WS_LIST); float* PML = (float*)(ws + WS_PML); bf16* PO = (bf16*)(ws + WS_PO);
        float* biasL = (float*)(lds + att::L_BIAS); unsigned* pref = (unsigned*)(lds + att::L_PREF); unsigned* wtot = pref + 1028;
        for (int i = tid; i < 16 * 132; i += NWAVES * 64) biasL[i] = BIAS[i];
        unsigned* cntS = (unsigned*)(lds + att::L_CNT);
        { const unsigned ca = __hip_atomic_load(GCNT + 2 * tid, RLX_AGENT), cb = __hip_atomic_load(GCNT + 2 * tid + 1, RLX_AGENT); cntS[2 * tid] = ca; cntS[2 * tid + 1] = cb;
          const unsigned a = (ca + 255u) >> 8, b = (cb + 255u) >> 8;
          unsigned s = a + b;
#pragma unroll
          for (int o_ = 1; o_ < 64; o_ <<= 1) { const unsigned y = __shfl_up(s, o_); if (lane >= o_) s += y; }
          if (lane == 63) wtot[wave] = s;
          __syncthreads();
          unsigned offs = 0; for (int w = 0; w < wave; ++w) offs += wtot[w];
          const unsigned incl = s + offs; pref[2 * tid] = incl - a - b; pref[2 * tid + 1] = incl - b; if (tid == NWAVES * 64 - 1) pref[1024] = incl; }
        __syncthreads();
        const int U = (int)pref[1024];
        int cslot = 0;
        const float c2_mla = 0.07216878364870322f * 1.4426950408889634f;
        const float c2_moba = 0.08838834764831845f * 1.4426950408889634f;
        if constexpr (WHICH & 1) for (int p = bid; p < 512; p += G) { const int h = p & 15, xx = p >> 4;
#pragma unroll 1
            for (int k = 0; k < 2; ++k) { const int qb = k ? xx : 63 - xx;
                att::UnitArgs A; A.Q = QM + h * 192; A.qpitch = QUP; A.K = KV + h * 256; A.kpitch = KVUP; A.Kr = KR; A.Q8 = ws + WS_QM8 + h * 192; A.K8 = ws + WS_KN8 + h * 128; A.Kr8 = ws + WS_KR8; A.V8 = ws + WS_V8 + (size_t)h * 256 * 8192; A.V = KV + h * 256 + 128; A.vpitch = KVUP;
                A.O = OA + h * 128; A.opitch = MLAOUT; A.PO = nullptr; A.PML = nullptr; A.pos = pos; A.tpmax = TPMAX; A.list = nullptr; A.nrows = 256;
                A.q0 = qb * 256; A.k0 = 0; A.NT = 4 * (qb + 1); A.h = h; A.c2 = c2_mla;
                att::attn_unit<192, 0>(A, (char*)lds, wv);
                if (cslot < 4) { conv(cslot++, wv, lds); __syncthreads(); } } }
        if constexpr (WHICH & 1) while (cslot < 4) { conv(cslot++, wv, lds); __syncthreads(); }
        if constexpr (WHICH & 2) for (int u = bid; u < U; u += G) {
            int lo = 0, hi_ = 1024;
            while (hi_ - lo > 1) { const int mid = (lo + hi_) >> 1; if (pref[mid] <= (unsigned)u) lo = mid; else hi_ = mid; }
            const int h = lo >> 6, kb = lo & 63, c = u - (int)pref[lo];
            const int cnt = (int)cntS[lo];
            att::UnitArgs A; A.Q = QB + h * 128; A.qpitch = MOBAW; A.K = KB + h * 128; A.kpitch = MOBAW; A.Kr = nullptr; A.Q8 = ws + WS_QB8 + h * 128; A.K8 = ws + WS_KB8 + h * 128; A.Kr8 = nullptr; A.V8 = ws + WS_VB8 + (size_t)h * 256 * 8192; A.V = VB + h * 128; A.vpitch = MOBAW;
            A.O = nullptr; A.opitch = 0; A.PO = PO; A.PML = PML; A.pos = pos; A.tpmax = TPMAX;
            A.list = LIST + (size_t)h * LIST_PER_HEAD + list_off(kb) + c * 256; A.nrows = min(256, cnt - c * 256);
            A.q0 = 0; A.k0 = kb * 256; A.NT = 4; A.h = h; A.c2 = c2_moba;
            att::attn_unit<128, 1>(A, (char*)lds, wv); }
        if constexpr (WHICH & 4) for (int u = bid; u < NBLK * NH; u += G) { const int h = u & 15, qb = u >> 4;
            att::UnitArgs A; A.Q = QB + h * 128; A.qpitch = MOBAW; A.K = KB + h * 128; A.kpitch = MOBAW; A.Kr = nullptr; A.Q8 = ws + WS_QB8 + h * 128; A.K8 = ws + WS_KB8 + h * 128; A.Kr8 = nullptr; A.V8 = ws + WS_VB8 + (size_t)h * 256 * 8192; A.V = VB + h * 128; A.vpitch = MOBAW;
            A.O = nullptr; A.opitch = 0; A.PO = PO; A.PML = PML; A.pos = pos; A.tpmax = TPMAX; A.list = nullptr; A.nrows = 256;
            A.q0 = qb * 256; A.k0 = qb * 256; A.NT = 4; A.h = h; A.c2 = c2_moba;
            att::attn_unit<128, 2>(A, (char*)lds, wv); }
}
__global__ void __launch_bounds__(NWAVES * 64, 2) hybrid_fwd(Args args) {
    extern __shared__ __attribute__((aligned(16))) unsigned char lds[];
    LAS unsigned char* ldsl = (LAS unsigned char*)lds;
    volatile LAS unsigned* MISC = (volatile LAS unsigned*)(ldsl + MISC_OFF);
    const int tid = threadIdx.x, lane = tid & 63, wave = __builtin_amdgcn_readfirstlane(tid >> 6);
    const int G = gridDim.x, bid = blockIdx.x;
    const int vcu = (G % 8 == 0) ? (bid % 8) * (G / 8) + bid / 8 : bid;
    const int gw = vcu * NWAVES + wave, NGW = G * NWAVES;
    unsigned char* ws = args.ws;
    gu32* ctl = (gu32*)(ws + WS_CTL);
    for (int u = tid; u < (LDS_BYTES - LDSCTL_OFF) / 4; u += NWAVES * 64) ((LAS unsigned*)(ldsl + LDSCTL_OFF))[u] = 0u;
    __syncthreads();
    XcdBarrier bar = xcd_barrier_post((unsigned*)(ctl + CW_BAR), MISC + 8, wave);
#if PROBE_PHASE == 99
#define GRID_BAR() do { xcd_barrier(bar, wave); xcd_barrier(bar, wave); } while (0)
#else
#define GRID_BAR() xcd_barrier(bar, wave)
#endif
    const float* x = args.in[0]; const int* pos = (const int*)args.in[1]; const float* rel_bias = args.in[2];
    float* out = args.out;
    bf16* WFI = (bf16*)(ws + WS_WFFN_IN); bf16* WFO = (bf16*)(ws + WS_WFFN_OUT); bf16* WIN = (bf16*)(ws + WS_WIN); bf16* WUQ = (bf16*)(ws + WS_WUQ);
    bf16* WUKV = (bf16*)(ws + WS_WUKV); bf16* WBRA = (bf16*)(ws + WS_WBRA); bf16* WBRB = (bf16*)(ws + WS_WBRB); bf16* WOUT = (bf16*)(ws + WS_WOUT);
    bf16* H = (bf16*)(ws + WS_H); bf16* ACT = (bf16*)(ws + WS_BIG);
    bf16* CQ = (bf16*)(ws + WS_CQ); bf16* CKV = (bf16*)(ws + WS_CKV); bf16* KR = (bf16*)(ws + WS_KR); bf16* QB = (bf16*)(ws + WS_QB); bf16* KB = (bf16*)(ws + WS_KB);
    bf16* VB = (bf16*)(ws + WS_VB); bf16* GA = (bf16*)(ws + WS_GA); bf16* GB = (bf16*)(ws + WS_GB);
    bf16* QM = (bf16*)(ws + WS_QM); bf16* KV = (bf16*)(ws + WS_KV); bf16* OA = (bf16*)(ws + WS_OA);
    float* COS = (float*)(ws + WS_COS); float* SIN = (float*)(ws + WS_SIN);
    bf16* KMH = (bf16*)(ws + WS_KMH); bf16* KML = (bf16*)(ws + WS_KML); float* BIAS = (float*)(ws + WS_BIAS); int* TPMAX = (int*)(ws + WS_TPMAX);
    unsigned* LIST = (unsigned*)(ws + WS_LIST); float* PML = (float*)(ws + WS_PML); bf16* PO = (bf16*)(ws + WS_PO);
    unsigned* GCNT = (unsigned*)(ctl + CW_GCNT);
    float* PART = (float*)(ws + WS_PART); float* RSTD = (float*)(ws + WS_RSTD); float* PARTQ = (float*)(ws + WS_PARTQ); float* PARTKV = (float*)(ws + WS_PARTKV);
    float* RSTDQ = (float*)(ws + WS_RSTDQ); float* RSTDKV = (float*)(ws + WS_RSTDKV); bf16* H3 = GB; (void)RSTDQ; (void)RSTDKV;
    float* CPART = (float*)(ws + WS_CPART); float* CMAXF = (float*)(ws + WS_CMAXF); const float* CMAX1 = CMAXF; const float* CMAX2 = CMAXF + NFF2; float* PMAX = (float*)(ws + WS_PMAX);
    unsigned char* H8 = ws + WS_H8; unsigned char* OA8 = ws + WS_OA8; unsigned char* OB8 = ws + WS_OB8; unsigned char* MG8 = ws + WS_MG8; unsigned char* WIN8 = ws + WS_WIN8;
#if PROBE_PHASE == 500
    bf16* OBC = (bf16*)(ws + ((WS_END + 4095) / 4096) * 4096);
#else
    bf16* OBC = QB;
#endif
    LAS unsigned char* cvtT = ldsl + RING_OFF + wave * 8704;

    { int tid_f = wave * 64 + lane_id_(); asm volatile("" : "+v"(tid_f)); const int tid = tid_f, lane = tid & 63; (void)lane; (void)tid;
    {
    colmax_job(args.in[4], DM, NFF2, CPART, 2 * NFF2, gw, NGW, lane); colmax_job(args.in[16], DM, NFF2, CPART + NFF2, 2 * NFF2, gw, NGW, lane);
    cvt_job<2>(args.in[7], DM, INCOLS, WIN, INPAD1 / 64, cvtT, gw, NGW, lane, nullptr, INPAD1);
    cvt_job<4>(args.in[7], DM, INCOLS, (bf16*)WIN8, IN2 / 64, cvtT, gw, NGW, lane, nullptr, IN2, 6);
    cvt_job<3>(args.in[9], QLORA, QUP, WUQ, QUP / 64, cvtT, gw, NGW, lane, args.in[8]);
    cvt_job<0>(args.in[11], KVLORA, KVUP, WUKV, KVUP / 64, cvtT, gw, NGW, lane, args.in[10]);
    for (int idx = vcu * (NWAVES * 64) + tid; idx < M_ * 32; idx += G * NWAVES * 64) { const int s = idx >> 5, i = idx & 31;
        float sn, cs; sincos_d((double)pos[s] * args.invf[i], sn, cs); COS[idx] = cs; SIN[idx] = sn; }
    for (int idx = vcu * (NWAVES * 64) + tid; idx < 16 * 132; idx += G * NWAVES * 64) { const int h = idx / 132, d = idx - h * 132;
        BIAS[idx] = d <= 128 ? rel_bias[(int)args.bucket[d] * NH + h] * 1.4426950408889634f : 0.f; }
    for (int t = gw; t < 256; t += NGW) { int p = pos[t * 64 + lane];
#pragma unroll
        for (int o_ = 1; o_ < 64; o_ <<= 1) p = max(p, __shfl_xor(p, o_));
        if (lane == 0) TPMAX[t] = p; }
    for (int m = gw; m < M_; m += NGW) rms_row4096_i8(x + (size_t)m * DM, args.in[3], H8, m, RSTD, lane);
    }
#if PROBE_PHASE == 0
    {
    colmax_job(args.in[4], DM, NFF2, CPART, 2 * NFF2, gw, NGW, lane); colmax_job(args.in[16], DM, NFF2, CPART + NFF2, 2 * NFF2, gw, NGW, lane);
    cvt_job<2>(args.in[7], DM, INCOLS, WIN, INPAD1 / 64, cvtT, gw, NGW, lane, nullptr, INPAD1);
    cvt_job<4>(args.in[7], DM, INCOLS, (bf16*)WIN8, IN2 / 64, cvtT, gw, NGW, lane, nullptr, IN2, 6);
    cvt_job<3>(args.in[9], QLORA, QUP, WUQ, QUP / 64, cvtT, gw, NGW, lane, args.in[8]);
    cvt_job<0>(args.in[11], KVLORA, KVUP, WUKV, KVUP / 64, cvtT, gw, NGW, lane, args.in[10]);
    for (int idx = vcu * (NWAVES * 64) + tid; idx < M_ * 32; idx += G * NWAVES * 64) { const int s = idx >> 5, i = idx & 31;
        float sn, cs; sincos_d((double)pos[s] * args.invf[i], sn, cs); COS[idx] = cs; SIN[idx] = sn; }
    for (int idx = vcu * (NWAVES * 64) + tid; idx < 16 * 132; idx += G * NWAVES * 64) { const int h = idx / 132, d = idx - h * 132;
        BIAS[idx] = d <= 128 ? rel_bias[(int)args.bucket[d] * NH + h] * 1.4426950408889634f : 0.f; }
    for (int t = gw; t < 256; t += NGW) { int p = pos[t * 64 + lane];
#pragma unroll
        for (int o_ = 1; o_ < 64; o_ <<= 1) p = max(p, __shfl_xor(p, o_));
        if (lane == 0) TPMAX[t] = p; }
    for (int m = gw; m < M_; m += NGW) rms_row4096_i8(x + (size_t)m * DM, args.in[3], H8, m, RSTD, lane);
    }
#endif
    }
    GRID_BAR();
#if PROBE_PHASE == 300
    {
        const bf16x8 fa = *(const GAS bf16x8*)(H + (size_t)(bid * 512 + tid) * 8), fb = *(const GAS bf16x8*)(H + (size_t)(bid * 512 + tid) * 8 + 65536);
        f32x4 ac[8];
#pragma unroll
        for (int i = 0; i < 8; ++i) ac[i] = (f32x4){0.f, 0.f, 0.f, 0.f};
#pragma unroll 1
        for (int it = 0; it < 5120; ++it) {
#pragma unroll
            for (int i = 0; i < 8; ++i) ac[i] = __builtin_amdgcn_mfma_f32_16x16x32_bf16(fa, fb, ac[i], 0, 0, 0); }
        float sacc = 0.f;
#pragma unroll
        for (int i = 0; i < 8; ++i) sacc += ac[i][0] + ac[i][1] + ac[i][2] + ac[i][3];
        if (sacc == 12345.678f) out[0] = 1.f;
    }
#endif
    { int tid_f = wave * 64 + lane_id_(); asm volatile("" : "+v"(tid_f)); const int lane = tid_f & 63;
      cvt_job<1>(args.in[4], DM, NFF2, WFI, NFF2 / 64, cvtT, gw, NGW, lane, nullptr, NFF2, -1, CPART, 2 * NFF2, CMAXF); }
    GRID_BAR();
    { pg8::Gemm g{(const bf16*)H8, WFI, M_, NFF2, DM / 2}; pg8::StaticOrder S; S.init(M_, NFF2, G, bid); pg8::EpiSwiglu E{ACT, DFF, RSTD, M_, CMAX1};
      pg8::gemm_phase<pg8::EpiSwiglu, pg8::StaticOrder, true, true, true, false, true>(ldsl + RING_OFF, g, S, E, wave); }
#if PROBE_PHASE == 1
    { pg8::Gemm g{(const bf16*)H8, WFI, M_, NFF2, DM / 2}; pg8::StaticOrder S; S.init(M_, NFF2, G, bid); pg8::EpiSwiglu E{ACT, DFF, RSTD, M_, CMAX1};
      pg8::gemm_phase<pg8::EpiSwiglu, pg8::StaticOrder, true, true, true, false, true>(ldsl + RING_OFF, g, S, E, wave); }
#endif
    if (G == 256 && bid >= 128) { int tid_f = wave * 64 + lane_id_(); asm volatile("" : "+v"(tid_f)); const int lane = tid_f & 63;
        cvt_job<0>(args.in[5], DFF, DM, WFO, DM / 64, cvtT, (bid - 128) * NWAVES + wave, 128 * NWAVES, lane, nullptr, DM); }
    else if (G != 256) { int tid_f = wave * 64 + lane_id_(); asm volatile("" : "+v"(tid_f)); const int lane = tid_f & 63; cvt_job<0>(args.in[5], DFF, DM, WFO, DM / 64, cvtT, gw, NGW, lane, nullptr, DM); }
    GRID_BAR();
    { pg8::Gemm g{ACT, WFO, M_, DM, DFF}; pg8::StaticOrder S; S.init(M_, DM, G, bid); pg8::EpiResidNorm<(long)WS_H8 - (long)WS_H> E{x, out, 0.5f, H, args.in[6], PART, nullptr};
      pg8::gemm_phase<pg8::EpiResidNorm<(long)WS_H8 - (long)WS_H>, pg8::StaticOrder, true, true, true>(ldsl + RING_OFF, g, S, E, wave); }
#if PROBE_PHASE == 2
    { pg8::Gemm g{ACT, WFO, M_, DM, DFF}; pg8::StaticOrder S; S.init(M_, DM, G, bid); pg8::EpiResidNorm<(long)WS_H8 - (long)WS_H> E{x, out, 0.5f, H, args.in[6], PART, nullptr};
      pg8::gemm_phase<pg8::EpiResidNorm<(long)WS_H8 - (long)WS_H>, pg8::StaticOrder, true, true, true>(ldsl + RING_OFF, g, S, E, wave); }
#endif
#if PROBE_PHASE == 801 || PROBE_PHASE == 802
    GRID_BAR();
    { pg8::Gemm g{ACT, WFO, PROBE_PHASE == 801 ? M_ : 0, PROBE_PHASE == 801 ? DM : 0, DFF}; pg8::StaticOrder S; S.init(M_, DM, G, bid); pg8::EpiNull E{};
      pg8::gemm_phase<pg8::EpiNull, pg8::StaticOrder, true, true, true>(ldsl + RING_OFF, g, S, E, wave); }
#endif
#if PROBE_PHASE == 803 || PROBE_PHASE == 804
    GRID_BAR();
    { pg8::Gemm g{(const bf16*)H8, WFI, PROBE_PHASE == 803 ? M_ : 0, PROBE_PHASE == 803 ? NFF2 : 0, DM / 2}; pg8::StaticOrder S; S.init(M_, NFF2, G, bid); pg8::EpiNull E{};
      pg8::gemm_phase<pg8::EpiNull, pg8::StaticOrder, true, true, true, false, true>(ldsl + RING_OFF, g, S, E, wave); }
#endif
    GRID_BAR();
    { int tid_f = wave * 64 + lane_id_(); asm volatile("" : "+v"(tid_f)); const int tid = tid_f, lane = tid & 63; (void)lane; (void)tid;
    rstd_reduce<64>(PART, RSTD, 1.f / DM, vcu, tid, G);
#if PROBE_PHASE == 3 || PROBE_PHASE == 38
    rstd_reduce<64>(PART, RSTD, 1.f / DM, vcu, tid, G);
#endif
    }
    GRID_BAR();
    { pg8::Gemm g{H, WIN, M_, INPAD1, DM}; pg8::StaticOrder S; S.init(M_, INPAD1, G, bid);
      pg8::EpiProj<1> E{CQ, CKV, KR, QB, KB, VB, GA, GB, COS, SIN, RSTD, PARTQ, PARTKV, (float*)(ctl + CW_KMEAN), ws + WS_KR8, ws + WS_QB8, ws + WS_KB8, ws + WS_VB8, 1.0f};
      pg8::gemm_phase<pg8::EpiProj<1>, pg8::StaticOrder, true, true, true>(ldsl + RING_OFF, g, S, E, wave); }
    { pg8::Gemm g{(const bf16*)H8, (const bf16*)WIN8, M_, IN2, DM / 2}; pg8::StaticOrder S; S.init(M_, IN2, G, bid);
      pg8::EpiProj<2> E{CQ, CKV, KR, QB, KB, VB, GA, GB, COS, SIN, RSTD, PARTQ, PARTKV, (float*)(ctl + CW_KMEAN), ws + WS_KR8, ws + WS_QB8, ws + WS_KB8, ws + WS_VB8, 0.015625f};
      pg8::gemm_phase<pg8::EpiProj<2>, pg8::StaticOrder, true, true, true, true>(ldsl + RING_OFF, g, S, E, wave); }
    GRID_BAR();
    { LAS unsigned* cntL = (LAS unsigned*)(ldsl + RING_OFF); LAS unsigned* baseL = cntL + 64;
      for (int u = bid; u < NBLK * NH; u += G) moba_gate_unit(u & 15, u >> 4, QB, (const float*)(ctl + CW_KMEAN), GCNT, LIST, PML, cntL, baseL, wave); }
    { pg8::Gemm g{CQ, WUQ, M_, QUP, QLORA}; pg8::StaticOrder S; S.init(M_, QUP, G, bid); pg8::EpiQ E{MLA_BF16 ? QM : nullptr, COS, SIN, PARTQ, ws + WS_QM8};
      pg8::gemm_phase<pg8::EpiQ, pg8::StaticOrder, true, true>(ldsl + RING_OFF, g, S, E, wave); }
    { pg8::Gemm g{CKV, WUKV, M_, KVUP, KVLORA}; pg8::StaticOrder S; S.init(M_, KVUP, G, bid); pg8::EpiPlain E{MLA_BF16 ? KV : nullptr, KVUP, PARTKV, ws + WS_KN8, ws + WS_V8};
      pg8::gemm_phase<pg8::EpiPlain, pg8::StaticOrder, true, true>(ldsl + RING_OFF, g, S, E, wave); }
#if PROBE_PHASE == 6
    { pg8::Gemm g{CQ, WUQ, M_, QUP, QLORA}; pg8::StaticOrder S; S.init(M_, QUP, G, bid); pg8::EpiQ E{MLA_BF16 ? QM : nullptr, COS, SIN, PARTQ, ws + WS_QM8};
      pg8::gemm_phase<pg8::EpiQ, pg8::StaticOrder, true, true>(ldsl + RING_OFF, g, S, E, wave); }
    { pg8::Gemm g{CKV, WUKV, M_, KVUP, KVLORA}; pg8::StaticOrder S; S.init(M_, KVUP, G, bid); pg8::EpiPlain E{MLA_BF16 ? KV : nullptr, KVUP, PARTKV, ws + WS_KN8, ws + WS_V8};
      pg8::gemm_phase<pg8::EpiPlain, pg8::StaticOrder, true, true>(ldsl + RING_OFF, g, S, E, wave); }
#endif
    GRID_BAR();
#if I8_FFN2
    p7_attention<7>(lds, ws, pos, G, bid, wave, P7Conv{args, vcu});
#else
    p7_attention<7>(lds, ws, pos, G, bid, wave, NoConv{});
#endif
#if PROBE_PHASE == 7
    p7_attention<7>(lds, ws, pos, G, bid, wave, NoConv{});
#endif
#if PROBE_PHASE == 71
    p7_attention<1>(lds, ws, pos, G, bid, wave, NoConv{});
#endif
#if PROBE_PHASE == 72
    p7_attention<2>(lds, ws, pos, G, bid, wave, NoConv{});
#endif
#if PROBE_PHASE == 74
    p7_attention<4>(lds, ws, pos, G, bid, wave, NoConv{});
#endif
    GRID_BAR();
    { int tid_f = wave * 64 + lane_id_(); asm volatile("" : "+v"(tid_f)); const int tid = tid_f, lane = tid & 63; (void)lane; (void)tid;
    for (int it = gw; it < M_ * NH / 4; it += NGW) { const int pair = it * 4 + (lane >> 4), c8 = lane & 15;
        const f32x4 ml0 = *(const GAS f32x4*)(PML + (size_t)pair * 8), ml1 = *(const GAS f32x4*)(PML + (size_t)pair * 8 + 4);
        const float m[4] = {ml0.x, ml0.z, ml1.x, ml1.z}, l[4] = {ml0.y, ml0.w, ml1.y, ml1.w};
        float mx = -1e30f;
#pragma unroll
        for (int j = 0; j < 4; ++j) if (l[j] > 0.f) mx = fmaxf(mx, m[j]);
        float w[4], wsum = 0.f;
#pragma unroll
        for (int j = 0; j < 4; ++j) { w[j] = l[j] > 0.f ? __builtin_amdgcn_exp2f(m[j] - mx) * l[j] : 0.f; wsum += w[j]; }
        const float inv = 1.0f / wsum; float acc[8] = {0.f, 0.f, 0.f, 0.f, 0.f, 0.f, 0.f, 0.f};
#pragma unroll
        for (int j = 0; j < 4; ++j) { const v4u o = *(const GAS v4u*)(PO + ((size_t)pair * 4 + j) * 128 + c8 * 8); const float wj = w[j] * inv;
            if (w[j] > 0.f) {
#pragma unroll
                for (int e = 0; e < 4; ++e) { acc[2 * e] += wj * bfu_lo(o[e]); acc[2 * e + 1] += wj * bfu_hi(o[e]); } } }
        const int row = pair >> 4, h = pair & 15; v4u r; r.x = pk2(acc[0], acc[1]); r.y = pk2(acc[2], acc[3]); r.z = pk2(acc[4], acc[5]); r.w = pk2(acc[6], acc[7]);
        *(GAS v4u*)(OBC + (size_t)row * MOBAW + h * 128 + c8 * 8) = r;
        { int w0 = 0, w1 = 0;
          w0 = __builtin_amdgcn_cvt_pk_fp8_f32(acc[0] * 16.f, acc[1] * 16.f, w0, false); w0 = __builtin_amdgcn_cvt_pk_fp8_f32(acc[2] * 16.f, acc[3] * 16.f, w0, true);
          w1 = __builtin_amdgcn_cvt_pk_fp8_f32(acc[4] * 16.f, acc[5] * 16.f, w1, false); w1 = __builtin_amdgcn_cvt_pk_fp8_f32(acc[6] * 16.f, acc[7] * 16.f, w1, true);
          v2u q; q.x = (unsigned)w0; q.y = (unsigned)w1; *(GAS v2u*)(OB8 + ((size_t)h * M_ + row) * 128 + c8 * 8) = q; } }
    for (int it = gw * 64 + lane; it < M_ * MLAOUT / 8; it += NGW * 64) { const int row = it >> 8, c8 = it & 255;
        const v4u o = *(const GAS v4u*)(OA + (size_t)row * MLAOUT + c8 * 8); int w0 = 0, w1 = 0;
        w0 = __builtin_amdgcn_cvt_pk_fp8_f32(bfu_lo(o.x) * 16.f, bfu_hi(o.x) * 16.f, w0, false); w0 = __builtin_amdgcn_cvt_pk_fp8_f32(bfu_lo(o.y) * 16.f, bfu_hi(o.y) * 16.f, w0, true);
        w1 = __builtin_amdgcn_cvt_pk_fp8_f32(bfu_lo(o.z) * 16.f, bfu_hi(o.z) * 16.f, w1, false); w1 = __builtin_amdgcn_cvt_pk_fp8_f32(bfu_lo(o.w) * 16.f, bfu_hi(o.w) * 16.f, w1, true);
        v2u q; q.x = (unsigned)w0; q.y = (unsigned)w1; *(GAS v2u*)(OA8 + ((size_t)(c8 >> 4) * M_ + row) * 128 + (c8 & 15) * 8) = q; }
#if PROBE_PHASE == 8 || PROBE_PHASE == 38
    for (int it = gw; it < M_ * NH / 4; it += NGW) { const int pair = it * 4 + (lane >> 4), c8 = lane & 15;
        const f32x4 ml0 = *(const GAS f32x4*)(PML + (size_t)pair * 8), ml1 = *(const GAS f32x4*)(PML + (size_t)pair * 8 + 4);
        const float m[4] = {ml0.x, ml0.z, ml1.x, ml1.z}, l[4] = {ml0.y, ml0.w, ml1.y, ml1.w};
        float mx = -1e30f;
#pragma unroll
        for (int j = 0; j < 4; ++j) if (l[j] > 0.f) mx = fmaxf(mx, m[j]);
        float w[4], wsum = 0.f;
#pragma unroll
        for (int j = 0; j < 4; ++j) { w[j] = l[j] > 0.f ? __builtin_amdgcn_exp2f(m[j] - mx) * l[j] : 0.f; wsum += w[j]; }
        const float inv = 1.0f / wsum; float acc[8] = {0.f, 0.f, 0.f, 0.f, 0.f, 0.f, 0.f, 0.f};
#pragma unroll
        for (int j = 0; j < 4; ++j) { const v4u o = *(const GAS v4u*)(PO + ((size_t)pair * 4 + j) * 128 + c8 * 8); const float wj = w[j] * inv;
            if (w[j] > 0.f) {
#pragma unroll
                for (int e = 0; e < 4; ++e) { acc[2 * e] += wj * bfu_lo(o[e]); acc[2 * e + 1] += wj * bfu_hi(o[e]); } } }
        const int row = pair >> 4, h = pair & 15; v4u r; r.x = pk2(acc[0], acc[1]); r.y = pk2(acc[2], acc[3]); r.z = pk2(acc[4], acc[5]); r.w = pk2(acc[6], acc[7]);
        *(GAS v4u*)(OBC + (size_t)row * MOBAW + h * 128 + c8 * 8) = r;
        { int w0 = 0, w1 = 0;
          w0 = __builtin_amdgcn_cvt_pk_fp8_f32(acc[0] * 16.f, acc[1] * 16.f, w0, false); w0 = __builtin_amdgcn_cvt_pk_fp8_f32(acc[2] * 16.f, acc[3] * 16.f, w0, true);
          w1 = __builtin_amdgcn_cvt_pk_fp8_f32(acc[4] * 16.f, acc[5] * 16.f, w1, false); w1 = __builtin_amdgcn_cvt_pk_fp8_f32(acc[6] * 16.f, acc[7] * 16.f, w1, true);
          v2u q; q.x = (unsigned)w0; q.y = (unsigned)w1; *(GAS v2u*)(OB8 + ((size_t)h * M_ + row) * 128 + c8 * 8) = q; } }
    for (int it = gw * 64 + lane; it < M_ * MLAOUT / 8; it += NGW * 64) { const int row = it >> 8, c8 = it & 255;
        const v4u o = *(const GAS v4u*)(OA + (size_t)row * MLAOUT + c8 * 8); int w0 = 0, w1 = 0;
        w0 = __builtin_amdgcn_cvt_pk_fp8_f32(bfu_lo(o.x) * 16.f, bfu_hi(o.x) * 16.f, w0, false); w0 = __builtin_amdgcn_cvt_pk_fp8_f32(bfu_lo(o.y) * 16.f, bfu_hi(o.y) * 16.f, w0, true);
        w1 = __builtin_amdgcn_cvt_pk_fp8_f32(bfu_lo(o.z) * 16.f, bfu_hi(o.z) * 16.f, w1, false); w1 = __builtin_amdgcn_cvt_pk_fp8_f32(bfu_lo(o.w) * 16.f, bfu_hi(o.w) * 16.f, w1, true);
        v2u q; q.x = (unsigned)w0; q.y = (unsigned)w1; *(GAS v2u*)(OA8 + ((size_t)(c8 >> 4) * M_ + row) * 128 + (c8 & 15) * 8) = q; }
#endif
    }
    GRID_BAR();
#if PROBE_PHASE == 500
    selfcheck(lds, ws, pos, OBC, G, bid);
    GRID_BAR();
#endif
#if FP8_BR
    { pg8::Gemm g{(const bf16*)OA8, WBRA, M_, DM, MLAOUT / 2}; pg8::StaticOrder S; S.init(M_, DM, G, bid); pg8::EpiMerge<false> E{GA, H, nullptr, 0.001953125f};
      pg8::gemm_phase<pg8::EpiMerge<false>, pg8::StaticOrder, true, true, true, true>(ldsl + RING_OFF, g, S, E, wave); }
    { pg8::Gemm g{(const bf16*)OB8, WBRB, M_, DM, MOBAW / 2}; pg8::StaticOrder S; S.init(M_, DM, G, bid); pg8::EpiMerge<true> E{GB, H, FP8_OUT ? MG8 : nullptr, 0.001953125f};
      pg8::gemm_phase<pg8::EpiMerge<true>, pg8::StaticOrder, true, true, true, true>(ldsl + RING_OFF, g, S, E, wave); }
#else
    { pg8::Gemm g{OA, WBRA, M_, DM, MLAOUT}; pg8::StaticOrder S; S.init(M_, DM, G, bid); pg8::EpiMerge<false> E{GA, H, nullptr, 1.0f};
      pg8::gemm_phase<pg8::EpiMerge<false>, pg8::StaticOrder, true, true>(ldsl + RING_OFF, g, S, E, wave); }
    { pg8::Gemm g{OBC, WBRB, M_, DM, MOBAW}; pg8::StaticOrder S; S.init(M_, DM, G, bid); pg8::EpiMerge<true> E{GB, H, FP8_OUT ? MG8 : nullptr, 1.0f};
      pg8::gemm_phase<pg8::EpiMerge<true>, pg8::StaticOrder, true, true>(ldsl + RING_OFF, g, S, E, wave); }
#endif
    GRID_BAR();
#if FP8_OUT
    { pg8::Gemm g{(const bf16*)MG8, WOUT, M_, DM, DM / 2}; pg8::StaticOrder S; S.init(M_, DM, G, bid); pg8::EpiResidNorm<0> E{out, out, 0.0009765625f, H3, args.in[15], PART, PMAX};
      pg8::gemm_phase<pg8::EpiResidNorm<0>, pg8::StaticOrder, true, true, true, true>(ldsl + RING_OFF, g, S, E, wave); }
#else
    { pg8::Gemm g{H, WOUT, M_, DM, DM}; pg8::StaticOrder S; S.init(M_, DM, G, bid); pg8::EpiResidNorm<0> E{out, out, 1.0f, H3, args.in[15], PART, PMAX};
      pg8::gemm_phase<pg8::EpiResidNorm<0>, pg8::StaticOrder, true, true>(ldsl + RING_OFF, g, S, E, wave); }
#endif
    GRID_BAR();
    { int tid_f = wave * 64 + lane_id_(); asm volatile("" : "+v"(tid_f)); const int tid = tid_f, lane = tid & 63; (void)lane; (void)tid;
#if !I8_FFN2
    cvt_job<1>(args.in[16], DM, NFF2, WFI, NFF2 / 64, cvtT, gw, NGW, lane, nullptr, NFF2);
#endif
#if I8_FFN2
    for (int m = gw; m < M_; m += NGW) quant_row_i8(H3, PART, PMAX, H8, m, RSTD, lane);
#else
    rstd_reduce<64>(PART, RSTD, 1.f / DM, vcu, tid, G);
#endif
#if PROBE_PHASE == 11
#if !I8_FFN2
    cvt_job<1>(args.in[16], DM, NFF2, WFI, NFF2 / 64, cvtT, gw, NGW, lane, nullptr, NFF2);
#endif
#if I8_FFN2
    for (int m = gw; m < M_; m += NGW) quant_row_i8(H3, PART, PMAX, H8, m, RSTD, lane);
#else
    rstd_reduce<64>(PART, RSTD, 1.f / DM, vcu, tid, G);
#endif
#endif
    }
    GRID_BAR();
#if I8_FFN2
    { pg8::Gemm g{(const bf16*)H8, (const bf16*)(ws + WS_WFI2), M_, NFF2, DM / 2}; pg8::StaticOrder S; S.init(M_, NFF2, G, bid); pg8::EpiSwiglu E{ACT, DFF, RSTD, M_, CMAX2};
      pg8::gemm_phase<pg8::EpiSwiglu, pg8::StaticOrder, true, true, true, false, true>(ldsl + RING_OFF, g, S, E, wave); }
#else
    { pg8::Gemm g{H3, WFI, M_, NFF2, DM}; pg8::StaticOrder S; S.init(M_, NFF2, G, bid); pg8::EpiSwiglu E{ACT, DFF, RSTD, M_, nullptr};
      pg8::gemm_phase<pg8::EpiSwiglu, pg8::StaticOrder, true, true, true>(ldsl + RING_OFF, g, S, E, wave); }
#endif
    if (G == 256 && bid >= 128) { int tid_f = wave * 64 + lane_id_(); asm volatile("" : "+v"(tid_f)); const int lane = tid_f & 63;
        cvt_job<0>(args.in[17], DFF, DM, WFO, DM / 64, cvtT, (bid - 128) * NWAVES + wave, 128 * NWAVES, lane, nullptr, DM); }
    else if (G != 256) { int tid_f = wave * 64 + lane_id_(); asm volatile("" : "+v"(tid_f)); const int lane = tid_f & 63; cvt_job<0>(args.in[17], DFF, DM, WFO, DM / 64, cvtT, gw, NGW, lane, nullptr, DM); }
    GRID_BAR();
    { pg8::Gemm g{ACT, WFO, M_, DM, DFF}; pg8::StaticOrder S; S.init(M_, DM, G, bid); pg8::EpiResid E{out, out, DM, 0.5f};
      pg8::gemm_phase<pg8::EpiResid, pg8::StaticOrder, true, true, true>(ldsl + RING_OFF, g, S, E, wave); }
    GRID_BAR();
    { int tid_f = wave * 64 + lane_id_(); asm volatile("" : "+v"(tid_f)); const int tid = tid_f, lane = tid & 63; (void)lane; (void)tid;
#if PROBE_PHASE == 500
    if (__hip_atomic_load(ctl + CW_FAIL, RLX_AGENT) > SELFCHECK_TOL) { for (int m = gw; m < M_; m += NGW) for (int j = lane; j < DM; j += 64) out[(size_t)m * DM + j] = __builtin_nanf(""); return; }
#endif
    for (int m = gw; m < M_; m += NGW) rms_row4096<true>(out + (size_t)m * DM, args.in[18], out + (size_t)m * DM, lane);
    }
}

extern "C" void kernel_launch(void* const* d_in, const int* in_sizes, int n_in, void* d_out, int out_size, void* d_ws, size_t ws_size, hipStream_t stream) {
    static int grid = 0;
    if (grid == 0) {
        if (n_in != 19 || out_size != M_ * DM || ws_size < WS_END) { fprintf(stderr, "kernel_launch: unexpected shapes (n_in %d out %d ws %zu need %zu)\n", n_in, out_size, ws_size, (size_t)WS_END); grid = -1; return; }
        int dev = 0, cus = 0;
        if (hipGetDevice(&dev) != hipSuccess || hipDeviceGetAttribute(&cus, hipDeviceAttributeMultiprocessorCount, dev) != hipSuccess) { grid = -1; return; }
        if (hipFuncSetAttribute((const void*)hybrid_fwd, hipFuncAttributeMaxDynamicSharedMemorySize, LDS_BYTES) != hipSuccess) { fprintf(stderr, "kernel_launch: hipFuncSetAttribute failed\n"); grid = -1; return; }
        int per_cu = 0;
        if (hipOccupancyMaxActiveBlocksPerMultiprocessor(&per_cu, (const void*)hybrid_fwd, NWAVES * 64, LDS_BYTES) != hipSuccess || per_cu < 1) { fprintf(stderr, "kernel_launch: occupancy query says %d\n", per_cu); }
        (void)hipGetLastError();
        grid = cus;
    }
    if (grid < 0) return;
    if (hipMemsetAsync((char*)d_ws + WS_CTL, 0, CTL_ZERO_BYTES, stream) != hipSuccess) { fprintf(stderr, "kernel_launch: memset failed\n"); return; }
    Args a{};
    for (int i = 0; i < 19; ++i) a.in[i] = (const float*)d_in[i];
    a.out = (float*)d_out; a.ws = (unsigned char*)d_ws;
    for (int i = 0; i < 32; ++i) a.invf[i] = pow(10000.0, -(double)(2 * i) / 64.0);
    for (int d = 0; d < 136; ++d) { int b;
        if (d < 16) b = d; else { const double dd = d > 128 ? 128.0 : (double)d; b = 16 + (int)(log(dd / 16.0) / log(128.0 / 16.0) * 16.0); if (b > 31) b = 31; }
        a.bucket[d] = (unsigned char)b; }
    hipLaunchKernelGGL(hybrid_fwd, dim3(grid), dim3(NWAVES * 64), LDS_BYTES, stream, a);
    const hipError_t le = hipPeekAtLastError();
    if (le != hipSuccess) fprintf(stderr, "kernel_launch: launch failed: %s\n", hipGetErrorName(le));
}
```

```cpp
#ifndef CMP_REL
#define CMP_REL 0.03f
#define CMP_THR 0.2f
#define CMP_NBAD 0.f
#endif
#ifndef I8_FFN2
#define I8_FFN2 1
#endif
#ifndef FP8_BR
#define FP8_BR 1
#endif
#ifndef FP8_OUT
#define FP8_OUT 0
#endif
#ifndef PROBE_PHASE
#define PROBE_PHASE -1
#endif
#define MLA_BF16 (PROBE_PHASE == 500)
#ifndef SELFCHECK_REL
#define SELFCHECK_REL 0.03f
#define SELFCHECK_ABS 1e-4f
#endif
#ifndef SELFCHECK_TOL
#define SELFCHECK_TOL 0u
#endif
#include <hip/hip_runtime.h>
#include <cstdio>
#include <cstdint>
#include <cmath>
__device__ __forceinline__ int lane_id_() { return (int)__builtin_amdgcn_mbcnt_hi(~0u, __builtin_amdgcn_mbcnt_lo(~0u, 0u)); }
namespace pg8 {
#define PG8_LAS __attribute__((address_space(3)))
typedef unsigned short bf16_t;
typedef short bf16x8 __attribute__((ext_vector_type(8)));
typedef float f32x4 __attribute__((ext_vector_type(4)));
typedef unsigned u32x4 __attribute__((ext_vector_type(4)));
constexpr int BM = 256, BK = 64, HALF = 128, HTB = HALF * BK * 2  , STAGE_BYTES = 8 * HTB, NXCD = 8, WGM = 8;

__host__ __device__ __forceinline__ int lds_byte(int r, int c) { const int st = (r >> 4) * 2 + (c >> 5), rr = r & 15, cc = c & 31, ob = rr * 64 + cc * 2; return st * 1024 + (ob ^ (((ob >> 9) & 1) << 5)); }
__host__ __device__ __forceinline__ void stage_rc(int b, int& R, int& C) { const int st = b / 1024, sb = b % 1024, swz = sb ^ (((sb >> 9) & 1) << 5); R = (st >> 1) * 16 + swz / 64; C = (st & 1) * 32 + (swz % 64) / 2; }
__host__ __device__ __forceinline__ int perm32(int rho) { const int n = rho >> 4, i = rho & 15; return 8 * (i >> 2) + 4 * n + (i & 3); }

struct Unit { int pm, pn; };
struct Gemm { const bf16_t* A; const bf16_t* Bt; int M, N, K; };

struct StaticOrder {
    int nM, nN, nwg, G, c;
    __host__ __device__ void init(int M, int N, int G_, int c_) { nM = M / BM; nN = N / BM; nwg = nM * nN; G = G_; c = c_; }
    __host__ __device__ bool next(int i, Unit& u) const {
        const long L = (long)i * G + c; if (L >= nwg) return false;
        int wgid = (int)L; { const int q = nwg / NXCD, r = nwg % NXCD, xcd = wgid % NXCD, off = wgid / NXCD; wgid = (xcd < r ? xcd * (q + 1) : r * (q + 1) + (xcd - r) * q) + off; }
        const int nig = WGM * nN, gid = wgid / nig, fm = gid * WGM, gsz = (nM - fm) < WGM ? (nM - fm) : WGM;
        u.pm = fm + ((wgid % nig) % gsz); u.pn = (wgid % nig) / gsz; return true;
    }
    __device__ __forceinline__ void a_ready(const Unit&) const {}
    __device__ __forceinline__ void done(const Unit&) const {}
};

__device__ __forceinline__ unsigned cvt_pk_bf16(float lo, float hi) { unsigned r; asm volatile("v_cvt_pk_bf16_f32 %0, %1, %2" : "=v"(r) : "v"(lo), "v"(hi)); return r; }
typedef float f32x2 __attribute__((ext_vector_type(2)));
typedef unsigned u32x2 __attribute__((ext_vector_type(2)));
__device__ __forceinline__ float bf_lo(unsigned w) { return __uint_as_float(w << 16); }
__device__ __forceinline__ float bf_hi(unsigned w) { return __uint_as_float(w & 0xffff0000u); }
__device__ __forceinline__ float sigmoid_f(float x) { return __builtin_amdgcn_rcpf(1.0f + __builtin_amdgcn_exp2f(-1.4426950408889634f * x)); }
__device__ __forceinline__ u32x4 pack8f(f32x4 a, f32x4 b) { u32x4 w; w.x = cvt_pk_bf16(a[0], a[1]); w.y = cvt_pk_bf16(a[2], a[3]); w.z = cvt_pk_bf16(b[0], b[1]); w.w = cvt_pk_bf16(b[2], b[3]); return w; }

__device__ __forceinline__ unsigned pack4_fp8(f32x4 v) { int w = 0; w = __builtin_amdgcn_cvt_pk_fp8_f32(v[0], v[1], w, false); w = __builtin_amdgcn_cvt_pk_fp8_f32(v[2], v[3], w, true); return (unsigned)w; }
struct EpiPlain {
    static constexpr bool PERM = true, AFTER_DRAIN = false; __device__ __forceinline__ bool idem() const { return true; }
    bf16_t* O; int ldc; const float* part8; unsigned char* K8; unsigned char* V8;
    __device__ __forceinline__ void operator()(const f32x4 (&acc)[2][2][4][2], const Unit& u, int wr, int wc, int fr, int fq) const {
        const int row0 = u.pm * BM + wr * 64 + fr, col0 = u.pn * BM + wc * 32 + 8 * fq;
#pragma unroll
        for (int ai = 0; ai < 2; ++ai)
#pragma unroll
            for (int m = 0; m < 4; ++m) { const int row = row0 + ai * HALF + m * 16; bf16_t* rowp = O + (size_t)row * ldc + col0; float sc = 1.f;
                if (part8) { const f32x4* p = (const f32x4*)(part8 + (size_t)row * 8); const f32x4 a = p[0], b = p[1];
                    sc = 1.0f / sqrtf((((a[0] + a[1]) + (a[2] + a[3])) + ((b[0] + b[1]) + (b[2] + b[3]))) * (1.f / 512.f) + 1e-6f); }
#pragma unroll
                for (int bj = 0; bj < 2; ++bj) { const f32x4 v0 = acc[ai][bj][m][0] * sc, v1 = acc[ai][bj][m][1] * sc; if (O) *(u32x4*)(rowp + bj * HALF) = pack8f(v0, v1);
                    if (bj == 0 && K8) { u32x2 w8; w8.x = pack4_fp8(v0); w8.y = pack4_fp8(v1); *(u32x2*)(K8 + (size_t)row * 2048 + u.pn * 128 + wc * 32 + 8 * fq) = w8; }
                    if (bj == 1 && V8) { const int kk = row & 63; const unsigned w0 = pack4_fp8(v0), w1 = pack4_fp8(v1);
                        unsigned char* vp = V8 + ((size_t)(u.pn * 256 + (row >> 6)) * 128 + (wc * 32 + 8 * fq)) * 64 + (((kk >> 2) & 1) * 32 + (kk >> 5) * 16 + ((kk >> 3) & 3) * 4 + (kk & 3));
                        vp[0] = (unsigned char)w0; vp[64] = (unsigned char)(w0 >> 8); vp[128] = (unsigned char)(w0 >> 16); vp[192] = (unsigned char)(w0 >> 24);
                        vp[256] = (unsigned char)w1; vp[320] = (unsigned char)(w1 >> 8); vp[384] = (unsigned char)(w1 >> 16); vp[448] = (unsigned char)(w1 >> 24); } } }
    }
};
struct EpiSwiglu {
    static constexpr bool PERM = true, AFTER_DRAIN = false;
    bf16_t* O; int ldc; const float* rs; int tiledM; const float* cmax;
    __device__ __forceinline__ void operator()(const f32x4 (&acc)[2][2][4][2], const Unit& u, int wr, int wc, int fr, int fq) const {
        const int row0 = u.pm * BM + wr * 64 + fr, col0 = u.pn * HALF + wc * 32 + 8 * fq;
        f32x4 cg[2] = {{1.f, 1.f, 1.f, 1.f}, {1.f, 1.f, 1.f, 1.f}}, cu[2] = {{1.f, 1.f, 1.f, 1.f}, {1.f, 1.f, 1.f, 1.f}};
        if (cmax) {
#pragma unroll
            for (int n = 0; n < 2; ++n) { cg[n] = *(const f32x4*)(cmax + col0 + 4 * n) * (1.f / 127.f); cu[n] = *(const f32x4*)(cmax + (ldc + col0) + 4 * n) * (1.f / 127.f); } }
#pragma unroll
        for (int ai = 0; ai < 2; ++ai)
#pragma unroll
            for (int m = 0; m < 4; ++m) { const int row = row0 + ai * HALF + m * 16;
                bf16_t* rowp = tiledM ? O + ((size_t)(col0 >> 6) * tiledM + row) * 64 + (col0 & 63) : O + (size_t)row * ldc + col0;
                const float sc = rs ? rs[row] : 1.f;
                f32x4 h[2];
#pragma unroll
                for (int n = 0; n < 2; ++n) { f32x4 g = acc[ai][0][m][n], up = acc[ai][1][m][n];
                    if (cmax) { typedef int i32x4_t __attribute__((ext_vector_type(4)));
                        g = __builtin_convertvector(__builtin_bit_cast(i32x4_t, g), f32x4) * cg[n]; up = __builtin_convertvector(__builtin_bit_cast(i32x4_t, up), f32x4) * cu[n]; }
                    g = g * sc; up = up * sc;
#pragma unroll
                    for (int e = 0; e < 4; ++e) h[n][e] = g[e] * sigmoid_f(g[e]) * up[e]; }
                *(u32x4*)rowp = pack8f(h[0], h[1]); }
    }
};

struct EpiSwigluCmp {
    static constexpr bool PERM = true, AFTER_DRAIN = false;
    bf16_t* O; int ldc; int tiledM; float* stats; float thr;
    __device__ __forceinline__ void operator()(const f32x4 (&acc)[2][2][4][2], const Unit& u, int wr, int wc, int fr, int fq) const {
        const int row0 = u.pm * BM + wr * 64 + fr, col0 = u.pn * HALF + wc * 32 + 8 * fq; float sd = 0.f, sh = 0.f, nb = 0.f;
#pragma unroll
        for (int ai = 0; ai < 2; ++ai)
#pragma unroll
            for (int m = 0; m < 4; ++m) { const int row = row0 + ai * HALF + m * 16;
                bf16_t* rowp = O + ((size_t)(col0 >> 6) * tiledM + row) * 64 + (col0 & 63);
                const u32x4 old = *(const u32x4*)rowp; const float ov[8] = {bf_lo(old.x), bf_hi(old.x), bf_lo(old.y), bf_hi(old.y), bf_lo(old.z), bf_hi(old.z), bf_lo(old.w), bf_hi(old.w)};
                f32x4 h[2];
#pragma unroll
                for (int n = 0; n < 2; ++n) { const f32x4 g = acc[ai][0][m][n], up = acc[ai][1][m][n];
#pragma unroll
                    for (int e = 0; e < 4; ++e) { h[n][e] = g[e] * sigmoid_f(g[e]) * up[e]; const float d = h[n][e] - ov[4 * n + e]; sd += d * d; sh += h[n][e] * h[n][e]; nb += fabsf(d) > thr ? 1.f : 0.f; } }
                *(u32x4*)rowp = pack8f(h[0], h[1]); }
#pragma unroll
        for (int o = 1; o < 64; o <<= 1) { sd += __shfl_xor(sd, o); sh += __shfl_xor(sh, o); nb += __shfl_xor(nb, o); }
        if (fr == 0 && fq == 0) { atomicAdd(stats, sd); atomicAdd(stats + 1, sh); atomicAdd(stats + 2, nb); }
    }
};
struct EpiNull {
    static constexpr bool PERM = false, AFTER_DRAIN = false;
    __device__ __forceinline__ void operator()(const f32x4 (&acc)[2][2][4][2], const Unit&, int, int, int, int) const {
#pragma unroll
        for (int ai = 0; ai < 2; ++ai)
#pragma unroll
            for (int bj = 0; bj < 2; ++bj)
#pragma unroll
                for (int m = 0; m < 4; ++m)
#pragma unroll
                    for (int n = 0; n < 2; ++n) asm volatile("" :: "v"(acc[ai][bj][m][n]));
    }
};
struct EpiResid {
    static constexpr bool PERM = false, AFTER_DRAIN = false;
    const float* base; float* out; int ldc; float s;
    __device__ __forceinline__ void operator()(const f32x4 (&acc)[2][2][4][2], const Unit& u, int wr, int wc, int fr, int fq) const {
        const int row0 = u.pm * BM + wr * 64 + fr, col0 = u.pn * BM + wc * 32 + 4 * fq;
#pragma unroll
        for (int ai = 0; ai < 2; ++ai)
#pragma unroll
            for (int m = 0; m < 4; ++m) { const size_t off = (size_t)(row0 + ai * HALF + m * 16) * ldc + col0;
#pragma unroll
                for (int bj = 0; bj < 2; ++bj)
#pragma unroll
                    for (int n = 0; n < 2; ++n) { const f32x4 b = *(const f32x4*)(base + off + bj * HALF + n * 16); *(f32x4*)(out + off + bj * HALF + n * 16) = b + acc[ai][bj][m][n] * s; } }
    }
};
template <long F8> struct EpiResidNorm {
    static constexpr bool PERM = false, AFTER_DRAIN = false;
    const float* base; float* out; float s; bf16_t* hb; const float* gain; float* part; float* pmax;
    __device__ __forceinline__ void operator()(const f32x4 (&acc)[2][2][4][2], const Unit& u, int wr, int wc, int fr, int fq) const {
        constexpr int ldc = 4096, hbM = 16384;
        const int row0 = u.pm * BM + wr * 64 + fr, col0 = u.pn * BM + wc * 32 + 4 * fq;
        f32x4 gv[2][2];
#pragma unroll
        for (int bj = 0; bj < 2; ++bj)
#pragma unroll
            for (int n = 0; n < 2; ++n) gv[bj][n] = *(const f32x4*)(gain + col0 + bj * HALF + n * 16);
#pragma unroll
        for (int ai = 0; ai < 2; ++ai)
#pragma unroll
            for (int m = 0; m < 4; ++m) { const int row = row0 + ai * HALF + m * 16; const size_t off = (size_t)row * ldc + col0; float ss = 0.f, mx = 0.f;
#pragma unroll
                for (int bj = 0; bj < 2; ++bj)
#pragma unroll
                    for (int n = 0; n < 2; ++n) { const f32x4 b = *(const f32x4*)(base + off + bj * HALF + n * 16); const f32x4 o = b + acc[ai][bj][m][n] * s;
                        *(f32x4*)(out + off + bj * HALF + n * 16) = o;
                        ss += (o[0] * o[0] + o[1] * o[1]) + (o[2] * o[2] + o[3] * o[3]); const f32x4 y = o * gv[bj][n];
                        mx = fmaxf(fmaxf(mx, fmaxf(fabsf(y[0]), fabsf(y[1]))), fmaxf(fabsf(y[2]), fabsf(y[3])));
                        u32x2 w; w.x = cvt_pk_bf16(y[0], y[1]); w.y = cvt_pk_bf16(y[2], y[3]);
                        const int col = col0 + bj * HALF + n * 16;
                        *(u32x2*)(hb + ((size_t)(col >> 6) * hbM + row) * 64 + (col & 63)) = w;
                        if constexpr (F8 != 0) *(unsigned*)((unsigned char*)hb + F8 + ((size_t)(col >> 7) * hbM + row) * 128 + (col & 127)) = pack4_fp8(y); }
                ss += __shfl_xor(ss, 16); ss += __shfl_xor(ss, 32); if (fq == 0) part[(size_t)row * 64 + u.pn * 4 + wc] = ss;
                if (pmax) { mx = fmaxf(mx, __shfl_xor(mx, 16)); mx = fmaxf(mx, __shfl_xor(mx, 32)); if (fq == 0) pmax[(size_t)row * 64 + u.pn * 4 + wc] = mx; } }
    }
};
template <int MODE_> struct EpiProj {
    static constexpr bool PERM = true, AFTER_DRAIN = false; static constexpr int mode = MODE_; __device__ __forceinline__ bool idem() const { return true; }
    bf16_t *cq, *ckv, *kr, *qb, *kb, *vb, *ga, *gb; const float* cosT; const float* sinT; const float* rs; float* partq; float* partkv; float* kmean; unsigned char* kr8; unsigned char* qb8; unsigned char* kb8; unsigned char* vb8;
    float post;
    __device__ __forceinline__ void operator()(const f32x4 (&acc)[2][2][4][2], const Unit& u, int wr, int wc, int fr, int fq) const {
        const int row0 = u.pm * BM + wr * 64 + fr; const int pn = mode == 1 ? (u.pn == 22 ? 62 : u.pn) : u.pn + 22;
        if (mode == 1 && pn == 62) {
            if (wc < 2) { const int g = wc * 4 + fq;
#pragma unroll
                for (int ai = 0; ai < 2; ++ai)
#pragma unroll
                    for (int m = 0; m < 4; ++m) { const int row = row0 + ai * HALF + m * 16;
                        const f32x4 c = *(const f32x4*)(cosT + (size_t)row * 32 + 4 * g), s = *(const f32x4*)(sinT + (size_t)row * 32 + 4 * g);
                        const float sc = rs[row] * post;
                        const f32x4 x1 = acc[ai][0][m][0] * sc, x2 = acc[ai][0][m][1] * sc;
                        const f32x4 o1 = x1 * c - x2 * s, o2 = x2 * c + x1 * s;
                        u32x2 w1, w2; w1.x = cvt_pk_bf16(o1[0], o1[1]); w1.y = cvt_pk_bf16(o1[2], o1[3]); w2.x = cvt_pk_bf16(o2[0], o2[1]); w2.y = cvt_pk_bf16(o2[2], o2[3]);
                        *(u32x2*)(kr + (size_t)row * 64 + 4 * g) = w1; *(u32x2*)(kr + (size_t)row * 64 + 32 + 4 * g) = w2;
                        *(unsigned*)(kr8 + (size_t)row * 64 + 4 * g) = pack4_fp8(o1); *(unsigned*)(kr8 + (size_t)row * 64 + 32 + 4 * g) = pack4_fp8(o2); } }
            return; }
        bf16_t* base; int ldc, colt; bool sig = false;
        if (pn < 4) { base = cq; ldc = 1024; colt = pn * BM; }
        else if (pn < 6) { base = ckv; ldc = 512; colt = (pn - 4) * BM; }
        else if (pn < 14) { base = qb; ldc = 2048; colt = (pn - 6) * BM; }
        else if (pn < 22) { base = kb; ldc = 2048; colt = (pn - 14) * BM; }
        else if (pn < 30) { base = vb; ldc = 2048; colt = (pn - 22) * BM; }
        else if (pn < 46) { base = ga; ldc = 4096; colt = (pn - 30) * BM; sig = true; }
        else { base = gb; ldc = 4096; colt = (pn - 46) * BM; sig = true; }
        const int col0 = colt + wc * 32 + 8 * fq;
        float* part = mode != 1 ? nullptr : (pn < 4 ? partq + pn * 4 + wc : (pn < 6 ? partkv + (pn - 4) * 4 + wc : nullptr)); const int pstride = pn < 4 ? 16 : 8;
        const bool iskb = mode == 1 && pn >= 14 && pn < 22; f32x4 cs[2][2] = {};
        const bool isvb = mode == 2 && pn < 30;
        unsigned char* f8p = mode == 1 && pn >= 6 && pn < 22 ? (pn < 14 ? qb8 : kb8) : nullptr;
#pragma unroll
        for (int ai = 0; ai < 2; ++ai)
#pragma unroll
            for (int m = 0; m < 4; ++m) { const int row = row0 + ai * HALF + m * 16; bf16_t* rowp = base + (size_t)row * ldc + col0; const float sc = rs[row] * post; float ss = 0.f;
#pragma unroll
                for (int bj = 0; bj < 2; ++bj) { f32x4 v0 = acc[ai][bj][m][0] * sc, v1 = acc[ai][bj][m][1] * sc;
                    if (sig) {
#pragma unroll
                        for (int e = 0; e < 4; ++e) { v0[e] = sigmoid_f(v0[e]); v1[e] = sigmoid_f(v1[e]); } }
                    if (part) ss += ((v0[0] * v0[0] + v0[1] * v0[1]) + (v0[2] * v0[2] + v0[3] * v0[3])) + ((v1[0] * v1[0] + v1[1] * v1[1]) + (v1[2] * v1[2] + v1[3] * v1[3]));
                    if (iskb) { cs[bj][0] += v0; cs[bj][1] += v1; }
                    if (f8p) { u32x2 w8; w8.x = pack4_fp8(v0); w8.y = pack4_fp8(v1); *(u32x2*)(f8p + (size_t)row * 2048 + col0 + bj * HALF) = w8; }
                    if (isvb) { const int kk = row & 63; const unsigned w0 = pack4_fp8(v0), w1 = pack4_fp8(v1);
                        unsigned char* vp = vb8 + ((size_t)((2 * (pn - 22) + bj) * 256 + (row >> 6)) * 128 + (wc * 32 + 8 * fq)) * 64 + (((kk >> 2) & 1) * 32 + (kk >> 5) * 16 + ((kk >> 3) & 3) * 4 + (kk & 3));
                        vp[0] = (unsigned char)w0; vp[64] = (unsigned char)(w0 >> 8); vp[128] = (unsigned char)(w0 >> 16); vp[192] = (unsigned char)(w0 >> 24);
                        vp[256] = (unsigned char)w1; vp[320] = (unsigned char)(w1 >> 8); vp[384] = (unsigned char)(w1 >> 16); vp[448] = (unsigned char)(w1 >> 24); }
                    if (!isvb || MLA_BF16) *(u32x4*)(rowp + bj * HALF) = pack8f(v0, v1); }
                if (part) { ss += __shfl_xor(ss, 16); ss += __shfl_xor(ss, 32); if (fq == 0) part[(size_t)row * pstride] = ss; } }
        if (iskb) {
#pragma unroll
            for (int bj = 0; bj < 2; ++bj)
#pragma unroll
                for (int n = 0; n < 2; ++n)
#pragma unroll
                    for (int e2 = 0; e2 < 4; ++e2) { float c = cs[bj][n][e2];
                        c += __shfl_xor(c, 1); c += __shfl_xor(c, 2); c += __shfl_xor(c, 4); c += __shfl_xor(c, 8);
                        if (fr == 0) atomicAdd(kmean + (size_t)((2 * (pn - 14) + bj) * 64 + u.pm) * 128 + wc * 32 + 8 * fq + 4 * n + e2, c * (1.f / 256.f)); }
        }
    }
};
struct EpiQ {
    static constexpr bool PERM = true, AFTER_DRAIN = false; __device__ __forceinline__ bool idem() const { return true; }
    bf16_t* Q; const float* cosT; const float* sinT; const float* partq; unsigned char* Q8;
    __device__ __forceinline__ float rstd_of(int row) const { const f32x4* p = (const f32x4*)(partq + (size_t)row * 16); const f32x4 a = p[0], b = p[1], c = p[2], d = p[3];
        const float s = ((a[0] + a[1]) + (a[2] + a[3])) + ((b[0] + b[1]) + (b[2] + b[3])) + ((c[0] + c[1]) + (c[2] + c[3])) + ((d[0] + d[1]) + (d[2] + d[3])); return 1.0f / sqrtf(s * (1.f / 1024.f) + 1e-6f); }
    __device__ __forceinline__ void operator()(const f32x4 (&acc)[2][2][4][2], const Unit& u, int wr, int wc, int fr, int fq) const {
        const int row0 = u.pm * BM + wr * 64 + fr;
        float rsv[2][4];
#pragma unroll
        for (int ai = 0; ai < 2; ++ai)
#pragma unroll
            for (int m = 0; m < 4; ++m) rsv[ai][m] = rstd_of(row0 + ai * HALF + m * 16);
#pragma unroll
        for (int bj = 0; bj < 2; ++bj) {
            const int cw = u.pn * BM + bj * HALF + wc * 32;
            const int hc = cw % 192, hb = cw - hc;
            if (hc < 128) {
#pragma unroll
                for (int ai = 0; ai < 2; ++ai)
#pragma unroll
                    for (int m = 0; m < 4; ++m) { const int row = row0 + ai * HALF + m * 16; const float sc = rsv[ai][m];
                        const f32x4 q0 = acc[ai][bj][m][0] * sc, q1 = acc[ai][bj][m][1] * sc;
                        if (Q) *(u32x4*)(Q + (size_t)row * 3072 + cw + 8 * fq) = pack8f(q0, q1);
                        u32x2 w8; w8.x = pack4_fp8(q0); w8.y = pack4_fp8(q1); *(u32x2*)(Q8 + (size_t)row * 3072 + cw + 8 * fq) = w8; }
            } else {
                const int g = ((hc - 128) >> 3) + fq;
#pragma unroll
                for (int ai = 0; ai < 2; ++ai)
#pragma unroll
                    for (int m = 0; m < 4; ++m) { const int row = row0 + ai * HALF + m * 16;
                        const f32x4 c = *(const f32x4*)(cosT + (size_t)row * 32 + 4 * g), s = *(const f32x4*)(sinT + (size_t)row * 32 + 4 * g);
                        const float sc = rsv[ai][m];
                        const f32x4 x1 = acc[ai][bj][m][0] * sc, x2 = acc[ai][bj][m][1] * sc;
                        const f32x4 o1 = x1 * c - x2 * s, o2 = x2 * c + x1 * s;
                        if (Q) { u32x2 w1, w2; w1.x = cvt_pk_bf16(o1[0], o1[1]); w1.y = cvt_pk_bf16(o1[2], o1[3]); w2.x = cvt_pk_bf16(o2[0], o2[1]); w2.y = cvt_pk_bf16(o2[2], o2[3]);
                            bf16_t* qp = Q + (size_t)row * 3072 + hb + 128 + 4 * g;
                            *(u32x2*)qp = w1; *(u32x2*)(qp + 32) = w2; }
                        unsigned char* q8p = Q8 + (size_t)row * 3072 + hb + 128 + 4 * g; *(unsigned*)q8p = pack4_fp8(o1); *(unsigned*)(q8p + 32) = pack4_fp8(o2); }
            }
        }
    }
};
template <bool ADD> struct EpiMerge {
    static constexpr bool PERM = true, AFTER_DRAIN = false; const bf16_t* gate; bf16_t* T; unsigned char* O8; float post;
    __device__ __forceinline__ void operator()(const f32x4 (&acc)[2][2][4][2], const Unit& u, int wr, int wc, int fr, int fq) const {
        const int row0 = u.pm * BM + wr * 64 + fr, col0 = u.pn * BM + wc * 32 + 8 * fq;
#pragma unroll
        for (int ai = 0; ai < 2; ++ai)
#pragma unroll
            for (int m = 0; m < 4; ++m) { const int row = row0 + ai * HALF + m * 16; const size_t off = (size_t)row * 4096 + col0;
#pragma unroll
                for (int bj = 0; bj < 2; ++bj) { const u32x4 gw = *(const u32x4*)(gate + off + bj * HALF);
                    f32x4 v0 = acc[ai][bj][m][0] * post, v1 = acc[ai][bj][m][1] * post;
                    v0[0] *= bf_lo(gw.x); v0[1] *= bf_hi(gw.x); v0[2] *= bf_lo(gw.y); v0[3] *= bf_hi(gw.y);
                    v1[0] *= bf_lo(gw.z); v1[1] *= bf_hi(gw.z); v1[2] *= bf_lo(gw.w); v1[3] *= bf_hi(gw.w);
                    if (ADD) { const u32x4 pw = *(const u32x4*)(T + off + bj * HALF);
                        v0[0] += bf_lo(pw.x); v0[1] += bf_hi(pw.x); v0[2] += bf_lo(pw.y); v0[3] += bf_hi(pw.y);
                        v1[0] += bf_lo(pw.z); v1[1] += bf_hi(pw.z); v1[2] += bf_lo(pw.w); v1[3] += bf_hi(pw.w);
                        if (O8) { const int col = col0 + bj * HALF; u32x2 q; q.x = pack4_fp8(v0 * 16.f); q.y = pack4_fp8(v1 * 16.f);
                            *(u32x2*)(O8 + ((size_t)(col >> 7) * 16384 + row) * 128 + (col & 127)) = q; }
                        else *(u32x4*)(T + off + bj * HALF) = pack8f(v0, v1); }
                    else *(u32x4*)(T + off + bj * HALF) = pack8f(v0, v1); } }
    }
};
template <class Epi, class Sched, bool ALIGN_EPI = false, bool SP2 = false, bool TILED = false, bool FP8 = false, bool I8 = false>
__device__ __forceinline__ void gemm_phase(PG8_LAS unsigned char* lds, const Gemm g, const Sched S, const Epi E, int wv) {
    int tid_ = wv * 64 + lane_id_(); asm volatile("" : "+v"(tid_)); const int tid = tid_, wid = wv, lane = tid & 63, wr = wid >> 2, wc = wid & 3, fr = lane & 15, fq = lane >> 4;
    const int K = g.K, nt = K / BK;
    unsigned voffA[2], voffB[2];
#pragma unroll
    for (int i = 0; i < 2; ++i) { int R, C; stage_rc(tid * 16 + i * 8192, R, C); const int Rb = Epi::PERM ? ((R & ~31) + perm32(R & 31)) : R;
        voffA[i] = (unsigned)(R * (TILED ? BK : K) + C) * 2u; voffB[i] = (unsigned)(Rb * (TILED ? BK : K) + C) * 2u; }
    const size_t kstepA = TILED ? (size_t)g.M * BK * 2 : (size_t)(BK * 2), kstepB = TILED ? (size_t)g.N * BK * 2 : (size_t)(BK * 2);
    const size_t hstep = TILED ? (size_t)HALF * BK * 2 : (size_t)HALF * K * 2;
    const size_t tstep = 2 * hstep;
    const unsigned ldsw = (unsigned)wid * 1024u;
    const int aoff = lds_byte(wr * 64 + fr, fq * 8), boff = lds_byte(wc * 32 + fr, fq * 8);
#define PG8_SA(b, h) (((b) * 2 + (h)) * HTB)
#define PG8_SB(b, h) ((4 + (b) * 2 + (h)) * HTB)
#define PG8_STAGE(bufoff, gbase, voff) do { _Pragma("unroll") for (int _i = 0; _i < 2; ++_i) \
        __builtin_amdgcn_global_load_lds((const unsigned*)((const char*)(gbase) + (voff)[_i]), (PG8_LAS unsigned*)(lds + (bufoff) + ldsw + _i * 8192), 16, 0, 0); } while (0)
#define PG8_LDA(dst, b, h) do { _Pragma("unroll") for (int m = 0; m < 4; ++m) { if constexpr (FP8) { \
            dst##8[m].lo = *(const PG8_LAS v4i_t*)(lds + PG8_SA(b, h) + aoff + m * 2048); dst##8[m].hi = *(const PG8_LAS v4i_t*)(lds + PG8_SA(b, h) + aoff + m * 2048 + 1024); } \
        else { _Pragma("unroll") for (int k = 0; k < 2; ++k) dst[m][k] = *(const PG8_LAS bf16x8*)(lds + PG8_SA(b, h) + aoff + m * 2048 + k * 1024); } } } while (0)
#define PG8_LDB(dst, b, h) do { _Pragma("unroll") for (int n = 0; n < 2; ++n) { if constexpr (FP8) { \
            dst##8[n].lo = *(const PG8_LAS v4i_t*)(lds + PG8_SB(b, h) + boff + n * 2048); dst##8[n].hi = *(const PG8_LAS v4i_t*)(lds + PG8_SB(b, h) + boff + n * 2048 + 1024); } \
        else { _Pragma("unroll") for (int k = 0; k < 2; ++k) dst[n][k] = *(const PG8_LAS bf16x8*)(lds + PG8_SB(b, h) + boff + n * 2048 + k * 1024); } } } while (0)
#define PG8_MMA(ai, bj, At, Bt) do { __builtin_amdgcn_s_setprio(1); \
        if constexpr (I8) {   \
            _Pragma("unroll") for (int k = 0; k < 2; ++k) _Pragma("unroll") for (int m = 0; m < 4; ++m) _Pragma("unroll") for (int n = 0; n < 2; ++n) \
                acc[ai][bj][m][n] = __builtin_bit_cast(f32x4, __builtin_amdgcn_mfma_i32_16x16x64_i8(__builtin_bit_cast(v4i_t, Bt[n][k]), __builtin_bit_cast(v4i_t, At[m][k]), __builtin_bit_cast(v4i_t, acc[ai][bj][m][n]), 0, 0, 0)); } \
        else { _Pragma("unroll") for (int m = 0; m < 4; ++m) _Pragma("unroll") for (int n = 0; n < 2; ++n) { \
            if constexpr (FP8) asm volatile("v_mfma_scale_f32_16x16x128_f8f6f4 %0, %1, %2, %0, %3, %3 op_sel_hi:[0,0,0]" : "+v"(acc[ai][bj][m][n]) : "v"(Bt##8[n]), "v"(At##8[m]), "v"(f8scale));   \
            else { _Pragma("unroll") for (int k = 0; k < 2; ++k) acc[ai][bj][m][n] = __builtin_amdgcn_mfma_f32_16x16x32_bf16(Bt[n][k], At[m][k], acc[ai][bj][m][n], 0, 0, 0); } } } \
        __builtin_amdgcn_s_setprio(0); } while (0)
#define PG8_WAIT_V(n) asm volatile("s_waitcnt vmcnt(" #n ")" ::: "memory")
#define PG8_WAIT_L(n) asm volatile("s_waitcnt lgkmcnt(" #n ")" ::: "memory")
#define PG8_BAR __builtin_amdgcn_s_barrier()
#define PG8_SCHED __builtin_amdgcn_sched_barrier(0)
    Unit cur, nxt; int ui = 0;
    if (!S.next(0, cur)) return;
    f32x4 acc[2][2][4][2];
#pragma unroll
    for (int a = 0; a < 2; ++a)
#pragma unroll
        for (int b = 0; b < 2; ++b)
#pragma unroll
            for (int m = 0; m < 4; ++m)
#pragma unroll
                for (int n = 0; n < 2; ++n) acc[a][b][m][n] = (f32x4){0.f, 0.f, 0.f, 0.f};
    typedef int v8i_t __attribute__((ext_vector_type(8))); typedef int v4i_t __attribute__((ext_vector_type(4)));
    int f8scale = 0x7f7f7f7f; asm volatile("" : "+v"(f8scale));
    bf16x8 At[4][2], B0[2][2], B1[2][2]; v8i_t At8[4], B08[2], B18[2];
    const char* cA = (const char*)g.A + (size_t)cur.pm * tstep; const char* cB = (const char*)g.Bt + (size_t)cur.pn * tstep;
    S.a_ready(cur);
    if constexpr (SP2) {
        PG8_STAGE(PG8_SB(0, 0), cB, voffB); PG8_STAGE(PG8_SB(0, 1), cB + hstep, voffB); PG8_STAGE(PG8_SA(0, 0), cA, voffA); PG8_STAGE(PG8_SA(0, 1), cA + hstep, voffA);
        if (wr == 1) PG8_BAR;
        PG8_WAIT_V(2); PG8_BAR;
        PG8_STAGE(PG8_SB(1, 0), cB + kstepB, voffB); PG8_STAGE(PG8_SA(1, 0), cA + kstepA, voffA); PG8_STAGE(PG8_SB(1, 1), cB + hstep + kstepB, voffB);
        PG8_WAIT_V(6); PG8_BAR;
    } else {
        PG8_STAGE(PG8_SB(0, 0), cB, voffB); PG8_STAGE(PG8_SA(0, 0), cA, voffA); PG8_STAGE(PG8_SB(0, 1), cB + hstep, voffB); PG8_STAGE(PG8_SA(0, 1), cA + hstep, voffA);
        if (wr == 1) PG8_BAR;
        PG8_WAIT_V(4); PG8_BAR;
        PG8_STAGE(PG8_SB(1, 0), cB + kstepB, voffB); PG8_STAGE(PG8_SA(1, 0), cA + kstepA, voffA); PG8_STAGE(PG8_SB(1, 1), cB + hstep + kstepB, voffB);
        PG8_WAIT_V(6); PG8_BAR;
    }
    for (;;) {
        const bool has_next = S.next(ui + 1, nxt);
        const char* nA = has_next ? (const char*)g.A + (size_t)nxt.pm * tstep : cA; const char* nB = has_next ? (const char*)g.Bt + (size_t)nxt.pn * tstep : cB;
        for (int t = 0; t < nt; t += 2) {
            const bool last = (t == nt - 2);
            const char* a1 = cA + (size_t)(t + 1) * kstepA;
            const char* a2 = last ? nA : cA + (size_t)(t + 2) * kstepA; const char* b2 = last ? nB : cB + (size_t)(t + 2) * kstepB;
            const char* a3 = a2 + kstepA; const char* b3 = b2 + kstepB;
            if (last && has_next) S.a_ready(nxt);
            if constexpr (SP2) {
            PG8_LDB(B0, 0, 0); PG8_LDB(B1, 0, 1); PG8_SCHED; PG8_LDA(At, 0, 0); PG8_STAGE(PG8_SA(1, 1), a1 + hstep, voffA);
            PG8_WAIT_V(8); PG8_WAIT_L(0); PG8_BAR; PG8_MMA(0, 0, At, B0); PG8_MMA(0, 1, At, B1); PG8_BAR; PG8_SCHED;
            PG8_LDA(At, 0, 1); PG8_STAGE(PG8_SB(0, 0), b2, voffB); PG8_STAGE(PG8_SB(0, 1), b2 + hstep, voffB); PG8_STAGE(PG8_SA(0, 0), a2, voffA);
            PG8_WAIT_V(8); PG8_WAIT_L(0); PG8_BAR; PG8_MMA(1, 0, At, B0); PG8_MMA(1, 1, At, B1); PG8_BAR; PG8_SCHED;
            PG8_LDB(B0, 1, 0); PG8_LDB(B1, 1, 1); PG8_SCHED; PG8_LDA(At, 1, 0); PG8_STAGE(PG8_SA(0, 1), a2 + hstep, voffA);
            PG8_WAIT_V(8); PG8_WAIT_L(0); PG8_BAR; PG8_MMA(0, 0, At, B0); PG8_MMA(0, 1, At, B1); PG8_BAR; PG8_SCHED;
            PG8_LDA(At, 1, 1); PG8_STAGE(PG8_SB(1, 0), b3, voffB); PG8_STAGE(PG8_SB(1, 1), b3 + hstep, voffB); PG8_STAGE(PG8_SA(1, 0), a3, voffA);
            PG8_WAIT_V(8); PG8_WAIT_L(0); PG8_BAR; PG8_MMA(1, 0, At, B0); PG8_MMA(1, 1, At, B1); PG8_BAR; PG8_SCHED;
            } else {
            PG8_LDB(B0, 0, 0); PG8_SCHED; PG8_LDA(At, 0, 0); PG8_STAGE(PG8_SA(1, 1), a1 + hstep, voffA);
            PG8_WAIT_L(8); PG8_BAR; PG8_WAIT_L(0); PG8_MMA(0, 0, At, B0); PG8_BAR; PG8_SCHED;
            PG8_LDB(B1, 0, 1); PG8_STAGE(PG8_SB(0, 0), b2, voffB);
            PG8_BAR; PG8_WAIT_L(0); PG8_MMA(0, 1, At, B1); PG8_BAR;
            PG8_LDA(At, 0, 1); PG8_STAGE(PG8_SA(0, 0), a2, voffA);
            PG8_BAR; PG8_WAIT_L(0); PG8_MMA(1, 0, At, B0); PG8_BAR; PG8_SCHED;
            PG8_STAGE(PG8_SB(0, 1), b2 + hstep, voffB);
            PG8_WAIT_V(6); PG8_BAR; PG8_MMA(1, 1, At, B1); PG8_BAR;
            PG8_LDB(B0, 1, 0); PG8_SCHED; PG8_LDA(At, 1, 0); PG8_STAGE(PG8_SA(0, 1), a2 + hstep, voffA);
            PG8_WAIT_L(8); PG8_BAR; PG8_WAIT_L(0); PG8_MMA(0, 0, At, B0); PG8_BAR; PG8_SCHED;
            PG8_LDB(B1, 1, 1); PG8_STAGE(PG8_SB(1, 0), b3, voffB);
            PG8_BAR; PG8_WAIT_L(0); PG8_MMA(0, 1, At, B1); PG8_BAR;
            PG8_LDA(At, 1, 1); PG8_STAGE(PG8_SA(1, 0), a3, voffA);
            PG8_BAR; PG8_WAIT_L(0); PG8_MMA(1, 0, At, B0); PG8_BAR; PG8_SCHED;
            PG8_STAGE(PG8_SB(1, 1), b3 + hstep, voffB);
            PG8_WAIT_V(6); PG8_BAR; PG8_MMA(1, 1, At, B1); PG8_BAR;
            }
        }
        if constexpr (FP8 || I8) asm volatile("s_nop 15\n\ts_nop 7" ::: "memory");
        if constexpr (ALIGN_EPI) { if (wr == 0) PG8_BAR; }
        if constexpr (!Epi::AFTER_DRAIN) { int fr_e = fr, fq_e = fq; asm volatile("" : "+v"(fr_e), "+v"(fq_e));
            E(acc, cur, wr, wc, fr_e, fq_e); S.done(cur); }
        if (!has_next) break;
#pragma unroll
        for (int a = 0; a < 2; ++a)
#pragma unroll
            for (int b = 0; b < 2; ++b)
#pragma unroll
                for (int m = 0; m < 4; ++m)
#pragma unroll
                    for (int n = 0; n < 2; ++n) acc[a][b][m][n] = (f32x4){0.f, 0.f, 0.f, 0.f};
        cur = nxt; cA = nA; cB = nB; ++ui;
        if constexpr (ALIGN_EPI) { if (wr == 1) PG8_BAR; }
    }
    PG8_WAIT_V(0);
    if constexpr (!ALIGN_EPI) { if (wr == 0) PG8_BAR; }
    PG8_BAR;
    if constexpr (Epi::AFTER_DRAIN) { E.fused(acc, cur, wr, wc, fr, fq, lds, wid, lane); S.done(cur); }
#undef PG8_SA
#undef PG8_SB
#undef PG8_STAGE
#undef PG8_LDA
#undef PG8_LDB
#undef PG8_MMA
#undef PG8_WAIT_V
#undef PG8_WAIT_L
#undef PG8_BAR
#undef PG8_SCHED
}
}
namespace att {
typedef unsigned short bf16_t;
typedef short bf16x8 __attribute__((ext_vector_type(8)));
typedef short s16x4 __attribute__((ext_vector_type(4)));
typedef float f32x16 __attribute__((ext_vector_type(16)));
typedef float f32x4 __attribute__((ext_vector_type(4)));
typedef unsigned u32x4 __attribute__((ext_vector_type(4)));
typedef int i32x4 __attribute__((ext_vector_type(4)));
#define ASBAR() __builtin_amdgcn_sched_barrier(0)
constexpr int VT_BYTES = 16384;
constexpr int L_V = 0, L_K = 2 * VT_BYTES;
constexpr int KT_MAX = 64 * 192 * 2;
constexpr int L_WS = L_K + 2 * KT_MAX;
constexpr int L_BIAS = L_WS + 8 * 128 * 4;
constexpr int L_PREF = L_BIAS + 16 * 132 * 4;
constexpr int L_CNT = L_PREF + 1040 * 4 + 64;
constexpr int L_END = L_CNT + 1024 * 4;
constexpr float LOG2E = 1.4426950408889634f;
constexpr float THR2 = 6.0f;

__device__ __forceinline__ int v_st(int k, int c) { const int kk = (k & ~0xC) | ((k & 4) << 1) | ((k & 8) >> 1); return ((kk >> 3) * 4 + (c >> 5)) * 512 + ((kk & 7) * 32 + (c & 31)) * 2; }
__device__ __forceinline__ int v_rd_base(int lane) { return ((lane & 3) << 3) | (((lane >> 2) & 3) << 6) | (((lane >> 4) & 1) << 5) | (((lane >> 5) & 1) << 8); }
constexpr int v_rd_off(int d0, int ks, int half) { return d0 * 512 + ks * 4096 + half * 2048; }
__device__ __forceinline__ int crow(int r, int hi) { return (r & 3) + 8 * (r >> 2) + 4 * hi; }
__device__ __forceinline__ unsigned cvtpk(float lo, float hi) { unsigned r; asm volatile("v_cvt_pk_bf16_f32 %0, %1, %2" : "=v"(r) : "v"(lo), "v"(hi)); return r; }
__device__ __forceinline__ bf16x8 ld8(const bf16_t* p) { return *reinterpret_cast<const bf16x8*>(p); }
template <int DQK> __device__ __forceinline__ int kswz(int row, int chunk) {
    if constexpr (DQK == 128) return row * 256 + ((chunk ^ (row & 7)) << 4);
    else return row * 384 + (((chunk & ~7) | ((chunk ^ (row >> 1)) & 7)) << 4);
}
__device__ __forceinline__ void mask_tile(f32x16& p0, f32x16& p1, int dq) {
    const float NEG = -__builtin_inff();
#pragma unroll
    for (int r = 0; r < 16; ++r) { const int c = (r & 3) + 8 * (r >> 2); if (dq - c < 0) p0[r] = NEG; if (dq - c - 32 < 0) p1[r] = NEG; }
}
template <bool RAW>
__device__ __forceinline__ void partialSM(f32x16& p0, f32x16& p1, float& m_reg, float& alpha, float sc) {
    float pmax = p0[0];
#pragma unroll
    for (int r = 1; r < 16; ++r) pmax = fmaxf(pmax, p0[r]);
#pragma unroll
    for (int r = 0; r < 16; ++r) pmax = fmaxf(pmax, p1[r]);
    { auto rr = __builtin_amdgcn_permlane32_swap(__float_as_uint(pmax), __float_as_uint(pmax), false, false);
      pmax = fmaxf(__uint_as_float(rr[0]), __uint_as_float(rr[1])); }
    if (RAW) pmax *= sc;
    const bool need = pmax - m_reg > THR2;
    const float mn = need ? pmax : m_reg;
    alpha = need ? __builtin_amdgcn_exp2f(m_reg - mn) : 1.f; m_reg = mn;
    if (RAW) {
#pragma unroll
        for (int r = 0; r < 16; ++r) p0[r] = __builtin_amdgcn_exp2f(fmaf(p0[r], sc, -mn));
#pragma unroll
        for (int r = 0; r < 16; ++r) p1[r] = fmaf(p1[r], sc, -mn);
    } else {
#pragma unroll
        for (int r = 0; r < 16; ++r) p0[r] = __builtin_amdgcn_exp2f(p0[r] - mn);
#pragma unroll
        for (int r = 0; r < 16; ++r) p1[r] = p1[r] - mn;
    }
}
__device__ __forceinline__ void finishSM_e(f32x16& p1) {
#pragma unroll
    for (int r = 0; r < 16; ++r) p1[r] = __builtin_amdgcn_exp2f(p1[r]);
}
__device__ __forceinline__ void finishSM_a(f32x16& p0, f32x16& p1, float alpha, float& l_reg) {
#pragma unroll
    for (int r = 0; r < 16; ++r) p1[r] = __builtin_amdgcn_exp2f(p1[r]);
    float ps = 0;
#pragma unroll
    for (int r = 0; r < 16; ++r) ps += p0[r];
#pragma unroll
    for (int r = 0; r < 16; ++r) ps += p1[r];
    { auto rr = __builtin_amdgcn_permlane32_swap(__float_as_uint(ps), __float_as_uint(ps), false, false);
      ps = __uint_as_float(rr[0]) + __uint_as_float(rr[1]); }
    l_reg = l_reg * alpha + ps;
}
#define PK4(P, B_, OUT) do { unsigned a0 = cvtpk(P[B_+0], P[B_+1]), a1 = cvtpk(P[B_+2], P[B_+3]);                          \
        unsigned b0 = cvtpk(P[B_+4], P[B_+5]), b1 = cvtpk(P[B_+6], P[B_+7]);                                             \
        auto r0 = __builtin_amdgcn_permlane32_swap(a0, b0, false, false); auto r1 = __builtin_amdgcn_permlane32_swap(a1, b1, false, false); \
        u32x4 w = {r0[0], r1[0], r0[1], r1[1]}; OUT = *reinterpret_cast<bf16x8*>(&w); } while (0)
template <int DQK>
__device__ __forceinline__ void qkt(f32x16& p0, f32x16& p1, const char* kbuf, int r32, int hi, const bf16x8* qr) {
    p0 = f32x16{}; p1 = f32x16{};
    const char* kb[4];
    constexpr int RP = DQK * 2;
#pragma unroll
    for (int dd = 0; dd < 4; ++dd) kb[dd] = kbuf + kswz<DQK>(r32, 2 * dd + hi);
#pragma unroll
    for (int d0 = 0; d0 < DQK / 16; ++d0) { const char* a = kb[d0 & 3] + (d0 >> 2) * 128;
        bf16x8 b0 = *reinterpret_cast<const bf16x8*>(a);
        bf16x8 b1 = *reinterpret_cast<const bf16x8*>(a + 32 * RP);
        __builtin_amdgcn_s_setprio(1);
        p0 = __builtin_amdgcn_mfma_f32_32x32x16_bf16(b0, qr[d0], p0, 0, 0, 0);
        p1 = __builtin_amdgcn_mfma_f32_32x32x16_bf16(b1, qr[d0], p1, 0, 0, 0);
        __builtin_amdgcn_s_setprio(0); }
}
template <int VBOFF>
__device__ __forceinline__ void pv_tile(f32x16* o, int vb0, bf16x8 pa0, bf16x8 pa1, bf16x8 pa2, bf16x8 pa3) {
#define TRRD(dst, off) asm volatile("ds_read_b64_tr_b16 %0, %1 offset:%2" : "=&v"(dst) : "v"(vb0), "i"(off) : "memory")
#define PV_D0(d0) do { s16x4 l0, l1, l2, l3, h0, h1, h2, h3; constexpr int b_ = VBOFF + v_rd_off(d0, 0, 0); \
        TRRD(l0, b_); TRRD(h0, b_ + 2048); TRRD(l1, b_ + 4096); TRRD(h1, b_ + 6144); TRRD(l2, b_ + 8192); TRRD(h2, b_ + 10240); TRRD(l3, b_ + 12288); TRRD(h3, b_ + 14336); \
        asm volatile("s_waitcnt lgkmcnt(0)" ::: "memory"); ASBAR();   \
        o[d0] = __builtin_amdgcn_mfma_f32_32x32x16_bf16(pa0, (bf16x8){l0[0], l0[1], l0[2], l0[3], h0[0], h0[1], h0[2], h0[3]}, o[d0], 0, 0, 0);   \
        o[d0] = __builtin_amdgcn_mfma_f32_32x32x16_bf16(pa1, (bf16x8){l1[0], l1[1], l1[2], l1[3], h1[0], h1[1], h1[2], h1[3]}, o[d0], 0, 0, 0);   \
        o[d0] = __builtin_amdgcn_mfma_f32_32x32x16_bf16(pa2, (bf16x8){l2[0], l2[1], l2[2], l2[3], h2[0], h2[1], h2[2], h2[3]}, o[d0], 0, 0, 0);   \
        o[d0] = __builtin_amdgcn_mfma_f32_32x32x16_bf16(pa3, (bf16x8){l3[0], l3[1], l3[2], l3[3], h3[0], h3[1], h3[2], h3[3]}, o[d0], 0, 0, 0); } while (0)
    PV_D0(0); PV_D0(1); PV_D0(2); PV_D0(3);
#undef PV_D0
#undef TRRD
}

typedef __attribute__((address_space(3))) const char* lds_cptr;
typedef short v4i16_t __attribute__((ext_vector_type(4)));
__device__ __forceinline__ s16x4 vtr(lds_cptr p) { return __builtin_bit_cast(s16x4, __builtin_amdgcn_ds_read_tr16_b64_v4i16((__attribute__((address_space(3))) v4i16_t*)p)); }
#define VRD(S, vp, d0) do { _Pragma("unroll") for (int ks_ = 0; ks_ < 4; ++ks_) { S[2 * ks_] = vtr((vp) + (d0) * 512 + ks_ * 4096); S[2 * ks_ + 1] = vtr((vp) + (d0) * 512 + ks_ * 4096 + 2048); } } while (0)
#define VFR(S, k) (bf16x8){S[2 * (k)][0], S[2 * (k)][1], S[2 * (k)][2], S[2 * (k)][3], S[2 * (k) + 1][0], S[2 * (k) + 1][1], S[2 * (k) + 1][2], S[2 * (k) + 1][3]}
#define PVMMA(S, d0) do { __builtin_amdgcn_s_setprio(1); o[d0] = __builtin_amdgcn_mfma_f32_32x32x16_bf16(pa0, VFR(S, 0), o[d0], 0, 0, 0); o[d0] = __builtin_amdgcn_mfma_f32_32x32x16_bf16(pa1, VFR(S, 1), o[d0], 0, 0, 0); \
        o[d0] = __builtin_amdgcn_mfma_f32_32x32x16_bf16(pa2, VFR(S, 2), o[d0], 0, 0, 0); o[d0] = __builtin_amdgcn_mfma_f32_32x32x16_bf16(pa3, VFR(S, 3), o[d0], 0, 0, 0); __builtin_amdgcn_s_setprio(0); } while (0)

typedef int v8i_t __attribute__((ext_vector_type(8))); typedef int v4i_t __attribute__((ext_vector_type(4)));
__device__ __forceinline__ unsigned pk4f8(float a, float b, float c, float d) { int w = 0; w = __builtin_amdgcn_cvt_pk_fp8_f32(a, b, w, false); w = __builtin_amdgcn_cvt_pk_fp8_f32(c, d, w, true); return (unsigned)w; }
template <int DQK> __device__ __forceinline__ int k8swz(int row, int chunk) {
    if constexpr (DQK == 192) return row * 256 + ((chunk ^ (row & 15)) << 4);
    else return row * 128 + ((chunk ^ ((row >> 1) & 7)) << 4);
}
template <int DQK>
__device__ __forceinline__ void qkt8(f32x16& p0, f32x16& p1, const char* kbuf, int r32, int hi, const v8i_t* q8, int f8scale) {
    p0 = f32x16{}; p1 = f32x16{};
    constexpr int NS = DQK / 64, H32 = 32 * (DQK == 192 ? 256 : 128);
    v8i_t a0[NS], a1[NS];
#define K8LD(s_) do { const int c0 = 4 * (s_) + 2 * hi;                                                                          \
        const lds_cptr k0_ = (lds_cptr)kbuf + k8swz<DQK>(r32, c0), k1_ = (lds_cptr)kbuf + k8swz<DQK>(r32, c0 + 1);             \
        a0[s_].lo = *(const __attribute__((address_space(3))) v4i_t*)k0_; a0[s_].hi = *(const __attribute__((address_space(3))) v4i_t*)k1_;            \
        a1[s_].lo = *(const __attribute__((address_space(3))) v4i_t*)(k0_ + H32); a1[s_].hi = *(const __attribute__((address_space(3))) v4i_t*)(k1_ + H32); } while (0)
    K8LD(0); K8LD(1);
#pragma unroll
    for (int s_ = 0; s_ < NS; ++s_) {
        __builtin_amdgcn_s_setprio(1);
        asm volatile("v_mfma_scale_f32_32x32x64_f8f6f4 %0, %1, %2, %0, %3, %3 op_sel_hi:[0,0,0]" : "+v"(p0) : "v"(a0[s_]), "v"(q8[s_]), "v"(f8scale));
        asm volatile("v_mfma_scale_f32_32x32x64_f8f6f4 %0, %1, %2, %0, %3, %3 op_sel_hi:[0,0,0]" : "+v"(p1) : "v"(a1[s_]), "v"(q8[s_]), "v"(f8scale));
        __builtin_amdgcn_s_setprio(0);
        if (s_ == 0 && NS == 3) { ASBAR(); K8LD(2); } }
#undef K8LD
    asm volatile("s_nop 15\n\ts_nop 7" : "+v"(p0), "+v"(p1));
}
struct UnitArgs {
    const bf16_t* Q; int qpitch;
    const bf16_t* K; int kpitch;
    const bf16_t* Kr;
    const unsigned char* Q8; const unsigned char* K8; const unsigned char* Kr8; const unsigned char* V8;
    const bf16_t* V; int vpitch;
    bf16_t* O; int opitch;
    bf16_t* PO; float* PML;
    const int* pos; const int* tpmax;
    const unsigned* list; int nrows;
    int q0, k0, NT, h;
    float c2;
};
template <int DQK, int MODE>
__device__ __forceinline__ void attn_unit(const UnitArgs& A, char* lds, int wv) {
    int tid_ = wv * 64 + lane_id_(); asm volatile("" : "+v"(tid_)); const int tid = tid_, wid = wv, lane = tid & 63, r32 = lane & 31, hi = lane >> 5;
    constexpr bool F8 = true;
    constexpr int KT = F8 ? (DQK == 192 ? 16384 : 8192) : 64 * DQK * 2; constexpr int Q8P = DQK == 192 ? 3072 : 2048;
    char* V_lds = lds + L_V; char* K_lds = lds + L_K;
    float* ws = (float*)(lds + L_WS) + wid * 128; float* li_l = ws; float* al_l = ws + 32; int* ix_l = (int*)(ws + 64);
    const float* biasL = (const float*)(lds + L_BIAS) + A.h * 132;
    const int sr = tid >> 4, sc = (tid & 15) * 8, vst0 = v_st(sr, sc), vst1 = v_st(32 + sr, sc);
    const int kws0 = kswz<DQK>(sr, tid & 15), kws1 = kswz<DQK>(32 + sr, tid & 15);
    const int kws2 = (DQK == 192) ? kswz<DQK>(tid >> 3, 16 + (tid & 7)) : 0;
    const int k8w0 = k8swz<DQK>(tid >> 3, tid & 7), k8w2 = DQK == 192 ? k8swz<DQK>(tid >> 2, 8 + (tid & 3)) : 0;
    const int vb0 = (int)(uintptr_t)V_lds + v_rd_base(lane); (void)vb0;
    const int v8w = (tid >> 2) * 64 + (((tid & 3) ^ ((tid >> 4) & 3)) << 4), v8r = r32 * 64 + (((2 * hi) ^ ((r32 >> 2) & 3)) << 4);
    const lds_cptr vp0 = (lds_cptr)V_lds + v_rd_base(lane);
    bf16x8 st_k0, st_k1, st_k2, st_v0, st_v1;
#define SLOAD(t) do { const size_t kk_ = (size_t)(A.k0 + (t) * 64);                                                         \
        if constexpr (F8) st_v0 = ld8((const bf16_t*)(A.V8 + (kk_ >> 6) * 8192 + tid * 16));                             \
        else { st_v0 = ld8(A.V + (kk_ + sr) * A.vpitch + sc); st_v1 = ld8(A.V + (kk_ + 32 + sr) * A.vpitch + sc); }    \
        if constexpr (F8) { st_k0 = ld8((const bf16_t*)(A.K8 + (kk_ + (tid >> 3)) * 2048 + (tid & 7) * 16));             \
            if constexpr (DQK == 192) if (wid < 4) st_k2 = ld8((const bf16_t*)(A.Kr8 + (kk_ + (tid >> 2)) * 64 + (tid & 3) * 16)); }   \
        else { st_k0 = ld8(A.K + (kk_ + sr) * A.kpitch + sc); st_k1 = ld8(A.K + (kk_ + 32 + sr) * A.kpitch + sc);       \
            if constexpr (DQK == 192) st_k2 = ld8(A.Kr + (kk_ + (tid >> 3)) * 64 + (tid & 7) * 8); } } while (0)
#define SWRITE(bf) do { if constexpr (F8) *(bf16x8*)(V_lds + (bf) * VT_BYTES + v8w) = st_v0;                                  \
        else { *(bf16x8*)(V_lds + (bf) * VT_BYTES + vst0) = st_v0; *(bf16x8*)(V_lds + (bf) * VT_BYTES + vst1) = st_v1; } \
        if constexpr (F8) { *(bf16x8*)(K_lds + (bf) * KT + k8w0) = st_k0; if constexpr (DQK == 192) if (wid < 4) *(bf16x8*)(K_lds + (bf) * KT + k8w2) = st_k2; } \
        else { *(bf16x8*)(K_lds + (bf) * KT + kws0) = st_k0; *(bf16x8*)(K_lds + (bf) * KT + kws1) = st_k1;                 \
            if constexpr (DQK == 192) *(bf16x8*)(K_lds + (bf) * KT + kws2) = st_k2; } } while (0)
    SLOAD(0);
    int qrow, jslot = 3; bool valid = true;
    if constexpr (MODE == 1) { const int e = wid * 32 + r32; valid = e < A.nrows; const unsigned ent = A.list[valid ? e : 0]; qrow = (int)(ent & 0xffffu); jslot = (int)(ent >> 16); }
    else qrow = A.q0 + wid * 32 + r32;
    bf16x8 qr[F8 ? 1 : DQK / 16]; v8i_t q8[DQK / 64]; int f8scale = 0x7f7f7f7f;
    if constexpr (F8) { asm volatile("" : "+v"(f8scale));
#pragma unroll
        for (int s_ = 0; s_ < DQK / 64; ++s_) { const v4i_t* qp = (const v4i_t*)(A.Q8 + (size_t)qrow * Q8P + 64 * s_ + 32 * hi); q8[s_].lo = qp[0]; q8[s_].hi = qp[1]; } }
    else {
#pragma unroll
        for (int d0 = 0; d0 < DQK / 16; ++d0) qr[d0] = ld8(A.Q + (size_t)qrow * A.qpitch + d0 * 16 + hi * 8); }
    int posq = 0, qminw = 0;
    if constexpr (MODE != 0) { posq = A.pos[qrow]; int mn = posq;
#pragma unroll
        for (int o_ = 1; o_ < 64; o_ <<= 1) mn = min(mn, __shfl_xor(mn, o_));
        qminw = __builtin_amdgcn_readfirstlane(mn); }
    const int qlo = A.q0 + wid * 32;
    float m_reg = -1e30f, l_reg = 0.f; f32x16 o[4] = {};
    f32x16 o5 = {};
    f32x16 p0, p1; float alpha; bf16x8 pa0, pa1, pa2, pa3;
    const int NT = A.NT;
    SWRITE(0);
    __syncthreads();
    if constexpr (F8) {
#pragma unroll
        for (int s_ = 0; s_ < DQK / 64; ++s_) asm volatile("" : "+v"(q8[s_])); }
    else {
#pragma unroll
        for (int d0 = 0; d0 < DQK / 16; ++d0) asm volatile("" : "+v"(qr[d0])); }
#define KB_(t) (A.k0 + (t) * 64)
#define ACT(t) (MODE == 1 || KB_(t) <= qlo + 31)
#define NEEDMASK(t) (MODE != 1 && KB_(t) + 63 > qlo)
#define STEP(t, B) do {                                                                                                       \
        const bool more_ = (t) + 1 < NT;                                                                                      \
        if (more_) SLOAD((t) + 1);                                                                                            \
        if (ACT(t)) {                                                                                                         \
            ASBAR(); if constexpr (F8) qkt8<DQK>(p0, p1, K_lds + (B) * KT, r32, hi, q8, f8scale); else qkt<DQK>(p0, p1, K_lds + (B) * KT, r32, hi, qr);     \
            if constexpr (MODE != 0) {                                                                                                          \
                const int kmax_ = A.tpmax[KB_(t) >> 6];                                                                       \
                if (qminw - kmax_ >= 128) { const float bc = biasL[128];                                                      \
                    _Pragma("unroll") for (int r = 0; r < 16; ++r) { p0[r] = fmaf(p0[r], A.c2, bc); p1[r] = fmaf(p1[r], A.c2, bc); } }   \
                else {                                                                                                        \
                    _Pragma("unroll") for (int g4 = 0; g4 < 4; ++g4) {                                                        \
                        const i32x4 pk0 = *(const i32x4*)(A.pos + KB_(t) + 8 * g4 + 4 * hi);                                  \
                        const i32x4 pk1 = *(const i32x4*)(A.pos + KB_(t) + 32 + 8 * g4 + 4 * hi);                             \
                        _Pragma("unroll") for (int e = 0; e < 4; ++e) {                                                       \
                            const int d0_ = min(max(posq - pk0[e], 0), 128), d1_ = min(max(posq - pk1[e], 0), 128);           \
                            p0[4 * g4 + e] = fmaf(p0[4 * g4 + e], A.c2, biasL[d0_]); p1[4 * g4 + e] = fmaf(p1[4 * g4 + e], A.c2, biasL[d1_]); } } }   \
            }                                                                                                                 \
            if (NEEDMASK(t)) mask_tile(p0, p1, (qlo + r32 - 4 * hi) - KB_(t));                                                \
            partialSM<MODE == 0>(p0, p1, m_reg, alpha, A.c2);                                                                 \
            if (__any(alpha < 1.f)) { if (hi == 0) al_l[r32] = alpha; asm volatile("s_waitcnt lgkmcnt(0)" ::: "memory");      \
                _Pragma("unroll") for (int d_ = 0; d_ < 4; ++d_) _Pragma("unroll") for (int r = 0; r < 16; ++r) o[d_][r] *= al_l[crow(r, hi)];     \
                if constexpr (F8) { _Pragma("unroll") for (int r = 0; r < 16; ++r) o5[r] *= al_l[crow(r, hi)]; } }                                  \
            if constexpr (F8) { const lds_cptr vp_ = (lds_cptr)V_lds + (B) * VT_BYTES + v8r; v8i_t vf[4], p8;                   \
              _Pragma("unroll") for (int d_ = 0; d_ < 4; ++d_) { vf[d_].lo = *(const __attribute__((address_space(3))) v4i_t*)(vp_ + d_ * 2048);  \
                  vf[d_].hi = *(const __attribute__((address_space(3))) v4i_t*)((lds_cptr)V_lds + (B) * VT_BYTES + (v8r ^ 16) + d_ * 2048); }           \
              finishSM_e(p1);                                                                                                  \
              _Pragma("unroll") for (int j_ = 0; j_ < 4; ++j_) { p8[j_] = (int)pk4f8(p0[4 * j_], p0[4 * j_ + 1], p0[4 * j_ + 2], p0[4 * j_ + 3]);     \
                  p8[4 + j_] = (int)pk4f8(p1[4 * j_], p1[4 * j_ + 1], p1[4 * j_ + 2], p1[4 * j_ + 3]); }                       \
              __builtin_amdgcn_s_setprio(1);                                                                                   \
              _Pragma("unroll") for (int d_ = 0; d_ < 4; ++d_)                                                                 \
                  asm volatile("v_mfma_scale_f32_32x32x64_f8f6f4 %0, %1, %2, %0, %3, %3 op_sel_hi:[0,0,0]" : "+v"(o[d_]) : "v"(p8), "v"(vf[d_]), "v"(f8scale));   \
              { v8i_t ones8 = {0x38383838, 0x38383838, 0x38383838, 0x38383838, 0x38383838, 0x38383838, 0x38383838, 0x38383838}; asm volatile("" : "+v"(ones8));        \
                asm volatile("v_mfma_scale_f32_32x32x64_f8f6f4 %0, %1, %2, %0, %3, %3 op_sel_hi:[0,0,0]" : "+v"(o5) : "v"(p8), "v"(ones8), "v"(f8scale)); }        \
              __builtin_amdgcn_s_setprio(0); }                                                                                 \
            else { const lds_cptr vp_ = vp0 + (B) * VT_BYTES; s16x4 fa[8], fb[8];                                                    \
              finishSM_a(p0, p1, alpha, l_reg); PK4(p0, 0, pa0); PK4(p0, 8, pa1);                                             \
              VRD(fa, vp_, 0); PK4(p1, 0, pa2); PK4(p1, 8, pa3);                                                              \
              VRD(fb, vp_, 1); PVMMA(fa, 0); VRD(fa, vp_, 2); PVMMA(fb, 1); VRD(fb, vp_, 3); PVMMA(fa, 2); PVMMA(fb, 3); }    \
        }                                                                                                                     \
        if (more_) SWRITE((B) ^ 1);                                                                                           \
        __syncthreads(); } while (0)
    for (int t = 0; t < NT; t += 2) { STEP(t, 0); STEP(t + 1, 1); }
    if constexpr (F8) asm volatile("s_nop 15\n\ts_nop 7" : "+v"(o[0]), "+v"(o[1]), "+v"(o[2]), "+v"(o[3]), "+v"(o5));
#undef STEP
#undef ACT
#undef NEEDMASK
#undef KB_
#undef SLOAD
#undef SWRITE
    if (hi == 0) { if constexpr (!F8) li_l[r32] = l_reg; ix_l[r32] = valid ? (qrow * 16 + A.h) * 4 + jslot : -1; }
    asm volatile("s_waitcnt lgkmcnt(0)" ::: "memory");
    if constexpr (MODE != 0) { if (hi == 0 && valid) { float* ml = A.PML + (size_t)((qrow * 16 + A.h) * 4 + jslot) * 2; ml[0] = m_reg; if constexpr (!F8) ml[1] = l_reg; } }
#pragma unroll
    for (int r = 0; r < 16; ++r) { const int orow = crow(r, hi); const float rl = __builtin_amdgcn_rcpf(F8 ? o5[r] : li_l[orow]);
        bf16_t* dst; bool ok = true;
        if constexpr (MODE == 0) dst = A.O + (size_t)(qlo + orow) * A.opitch;
        else { const int ix = ix_l[orow]; ok = ix >= 0; dst = A.PO + (size_t)(ok ? ix : 0) * 128;
            if constexpr (F8) { if (r32 == 0 && ok) A.PML[(size_t)ix * 2 + 1] = o5[r]; } }
#pragma unroll
        for (int d0 = 0; d0 < 4; ++d0) { const float v = o[d0][r] * rl; const float vn = __shfl_xor(v, 1);
            if ((r32 & 1) == 0 && ok) *(unsigned*)(dst + d0 * 32 + r32) = cvtpk(v, vn); } }
    __syncthreads();
}
template <int MODE>
__device__ __forceinline__ void moba_unit(const UnitArgs& A, char* lds, int wv, int nchunk) {
    int tid_ = wv * 64 + lane_id_(); asm volatile("" : "+v"(tid_)); const int tid = tid_, wid = wv, lane = tid & 63, r32 = lane & 31, hi = lane >> 5;
    char* V_lds = lds + L_V; char* K_lds = lds + L_K;
    float* ws = (float*)(lds + L_WS) + wid * 128; float* al_l = ws + 32; int* ix_l = (int*)(ws + 64);
    const float* biasL = (const float*)(lds + L_BIAS) + A.h * 132;
    int qrow, jslot = 3, posq; bool valid = true; v8i_t q8[2]; unsigned ent = 0;
    if constexpr (MODE == 1) { const int e = wid * 32 + r32; valid = e < A.nrows; ent = A.list[valid ? e : 0]; }
    else qrow = A.q0 + wid * 32 + r32;
#define QLOAD(QF_, POSQ_, QROW_) do { _Pragma("unroll") for (int s_ = 0; s_ < 2; ++s_) { const v4i_t* qp = (const v4i_t*)(A.Q8 + (size_t)(QROW_) * 2048 + 64 * s_ + 32 * hi); QF_[s_].lo = qp[0]; QF_[s_].hi = qp[1]; } \
        POSQ_ = A.pos[QROW_]; } while (0)
    if constexpr (MODE != 1) QLOAD(q8, posq, qrow);
    { const int k8w0 = k8swz<128>(tid >> 3, tid & 7), v8w = (tid >> 2) * 64 + (((tid & 3) ^ ((tid >> 4) & 3)) << 4);
      bf16x8 sk[4], sv[4];
#pragma unroll
      for (int i = 0; i < 4; ++i) { const size_t kk_ = (size_t)(A.k0 + i * 64);
          sv[i] = ld8((const bf16_t*)(A.V8 + (kk_ >> 6) * 8192 + tid * 16)); sk[i] = ld8((const bf16_t*)(A.K8 + (kk_ + (tid >> 3)) * 2048 + (tid & 7) * 16)); }
      if constexpr (MODE == 1) { qrow = (int)(ent & 0xffffu); jslot = (int)(ent >> 16); QLOAD(q8, posq, qrow); }
#pragma unroll
      for (int i = 0; i < 4; ++i) { *(bf16x8*)(V_lds + i * 8192 + v8w) = sv[i]; *(bf16x8*)(K_lds + i * 8192 + k8w0) = sk[i]; } }
    __syncthreads();
    const int v8r = r32 * 64 + (((2 * hi) ^ ((r32 >> 2) & 3)) << 4);
    int f8scale = 0x7f7f7f7f; asm volatile("" : "+v"(f8scale));
    const int qlo = A.q0 + wid * 32;
#pragma unroll 1
    for (int c = 0; c < nchunk; ++c) {
        if (MODE == 1 && c * 256 + wid * 32 >= A.nrows) break;
        const bool has_next = MODE == 1 && (c + 1 < nchunk) && ((c + 1) * 256 + wid * 32 < A.nrows);
        unsigned entn = 0; bool validn = false; v8i_t q8n[2]; int posqn = 0, qrown = 0;
        if (has_next) { const int en = (c + 1) * 256 + wid * 32 + r32; validn = en < A.nrows; entn = A.list[validn ? en : 0]; }
        int qminw; { int mn = posq;
#pragma unroll
            for (int o_ = 1; o_ < 64; o_ <<= 1) mn = min(mn, __shfl_xor(mn, o_));
            qminw = __builtin_amdgcn_readfirstlane(mn); }
        float m_reg = -1e30f, alpha; f32x16 o[4] = {}, o5 = {}, p0, p1;
#pragma unroll
        for (int s_ = 0; s_ < 2; ++s_) asm volatile("" : "+v"(q8[s_]));
#define MTILE(t) do { const int kb_ = A.k0 + (t) * 64;                                                                          \
            if (MODE == 1 || kb_ <= qlo + 31) {                                                                               \
                ASBAR(); qkt8<128>(p0, p1, K_lds + (t) * 8192, r32, hi, q8, f8scale);                                         \
                const int kmax_ = A.tpmax[kb_ >> 6];                                                                          \
                if (qminw - kmax_ >= 128) { const float bc = biasL[128];                                                      \
                    _Pragma("unroll") for (int r = 0; r < 16; ++r) { p0[r] = fmaf(p0[r], A.c2, bc); p1[r] = fmaf(p1[r], A.c2, bc); } }   \
                else {                                                                                                        \
                    _Pragma("unroll") for (int g4 = 0; g4 < 4; ++g4) {                                                        \
                        const i32x4 pk0 = *(const i32x4*)(A.pos + kb_ + 8 * g4 + 4 * hi);                                     \
                        const i32x4 pk1 = *(const i32x4*)(A.pos + kb_ + 32 + 8 * g4 + 4 * hi);                                \
                        _Pragma("unroll") for (int e = 0; e < 4; ++e) {                                                       \
                            const int d0_ = min(max(posq - pk0[e], 0), 128), d1_ = min(max(posq - pk1[e], 0), 128);           \
                            p0[4 * g4 + e] = fmaf(p0[4 * g4 + e], A.c2, biasL[d0_]); p1[4 * g4 + e] = fmaf(p1[4 * g4 + e], A.c2, biasL[d1_]); } } }   \
                if (MODE != 1 && kb_ + 63 > qlo) mask_tile(p0, p1, (qlo + r32 - 4 * hi) - kb_);                               \
                partialSM<false>(p0, p1, m_reg, alpha, A.c2);                                                                 \
                if (__any(alpha < 1.f)) { if (hi == 0) al_l[r32] = alpha; asm volatile("s_waitcnt lgkmcnt(0)" ::: "memory");  \
                    _Pragma("unroll") for (int d_ = 0; d_ < 4; ++d_) _Pragma("unroll") for (int r = 0; r < 16; ++r) o[d_][r] *= al_l[crow(r, hi)];   \
                    _Pragma("unroll") for (int r = 0; r < 16; ++r) o5[r] *= al_l[crow(r, hi)]; }                              \
                { const lds_cptr vp_ = (lds_cptr)V_lds + (t) * 8192 + v8r; const lds_cptr vq_ = (lds_cptr)V_lds + (t) * 8192 + (v8r ^ 16); v8i_t vf[4], p8;   \
                  _Pragma("unroll") for (int d_ = 0; d_ < 4; ++d_) { vf[d_].lo = *(const __attribute__((address_space(3))) v4i_t*)(vp_ + d_ * 2048); vf[d_].hi = *(const __attribute__((address_space(3))) v4i_t*)(vq_ + d_ * 2048); }   \
                  finishSM_e(p1);                                                                                             \
                  _Pragma("unroll") for (int j_ = 0; j_ < 4; ++j_) { p8[j_] = (int)pk4f8(p0[4 * j_], p0[4 * j_ + 1], p0[4 * j_ + 2], p0[4 * j_ + 3]); p8[4 + j_] = (int)pk4f8(p1[4 * j_], p1[4 * j_ + 1], p1[4 * j_ + 2], p1[4 * j_ + 3]); }   \
                  __builtin_amdgcn_s_setprio(1);                                                                              \
                  _Pragma("unroll") for (int d_ = 0; d_ < 4; ++d_)                                                            \
                      asm volatile("v_mfma_scale_f32_32x32x64_f8f6f4 %0, %1, %2, %0, %3, %3 op_sel_hi:[0,0,0]" : "+v"(o[d_]) : "v"(p8), "v"(vf[d_]), "v"(f8scale));   \
                  { v8i_t ones8 = {0x38383838, 0x38383838, 0x38383838, 0x38383838, 0x38383838, 0x38383838, 0x38383838, 0x38383838}; asm volatile("" : "+v"(ones8));   \
                    asm volatile("v_mfma_scale_f32_32x32x64_f8f6f4 %0, %1, %2, %0, %3, %3 op_sel_hi:[0,0,0]" : "+v"(o5) : "v"(p8), "v"(ones8), "v"(f8scale)); }   \
                  __builtin_amdgcn_s_setprio(0); }                                                                            \
            } } while (0)
        MTILE(0); MTILE(1);
        if (has_next) { qrown = (int)(entn & 0xffffu); QLOAD(q8n, posqn, qrown); }
        MTILE(2); MTILE(3);
#undef MTILE
        asm volatile("s_nop 15\n\ts_nop 7" : "+v"(o[0]), "+v"(o[1]), "+v"(o[2]), "+v"(o[3]), "+v"(o5));
        if (hi == 0) ix_l[r32] = valid ? (qrow * 16 + A.h) * 4 + jslot : -1;
        asm volatile("s_waitcnt lgkmcnt(0)" ::: "memory");
        if (hi == 0 && valid) A.PML[(size_t)((qrow * 16 + A.h) * 4 + jslot) * 2] = m_reg;
#pragma unroll
        for (int r = 0; r < 16; ++r) { const int orow = crow(r, hi); const float rl = __builtin_amdgcn_rcpf(o5[r]);
            const int ix = ix_l[orow]; const bool ok = ix >= 0; bf16_t* dst = A.PO + (size_t)(ok ? ix : 0) * 128;
            if (r32 == 0 && ok) A.PML[(size_t)ix * 2 + 1] = o5[r];
#pragma unroll
            for (int d0 = 0; d0 < 4; ++d0) { const float v = o[d0][r] * rl; const float vn = __shfl_xor(v, 1);
                if ((r32 & 1) == 0 && ok) *(unsigned*)(dst + d0 * 32 + r32) = cvtpk(v, vn); } }
        asm volatile("s_waitcnt lgkmcnt(0)" ::: "memory");
        if (!has_next) break;
        qrow = qrown; jslot = (int)(entn >> 16); valid = validn; posq = posqn; q8[0] = q8n[0]; q8[1] = q8n[1];
    }
#undef QLOAD
    __syncthreads();
}
}
constexpr int NWAVES = 8;
constexpr int M_ = 16384, DM = 4096, DFF = 11008, NFF2 = 2 * DFF;
constexpr int NH = 16, QLORA = 1024, KVLORA = 512, ROPE = 64, NOPE = 128, VDIM = 128, QUP = NH * 192, KVUP = NH * 256, MLAOUT = NH * 128, MOBAW = NH * 128;
constexpr int INCOLS = 15936, INPAD1 = 5888, IN2 = 10240;
constexpr int MBLK = 256, NBLK = M_ / MBLK;
constexpr float RMS_EPS = 1e-6f;
constexpr size_t MiB = 1u << 20;
constexpr size_t WS_CTL = 0, CTL_ZERO_BYTES = 1 * MiB;
constexpr size_t WS_WFFN_IN = 1 * MiB;
constexpr size_t WS_WFFN_OUT = WS_WFFN_IN + (size_t)NFF2 * DM * 2;
constexpr size_t WS_WFFN_END = WS_WFFN_OUT + (size_t)DM * DFF * 2;
constexpr size_t WS_PO = WS_WFFN_IN;
constexpr size_t WS_WIN = WS_WFFN_END;
constexpr size_t WS_WIN8 = WS_WIN + (size_t)INPAD1 * DM * 2;
constexpr size_t WS_WUQ = WS_WIN8 + (size_t)IN2 * DM;
constexpr size_t WS_WUKV = WS_WUQ + (size_t)QUP * QLORA * 2;
constexpr size_t WS_WBRA = WS_WUKV + (size_t)KVUP * KVLORA * 2;
constexpr size_t WS_WBRB = WS_WBRA + (size_t)DM * MLAOUT * 2;
constexpr size_t WS_WOUT = WS_WBRB + (size_t)DM * MOBAW * 2;
constexpr size_t WS_H = WS_WOUT + (size_t)DM * DM * 2;
constexpr size_t WS_LIST = WS_H;
constexpr size_t LIST_PER_HEAD = 516096;
constexpr size_t WS_PML = WS_LIST + LIST_PER_HEAD * NH * 4;
constexpr size_t WS_BIG = WS_H + (size_t)M_ * DM * 2;
constexpr size_t WS_CQ = WS_BIG;
constexpr size_t WS_CKV = WS_CQ + (size_t)M_ * QLORA * 2;
constexpr size_t WS_KR = WS_CKV + (size_t)M_ * KVLORA * 2;
constexpr size_t WS_QB = WS_KR + (size_t)M_ * ROPE * 2;
constexpr size_t WS_KB = WS_QB + (size_t)M_ * MOBAW * 2;
constexpr size_t WS_VB = WS_KB + (size_t)M_ * MOBAW * 2;
constexpr size_t WS_GA = WS_VB + (size_t)M_ * MOBAW * 2;
constexpr size_t WS_GB = WS_GA + (size_t)M_ * DM * 2;
constexpr size_t WS_BIG_END = WS_GB + (size_t)M_ * DM * 2;
constexpr size_t WS_QM8 = WS_BIG_END;
constexpr size_t WS_KN8 = WS_QM8 + (size_t)M_ * QUP;
constexpr size_t WS_KR8 = WS_KN8 + (size_t)M_ * 2048;
constexpr size_t WS_V8 = WS_KR8 + (size_t)M_ * 64;
constexpr size_t WS_QB8 = WS_V8 + (size_t)M_ * 2048;
constexpr size_t WS_KB8 = WS_QB8 + (size_t)M_ * 2048;
constexpr size_t WS_VB8 = WS_KB8 + (size_t)M_ * 2048;
constexpr size_t WS_OA = WS_VB8 + (size_t)M_ * 2048;
constexpr size_t WS_COS = WS_OA + (size_t)M_ * MLAOUT * 2;
constexpr size_t WS_SIN = WS_COS + (size_t)M_ * 32 * 4;
constexpr size_t WS_KMH = WS_SIN + (size_t)M_ * 32 * 4;
constexpr size_t WS_KML = WS_KMH + (size_t)NH * NBLK * 128 * 2;
constexpr size_t WS_BIAS = WS_KML + (size_t)NH * NBLK * 128 * 2;
constexpr size_t WS_TPMAX = WS_BIAS + 16 * 132 * 4;
constexpr size_t WS_PART = WS_TPMAX + 256 * 4;
constexpr size_t WS_RSTD = WS_PART + (size_t)M_ * 64 * 4;
constexpr size_t WS_PARTQ = WS_RSTD + (size_t)M_ * 4;
constexpr size_t WS_PARTKV = WS_PARTQ + (size_t)M_ * 16 * 4;
constexpr size_t WS_RSTDQ = WS_PARTKV + (size_t)M_ * 8 * 4;
constexpr size_t WS_RSTDKV = WS_RSTDQ + (size_t)M_ * 4;
constexpr size_t WS_H8 = WS_RSTDKV + (size_t)M_ * 4;
constexpr size_t WS_OA8 = WS_H8 + (size_t)M_ * DM;
constexpr size_t WS_OB8 = WS_OA8 + (size_t)M_ * MLAOUT;
constexpr size_t WS_MG8 = WS_OB8 + (size_t)M_ * MOBAW;
constexpr size_t WS_PMAX = WS_MG8 + (size_t)M_ * DM;
constexpr size_t WS_CPART = WS_PMAX + (size_t)M_ * 64 * 4;
constexpr size_t WS_CMAXF = WS_CPART + (size_t)8 * 2 * NFF2 * 4;
constexpr size_t WS_QM = ((WS_CMAXF + (size_t)2 * NFF2 * 4 + 4095) / 4096) * 4096;
constexpr size_t WS_KV = WS_QM + (size_t)M_ * QUP * 2;
constexpr size_t WS_WFI2 = MLA_BF16 ? WS_KV + (size_t)M_ * KVUP * 2 : WS_QM;
constexpr size_t WS_END = WS_WFI2 + (size_t)NFF2 * DM;
static_assert(WS_PML + (size_t)M_ * NH * 4 * 2 * 4 <= WS_BIG, "lists + ml inside H");
static_assert((size_t)M_ * NH * 4 * 128 * 2 <= WS_WFFN_END - WS_WFFN_IN, "partial O inside FFN weight region");
static_assert((size_t)M_ * DFF * 2 <= WS_BIG_END - WS_BIG, "act inside BIG");
constexpr int CW_TMO = 0;
constexpr int CW_BAR = 4096;
constexpr int CW_GCNT = 16384;
constexpr int CW_CMAX = 196608;
constexpr int CW_KMEAN = 65536;
constexpr int RING_OFF = 0, RING_BYTES = 131072;
constexpr int LDSCTL_OFF = RING_BYTES, MISC_OFF = LDSCTL_OFF + 320;
constexpr int LDS_BYTES = 147456;
static_assert(att::L_END <= RING_BYTES, "attention LDS inside ring region");

#define GAS __attribute__((address_space(1)))
#define LAS __attribute__((address_space(3)))
typedef unsigned short bf16;
typedef unsigned v4u __attribute__((ext_vector_type(4)));
typedef unsigned v2u __attribute__((ext_vector_type(2)));
typedef float f32x4 __attribute__((ext_vector_type(4)));
typedef short bf16x8 __attribute__((ext_vector_type(8)));
typedef float f32x16 __attribute__((ext_vector_type(16)));
typedef GAS unsigned gu32;
#define RLX_AGENT __ATOMIC_RELAXED, __HIP_MEMORY_SCOPE_AGENT
#define LDS_WAIT() asm volatile("s_waitcnt lgkmcnt(0)" ::: "memory")
__device__ __forceinline__ unsigned f2bf(float f) { unsigned u = __builtin_bit_cast(unsigned, f); return (u + 0x7fffu + ((u >> 16) & 1u)) >> 16; }
__device__ __forceinline__ unsigned pk2(float lo, float hi) { return f2bf(lo) | (f2bf(hi) << 16); }
__device__ __forceinline__ float bfu_lo(unsigned w) { return __uint_as_float(w << 16); }
__device__ __forceinline__ float bfu_hi(unsigned w) { return __uint_as_float(w & 0xffff0000u); }

#define XB_TMO      128
#define XB_XCNT(j)  (256  + 64 * (j))
#define XB_XSUB(j)  (1280 + 64 * (j))
#define XB_XGEN(j)  (2304 + 64 * (j))
#define XB_TOP      3328
#define XB_TOPGEN   3392
#define XCD_BAR_WORDS 3456
#define XB_SPIN_CAP (1u << 22)
__device__ __forceinline__ unsigned xb_ld(unsigned* p)              { return __hip_atomic_load(p, __ATOMIC_RELAXED, __HIP_MEMORY_SCOPE_AGENT); }
__device__ __forceinline__ unsigned xb_add(unsigned* p, unsigned v) { return __hip_atomic_fetch_add(p, v, __ATOMIC_RELAXED, __HIP_MEMORY_SCOPE_AGENT); }
__device__ __forceinline__ unsigned xb_xcc_id() { return (unsigned)__builtin_amdgcn_s_getreg((3 << 11) | 20) & 0xFu; }
#define XB_SPIN(cond, bar) do { unsigned _sp = 0; while (cond) { __builtin_amdgcn_s_sleep(1); \
    if ((++_sp & 255u) == 0u) { if (xb_ld(&(bar)[XB_TMO])) break; if (_sp > XB_SPIN_CAP) { atomicAdd(&(bar)[XB_TMO], 1u); break; } } } } while (0)
struct XcdBarrier { unsigned* bar; unsigned x; volatile LAS unsigned* st; };
__device__ __forceinline__ XcdBarrier xcd_barrier_post(unsigned* bar, volatile LAS unsigned* st, int wv) {
    XcdBarrier b; b.bar = bar; b.x = xb_xcc_id(); b.st = st;
    if (wv == 0 && lane_id_() == 0) (void)xb_add(&bar[XB_XCNT(b.x)], 1u);
    return b;
}
__device__ __forceinline__ void xcd_barrier_complete(unsigned* bar, unsigned x, unsigned& nloc, unsigned& nx) {
    const unsigned G = gridDim.x * gridDim.y * gridDim.z;
    unsigned sum, cnt, mine, sp = 0u;
    for (;;) {
        sum = 0u; cnt = 0u; mine = 0u;
#pragma unroll
        for (unsigned j = 0; j < 16; ++j) { const unsigned c = xb_ld(&bar[XB_XCNT(j)]); sum += c; cnt += (c > 0u) ? 1u : 0u; mine = (j == x) ? c : mine; }
        if (sum == G) break;
        __builtin_amdgcn_s_sleep(1);
        if ((++sp & 255u) == 0u) { if (xb_ld(&bar[XB_TMO])) break; if (sp > XB_SPIN_CAP) { atomicAdd(&bar[XB_TMO], 1u); break; } }
    }
    nloc = mine > 0u ? mine : 1u; nx = cnt > 0u ? cnt : 1u;
}
__device__ __forceinline__ void xcd_barrier(const XcdBarrier& b, int wv) {
    asm volatile("s_waitcnt vmcnt(0)" ::: "memory");
    __syncthreads();
    if (wv == 0 && lane_id_() == 0) {
        unsigned* bar = b.bar;
        __builtin_amdgcn_s_waitcnt(0);
        unsigned nloc = b.st[0], nx = b.st[1];
        if (nloc == 0u) { xcd_barrier_complete(bar, b.x, nloc, nx); b.st[0] = nloc; b.st[1] = nx; }
        const unsigned old = xb_add(&bar[XB_XSUB(b.x)], 1u);
        const unsigned gen = old / nloc;
        if (old + 1u == (gen + 1u) * nloc) {
            __builtin_amdgcn_fence(__ATOMIC_RELEASE, "agent");
            asm volatile("s_waitcnt vmcnt(0)" ::: "memory");
            const unsigned og = xb_add(&bar[XB_TOP], 1u);
            const unsigned tg = og / nx;
            if (og + 1u == (tg + 1u) * nx) xb_add(&bar[XB_TOPGEN], 1u);
            else XB_SPIN(xb_ld(&bar[XB_TOPGEN]) == tg, bar);
            __builtin_amdgcn_fence(__ATOMIC_ACQUIRE, "agent");
            xb_add(&bar[XB_XGEN(b.x)], 1u);
            asm volatile("s_waitcnt vmcnt(0)" ::: "memory");
        } else {
            XB_SPIN(xb_ld(&bar[XB_XGEN(b.x)]) == gen, bar);
            __builtin_amdgcn_fence(__ATOMIC_ACQUIRE, "agent");
            asm volatile("s_waitcnt vmcnt(0)" ::: "memory");
        }
    }
    __syncthreads();
}
struct Args {
    const float* in[19]; float* out; unsigned char* ws;
    double invf[32];
    unsigned char bucket[136];
};
__device__ __forceinline__ float wave_sum(float v) {
#pragma unroll
    for (int o = 1; o < 64; o <<= 1) v += __shfl_xor(v, o);
    return v;
}
__device__ __forceinline__ void cvt_item(const float* W, int Nsrc, int scol0, bool ropep, bf16* Wt, int K, int drow0, int k0, LAS unsigned char* T, int lane, const float* gain, int tiledN = 0, int f8s = -1, const float* cmax = nullptr, int cstride = 0, float* cmfinal = nullptr) {
    const int rp = lane >> 4, c4 = lane & 15;
    if (scol0 >= 0) {
#pragma unroll
        for (int i = 0; i < 8; ++i) { const int k = 8 * i + 2 * rp;
            f32x4 a = __builtin_nontemporal_load((const GAS f32x4*)(W + (size_t)(k0 + k) * Nsrc + scol0 + 4 * c4));
            f32x4 b = __builtin_nontemporal_load((const GAS f32x4*)(W + (size_t)(k0 + k + 1) * Nsrc + scol0 + 4 * c4));
            if (gain) { a = a * gain[k0 + k]; b = b * gain[k0 + k + 1]; }
#pragma unroll
            for (int e = 0; e < 4; ++e) { const int c = 4 * c4 + e; *(LAS unsigned*)(T + c * 136 + k * 2) = pk2(a[e], b[e]); } }
    }
    LDS_WAIT(); asm volatile("" ::: "memory");
    const int kc = lane & 7, nr = lane >> 3;
#pragma unroll
    for (int j = 0; j < 8; ++j) { const int c = 8 * j + nr;
        v4u o = {0u, 0u, 0u, 0u};
        if (scol0 >= 0) { const v2u lo = *(const LAS v2u*)(T + c * 136 + kc * 16), hi2 = *(const LAS v2u*)(T + c * 136 + kc * 16 + 8); o.x = lo.x; o.y = lo.y; o.z = hi2.x; o.w = hi2.y; }
        int p = c; if (ropep) { const int half = c >> 5, i5 = c & 31; p = 8 * (i5 >> 2) + (i5 & 3) + 4 * half; }
        if (cmax) {
            float cm = 0.f;
#pragma unroll
            for (int sg_ = 0; sg_ < 8; ++sg_) cm = fmaxf(cm, cmax[(size_t)sg_ * cstride + scol0 + c]);
            if (k0 == 0 && kc == 0) cmfinal[scol0 + c] = cm;
            const float inv = 127.f / fmaxf(cm, 1e-30f); const float v8[8] = {bfu_lo(o.x), bfu_hi(o.x), bfu_lo(o.y), bfu_hi(o.y), bfu_lo(o.z), bfu_hi(o.z), bfu_lo(o.w), bfu_hi(o.w)};
            unsigned q0 = 0, q1 = 0;
#pragma unroll
            for (int e = 0; e < 4; ++e) { q0 |= ((unsigned)(int)rintf(v8[e] * inv) & 0xffu) << (8 * e); q1 |= ((unsigned)(int)rintf(v8[4 + e] * inv) & 0xffu) << (8 * e); }
            v2u q; q.x = q0; q.y = q1;
            *(GAS v2u*)((unsigned char*)Wt + ((size_t)(k0 >> 7) * tiledN + drow0 + p) * 128 + (k0 & 64) + 8 * kc) = q; }
        else if (f8s >= 0) {
            const float scl = __uint_as_float((unsigned)(127 + f8s) << 23); v2u q;
            int w0 = 0, w1 = 0;
            w0 = __builtin_amdgcn_cvt_pk_fp8_f32(bfu_lo(o.x) * scl, bfu_hi(o.x) * scl, w0, false); w0 = __builtin_amdgcn_cvt_pk_fp8_f32(bfu_lo(o.y) * scl, bfu_hi(o.y) * scl, w0, true);
            w1 = __builtin_amdgcn_cvt_pk_fp8_f32(bfu_lo(o.z) * scl, bfu_hi(o.z) * scl, w1, false); w1 = __builtin_amdgcn_cvt_pk_fp8_f32(bfu_lo(o.w) * scl, bfu_hi(o.w) * scl, w1, true);
            q.x = (unsigned)w0; q.y = (unsigned)w1;
            *(GAS v2u*)((unsigned char*)Wt + ((size_t)(k0 >> 7) * tiledN + drow0 + p) * 128 + (k0 & 64) + 8 * kc) = q; }
        else if (tiledN) *(GAS v4u*)(Wt + ((size_t)(k0 >> 6) * tiledN + drow0 + p) * 64 + 8 * kc) = o;
        else *(GAS v4u*)(Wt + (size_t)(drow0 + p) * K + k0 + 8 * kc) = o; }
    LDS_WAIT(); asm volatile("" ::: "memory");
}
template <int KIND>
__device__ __forceinline__ void cvt_job(const float* W, int K, int Nsrc, bf16* Wt, int ndb, LAS unsigned char* T, int gw, int NGW, int lane, const float* gain = nullptr, int tiledN = 0, int f8s = -1, const float* cmax = nullptr, int cstride = 0, float* cmfinal = nullptr, int jph = 0, int jnp = 1) {
    const int nkb = K / 64, nit = ndb * nkb;
    for (int it = gw + NGW * jph; it < nit; it += NGW * jnp) { const int db = it / nkb, kb = it - db * nkb;
        int scol = 64 * db; bool rp = false;
        if constexpr (KIND == 1) { const int pn = db >> 2, sub = db & 3; scol = (sub < 2) ? (128 * pn + 64 * sub) : (DFF + 128 * pn + 64 * (sub - 2)); }
        if constexpr (KIND == 2) { if (db < 24) scol = 64 * db; else if (db < 88) scol = 64 * db + 64; else if (db == 88) { scol = 1536; rp = true; } else scol = -1; }
        if constexpr (KIND == 4) { scol = 5696 + 64 * db; }
        if constexpr (KIND == 3) { rp = (db % 3) == 2; }
        cvt_item(W, Nsrc, scol, rp, Wt, K, 64 * db, 64 * kb, T, lane, gain, tiledN, f8s, cmax, cstride, cmfinal); }
}
template <bool OUTF32>
__device__ __forceinline__ void rms_row4096(const float* xrow, const float* g, void* orow, int lane, int tiledM = 0) {
    const GAS f32x4* xr = (const GAS f32x4*)xrow + lane;
    f32x4 v[16]; float s = 0.f;
#pragma unroll
    for (int j = 0; j < 16; ++j) { v[j] = xr[64 * j]; s += (v[j].x * v[j].x + v[j].y * v[j].y) + (v[j].z * v[j].z + v[j].w * v[j].w); }
    const float rstd = 1.0f / sqrtf(wave_sum(s) * (1.f / DM) + RMS_EPS);
    const GAS f32x4* gr = (const GAS f32x4*)g + lane;
#pragma unroll
    for (int j = 0; j < 16; ++j) { const f32x4 gg = gr[64 * j]; const f32x4 y = (v[j] * rstd) * gg;
        if constexpr (OUTF32) ((GAS f32x4*)orow)[64 * j + lane] = y;
        else { v2u w; w.x = pk2(y.x, y.y); w.y = pk2(y.z, y.w);
            if (tiledM) { const int col = 4 * (64 * j + lane); *(GAS v2u*)((bf16*)orow + ((size_t)(col >> 6) * tiledM) * 64 + (col & 63)) = w; }
            else ((GAS v2u*)orow)[64 * j + lane] = w; } }
}
template <int N>
__device__ __forceinline__ void rms_row_bf16(bf16* row, const float* g, int lane) {
    constexpr int NV = N / 512;
    v4u w[NV]; float s = 0.f;
#pragma unroll
    for (int j = 0; j < NV; ++j) { w[j] = *(const GAS v4u*)(row + (64 * j + lane) * 8);
#pragma unroll
        for (int e = 0; e < 4; ++e) { const float a = bfu_lo(w[j][e]), b = bfu_hi(w[j][e]); s += a * a + b * b; } }
    const float rstd = 1.0f / sqrtf(wave_sum(s) * (1.f / N) + RMS_EPS);
#pragma unroll
    for (int j = 0; j < NV; ++j) { const GAS f32x4* gp = (const GAS f32x4*)(g + (64 * j + lane) * 8); const f32x4 g0 = gp[0], g1 = gp[1]; v4u o;
        o.x = pk2(bfu_lo(w[j].x) * rstd * g0.x, bfu_hi(w[j].x) * rstd * g0.y); o.y = pk2(bfu_lo(w[j].y) * rstd * g0.z, bfu_hi(w[j].y) * rstd * g0.w);
        o.z = pk2(bfu_lo(w[j].z) * rstd * g1.x, bfu_hi(w[j].z) * rstd * g1.y); o.w = pk2(bfu_lo(w[j].w) * rstd * g1.z, bfu_hi(w[j].w) * rstd * g1.w);
        *(GAS v4u*)(row + (64 * j + lane) * 8) = o; }
}
__device__ __forceinline__ void colmax_job(const float* W, int K, int N, float* cpart, int cstride, int gw, int NGW, int lane) {
    const int nseg = K / 512, ntask = (N / 64) * nseg, rp = lane >> 4, c4 = lane & 15;
    for (int it = gw; it < ntask; it += NGW) { const int cb = it / nseg, sg = it - cb * nseg; f32x4 m = {0.f, 0.f, 0.f, 0.f};
        const float* wp = W + (size_t)(sg * 512 + rp) * N + cb * 64 + 4 * c4;
#pragma unroll 8
        for (int i = 0; i < 128; ++i) { const f32x4 v = __builtin_nontemporal_load((const GAS f32x4*)(wp + (size_t)(4 * i) * N));
            m[0] = fmaxf(m[0], fabsf(v[0])); m[1] = fmaxf(m[1], fabsf(v[1])); m[2] = fmaxf(m[2], fabsf(v[2])); m[3] = fmaxf(m[3], fabsf(v[3])); }
#pragma unroll
        for (int e = 0; e < 4; ++e) { float x = m[e]; x = fmaxf(x, __shfl_xor(x, 16)); x = fmaxf(x, __shfl_xor(x, 32)); if (rp == 0) cpart[(size_t)sg * cstride + cb * 64 + 4 * c4 + e] = x; } }
}
__device__ __forceinline__ void rms_row4096_i8(const float* xrow, const float* g, unsigned char* a8, int row, float* rs, int lane) {
    const GAS f32x4* xr = (const GAS f32x4*)xrow + lane;
    f32x4 v[16]; float s = 0.f;
#pragma unroll
    for (int j = 0; j < 16; ++j) { v[j] = xr[64 * j]; s += (v[j].x * v[j].x + v[j].y * v[j].y) + (v[j].z * v[j].z + v[j].w * v[j].w); }
    const float rstd = 1.0f / sqrtf(wave_sum(s) * (1.f / DM) + RMS_EPS);
    const GAS f32x4* gr = (const GAS f32x4*)g + lane; float mx = 0.f;
#pragma unroll
    for (int j = 0; j < 16; ++j) { const f32x4 gg = gr[64 * j]; v[j] = (v[j] * rstd) * gg; mx = fmaxf(fmaxf(mx, fmaxf(fabsf(v[j].x), fabsf(v[j].y))), fmaxf(fabsf(v[j].z), fabsf(v[j].w))); }
#pragma unroll
    for (int o = 1; o < 64; o <<= 1) mx = fmaxf(mx, __shfl_xor(mx, o));
    mx = fmaxf(mx, 1e-30f); const float inv = 127.f / mx;
#pragma unroll
    for (int j = 0; j < 16; ++j) { const int col = 4 * (64 * j + lane);
        const unsigned q = ((unsigned)(int)rintf(v[j].x * inv) & 0xffu) | (((unsigned)(int)rintf(v[j].y * inv) & 0xffu) << 8) | (((unsigned)(int)rintf(v[j].z * inv) & 0xffu) << 16) | (((unsigned)(int)rintf(v[j].w * inv) & 0xffu) << 24);
        *(GAS unsigned*)(a8 + ((size_t)(col >> 7) * M_ + row) * 128 + (col & 127)) = q; }
    if (lane == 0) rs[row] = mx * (1.f / 127.f);
}
__device__ __forceinline__ void quant_row_i8(const bf16* hb, const float* part, const float* pmax, unsigned char* a8, int row, float* rs, int lane) {
    float s = part[(size_t)row * 64 + lane], mx = pmax[(size_t)row * 64 + lane];
    s = wave_sum(s);
#pragma unroll
    for (int o = 1; o < 64; o <<= 1) mx = fmaxf(mx, __shfl_xor(mx, o));
    mx = fmaxf(mx, 1e-30f); const float inv = 127.f / mx;
    const GAS v4u* src = (const GAS v4u*)(hb + ((size_t)lane * M_ + row) * 64);
    v4u w[8];
#pragma unroll
    for (int j = 0; j < 8; ++j) w[j] = src[j];
    v4u o[4];
#pragma unroll
    for (int j = 0; j < 8; ++j) { unsigned q0 = 0, q1 = 0;
#pragma unroll
        for (int e = 0; e < 2; ++e) { const unsigned a = w[j][e], b = w[j][2 + e];
            q0 |= (((unsigned)(int)rintf(bfu_lo(a) * inv) & 0xffu) | (((unsigned)(int)rintf(bfu_hi(a) * inv) & 0xffu) << 8)) << (16 * e);
            q1 |= (((unsigned)(int)rintf(bfu_lo(b) * inv) & 0xffu) | (((unsigned)(int)rintf(bfu_hi(b) * inv) & 0xffu) << 8)) << (16 * e); }
        o[j >> 1][2 * (j & 1)] = q0; o[j >> 1][2 * (j & 1) + 1] = q1; }
    GAS v4u* dst = (GAS v4u*)(a8 + ((size_t)(lane >> 1) * M_ + row) * 128 + (lane & 1) * 64);
#pragma unroll
    for (int j = 0; j < 4; ++j) dst[j] = o[j];
    if (lane == 0) rs[row] = mx * (1.f / 127.f) / sqrtf(s * (1.f / DM) + RMS_EPS);
}
template <int NP>
__device__ __forceinline__ void rstd_reduce(const float* part, float* rstd, float inv_n, int vcu, int tid, int G) {
    for (int row = vcu * (NWAVES * 64) + tid; row < M_; row += G * NWAVES * 64) { float s = 0.f;
#pragma unroll
        for (int j = 0; j < NP / 4; ++j) { const f32x4 v = *(const GAS f32x4*)(part + (size_t)row * NP + 4 * j); s += (v.x + v.y) + (v.z + v.w); }
        rstd[row] = 1.0f / sqrtf(s * inv_n + RMS_EPS); }
}
__device__ __forceinline__ void sincos_d(double a, float& sn, float& cs) {
    const double k = rint(a * 0.63661977236758134308);
    double r = fma(-k, 1.57079632679489655800, a); r = fma(-k, 6.12323399573676603587e-17, r);
    const double r2 = r * r;
    const double sp = r + r * r2 * (-1.0 / 6 + r2 * (1.0 / 120 + r2 * (-1.0 / 5040 + r2 * (1.0 / 362880 + r2 * (-1.0 / 39916800)))));
    const double cp = 1.0 + r2 * (-0.5 + r2 * (1.0 / 24 + r2 * (-1.0 / 720 + r2 * (1.0 / 40320 + r2 * (-1.0 / 3628800 + r2 * (1.0 / 479001600))))));
    const int q = (int)((long long)k & 3);
    const double s_ = (q & 1) ? cp : sp, c_ = (q & 1) ? sp : cp;
    sn = (float)((q & 2) ? -s_ : s_); cs = (float)(((q + 1) & 2) ? -c_ : c_);
}
__device__ __forceinline__ int list_off(int kb) { return 16384 * kb - 128 * kb * (kb + 1); }
__device__ __forceinline__ bool better(float v, int i, float cv, int ci) { return v > cv || (v == cv && i < ci); }
#define TOP3_INS(v_, i_) do { const float vv_ = (v_); const int ii_ = (i_);                                             \
        const bool c0_ = better(vv_, ii_, tv0, ti0), c1_ = better(vv_, ii_, tv1, ti1), c2_ = better(vv_, ii_, tv2, ti2); \
        tv2 = c1_ ? tv1 : (c2_ ? vv_ : tv2); ti2 = c1_ ? ti1 : (c2_ ? ii_ : ti2);                                       \
        tv1 = c0_ ? tv0 : (c1_ ? vv_ : tv1); ti1 = c0_ ? ti0 : (c1_ ? ii_ : ti1);                                       \
        tv0 = c0_ ? vv_ : tv0; ti0 = c0_ ? ii_ : ti0; } while (0)
__device__ __forceinline__ void moba_gate_unit(int h, int qb, const bf16* QB, const float* KMF, unsigned* gcnt, unsigned* list, float* PML,
                                               LAS unsigned* cntL, LAS unsigned* baseL, int wv) {
    int tid_ = wv * 64 + lane_id_(); asm volatile("" : "+v"(tid_)); const int tid = tid_, wid = wv, lane = tid & 63, r32 = lane & 31, hi = lane >> 5;
    if (tid < 64) cntL[tid] = 0u;
    __syncthreads();
    const int s = qb * MBLK + wid * 32 + r32;
    bf16x8 qr[8];
#pragma unroll
    for (int d0 = 0; d0 < 8; ++d0) qr[d0] = *(const GAS bf16x8*)(QB + (size_t)s * MOBAW + h * 128 + d0 * 16 + hi * 8);
    f32x16 p0 = {}, p1 = {};
#pragma unroll
    for (int d0 = 0; d0 < 8; ++d0) {
#pragma unroll
        for (int half = 0; half < 2; ++half) { const float* kp = KMF + (size_t)(h * NBLK + half * 32 + r32) * 128 + d0 * 16 + hi * 8;
            const f32x4 a = *(const GAS f32x4*)kp, b = *(const GAS f32x4*)(kp + 4); const float v[8] = {a[0], a[1], a[2], a[3], b[0], b[1], b[2], b[3]};
            bf16x8 fh, fl;
#pragma unroll
            for (int j = 0; j < 8; ++j) { const unsigned hb_ = f2bf(v[j]); fh[j] = (short)hb_; fl[j] = (short)f2bf(v[j] - __uint_as_float(hb_ << 16)); }
            if (half == 0) { p0 = __builtin_amdgcn_mfma_f32_32x32x16_bf16(fh, qr[d0], p0, 0, 0, 0); p0 = __builtin_amdgcn_mfma_f32_32x32x16_bf16(fl, qr[d0], p0, 0, 0, 0); }
            else { p1 = __builtin_amdgcn_mfma_f32_32x32x16_bf16(fh, qr[d0], p1, 0, 0, 0); p1 = __builtin_amdgcn_mfma_f32_32x32x16_bf16(fl, qr[d0], p1, 0, 0, 0); } } }
    const float NEG = -__builtin_inff();
    float tv0 = NEG, tv1 = NEG, tv2 = NEG; int ti0 = 1000, ti1 = 1001, ti2 = 1002;
#pragma unroll
    for (int r = 0; r < 16; ++r) { const int n = (r & 3) + 8 * (r >> 2) + 4 * hi; TOP3_INS(n < qb ? p0[r] : NEG, n); }
#pragma unroll
    for (int r = 0; r < 16; ++r) { const int n = 32 + (r & 3) + 8 * (r >> 2) + 4 * hi; TOP3_INS(n < qb ? p1[r] : NEG, n); }
    { const float ov0 = __shfl_xor(tv0, 32), ov1 = __shfl_xor(tv1, 32), ov2 = __shfl_xor(tv2, 32);
      const int oi0 = __shfl_xor(ti0, 32), oi1 = __shfl_xor(ti1, 32), oi2 = __shfl_xor(ti2, 32);
      TOP3_INS(ov0, oi0); TOP3_INS(ov1, oi1); TOP3_INS(ov2, oi2); }
    const bool act = (hi == 0);
    const bool ok0 = act && tv0 > NEG, ok1 = act && tv1 > NEG, ok2 = act && tv2 > NEG;
    unsigned rk0 = 0, rk1 = 0, rk2 = 0;
    if (ok0) rk0 = atomicAdd((unsigned*)(cntL + ti0), 1u);
    if (ok1) rk1 = atomicAdd((unsigned*)(cntL + ti1), 1u);
    if (ok2) rk2 = atomicAdd((unsigned*)(cntL + ti2), 1u);
    if (act) { float* ml = PML + (size_t)((s * 16 + h) * 4) * 2;
        if (!ok0) { ml[0] = -1e30f; ml[1] = 0.f; } if (!ok1) { ml[2] = -1e30f; ml[3] = 0.f; } if (!ok2) { ml[4] = -1e30f; ml[5] = 0.f; } }
    __syncthreads();
    if (tid < 64) { const unsigned n = cntL[tid]; baseL[tid] = n ? atomicAdd(gcnt + h * NBLK + tid, n) : 0u; }
    __syncthreads();
    unsigned* lh = list + (size_t)h * LIST_PER_HEAD;
    if (ok0) lh[list_off(ti0) + baseL[ti0] + rk0] = (unsigned)s | (0u << 16);
    if (ok1) lh[list_off(ti1) + baseL[ti1] + rk1] = (unsigned)s | (1u << 16);
    if (ok2) lh[list_off(ti2) + baseL[ti2] + rk2] = (unsigned)s | (2u << 16);
    __syncthreads();
}
#if PROBE_PHASE == 500
constexpr int CW_FAIL = 8;
__device__ __forceinline__ float blk_reduce(float v, bool domax, float* red, int tid) {
#pragma unroll
    for (int o = 1; o < 64; o <<= 1) { const float y = __shfl_xor(v, o); v = domax ? fmaxf(v, y) : v + y; }
    __syncthreads();
    if ((tid & 63) == 0) red[tid >> 6] = v;
    __syncthreads();
    float r = red[0];
    for (int w = 1; w < 8; ++w) r = domax ? fmaxf(r, red[w]) : r + red[w];
    return r;
}
__device__ __forceinline__ float bfv(const bf16* p) { return __uint_as_float(((unsigned)*p) << 16); }
__device__ __forceinline__ int sample_row(int i) {
    const int fixed[16] = {0, 1, 31, 32, 63, 64, 255, 256, 257, 511, 512, 767, 1023, 8191, 16383, 16128};
    if (i < 16) return fixed[i];
    return (int)(((unsigned)i * 2654435761u) >> 18) & 16383;
}
__device__ __forceinline__ void selfcheck(unsigned char* lds, unsigned char* ws, const int* pos, const bf16* OBc, int G, int bid) {
    const int tid = threadIdx.x;
    float* lg = (float*)lds;
    float* red = (float*)(lds + 65536);
    float* po = (float*)(lds + 65536 + 64);
    float* gate = (float*)(lds + 65536 + 64 + 2048);
    int* sel = (int*)(lds + 65536 + 64 + 2048 + 256);
    gu32* ctl = (gu32*)(ws + WS_CTL);
    bf16* KR = (bf16*)(ws + WS_KR); bf16* QB = (bf16*)(ws + WS_QB); bf16* KB = (bf16*)(ws + WS_KB); bf16* VB = (bf16*)(ws + WS_VB);
    bf16* QM = (bf16*)(ws + WS_QM); bf16* KV = (bf16*)(ws + WS_KV); bf16* OA = (bf16*)(ws + WS_OA); float* BIAS = (float*)(ws + WS_BIAS);
    unsigned nbad = 0;
    for (int u = bid; u < 64 * 16; u += G) { const int s = sample_row(u >> 4), h = u & 15;
        { const bf16* q = QM + (size_t)s * QUP + h * 192; float mx = -1e30f;
          for (int k = tid; k <= s; k += 512) { const bf16* kn = KV + (size_t)k * KVUP + h * 256; const bf16* kr = KR + (size_t)k * 64; float a = 0.f;
              for (int d = 0; d < 128; ++d) a += bfv(q + d) * bfv(kn + d);
              for (int d = 0; d < 64; ++d) a += bfv(q + 128 + d) * bfv(kr + d);
              a *= 0.07216878364870322f; lg[k] = a; mx = fmaxf(mx, a); }
          mx = blk_reduce(mx, true, red, tid);
          float sm = 0.f; for (int k = tid; k <= s; k += 512) { const float p = expf(lg[k] - mx); lg[k] = p; sm += p; }
          sm = blk_reduce(sm, false, red, tid);
          const int d = tid & 127, part = tid >> 7; float o = 0.f;
          for (int k = part; k <= s; k += 4) o += lg[k] * bfv(KV + (size_t)k * KVUP + h * 256 + 128 + d);
          po[part * 128 + d] = o; __syncthreads();
          float amax = 0.f;
          if (tid < 128) { const float ref = (po[tid] + po[128 + tid] + po[256 + tid] + po[384 + tid]) / sm; po[tid] = ref; amax = fabsf(ref); }
          amax = blk_reduce(amax, true, red, tid);
          if (tid < 128) { const float got = bfv(OA + (size_t)s * MLAOUT + h * 128 + tid); if (!(fabsf(got - po[tid]) <= SELFCHECK_REL * amax + SELFCHECK_ABS)) nbad++; }
          __syncthreads(); }
        { const bf16* q = QB + (size_t)s * MOBAW + h * 128; const int qb = s >> 8; const int d = tid & 127, part = tid >> 7;
          for (int n = 0; n < qb; ++n) { float a = 0.f;
              for (int r = part * 64; r < part * 64 + 64; ++r) a += bfv(KB + (size_t)(n * 256 + r) * MOBAW + h * 128 + d);
              a = a * (1.f / 256.f) * bfv(q + d);
              a = blk_reduce(a, false, red, tid);
              if (tid == 0) gate[n] = a; }
          __syncthreads();
          if (tid == 0) { float g0 = -1e30f, g1 = -1e30f, g2 = -1e30f; int i0 = -1, i1 = -1, i2 = -1;
              for (int n = 0; n < qb; ++n) { const float g = gate[n];
                  if (g > g0) { g2 = g1; i2 = i1; g1 = g0; i1 = i0; g0 = g; i0 = n; } else if (g > g1) { g2 = g1; i2 = i1; g1 = g; i1 = n; } else if (g > g2) { g2 = g; i2 = n; } }
              sel[0] = i0; sel[1] = i1; sel[2] = i2; sel[3] = qb; }
          __syncthreads();
          float mx = -1e30f; const int pq = pos[s];
          for (int e = tid; e < 1024; e += 512) { const int j = e >> 8, kk = e & 255; const int blk = sel[j]; float a = -1e30f;
              if (blk >= 0) { const int key = blk * 256 + kk;
                  if (j < 3 || key <= s) { const bf16* kp = KB + (size_t)key * MOBAW + h * 128; float dsum = 0.f;
                      for (int dd = 0; dd < 128; ++dd) dsum += bfv(q + dd) * bfv(kp + dd);
                      int dist = pq - pos[key]; dist = dist < 0 ? 0 : (dist > 128 ? 128 : dist);
                      a = dsum * (0.08838834764831845f * 1.4426950408889634f) + BIAS[h * 132 + dist]; } }
              lg[e] = a; mx = fmaxf(mx, a); }
          mx = blk_reduce(mx, true, red, tid);
          float sm = 0.f; for (int e = tid; e < 1024; e += 512) { const float p = lg[e] > -1e29f ? exp2f(lg[e] - mx) : 0.f; lg[e] = p; sm += p; }
          sm = blk_reduce(sm, false, red, tid);
          float o = 0.f;
          for (int e = part; e < 1024; e += 4) { const int blk = sel[e >> 8]; if (blk >= 0 && lg[e] > 0.f) o += lg[e] * bfv(VB + (size_t)(blk * 256 + (e & 255)) * MOBAW + h * 128 + d); }
          po[part * 128 + d] = o; __syncthreads();
          float amax = 0.f;
          if (tid < 128) { const float ref = (po[tid] + po[128 + tid] + po[256 + tid] + po[384 + tid]) / sm; po[tid] = ref; amax = fabsf(ref); }
          amax = blk_reduce(amax, true, red, tid);
          if (tid < 128) { const float got = bfv(OBc + (size_t)s * MOBAW + h * 128 + tid); if (!(fabsf(got - po[tid]) <= SELFCHECK_REL * amax + SELFCHECK_ABS)) nbad++; }
          __syncthreads(); }
    }
    if (nbad) atomicAdd((unsigned*)(ctl + CW_FAIL), nbad);
}
#endif
struct NoConv { __device__ __forceinline__ void operator()(int, int, unsigned char*) const {} };
struct P7Conv {
    const Args& args; int vcu;
    __device__ __forceinline__ void operator()(int s, int wave, unsigned char* lds) const { int lane_ = lane_id_(); asm volatile("" : "+v"(lane_)); const int lane = lane_;
        unsigned char* ws = args.ws; const int G = (int)gridDim.x, NGW = G * NWAVES, gw = vcu * NWAVES + wave;
        LAS unsigned char* T = (LAS unsigned char*)lds + RING_OFF + wave * 8704;
        float* cpart = (float*)(ws + WS_CPART) + NFF2; float* cmf = (float*)(ws + WS_CMAXF) + NFF2; bf16* WFI2 = (bf16*)(ws + WS_WFI2);
        if (G != 256) {
            cvt_job<1>(args.in[16], DM, NFF2, WFI2, NFF2 / 64, T, gw, NGW, lane, nullptr, NFF2, -1, cpart, 2 * NFF2, cmf, s, 4);
            cvt_job<0>(args.in[12], MLAOUT, DM, (bf16*)(ws + WS_WBRA), DM / 64, T, gw, NGW, lane, nullptr, FP8_BR ? DM : 0, FP8_BR ? 5 : -1, nullptr, 0, nullptr, (s + 1) & 3, 4);
            cvt_job<0>(args.in[13], MOBAW, DM, (bf16*)(ws + WS_WBRB), DM / 64, T, gw, NGW, lane, nullptr, FP8_BR ? DM : 0, FP8_BR ? 5 : -1, nullptr, 0, nullptr, (s + 2) & 3, 4);
            cvt_job<0>(args.in[14], DM, DM, (bf16*)(ws + WS_WOUT), DM / 64, T, gw, NGW, lane, nullptr, FP8_OUT ? DM : 0, FP8_OUT ? 6 : -1, nullptr, 0, nullptr, (s + 1) & 3, 4);
            return; }
        const int nstrip = NFF2 / 64, two = (vcu + 256 < nstrip) ? 1 : 0;
        auto scol_of = [](int db) { const int pn = db >> 2, sub = db & 3; return (sub < 2) ? (128 * pn + 64 * sub) : (DFF + 128 * pn + 64 * (sub - 2)); };
        if (s == 0) { const int rp = lane >> 4, c4 = lane & 15;
            for (int q = 0; q <= two; ++q) { const int scol = scol_of(vcu + 256 * q); f32x4 m = {0.f, 0.f, 0.f, 0.f};
                const float* wp = args.in[16] + (size_t)(wave * 512 + rp) * NFF2 + scol + 4 * c4;
#pragma unroll 32
                for (int i = 0; i < 128; ++i) { const f32x4 v = *(const GAS f32x4*)(wp + (size_t)(4 * i) * NFF2);
                    m[0] = fmaxf(m[0], fabsf(v[0])); m[1] = fmaxf(m[1], fabsf(v[1])); m[2] = fmaxf(m[2], fabsf(v[2])); m[3] = fmaxf(m[3], fabsf(v[3])); }
#pragma unroll
                for (int e = 0; e < 4; ++e) { float x = m[e]; x = fmaxf(x, __shfl_xor(x, 16)); x = fmaxf(x, __shfl_xor(x, 32)); if (rp == 0) cpart[(size_t)wave * (2 * NFF2) + scol + 4 * c4 + e] = x; } } }
        else if (s <= 2) { if (s == 1 || two) { const int db = vcu + 256 * (s - 1), scol = scol_of(db);
#pragma unroll 1
                for (int kb = wave * 8; kb < wave * 8 + 8; ++kb) cvt_item(args.in[16], NFF2, scol, false, WFI2, DM, 64 * db, 64 * kb, T, lane, nullptr, NFF2, -1, cpart, 2 * NFF2, cmf); } }
        if (s >= 2 && !two) { const int gw1 = (vcu - (nstrip - 256)) * NWAVES + wave, NGW1 = (512 - nstrip) * NWAVES;
            cvt_job<0>(args.in[12], MLAOUT, DM, (bf16*)(ws + WS_WBRA), DM / 64, T, gw1, NGW1, lane, nullptr, FP8_BR ? DM : 0, FP8_BR ? 5 : -1, nullptr, 0, nullptr, s - 2, 2);
            cvt_job<0>(args.in[13], MOBAW, DM, (bf16*)(ws + WS_WBRB), DM / 64, T, gw1, NGW1, lane, nullptr, FP8_BR ? DM : 0, FP8_BR ? 5 : -1, nullptr, 0, nullptr, 3 - s, 2);
            cvt_job<0>(args.in[14], DM, DM, (bf16*)(ws + WS_WOUT), DM / 64, T, gw1, NGW1, lane, nullptr, FP8_OUT ? DM : 0, FP8_OUT ? 6 : -1, nullptr, 0, nullptr, s - 2, 2); } }
};
template <int WHICH, class Conv>
__device__ __forceinline__ void p7_attention(unsigned char* lds, unsigned char* ws, const int* pos, int G, int bid, int wv, Conv conv) {
    int tid_ = wv * 64 + lane_id_(); asm volatile("" : "+v"(tid_)); const int tid = tid_, lane = tid & 63, wave = wv;
    gu32* ctl = (gu32*)(ws + WS_CTL); unsigned* GCNT = (unsigned*)(ctl + CW_GCNT);
    bf16* KR = (bf16*)(ws + WS_KR); bf16* QB = (bf16*)(ws + WS_QB); bf16* KB = (bf16*)(ws + WS_KB); bf16* VB = (bf16*)(ws + WS_VB);
    bf16* QM = (bf16*)(ws + WS_QM); bf16* KV = (bf16*)(ws + WS_KV); bf16* OA = (bf16*)(ws + WS_OA);
    float* BIAS = (float*)(ws + WS_BIAS); int* TPMAX = (int*)(ws + WS_TPMAX);
    unsigned* LIST = (unsigned*)(ws + WS_LIST); float* PML = (float*)(ws + WS_PML); bf16* PO = (bf16*)(ws + WS_PO);
        float* biasL = (float*)(lds + att::L_BIAS); unsigned* pref = (unsigned*)(lds + att::L_PREF); unsigned* wtot = pref + 1028;
        for (int i = tid; i < 16 * 132; i += NWAVES * 64) biasL[i] = BIAS[i];
        unsigned* cntS = (unsigned*)(lds + att::L_CNT);
        { const unsigned ca = __hip_atomic_load(GCNT + 2 * tid, RLX_AGENT), cb = __hip_atomic_load(GCNT + 2 * tid + 1, RLX_AGENT); cntS[2 * tid] = ca; cntS[2 * tid + 1] = cb;
          const unsigned a = (ca + 511u) >> 9, b = (cb + 511u) >> 9;
          unsigned s = a + b;
#pragma unroll
          for (int o_ = 1; o_ < 64; o_ <<= 1) { const unsigned y = __shfl_up(s, o_); if (lane >= o_) s += y; }
          if (lane == 63) wtot[wave] = s;
          __syncthreads();
          unsigned offs = 0; for (int w = 0; w < wave; ++w) offs += wtot[w];
          const unsigned incl = s + offs; pref[2 * tid] = incl - a - b; pref[2 * tid + 1] = incl - b; if (tid == NWAVES * 64 - 1) pref[1024] = incl; }
        __syncthreads();
        const int U = (int)pref[1024];
        int cslot = 0;
        const float c2_mla = 0.07216878364870322f * 1.4426950408889634f;
        const float c2_moba = 0.08838834764831845f * 1.4426950408889634f;
        if constexpr (WHICH & 1) for (int p = bid; p < 512; p += G) { const int h = p & 15, xx = p >> 4;
#pragma unroll 1
            for (int k = 0; k < 2; ++k) { const int qb = k ? xx : 63 - xx;
                att::UnitArgs A; A.Q = QM + h * 192; A.qpitch = QUP; A.K = KV + h * 256; A.kpitch = KVUP; A.Kr = KR; A.Q8 = ws + WS_QM8 + h * 192; A.K8 = ws + WS_KN8 + h * 128; A.Kr8 = ws + WS_KR8; A.V8 = ws + WS_V8 + (size_t)h * 256 * 8192; A.V = KV + h * 256 + 128; A.vpitch = KVUP;
                A.O = OA + h * 128; A.opitch = MLAOUT; A.PO = nullptr; A.PML = nullptr; A.pos = pos; A.tpmax = TPMAX; A.list = nullptr; A.nrows = 256;
                A.q0 = qb * 256; A.k0 = 0; A.NT = 4 * (qb + 1); A.h = h; A.c2 = c2_mla;
                att::attn_unit<192, 0>(A, (char*)lds, wv);
                if (cslot < 4) { conv(cslot++, wv, lds); __syncthreads(); } } }
        if constexpr (WHICH & 1) while (cslot < 4) { conv(cslot++, wv, lds); __syncthreads(); }
        if constexpr (WHICH & 2) for (int u = bid; u < U; u += G) {
            int lo = 0, hi_ = 1024;
            while (hi_ - lo > 1) { const int mid = (lo + hi_) >> 1; if (pref[mid] <= (unsigned)u) lo = mid; else hi_ = mid; }
            const int h = lo >> 6, kb = lo & 63, c = u - (int)pref[lo];
            const int cnt = (int)cntS[lo];
            att::UnitArgs A; A.Q = QB + h * 128; A.qpitch = MOBAW; A.K = KB + h * 128; A.kpitch = MOBAW; A.Kr = nullptr; A.Q8 = ws + WS_QB8 + h * 128; A.K8 = ws + WS_KB8 + h * 128; A.Kr8 = nullptr; A.V8 = ws + WS_VB8 + (size_t)h * 256 * 8192; A.V = VB + h * 128; A.vpitch = MOBAW;
            A.O = nullptr; A.opitch = 0; A.PO = PO; A.PML = PML; A.pos = pos; A.tpmax = TPMAX;
            A.list = LIST + (size_t)h * LIST_PER_HEAD + list_off(kb) + c * 512; A.nrows = min(512, cnt - c * 512);
            A.q0 = 0; A.k0 = kb * 256; A.NT = 4; A.h = h; A.c2 = c2_moba;
            att::moba_unit<1>(A, (char*)lds, wv, (A.nrows + 255) >> 8); }
        if constexpr (WHICH & 4) for (int u = bid; u < NBLK * NH; u += G) { const int h = u & 15, qb = u >> 4;
            att::UnitArgs A; A.Q = QB + h * 128; A.qpitch = MOBAW; A.K = KB + h * 128; A.kpitch = MOBAW; A.Kr = nullptr; A.Q8 = ws + WS_QB8 + h * 128; A.K8 = ws + WS_KB8 + h * 128; A.Kr8 = nullptr; A.V8 = ws + WS_VB8 + (size_t)h * 256 * 8192; A.V = VB + h * 128; A.vpitch = MOBAW;
            A.O = nullptr; A.opitch = 0; A.PO = PO; A.PML = PML; A.pos = pos; A.tpmax = TPMAX; A.list = nullptr; A.nrows = 256;
            A.q0 = qb * 256; A.k0 = qb * 256; A.NT = 4; A.h = h; A.c2 = c2_moba;
            att::moba_unit<2>(A, (char*)lds, wv, 1); }
}
__global__ void __launch_bounds__(NWAVES * 64, 2) hybrid_fwd(Args args) {
    extern __shared__ __attribute__((aligned(16))) unsigned char lds[];
    LAS unsigned char* ldsl = (LAS unsigned char*)lds;
    volatile LAS unsigned* MISC = (volatile LAS unsigned*)(ldsl + MISC_OFF);
    const int tid = threadIdx.x, lane = tid & 63, wave = __builtin_amdgcn_readfirstlane(tid >> 6);
    const int G = gridDim.x, bid = blockIdx.x;
    const int vcu = (G % 8 == 0) ? (bid % 8) * (G / 8) + bid / 8 : bid;
    const int gw = vcu * NWAVES + wave, NGW = G * NWAVES;
    unsigned char* ws = args.ws;
    gu32* ctl = (gu32*)(ws + WS_CTL);
    for (int u = tid; u < (LDS_BYTES - LDSCTL_OFF) / 4; u += NWAVES * 64) ((LAS unsigned*)(ldsl + LDSCTL_OFF))[u] = 0u;
    __syncthreads();
    XcdBarrier bar = xcd_barrier_post((unsigned*)(ctl + CW_BAR), MISC + 8, wave);
#if PROBE_PHASE == 99
#define GRID_BAR() do { xcd_barrier(bar, wave); xcd_barrier(bar, wave); } while (0)
#else
#define GRID_BAR() xcd_barrier(bar, wave)
#endif
    const float* x = args.in[0]; const int* pos = (const int*)args.in[1]; const float* rel_bias = args.in[2];
    float* out = args.out;
    bf16* WFI = (bf16*)(ws + WS_WFFN_IN); bf16* WFO = (bf16*)(ws + WS_WFFN_OUT); bf16* WIN = (bf16*)(ws + WS_WIN); bf16* WUQ = (bf16*)(ws + WS_WUQ);
    bf16* WUKV = (bf16*)(ws + WS_WUKV); bf16* WBRA = (bf16*)(ws + WS_WBRA); bf16* WBRB = (bf16*)(ws + WS_WBRB); bf16* WOUT = (bf16*)(ws + WS_WOUT);
    bf16* H = (bf16*)(ws + WS_H); bf16* ACT = (bf16*)(ws + WS_BIG);
    bf16* CQ = (bf16*)(ws + WS_CQ); bf16* CKV = (bf16*)(ws + WS_CKV); bf16* KR = (bf16*)(ws + WS_KR); bf16* QB = (bf16*)(ws + WS_QB); bf16* KB = (bf16*)(ws + WS_KB);
    bf16* VB = (bf16*)(ws + WS_VB); bf16* GA = (bf16*)(ws + WS_GA); bf16* GB = (bf16*)(ws + WS_GB);
    bf16* QM = (bf16*)(ws + WS_QM); bf16* KV = (bf16*)(ws + WS_KV); bf16* OA = (bf16*)(ws + WS_OA);
    float* COS = (float*)(ws + WS_COS); float* SIN = (float*)(ws + WS_SIN);
    bf16* KMH = (bf16*)(ws + WS_KMH); bf16* KML = (bf16*)(ws + WS_KML); float* BIAS = (float*)(ws + WS_BIAS); int* TPMAX = (int*)(ws + WS_TPMAX);
    unsigned* LIST = (unsigned*)(ws + WS_LIST); float* PML = (float*)(ws + WS_PML); bf16* PO = (bf16*)(ws + WS_PO);
    unsigned* GCNT = (unsigned*)(ctl + CW_GCNT);
    float* PART = (float*)(ws + WS_PART); float* RSTD = (float*)(ws + WS_RSTD); float* PARTQ = (float*)(ws + WS_PARTQ); float* PARTKV = (float*)(ws + WS_PARTKV);
    float* RSTDQ = (float*)(ws + WS_RSTDQ); float* RSTDKV = (float*)(ws + WS_RSTDKV); bf16* H3 = GB; (void)RSTDQ; (void)RSTDKV;
    float* CPART = (float*)(ws + WS_CPART); float* CMAXF = (float*)(ws + WS_CMAXF); const float* CMAX1 = CMAXF; const float* CMAX2 = CMAXF + NFF2; float* PMAX = (float*)(ws + WS_PMAX);
    unsigned char* H8 = ws + WS_H8; unsigned char* OA8 = ws + WS_OA8; unsigned char* OB8 = ws + WS_OB8; unsigned char* MG8 = ws + WS_MG8; unsigned char* WIN8 = ws + WS_WIN8;
#if PROBE_PHASE == 500
    bf16* OBC = (bf16*)(ws + ((WS_END + 4095) / 4096) * 4096);
#else
    bf16* OBC = QB;
#endif
    LAS unsigned char* cvtT = ldsl + RING_OFF + wave * 8704;

    { int tid_f = wave * 64 + lane_id_(); asm volatile("" : "+v"(tid_f)); const int tid = tid_f, lane = tid & 63; (void)lane; (void)tid;
    {
    colmax_job(args.in[4], DM, NFF2, CPART, 2 * NFF2, gw, NGW, lane);
    if (G != 256) colmax_job(args.in[16], DM, NFF2, CPART + NFF2, 2 * NFF2, gw, NGW, lane);
    cvt_job<2>(args.in[7], DM, INCOLS, WIN, INPAD1 / 64, cvtT, gw, NGW, lane, nullptr, INPAD1);
    cvt_job<4>(args.in[7], DM, INCOLS, (bf16*)WIN8, IN2 / 64, cvtT, gw, NGW, lane, nullptr, IN2, 6);
    cvt_job<3>(args.in[9], QLORA, QUP, WUQ, QUP / 64, cvtT, gw, NGW, lane, args.in[8]);
    cvt_job<0>(args.in[11], KVLORA, KVUP, WUKV, KVUP / 64, cvtT, gw, NGW, lane, args.in[10]);
    for (int idx = vcu * (NWAVES * 64) + tid; idx < M_ * 32; idx += G * NWAVES * 64) { const int s = idx >> 5, i = idx & 31;
        float sn, cs; sincos_d((double)pos[s] * args.invf[i], sn, cs); COS[idx] = cs; SIN[idx] = sn; }
    for (int idx = vcu * (NWAVES * 64) + tid; idx < 16 * 132; idx += G * NWAVES * 64) { const int h = idx / 132, d = idx - h * 132;
        BIAS[idx] = d <= 128 ? rel_bias[(int)args.bucket[d] * NH + h] * 1.4426950408889634f : 0.f; }
    for (int t = gw; t < 256; t += NGW) { int p = pos[t * 64 + lane];
#pragma unroll
        for (int o_ = 1; o_ < 64; o_ <<= 1) p = max(p, __shfl_xor(p, o_));
        if (lane == 0) TPMAX[t] = p; }
    for (int m = gw; m < M_; m += NGW) rms_row4096_i8(x + (size_t)m * DM, args.in[3], H8, m, RSTD, lane);
    }
#if PROBE_PHASE == 0
    {
    colmax_job(args.in[4], DM, NFF2, CPART, 2 * NFF2, gw, NGW, lane);
    if (G != 256) colmax_job(args.in[16], DM, NFF2, CPART + NFF2, 2 * NFF2, gw, NGW, lane);
    cvt_job<2>(args.in[7], DM, INCOLS, WIN, INPAD1 / 64, cvtT, gw, NGW, lane, nullptr, INPAD1);
    cvt_job<4>(args.in[7], DM, INCOLS, (bf16*)WIN8, IN2 / 64, cvtT, gw, NGW, lane, nullptr, IN2, 6);
    cvt_job<3>(args.in[9], QLORA, QUP, WUQ, QUP / 64, cvtT, gw, NGW, lane, args.in[8]);
    cvt_job<0>(args.in[11], KVLORA, KVUP, WUKV, KVUP / 64, cvtT, gw, NGW, lane, args.in[10]);
    for (int idx = vcu * (NWAVES * 64) + tid; idx < M_ * 32; idx += G * NWAVES * 64) { const int s = idx >> 5, i = idx & 31;
        float sn, cs; sincos_d((double)pos[s] * args.invf[i], sn, cs); COS[idx] = cs; SIN[idx] = sn; }
    for (int idx = vcu * (NWAVES * 64) + tid; idx < 16 * 132; idx += G * NWAVES * 64) { const int h = idx / 132, d = idx - h * 132;
        BIAS[idx] = d <= 128 ? rel_bias[(int)args.bucket[d] * NH + h] * 1.4426950408889634f : 0.f; }
    for (int t = gw; t < 256; t += NGW) { int p = pos[t * 64 + lane];
#pragma unroll
        for (int o_ = 1; o_ < 64; o_ <<= 1) p = max(p, __shfl_xor(p, o_));
        if (lane == 0) TPMAX[t] = p; }
    for (int m = gw; m < M_; m += NGW) rms_row4096_i8(x + (size_t)m * DM, args.in[3], H8, m, RSTD, lane);
    }
#endif
    }
    GRID_BAR();
#if PROBE_PHASE == 300
    {
        const bf16x8 fa = *(const GAS bf16x8*)(H + (size_t)(bid * 512 + tid) * 8), fb = *(const GAS bf16x8*)(H + (size_t)(bid * 512 + tid) * 8 + 65536);
        f32x4 ac[8];
#pragma unroll
        for (int i = 0; i < 8; ++i) ac[i] = (f32x4){0.f, 0.f, 0.f, 0.f};
#pragma unroll 1
        for (int it = 0; it < 5120; ++it) {
#pragma unroll
            for (int i = 0; i < 8; ++i) ac[i] = __builtin_amdgcn_mfma_f32_16x16x32_bf16(fa, fb, ac[i], 0, 0, 0); }
        float sacc = 0.f;
#pragma unroll
        for (int i = 0; i < 8; ++i) sacc += ac[i][0] + ac[i][1] + ac[i][2] + ac[i][3];
        if (sacc == 12345.678f) out[0] = 1.f;
    }
#endif
    { int tid_f = wave * 64 + lane_id_(); asm volatile("" : "+v"(tid_f)); const int lane = tid_f & 63;
      cvt_job<1>(args.in[4], DM, NFF2, WFI, NFF2 / 64, cvtT, gw, NGW, lane, nullptr, NFF2, -1, CPART, 2 * NFF2, CMAXF); }
    GRID_BAR();
    { pg8::Gemm g{(const bf16*)H8, WFI, M_, NFF2, DM / 2}; pg8::StaticOrder S; S.init(M_, NFF2, G, bid); pg8::EpiSwiglu E{ACT, DFF, RSTD, M_, CMAX1};
      pg8::gemm_phase<pg8::EpiSwiglu, pg8::StaticOrder, true, true, true, false, true>(ldsl + RING_OFF, g, S, E, wave); }
#if PROBE_PHASE == 1
    { pg8::Gemm g{(const bf16*)H8, WFI, M_, NFF2, DM / 2}; pg8::StaticOrder S; S.init(M_, NFF2, G, bid); pg8::EpiSwiglu E{ACT, DFF, RSTD, M_, CMAX1};
      pg8::gemm_phase<pg8::EpiSwiglu, pg8::StaticOrder, true, true, true, false, true>(ldsl + RING_OFF, g, S, E, wave); }
#endif
    if (G == 256 && bid >= 128) { int tid_f = wave * 64 + lane_id_(); asm volatile("" : "+v"(tid_f)); const int lane = tid_f & 63;
        cvt_job<0>(args.in[5], DFF, DM, WFO, DM / 64, cvtT, (bid - 128) * NWAVES + wave, 128 * NWAVES, lane, nullptr, DM); }
    else if (G != 256) { int tid_f = wave * 64 + lane_id_(); asm volatile("" : "+v"(tid_f)); const int lane = tid_f & 63; cvt_job<0>(args.in[5], DFF, DM, WFO, DM / 64, cvtT, gw, NGW, lane, nullptr, DM); }
    GRID_BAR();
    { pg8::Gemm g{ACT, WFO, M_, DM, DFF}; pg8::StaticOrder S; S.init(M_, DM, G, bid); pg8::EpiResidNorm<(long)WS_H8 - (long)WS_H> E{x, out, 0.5f, H, args.in[6], PART, nullptr};
      pg8::gemm_phase<pg8::EpiResidNorm<(long)WS_H8 - (long)WS_H>, pg8::StaticOrder, true, true, true>(ldsl + RING_OFF, g, S, E, wave); }
#if PROBE_PHASE == 2
    { pg8::Gemm g{ACT, WFO, M_, DM, DFF}; pg8::StaticOrder S; S.init(M_, DM, G, bid); pg8::EpiResidNorm<(long)WS_H8 - (long)WS_H> E{x, out, 0.5f, H, args.in[6], PART, nullptr};
      pg8::gemm_phase<pg8::EpiResidNorm<(long)WS_H8 - (long)WS_H>, pg8::StaticOrder, true, true, true>(ldsl + RING_OFF, g, S, E, wave); }
#endif
#if PROBE_PHASE == 801 || PROBE_PHASE == 802
    GRID_BAR();
    { pg8::Gemm g{ACT, WFO, PROBE_PHASE == 801 ? M_ : 0, PROBE_PHASE == 801 ? DM : 0, DFF}; pg8::StaticOrder S; S.init(M_, DM, G, bid); pg8::EpiNull E{};
      pg8::gemm_phase<pg8::EpiNull, pg8::StaticOrder, true, true, true>(ldsl + RING_OFF, g, S, E, wave); }
#endif
#if PROBE_PHASE == 803 || PROBE_PHASE == 804
    GRID_BAR();
    { pg8::Gemm g{(const bf16*)H8, WFI, PROBE_PHASE == 803 ? M_ : 0, PROBE_PHASE == 803 ? NFF2 : 0, DM / 2}; pg8::StaticOrder S; S.init(M_, NFF2, G, bid); pg8::EpiNull E{};
      pg8::gemm_phase<pg8::EpiNull, pg8::StaticOrder, true, true, true, false, true>(ldsl + RING_OFF, g, S, E, wave); }
#endif
    GRID_BAR();
    { int tid_f = wave * 64 + lane_id_(); asm volatile("" : "+v"(tid_f)); const int tid = tid_f, lane = tid & 63; (void)lane; (void)tid;
    rstd_reduce<64>(PART, RSTD, 1.f / DM, vcu, tid, G);
#if PROBE_PHASE == 3 || PROBE_PHASE == 38
    rstd_reduce<64>(PART, RSTD, 1.f / DM, vcu, tid, G);
#endif
    }
    GRID_BAR();
    { pg8::Gemm g{H, WIN, M_, INPAD1, DM}; pg8::StaticOrder S; S.init(M_, INPAD1, G, bid);
      pg8::EpiProj<1> E{CQ, CKV, KR, QB, KB, VB, GA, GB, COS, SIN, RSTD, PARTQ, PARTKV, (float*)(ctl + CW_KMEAN), ws + WS_KR8, ws + WS_QB8, ws + WS_KB8, ws + WS_VB8, 1.0f};
      pg8::gemm_phase<pg8::EpiProj<1>, pg8::StaticOrder, true, true, true>(ldsl + RING_OFF, g, S, E, wave); }
    { pg8::Gemm g{(const bf16*)H8, (const bf16*)WIN8, M_, IN2, DM / 2}; pg8::StaticOrder S; S.init(M_, IN2, G, bid);
      pg8::EpiProj<2> E{CQ, CKV, KR, QB, KB, VB, GA, GB, COS, SIN, RSTD, PARTQ, PARTKV, (float*)(ctl + CW_KMEAN), ws + WS_KR8, ws + WS_QB8, ws + WS_KB8, ws + WS_VB8, 0.015625f};
      pg8::gemm_phase<pg8::EpiProj<2>, pg8::StaticOrder, true, true, true, true>(ldsl + RING_OFF, g, S, E, wave); }
    GRID_BAR();
    { LAS unsigned* cntL = (LAS unsigned*)(ldsl + RING_OFF); LAS unsigned* baseL = cntL + 64;
      for (int u = bid; u < NBLK * NH; u += G) moba_gate_unit(u & 15, u >> 4, QB, (const float*)(ctl + CW_KMEAN), GCNT, LIST, PML, cntL, baseL, wave); }
    { pg8::Gemm g{CQ, WUQ, M_, QUP, QLORA}; pg8::StaticOrder S; S.init(M_, QUP, G, bid); pg8::EpiQ E{MLA_BF16 ? QM : nullptr, COS, SIN, PARTQ, ws + WS_QM8};
      pg8::gemm_phase<pg8::EpiQ, pg8::StaticOrder, true, true>(ldsl + RING_OFF, g, S, E, wave); }
    { pg8::Gemm g{CKV, WUKV, M_, KVUP, KVLORA}; pg8::StaticOrder S; S.init(M_, KVUP, G, bid); pg8::EpiPlain E{MLA_BF16 ? KV : nullptr, KVUP, PARTKV, ws + WS_KN8, ws + WS_V8};
      pg8::gemm_phase<pg8::EpiPlain, pg8::StaticOrder, true, true>(ldsl + RING_OFF, g, S, E, wave); }
#if PROBE_PHASE == 6
    { pg8::Gemm g{CQ, WUQ, M_, QUP, QLORA}; pg8::StaticOrder S; S.init(M_, QUP, G, bid); pg8::EpiQ E{MLA_BF16 ? QM : nullptr, COS, SIN, PARTQ, ws + WS_QM8};
      pg8::gemm_phase<pg8::EpiQ, pg8::StaticOrder, true, true>(ldsl + RING_OFF, g, S, E, wave); }
    { pg8::Gemm g{CKV, WUKV, M_, KVUP, KVLORA}; pg8::StaticOrder S; S.init(M_, KVUP, G, bid); pg8::EpiPlain E{MLA_BF16 ? KV : nullptr, KVUP, PARTKV, ws + WS_KN8, ws + WS_V8};
      pg8::gemm_phase<pg8::EpiPlain, pg8::StaticOrder, true, true>(ldsl + RING_OFF, g, S, E, wave); }
#endif
    GRID_BAR();
#if I8_FFN2
    p7_attention<7>(lds, ws, pos, G, bid, wave, P7Conv{args, vcu});
#else
    p7_attention<7>(lds, ws, pos, G, bid, wave, NoConv{});
#endif
#if PROBE_PHASE == 7
    p7_attention<7>(lds, ws, pos, G, bid, wave, NoConv{});
#endif
#if PROBE_PHASE == 71
    p7_attention<1>(lds, ws, pos, G, bid, wave, NoConv{});
#endif
#if PROBE_PHASE == 72
    p7_attention<2>(lds, ws, pos, G, bid, wave, NoConv{});
#endif
#if PROBE_PHASE == 74
    p7_attention<4>(lds, ws, pos, G, bid, wave, NoConv{});
#endif
    GRID_BAR();
    { int tid_f = wave * 64 + lane_id_(); asm volatile("" : "+v"(tid_f)); const int tid = tid_f, lane = tid & 63; (void)lane; (void)tid;
    for (int it = gw; it < M_ * NH / 4; it += NGW) { const int pair = it * 4 + (lane >> 4), c8 = lane & 15;
        const f32x4 ml0 = *(const GAS f32x4*)(PML + (size_t)pair * 8), ml1 = *(const GAS f32x4*)(PML + (size_t)pair * 8 + 4);
        const float m[4] = {ml0.x, ml0.z, ml1.x, ml1.z}, l[4] = {ml0.y, ml0.w, ml1.y, ml1.w};
        float mx = -1e30f;
#pragma unroll
        for (int j = 0; j < 4; ++j) if (l[j] > 0.f) mx = fmaxf(mx, m[j]);
        float w[4], wsum = 0.f;
#pragma unroll
        for (int j = 0; j < 4; ++j) { w[j] = l[j] > 0.f ? __builtin_amdgcn_exp2f(m[j] - mx) * l[j] : 0.f; wsum += w[j]; }
        const float inv = 1.0f / wsum; float acc[8] = {0.f, 0.f, 0.f, 0.f, 0.f, 0.f, 0.f, 0.f};
#pragma unroll
        for (int j = 0; j < 4; ++j) { const v4u o = *(const GAS v4u*)(PO + ((size_t)pair * 4 + j) * 128 + c8 * 8); const float wj = w[j] * inv;
            if (w[j] > 0.f) {
#pragma unroll
                for (int e = 0; e < 4; ++e) { acc[2 * e] += wj * bfu_lo(o[e]); acc[2 * e + 1] += wj * bfu_hi(o[e]); } } }
        const int row = pair >> 4, h = pair & 15; v4u r; r.x = pk2(acc[0], acc[1]); r.y = pk2(acc[2], acc[3]); r.z = pk2(acc[4], acc[5]); r.w = pk2(acc[6], acc[7]);
        *(GAS v4u*)(OBC + (size_t)row * MOBAW + h * 128 + c8 * 8) = r;
        { int w0 = 0, w1 = 0;
          w0 = __builtin_amdgcn_cvt_pk_fp8_f32(acc[0] * 16.f, acc[1] * 16.f, w0, false); w0 = __builtin_amdgcn_cvt_pk_fp8_f32(acc[2] * 16.f, acc[3] * 16.f, w0, true);
          w1 = __builtin_amdgcn_cvt_pk_fp8_f32(acc[4] * 16.f, acc[5] * 16.f, w1, false); w1 = __builtin_amdgcn_cvt_pk_fp8_f32(acc[6] * 16.f, acc[7] * 16.f, w1, true);
          v2u q; q.x = (unsigned)w0; q.y = (unsigned)w1; *(GAS v2u*)(OB8 + ((size_t)h * M_ + row) * 128 + c8 * 8) = q; } }
    for (int it = gw * 64 + lane; it < M_ * MLAOUT / 8; it += NGW * 64) { const int row = it >> 8, c8 = it & 255;
        const v4u o = *(const GAS v4u*)(OA + (size_t)row * MLAOUT + c8 * 8); int w0 = 0, w1 = 0;
        w0 = __builtin_amdgcn_cvt_pk_fp8_f32(bfu_lo(o.x) * 16.f, bfu_hi(o.x) * 16.f, w0, false); w0 = __builtin_amdgcn_cvt_pk_fp8_f32(bfu_lo(o.y) * 16.f, bfu_hi(o.y) * 16.f, w0, true);
        w1 = __builtin_amdgcn_cvt_pk_fp8_f32(bfu_lo(o.z) * 16.f, bfu_hi(o.z) * 16.f, w1, false); w1 = __builtin_amdgcn_cvt_pk_fp8_f32(bfu_lo(o.w) * 16.f, bfu_hi(o.w) * 16.f, w1, true);
        v2u q; q.x = (unsigned)w0; q.y = (unsigned)w1; *(GAS v2u*)(OA8 + ((size_t)(c8 >> 4) * M_ + row) * 128 + (c8 & 15) * 8) = q; }
#if PROBE_PHASE == 8 || PROBE_PHASE == 38
    for (int it = gw; it < M_ * NH / 4; it += NGW) { const int pair = it * 4 + (lane >> 4), c8 = lane & 15;
        const f32x4 ml0 = *(const GAS f32x4*)(PML + (size_t)pair * 8), ml1 = *(const GAS f32x4*)(PML + (size_t)pair * 8 + 4);
        const float m[4] = {ml0.x, ml0.z, ml1.x, ml1.z}, l[4] = {ml0.y, ml0.w, ml1.y, ml1.w};
        float mx = -1e30f;
#pragma unroll
        for (int j = 0; j < 4; ++j) if (l[j] > 0.f) mx = fmaxf(mx, m[j]);
        float w[4], wsum = 0.f;
#pragma unroll
        for (int j = 0; j < 4; ++j) { w[j] = l[j] > 0.f ? __builtin_amdgcn_exp2f(m[j] - mx) * l[j] : 0.f; wsum += w[j]; }
        const float inv = 1.0f / wsum; float acc[8] = {0.f, 0.f, 0.f, 0.f, 0.f, 0.f, 0.f, 0.f};
#pragma unroll
        for (int j = 0; j < 4; ++j) { const v4u o = *(const GAS v4u*)(PO + ((size_t)pair * 4 + j) * 128 + c8 * 8); const float wj = w[j] * inv;
            if (w[j] > 0.f) {
#pragma unroll
                for (int e = 0; e < 4; ++e) { acc[2 * e] += wj * bfu_lo(o[e]); acc[2 * e + 1] += wj * bfu_hi(o[e]); } } }
        const int row = pair >> 4, h = pair & 15; v4u r; r.x = pk2(acc[0], acc[1]); r.y = pk2(acc[2], acc[3]); r.z = pk2(acc[4], acc[5]); r.w = pk2(acc[6], acc[7]);
        *(GAS v4u*)(OBC + (size_t)row * MOBAW + h * 128 + c8 * 8) = r;
        { int w0 = 0, w1 = 0;
          w0 = __builtin_amdgcn_cvt_pk_fp8_f32(acc[0] * 16.f, acc[1] * 16.f, w0, false); w0 = __builtin_amdgcn_cvt_pk_fp8_f32(acc[2] * 16.f, acc[3] * 16.f, w0, true);
          w1 = __builtin_amdgcn_cvt_pk_fp8_f32(acc[4] * 16.f, acc[5] * 16.f, w1, false); w1 = __builtin_amdgcn_cvt_pk_fp8_f32(acc[6] * 16.f, acc[7] * 16.f, w1, true);
          v2u q; q.x = (unsigned)w0; q.y = (unsigned)w1; *(GAS v2u*)(OB8 + ((size_t)h * M_ + row) * 128 + c8 * 8) = q; } }
    for (int it = gw * 64 + lane; it < M_ * MLAOUT / 8; it += NGW * 64) { const int row = it >> 8, c8 = it & 255;
        const v4u o = *(const GAS v4u*)(OA + (size_t)row * MLAOUT + c8 * 8); int w0 = 0, w1 = 0;
        w0 = __builtin_amdgcn_cvt_pk_fp8_f32(bfu_lo(o.x) * 16.f, bfu_hi(o.x) * 16.f, w0, false); w0 = __builtin_amdgcn_cvt_pk_fp8_f32(bfu_lo(o.y) * 16.f, bfu_hi(o.y) * 16.f, w0, true);
        w1 = __builtin_amdgcn_cvt_pk_fp8_f32(bfu_lo(o.z) * 16.f, bfu_hi(o.z) * 16.f, w1, false); w1 = __builtin_amdgcn_cvt_pk_fp8_f32(bfu_lo(o.w) * 16.f, bfu_hi(o.w) * 16.f, w1, true);
        v2u q; q.x = (unsigned)w0; q.y = (unsigned)w1; *(GAS v2u*)(OA8 + ((size_t)(c8 >> 4) * M_ + row) * 128 + (c8 & 15) * 8) = q; }
#endif
    }
    GRID_BAR();
#if PROBE_PHASE == 500
    selfcheck(lds, ws, pos, OBC, G, bid);
    GRID_BAR();
#endif
#if FP8_BR
    { pg8::Gemm g{(const bf16*)OA8, WBRA, M_, DM, MLAOUT / 2}; pg8::StaticOrder S; S.init(M_, DM, G, bid); pg8::EpiMerge<false> E{GA, H, nullptr, 0.001953125f};
      pg8::gemm_phase<pg8::EpiMerge<false>, pg8::StaticOrder, true, true, true, true>(ldsl + RING_OFF, g, S, E, wave); }
    { pg8::Gemm g{(const bf16*)OB8, WBRB, M_, DM, MOBAW / 2}; pg8::StaticOrder S; S.init(M_, DM, G, bid); pg8::EpiMerge<true> E{GB, H, FP8_OUT ? MG8 : nullptr, 0.001953125f};
      pg8::gemm_phase<pg8::EpiMerge<true>, pg8::StaticOrder, true, true, true, true>(ldsl + RING_OFF, g, S, E, wave); }
#else
    { pg8::Gemm g{OA, WBRA, M_, DM, MLAOUT}; pg8::StaticOrder S; S.init(M_, DM, G, bid); pg8::EpiMerge<false> E{GA, H, nullptr, 1.0f};
      pg8::gemm_phase<pg8::EpiMerge<false>, pg8::StaticOrder, true, true>(ldsl + RING_OFF, g, S, E, wave); }
    { pg8::Gemm g{OBC, WBRB, M_, DM, MOBAW}; pg8::StaticOrder S; S.init(M_, DM, G, bid); pg8::EpiMerge<true> E{GB, H, FP8_OUT ? MG8 : nullptr, 1.0f};
      pg8::gemm_phase<pg8::EpiMerge<true>, pg8::StaticOrder, true, true>(ldsl + RING_OFF, g, S, E, wave); }
#endif
    GRID_BAR();
#if FP8_OUT
    { pg8::Gemm g{(const bf16*)MG8, WOUT, M_, DM, DM / 2}; pg8::StaticOrder S; S.init(M_, DM, G, bid); pg8::EpiResidNorm<0> E{out, out, 0.0009765625f, H3, args.in[15], PART, PMAX};
      pg8::gemm_phase<pg8::EpiResidNorm<0>, pg8::StaticOrder, true, true, true, true>(ldsl + RING_OFF, g, S, E, wave); }
#else
    { pg8::Gemm g{H, WOUT, M_, DM, DM}; pg8::StaticOrder S; S.init(M_, DM, G, bid); pg8::EpiResidNorm<0> E{out, out, 1.0f, H3, args.in[15], PART, PMAX};
      pg8::gemm_phase<pg8::EpiResidNorm<0>, pg8::StaticOrder, true, true>(ldsl + RING_OFF, g, S, E, wave); }
#endif
    GRID_BAR();
    { int tid_f = wave * 64 + lane_id_(); asm volatile("" : "+v"(tid_f)); const int tid = tid_f, lane = tid & 63; (void)lane; (void)tid;
#if !I8_FFN2
    cvt_job<1>(args.in[16], DM, NFF2, WFI, NFF2 / 64, cvtT, gw, NGW, lane, nullptr, NFF2);
#endif
#if I8_FFN2
    for (int m = gw; m < M_; m += NGW) quant_row_i8(H3, PART, PMAX, H8, m, RSTD, lane);
#else
    rstd_reduce<64>(PART, RSTD, 1.f / DM, vcu, tid, G);
#endif
#if PROBE_PHASE == 11
#if !I8_FFN2
    cvt_job<1>(args.in[16], DM, NFF2, WFI, NFF2 / 64, cvtT, gw, NGW, lane, nullptr, NFF2);
#endif
#if I8_FFN2
    for (int m = gw; m < M_; m += NGW) quant_row_i8(H3, PART, PMAX, H8, m, RSTD, lane);
#else
    rstd_reduce<64>(PART, RSTD, 1.f / DM, vcu, tid, G);
#endif
#endif
    }
    GRID_BAR();
#if I8_FFN2
    { pg8::Gemm g{(const bf16*)H8, (const bf16*)(ws + WS_WFI2), M_, NFF2, DM / 2}; pg8::StaticOrder S; S.init(M_, NFF2, G, bid); pg8::EpiSwiglu E{ACT, DFF, RSTD, M_, CMAX2};
      pg8::gemm_phase<pg8::EpiSwiglu, pg8::StaticOrder, true, true, true, false, true>(ldsl + RING_OFF, g, S, E, wave); }
#else
    { pg8::Gemm g{H3, WFI, M_, NFF2, DM}; pg8::StaticOrder S; S.init(M_, NFF2, G, bid); pg8::EpiSwiglu E{ACT, DFF, RSTD, M_, nullptr};
      pg8::gemm_phase<pg8::EpiSwiglu, pg8::StaticOrder, true, true, true>(ldsl + RING_OFF, g, S, E, wave); }
#endif
    if (G == 256 && bid >= 128) { int tid_f = wave * 64 + lane_id_(); asm volatile("" : "+v"(tid_f)); const int lane = tid_f & 63;
        cvt_job<0>(args.in[17], DFF, DM, WFO, DM / 64, cvtT, (bid - 128) * NWAVES + wave, 128 * NWAVES, lane, nullptr, DM); }
    else if (G != 256) { int tid_f = wave * 64 + lane_id_(); asm volatile("" : "+v"(tid_f)); const int lane = tid_f & 63; cvt_job<0>(args.in[17], DFF, DM, WFO, DM / 64, cvtT, gw, NGW, lane, nullptr, DM); }
    GRID_BAR();
    { pg8::Gemm g{ACT, WFO, M_, DM, DFF}; pg8::StaticOrder S; S.init(M_, DM, G, bid); pg8::EpiResid E{out, out, DM, 0.5f};
      pg8::gemm_phase<pg8::EpiResid, pg8::StaticOrder, true, true, true>(ldsl + RING_OFF, g, S, E, wave); }
    GRID_BAR();
    { int tid_f = wave * 64 + lane_id_(); asm volatile("" : "+v"(tid_f)); const int tid = tid_f, lane = tid & 63; (void)lane; (void)tid;
#if PROBE_PHASE == 500
    if (__hip_atomic_load(ctl + CW_FAIL, RLX_AGENT) > SELFCHECK_TOL) { for (int m = gw; m < M_; m += NGW) for (int j = lane; j < DM; j += 64) out[(size_t)m * DM + j] = __builtin_nanf(""); return; }
#endif
    for (int m = gw; m < M_; m += NGW) rms_row4096<true>(out + (size_t)m * DM, args.in[18], out + (size_t)m * DM, lane);
    }
}

extern "C" void kernel_launch(void* const* d_in, const int* in_sizes, int n_in, void* d_out, int out_size, void* d_ws, size_t ws_size, hipStream_t stream) {
    static int grid = 0;
    if (grid == 0) {
        if (n_in != 19 || out_size != M_ * DM || ws_size < WS_END) { fprintf(stderr, "kernel_launch: unexpected shapes (n_in %d out %d ws %zu need %zu)\n", n_in, out_size, ws_size, (size_t)WS_END); grid = -1; return; }
        int dev = 0, cus = 0;
        if (hipGetDevice(&dev) != hipSuccess || hipDeviceGetAttribute(&cus, hipDeviceAttributeMultiprocessorCount, dev) != hipSuccess) { grid = -1; return; }
        if (hipFuncSetAttribute((const void*)hybrid_fwd, hipFuncAttributeMaxDynamicSharedMemorySize, LDS_BYTES) != hipSuccess) { fprintf(stderr, "kernel_launch: hipFuncSetAttribute failed\n"); grid = -1; return; }
        int per_cu = 0;
        if (hipOccupancyMaxActiveBlocksPerMultiprocessor(&per_cu, (const void*)hybrid_fwd, NWAVES * 64, LDS_BYTES) != hipSuccess || per_cu < 1) { fprintf(stderr, "kernel_launch: occupancy query says %d\n", per_cu); }
        (void)hipGetLastError();
        grid = cus;
    }
    if (grid < 0) return;
    if (hipMemsetAsync((char*)d_ws + WS_CTL, 0, CTL_ZERO_BYTES, stream) != hipSuccess) { fprintf(stderr, "kernel_launch: memset failed\n"); return; }
    Args a{};
    for (int i = 0; i < 19; ++i) a.in[i] = (const float*)d_in[i];
    a.out = (float*)d_out; a.ws = (unsigned char*)d_ws;
    for (int i = 0; i < 32; ++i) a.invf[i] = pow(10000.0, -(double)(2 * i) / 64.0);
    for (int d = 0; d < 136; ++d) { int b;
        if (d < 16) b = d; else { const double dd = d > 128 ? 128.0 : (double)d; b = 16 + (int)(log(dd / 16.0) / log(128.0 / 16.0) * 16.0); if (b > 31) b = 31; }
        a.bucket[d] = (unsigned char)b; }
    hipLaunchKernelGGL(hybrid_fwd, dim3(grid), dim3(NWAVES * 64), LDS_BYTES, stream, a);
    const hipError_t le = hipPeekAtLastError();
    if (le != hipSuccess) fprintf(stderr, "kernel_launch: launch failed: %s\n", hipGetErrorName(le));
}
```

```cpp
#ifndef CMP_REL
#define CMP_REL 0.03f
#define CMP_THR 0.2f
#define CMP_NBAD 0.f
#endif
#ifndef I8_OUT
#define I8_OUT 1
#endif
#ifndef I8_FFN2
#define I8_FFN2 1
#endif
#ifndef FP8_BR
#define FP8_BR 1
#endif
#ifndef FP8_OUT
#define FP8_OUT 0
#endif
#ifndef PROBE_PHASE
#define PROBE_PHASE -1
#endif
#define MLA_BF16 (PROBE_PHASE == 500)
#ifndef SELFCHECK_REL
#define SELFCHECK_REL 0.03f
#define SELFCHECK_ABS 1e-4f
#endif
#ifndef SELFCHECK_TOL
#define SELFCHECK_TOL 0u
#endif
#include <hip/hip_runtime.h>
#include <cstdio>
#include <cstdint>
#include <cmath>
__device__ __forceinline__ int lane_id_() { return (int)__builtin_amdgcn_mbcnt_hi(~0u, __builtin_amdgcn_mbcnt_lo(~0u, 0u)); }
namespace pg8 {
#define PG8_LAS __attribute__((address_space(3)))
typedef unsigned short bf16_t;
typedef short bf16x8 __attribute__((ext_vector_type(8)));
typedef float f32x4 __attribute__((ext_vector_type(4)));
typedef unsigned u32x4 __attribute__((ext_vector_type(4)));
constexpr int BM = 256, BK = 64, HALF = 128, HTB = HALF * BK * 2  , STAGE_BYTES = 8 * HTB, NXCD = 8, WGM = 8;

__host__ __device__ __forceinline__ int lds_byte(int r, int c) { const int st = (r >> 4) * 2 + (c >> 5), rr = r & 15, cc = c & 31, ob = rr * 64 + cc * 2; return st * 1024 + (ob ^ (((ob >> 9) & 1) << 5)); }
__host__ __device__ __forceinline__ void stage_rc(int b, int& R, int& C) { const int st = b / 1024, sb = b % 1024, swz = sb ^ (((sb >> 9) & 1) << 5); R = (st >> 1) * 16 + swz / 64; C = (st & 1) * 32 + (swz % 64) / 2; }
__host__ __device__ __forceinline__ int perm32(int rho) { const int n = rho >> 4, i = rho & 15; return 8 * (i >> 2) + 4 * n + (i & 3); }

struct Unit { int pm, pn; };
struct Gemm { const bf16_t* A; const bf16_t* Bt; int M, N, K; };

struct StaticOrder {
    int nM, nN, nwg, G, c;
    __host__ __device__ void init(int M, int N, int G_, int c_) { nM = M / BM; nN = N / BM; nwg = nM * nN; G = G_; c = c_; }
    __host__ __device__ bool next(int i, Unit& u) const {
        const long L = (long)i * G + c; if (L >= nwg) return false;
        int wgid = (int)L; { const int q = nwg / NXCD, r = nwg % NXCD, xcd = wgid % NXCD, off = wgid / NXCD; wgid = (xcd < r ? xcd * (q + 1) : r * (q + 1) + (xcd - r) * q) + off; }
        const int nig = WGM * nN, gid = wgid / nig, fm = gid * WGM, gsz = (nM - fm) < WGM ? (nM - fm) : WGM;
        u.pm = fm + ((wgid % nig) % gsz); u.pn = (wgid % nig) / gsz; return true;
    }
    __device__ __forceinline__ void a_ready(const Unit&) const {}
    __device__ __forceinline__ void done(const Unit&) const {}
};

__device__ __forceinline__ unsigned cvt_pk_bf16(float lo, float hi) { unsigned r; asm volatile("v_cvt_pk_bf16_f32 %0, %1, %2" : "=v"(r) : "v"(lo), "v"(hi)); return r; }
typedef float f32x2 __attribute__((ext_vector_type(2)));
typedef unsigned u32x2 __attribute__((ext_vector_type(2)));
__device__ __forceinline__ float bf_lo(unsigned w) { return __uint_as_float(w << 16); }
__device__ __forceinline__ float bf_hi(unsigned w) { return __uint_as_float(w & 0xffff0000u); }
__device__ __forceinline__ float sigmoid_f(float x) { return __builtin_amdgcn_rcpf(1.0f + __builtin_amdgcn_exp2f(-1.4426950408889634f * x)); }
__device__ __forceinline__ u32x4 pack8f(f32x4 a, f32x4 b) { u32x4 w; w.x = cvt_pk_bf16(a[0], a[1]); w.y = cvt_pk_bf16(a[2], a[3]); w.z = cvt_pk_bf16(b[0], b[1]); w.w = cvt_pk_bf16(b[2], b[3]); return w; }

__device__ __forceinline__ unsigned pack4_fp8(f32x4 v) { int w = 0; w = __builtin_amdgcn_cvt_pk_fp8_f32(v[0], v[1], w, false); w = __builtin_amdgcn_cvt_pk_fp8_f32(v[2], v[3], w, true); return (unsigned)w; }
struct EpiPlain {
    static constexpr bool PERM = true, AFTER_DRAIN = false; __device__ __forceinline__ bool idem() const { return true; }
    bf16_t* O; int ldc; const float* part8; unsigned char* K8; unsigned char* V8;
    __device__ __forceinline__ void operator()(const f32x4 (&acc)[2][2][4][2], const Unit& u, int wr, int wc, int fr, int fq) const {
        const int row0 = u.pm * BM + wr * 64 + fr, col0 = u.pn * BM + wc * 32 + 8 * fq;
#pragma unroll
        for (int ai = 0; ai < 2; ++ai)
#pragma unroll
            for (int m = 0; m < 4; ++m) { const int row = row0 + ai * HALF + m * 16; bf16_t* rowp = O + (size_t)row * ldc + col0; float sc = 1.f;
                if (part8) { const f32x4* p = (const f32x4*)(part8 + (size_t)row * 8); const f32x4 a = p[0], b = p[1];
                    sc = 1.0f / sqrtf((((a[0] + a[1]) + (a[2] + a[3])) + ((b[0] + b[1]) + (b[2] + b[3]))) * (1.f / 512.f) + 1e-6f); }
#pragma unroll
                for (int bj = 0; bj < 2; ++bj) { const f32x4 v0 = acc[ai][bj][m][0] * sc, v1 = acc[ai][bj][m][1] * sc; if (O) *(u32x4*)(rowp + bj * HALF) = pack8f(v0, v1);
                    if (bj == 0 && K8) { u32x2 w8; w8.x = pack4_fp8(v0); w8.y = pack4_fp8(v1); *(u32x2*)(K8 + (size_t)row * 2048 + u.pn * 128 + wc * 32 + 8 * fq) = w8; }
                    if (bj == 1 && V8) { const int kk = row & 63; const unsigned w0 = pack4_fp8(v0), w1 = pack4_fp8(v1);
                        unsigned char* vp = V8 + ((size_t)(u.pn * 256 + (row >> 6)) * 128 + (wc * 32 + 8 * fq)) * 64 + (((kk >> 2) & 1) * 32 + (kk >> 5) * 16 + ((kk >> 3) & 3) * 4 + (kk & 3));
                        vp[0] = (unsigned char)w0; vp[64] = (unsigned char)(w0 >> 8); vp[128] = (unsigned char)(w0 >> 16); vp[192] = (unsigned char)(w0 >> 24);
                        vp[256] = (unsigned char)w1; vp[320] = (unsigned char)(w1 >> 8); vp[384] = (unsigned char)(w1 >> 16); vp[448] = (unsigned char)(w1 >> 24); } } }
    }
};
struct EpiSwiglu {
    static constexpr bool PERM = true, AFTER_DRAIN = false;
    bf16_t* O; int ldc; const float* rs; int tiledM; const float* cmax;
    __device__ __forceinline__ void operator()(const f32x4 (&acc)[2][2][4][2], const Unit& u, int wr, int wc, int fr, int fq) const {
        const int row0 = u.pm * BM + wr * 64 + fr, col0 = u.pn * HALF + wc * 32 + 8 * fq;
        f32x4 cg[2] = {{1.f, 1.f, 1.f, 1.f}, {1.f, 1.f, 1.f, 1.f}}, cu[2] = {{1.f, 1.f, 1.f, 1.f}, {1.f, 1.f, 1.f, 1.f}};
        if (cmax) {
#pragma unroll
            for (int n = 0; n < 2; ++n) { cg[n] = *(const f32x4*)(cmax + col0 + 4 * n) * (1.f / 127.f); cu[n] = *(const f32x4*)(cmax + (ldc + col0) + 4 * n) * (1.f / 127.f); } }
#pragma unroll
        for (int ai = 0; ai < 2; ++ai)
#pragma unroll
            for (int m = 0; m < 4; ++m) { const int row = row0 + ai * HALF + m * 16;
                bf16_t* rowp = tiledM ? O + ((size_t)(col0 >> 6) * tiledM + row) * 64 + (col0 & 63) : O + (size_t)row * ldc + col0;
                const float sc = rs ? rs[row] : 1.f;
                f32x4 h[2];
#pragma unroll
                for (int n = 0; n < 2; ++n) { f32x4 g = acc[ai][0][m][n], up = acc[ai][1][m][n];
                    if (cmax) { typedef int i32x4_t __attribute__((ext_vector_type(4)));
                        g = __builtin_convertvector(__builtin_bit_cast(i32x4_t, g), f32x4) * cg[n]; up = __builtin_convertvector(__builtin_bit_cast(i32x4_t, up), f32x4) * cu[n]; }
                    g = g * sc; up = up * sc;
#pragma unroll
                    for (int e = 0; e < 4; ++e) h[n][e] = g[e] * sigmoid_f(g[e]) * up[e]; }
                *(u32x4*)rowp = pack8f(h[0], h[1]); }
    }
};

struct EpiSwigluCmp {
    static constexpr bool PERM = true, AFTER_DRAIN = false;
    bf16_t* O; int ldc; int tiledM; float* stats; float thr;
    __device__ __forceinline__ void operator()(const f32x4 (&acc)[2][2][4][2], const Unit& u, int wr, int wc, int fr, int fq) const {
        const int row0 = u.pm * BM + wr * 64 + fr, col0 = u.pn * HALF + wc * 32 + 8 * fq; float sd = 0.f, sh = 0.f, nb = 0.f;
#pragma unroll
        for (int ai = 0; ai < 2; ++ai)
#pragma unroll
            for (int m = 0; m < 4; ++m) { const int row = row0 + ai * HALF + m * 16;
                bf16_t* rowp = O + ((size_t)(col0 >> 6) * tiledM + row) * 64 + (col0 & 63);
                const u32x4 old = *(const u32x4*)rowp; const float ov[8] = {bf_lo(old.x), bf_hi(old.x), bf_lo(old.y), bf_hi(old.y), bf_lo(old.z), bf_hi(old.z), bf_lo(old.w), bf_hi(old.w)};
                f32x4 h[2];
#pragma unroll
                for (int n = 0; n < 2; ++n) { const f32x4 g = acc[ai][0][m][n], up = acc[ai][1][m][n];
#pragma unroll
                    for (int e = 0; e < 4; ++e) { h[n][e] = g[e] * sigmoid_f(g[e]) * up[e]; const float d = h[n][e] - ov[4 * n + e]; sd += d * d; sh += h[n][e] * h[n][e]; nb += fabsf(d) > thr ? 1.f : 0.f; } }
                *(u32x4*)rowp = pack8f(h[0], h[1]); }
#pragma unroll
        for (int o = 1; o < 64; o <<= 1) { sd += __shfl_xor(sd, o); sh += __shfl_xor(sh, o); nb += __shfl_xor(nb, o); }
        if (fr == 0 && fq == 0) { atomicAdd(stats, sd); atomicAdd(stats + 1, sh); atomicAdd(stats + 2, nb); }
    }
};
struct EpiNull {
    static constexpr bool PERM = false, AFTER_DRAIN = false;
    __device__ __forceinline__ void operator()(const f32x4 (&acc)[2][2][4][2], const Unit&, int, int, int, int) const {
#pragma unroll
        for (int ai = 0; ai < 2; ++ai)
#pragma unroll
            for (int bj = 0; bj < 2; ++bj)
#pragma unroll
                for (int m = 0; m < 4; ++m)
#pragma unroll
                    for (int n = 0; n < 2; ++n) asm volatile("" :: "v"(acc[ai][bj][m][n]));
    }
};
struct EpiResid {
    static constexpr bool PERM = false, AFTER_DRAIN = false;
    const float* base; float* out; int ldc; float s;
    __device__ __forceinline__ void operator()(const f32x4 (&acc)[2][2][4][2], const Unit& u, int wr, int wc, int fr, int fq) const {
        const int row0 = u.pm * BM + wr * 64 + fr, col0 = u.pn * BM + wc * 32 + 4 * fq;
#pragma unroll
        for (int ai = 0; ai < 2; ++ai)
#pragma unroll
            for (int m = 0; m < 4; ++m) { const size_t off = (size_t)(row0 + ai * HALF + m * 16) * ldc + col0;
#pragma unroll
                for (int bj = 0; bj < 2; ++bj)
#pragma unroll
                    for (int n = 0; n < 2; ++n) { const f32x4 b = *(const f32x4*)(base + off + bj * HALF + n * 16); *(f32x4*)(out + off + bj * HALF + n * 16) = b + acc[ai][bj][m][n] * s; } }
    }
};
template <long F8, bool I8E = false> struct EpiResidNorm {
    static constexpr bool PERM = false, AFTER_DRAIN = false;
    const float* base; float* out; float s; bf16_t* hb; const float* gain; float* part; float* pmax;
    const float* rsm; const float* cmx;
    __device__ __forceinline__ void operator()(const f32x4 (&acc)[2][2][4][2], const Unit& u, int wr, int wc, int fr, int fq) const {
        constexpr int ldc = 4096, hbM = 16384;
        const int row0 = u.pm * BM + wr * 64 + fr, col0 = u.pn * BM + wc * 32 + 4 * fq;
        f32x4 gv[2][2];
#pragma unroll
        for (int bj = 0; bj < 2; ++bj)
#pragma unroll
            for (int n = 0; n < 2; ++n) gv[bj][n] = *(const f32x4*)(gain + col0 + bj * HALF + n * 16);
        f32x4 cv[2][2];
        if constexpr (I8E) {
#pragma unroll
            for (int bj = 0; bj < 2; ++bj)
#pragma unroll
                for (int n = 0; n < 2; ++n) cv[bj][n] = *(const f32x4*)(cmx + col0 + bj * HALF + n * 16) * (s * (1.f / 127.f)); }
#pragma unroll
        for (int ai = 0; ai < 2; ++ai)
#pragma unroll
            for (int m = 0; m < 4; ++m) { const int row = row0 + ai * HALF + m * 16; const size_t off = (size_t)row * ldc + col0; float ss = 0.f, mx = 0.f;
                float rsr = 0.f; if constexpr (I8E) rsr = rsm[row];
#pragma unroll
                for (int bj = 0; bj < 2; ++bj)
#pragma unroll
                    for (int n = 0; n < 2; ++n) { const f32x4 b = *(const f32x4*)(base + off + bj * HALF + n * 16); f32x4 o;
                        if constexpr (I8E) { typedef int i32x4_t __attribute__((ext_vector_type(4)));
                            o = b + __builtin_convertvector(__builtin_bit_cast(i32x4_t, acc[ai][bj][m][n]), f32x4) * (cv[bj][n] * rsr); }
                        else o = b + acc[ai][bj][m][n] * s;
                        *(f32x4*)(out + off + bj * HALF + n * 16) = o;
                        ss += (o[0] * o[0] + o[1] * o[1]) + (o[2] * o[2] + o[3] * o[3]); const f32x4 y = o * gv[bj][n];
                        mx = fmaxf(fmaxf(mx, fmaxf(fabsf(y[0]), fabsf(y[1]))), fmaxf(fabsf(y[2]), fabsf(y[3])));
                        u32x2 w; w.x = cvt_pk_bf16(y[0], y[1]); w.y = cvt_pk_bf16(y[2], y[3]);
                        const int col = col0 + bj * HALF + n * 16;
                        *(u32x2*)(hb + ((size_t)(col >> 6) * hbM + row) * 64 + (col & 63)) = w;
                        if constexpr (F8 != 0) *(unsigned*)((unsigned char*)hb + F8 + ((size_t)(col >> 7) * hbM + row) * 128 + (col & 127)) = pack4_fp8(y); }
                ss += __shfl_xor(ss, 16); ss += __shfl_xor(ss, 32); if (fq == 0) part[(size_t)row * 64 + u.pn * 4 + wc] = ss;
                if (pmax) { mx = fmaxf(mx, __shfl_xor(mx, 16)); mx = fmaxf(mx, __shfl_xor(mx, 32)); if (fq == 0) pmax[(size_t)row * 64 + u.pn * 4 + wc] = mx; } }
    }
};
template <int MODE_> struct EpiProj {
    static constexpr bool PERM = true, AFTER_DRAIN = false; static constexpr int mode = MODE_; __device__ __forceinline__ bool idem() const { return true; }
    bf16_t *cq, *ckv, *kr, *qb, *kb, *vb, *ga, *gb; const float* cosT; const float* sinT; const float* rs; float* partq; float* partkv; float* kmean; unsigned char* kr8; unsigned char* qb8; unsigned char* kb8; unsigned char* vb8;
    float post;
    __device__ __forceinline__ void operator()(const f32x4 (&acc)[2][2][4][2], const Unit& u, int wr, int wc, int fr, int fq) const {
        const int row0 = u.pm * BM + wr * 64 + fr; const int pn = mode == 1 ? (u.pn == 22 ? 62 : u.pn) : u.pn + 22;
        if (mode == 1 && pn == 62) {
            if (wc < 2) { const int g = wc * 4 + fq;
#pragma unroll
                for (int ai = 0; ai < 2; ++ai)
#pragma unroll
                    for (int m = 0; m < 4; ++m) { const int row = row0 + ai * HALF + m * 16;
                        const f32x4 c = *(const f32x4*)(cosT + (size_t)row * 32 + 4 * g), s = *(const f32x4*)(sinT + (size_t)row * 32 + 4 * g);
                        const float sc = rs[row] * post;
                        const f32x4 x1 = acc[ai][0][m][0] * sc, x2 = acc[ai][0][m][1] * sc;
                        const f32x4 o1 = x1 * c - x2 * s, o2 = x2 * c + x1 * s;
                        u32x2 w1, w2; w1.x = cvt_pk_bf16(o1[0], o1[1]); w1.y = cvt_pk_bf16(o1[2], o1[3]); w2.x = cvt_pk_bf16(o2[0], o2[1]); w2.y = cvt_pk_bf16(o2[2], o2[3]);
                        *(u32x2*)(kr + (size_t)row * 64 + 4 * g) = w1; *(u32x2*)(kr + (size_t)row * 64 + 32 + 4 * g) = w2;
                        *(unsigned*)(kr8 + (size_t)row * 64 + 4 * g) = pack4_fp8(o1); *(unsigned*)(kr8 + (size_t)row * 64 + 32 + 4 * g) = pack4_fp8(o2); } }
            return; }
        bf16_t* base; int ldc, colt; bool sig = false;
        if (pn < 4) { base = cq; ldc = 1024; colt = pn * BM; }
        else if (pn < 6) { base = ckv; ldc = 512; colt = (pn - 4) * BM; }
        else if (pn < 14) { base = qb; ldc = 2048; colt = (pn - 6) * BM; }
        else if (pn < 22) { base = kb; ldc = 2048; colt = (pn - 14) * BM; }
        else if (pn < 30) { base = vb; ldc = 2048; colt = (pn - 22) * BM; }
        else if (pn < 46) { base = ga; ldc = 4096; colt = (pn - 30) * BM; sig = true; }
        else { base = gb; ldc = 4096; colt = (pn - 46) * BM; sig = true; }
        const int col0 = colt + wc * 32 + 8 * fq;
        float* part = mode != 1 ? nullptr : (pn < 4 ? partq + pn * 4 + wc : (pn < 6 ? partkv + (pn - 4) * 4 + wc : nullptr)); const int pstride = pn < 4 ? 16 : 8;
        const bool iskb = mode == 1 && pn >= 14 && pn < 22; f32x4 cs[2][2] = {};
        const bool isvb = mode == 2 && pn < 30;
        unsigned char* f8p = mode == 1 && pn >= 6 && pn < 22 ? (pn < 14 ? qb8 : kb8) : nullptr;
#pragma unroll
        for (int ai = 0; ai < 2; ++ai)
#pragma unroll
            for (int m = 0; m < 4; ++m) { const int row = row0 + ai * HALF + m * 16; bf16_t* rowp = base + (size_t)row * ldc + col0; const float sc = rs[row] * post; float ss = 0.f;
#pragma unroll
                for (int bj = 0; bj < 2; ++bj) { f32x4 v0 = acc[ai][bj][m][0] * sc, v1 = acc[ai][bj][m][1] * sc;
                    if (sig) {
#pragma unroll
                        for (int e = 0; e < 4; ++e) { v0[e] = sigmoid_f(v0[e]); v1[e] = sigmoid_f(v1[e]); } }
                    if (part) ss += ((v0[0] * v0[0] + v0[1] * v0[1]) + (v0[2] * v0[2] + v0[3] * v0[3])) + ((v1[0] * v1[0] + v1[1] * v1[1]) + (v1[2] * v1[2] + v1[3] * v1[3]));
                    if (iskb) { cs[bj][0] += v0; cs[bj][1] += v1; }
                    if (f8p) { u32x2 w8; w8.x = pack4_fp8(v0); w8.y = pack4_fp8(v1); *(u32x2*)(f8p + (size_t)row * 2048 + col0 + bj * HALF) = w8; }
                    if (isvb) { const int kk = row & 63; const unsigned w0 = pack4_fp8(v0), w1 = pack4_fp8(v1);
                        unsigned char* vp = vb8 + ((size_t)((2 * (pn - 22) + bj) * 256 + (row >> 6)) * 128 + (wc * 32 + 8 * fq)) * 64 + (((kk >> 2) & 1) * 32 + (kk >> 5) * 16 + ((kk >> 3) & 3) * 4 + (kk & 3));
                        vp[0] = (unsigned char)w0; vp[64] = (unsigned char)(w0 >> 8); vp[128] = (unsigned char)(w0 >> 16); vp[192] = (unsigned char)(w0 >> 24);
                        vp[256] = (unsigned char)w1; vp[320] = (unsigned char)(w1 >> 8); vp[384] = (unsigned char)(w1 >> 16); vp[448] = (unsigned char)(w1 >> 24); }
                    if (!isvb || MLA_BF16) *(u32x4*)(rowp + bj * HALF) = pack8f(v0, v1); }
                if (part) { ss += __shfl_xor(ss, 16); ss += __shfl_xor(ss, 32); if (fq == 0) part[(size_t)row * pstride] = ss; } }
        if (iskb) {
#pragma unroll
            for (int bj = 0; bj < 2; ++bj)
#pragma unroll
                for (int n = 0; n < 2; ++n)
#pragma unroll
                    for (int e2 = 0; e2 < 4; ++e2) { float c = cs[bj][n][e2];
                        c += __shfl_xor(c, 1); c += __shfl_xor(c, 2); c += __shfl_xor(c, 4); c += __shfl_xor(c, 8);
                        if (fr == 0) atomicAdd(kmean + (size_t)((2 * (pn - 14) + bj) * 64 + u.pm) * 128 + wc * 32 + 8 * fq + 4 * n + e2, c * (1.f / 256.f)); }
        }
    }
};
struct EpiQ {
    static constexpr bool PERM = true, AFTER_DRAIN = false; __device__ __forceinline__ bool idem() const { return true; }
    bf16_t* Q; const float* cosT; const float* sinT; const float* partq; unsigned char* Q8;
    __device__ __forceinline__ float rstd_of(int row) const { const f32x4* p = (const f32x4*)(partq + (size_t)row * 16); const f32x4 a = p[0], b = p[1], c = p[2], d = p[3];
        const float s = ((a[0] + a[1]) + (a[2] + a[3])) + ((b[0] + b[1]) + (b[2] + b[3])) + ((c[0] + c[1]) + (c[2] + c[3])) + ((d[0] + d[1]) + (d[2] + d[3])); return 1.0f / sqrtf(s * (1.f / 1024.f) + 1e-6f); }
    __device__ __forceinline__ void operator()(const f32x4 (&acc)[2][2][4][2], const Unit& u, int wr, int wc, int fr, int fq) const {
        const int row0 = u.pm * BM + wr * 64 + fr;
        float rsv[2][4];
#pragma unroll
        for (int ai = 0; ai < 2; ++ai)
#pragma unroll
            for (int m = 0; m < 4; ++m) rsv[ai][m] = rstd_of(row0 + ai * HALF + m * 16);
#pragma unroll
        for (int bj = 0; bj < 2; ++bj) {
            const int cw = u.pn * BM + bj * HALF + wc * 32;
            const int hc = cw % 192, hb = cw - hc;
            if (hc < 128) {
#pragma unroll
                for (int ai = 0; ai < 2; ++ai)
#pragma unroll
                    for (int m = 0; m < 4; ++m) { const int row = row0 + ai * HALF + m * 16; const float sc = rsv[ai][m];
                        const f32x4 q0 = acc[ai][bj][m][0] * sc, q1 = acc[ai][bj][m][1] * sc;
                        if (Q) *(u32x4*)(Q + (size_t)row * 3072 + cw + 8 * fq) = pack8f(q0, q1);
                        u32x2 w8; w8.x = pack4_fp8(q0); w8.y = pack4_fp8(q1); *(u32x2*)(Q8 + (size_t)row * 3072 + cw + 8 * fq) = w8; }
            } else {
                const int g = ((hc - 128) >> 3) + fq;
#pragma unroll
                for (int ai = 0; ai < 2; ++ai)
#pragma unroll
                    for (int m = 0; m < 4; ++m) { const int row = row0 + ai * HALF + m * 16;
                        const f32x4 c = *(const f32x4*)(cosT + (size_t)row * 32 + 4 * g), s = *(const f32x4*)(sinT + (size_t)row * 32 + 4 * g);
                        const float sc = rsv[ai][m];
                        const f32x4 x1 = acc[ai][bj][m][0] * sc, x2 = acc[ai][bj][m][1] * sc;
                        const f32x4 o1 = x1 * c - x2 * s, o2 = x2 * c + x1 * s;
                        if (Q) { u32x2 w1, w2; w1.x = cvt_pk_bf16(o1[0], o1[1]); w1.y = cvt_pk_bf16(o1[2], o1[3]); w2.x = cvt_pk_bf16(o2[0], o2[1]); w2.y = cvt_pk_bf16(o2[2], o2[3]);
                            bf16_t* qp = Q + (size_t)row * 3072 + hb + 128 + 4 * g;
                            *(u32x2*)qp = w1; *(u32x2*)(qp + 32) = w2; }
                        unsigned char* q8p = Q8 + (size_t)row * 3072 + hb + 128 + 4 * g; *(unsigned*)q8p = pack4_fp8(o1); *(unsigned*)(q8p + 32) = pack4_fp8(o2); }
            }
        }
    }
};
template <bool ADD> struct EpiMerge {
    static constexpr bool PERM = true, AFTER_DRAIN = false; const bf16_t* gate; bf16_t* T; unsigned char* O8; float post;
    __device__ __forceinline__ void operator()(const f32x4 (&acc)[2][2][4][2], const Unit& u, int wr, int wc, int fr, int fq) const {
        const int row0 = u.pm * BM + wr * 64 + fr, col0 = u.pn * BM + wc * 32 + 8 * fq;
#pragma unroll
        for (int ai = 0; ai < 2; ++ai)
#pragma unroll
            for (int m = 0; m < 4; ++m) { const int row = row0 + ai * HALF + m * 16; const size_t off = (size_t)row * 4096 + col0;
#pragma unroll
                for (int bj = 0; bj < 2; ++bj) { const u32x4 gw = *(const u32x4*)(gate + off + bj * HALF);
                    f32x4 v0 = acc[ai][bj][m][0] * post, v1 = acc[ai][bj][m][1] * post;
                    v0[0] *= bf_lo(gw.x); v0[1] *= bf_hi(gw.x); v0[2] *= bf_lo(gw.y); v0[3] *= bf_hi(gw.y);
                    v1[0] *= bf_lo(gw.z); v1[1] *= bf_hi(gw.z); v1[2] *= bf_lo(gw.w); v1[3] *= bf_hi(gw.w);
                    if (ADD) { const u32x4 pw = *(const u32x4*)(T + off + bj * HALF);
                        v0[0] += bf_lo(pw.x); v0[1] += bf_hi(pw.x); v0[2] += bf_lo(pw.y); v0[3] += bf_hi(pw.y);
                        v1[0] += bf_lo(pw.z); v1[1] += bf_hi(pw.z); v1[2] += bf_lo(pw.w); v1[3] += bf_hi(pw.w);
                        if (O8) { const int col = col0 + bj * HALF; u32x2 q; q.x = pack4_fp8(v0 * 16.f); q.y = pack4_fp8(v1 * 16.f);
                            *(u32x2*)(O8 + ((size_t)(col >> 7) * 16384 + row) * 128 + (col & 127)) = q; }
                        else *(u32x4*)(T + off + bj * HALF) = pack8f(v0, v1); }
                    else *(u32x4*)(T + off + bj * HALF) = pack8f(v0, v1); } }
    }
};
template <class Epi, class Sched, bool ALIGN_EPI = false, bool SP2 = false, bool TILED = false, bool FP8 = false, bool I8 = false>
__device__ __forceinline__ void gemm_phase(PG8_LAS unsigned char* lds, const Gemm g, const Sched S, const Epi E, int wv) {
    int tid_ = wv * 64 + lane_id_(); asm volatile("" : "+v"(tid_)); const int tid = tid_, wid = wv, lane = tid & 63, wr = wid >> 2, wc = wid & 3, fr = lane & 15, fq = lane >> 4;
    const int K = g.K, nt = K / BK;
    unsigned voffA[2], voffB[2];
#pragma unroll
    for (int i = 0; i < 2; ++i) { int R, C; stage_rc(tid * 16 + i * 8192, R, C); const int Rb = Epi::PERM ? ((R & ~31) + perm32(R & 31)) : R;
        voffA[i] = (unsigned)(R * (TILED ? BK : K) + C) * 2u; voffB[i] = (unsigned)(Rb * (TILED ? BK : K) + C) * 2u; }
    const size_t kstepA = TILED ? (size_t)g.M * BK * 2 : (size_t)(BK * 2), kstepB = TILED ? (size_t)g.N * BK * 2 : (size_t)(BK * 2);
    const size_t hstep = TILED ? (size_t)HALF * BK * 2 : (size_t)HALF * K * 2;
    const size_t tstep = 2 * hstep;
    const unsigned ldsw = (unsigned)wid * 1024u;
    const int aoff = lds_byte(wr * 64 + fr, fq * 8), boff = lds_byte(wc * 32 + fr, fq * 8);
#define PG8_SA(b, h) (((b) * 2 + (h)) * HTB)
#define PG8_SB(b, h) ((4 + (b) * 2 + (h)) * HTB)
#define PG8_STAGE(bufoff, gbase, voff) do { _Pragma("unroll") for (int _i = 0; _i < 2; ++_i) \
        __builtin_amdgcn_global_load_lds((const unsigned*)((const char*)(gbase) + (voff)[_i]), (PG8_LAS unsigned*)(lds + (bufoff) + ldsw + _i * 8192), 16, 0, 0); } while (0)
#define PG8_LDA(dst, b, h) do { _Pragma("unroll") for (int m = 0; m < 4; ++m) { if constexpr (FP8) { \
            dst##8[m].lo = *(const PG8_LAS v4i_t*)(lds + PG8_SA(b, h) + aoff + m * 2048); dst##8[m].hi = *(const PG8_LAS v4i_t*)(lds + PG8_SA(b, h) + aoff + m * 2048 + 1024); } \
        else { _Pragma("unroll") for (int k = 0; k < 2; ++k) dst[m][k] = *(const PG8_LAS bf16x8*)(lds + PG8_SA(b, h) + aoff + m * 2048 + k * 1024); } } } while (0)
#define PG8_LDB(dst, b, h) do { _Pragma("unroll") for (int n = 0; n < 2; ++n) { if constexpr (FP8) { \
            dst##8[n].lo = *(const PG8_LAS v4i_t*)(lds + PG8_SB(b, h) + boff + n * 2048); dst##8[n].hi = *(const PG8_LAS v4i_t*)(lds + PG8_SB(b, h) + boff + n * 2048 + 1024); } \
        else { _Pragma("unroll") for (int k = 0; k < 2; ++k) dst[n][k] = *(const PG8_LAS bf16x8*)(lds + PG8_SB(b, h) + boff + n * 2048 + k * 1024); } } } while (0)
#define PG8_MMA(ai, bj, At, Bt) do { __builtin_amdgcn_s_setprio(1); \
        if constexpr (I8) {   \
            _Pragma("unroll") for (int k = 0; k < 2; ++k) _Pragma("unroll") for (int m = 0; m < 4; ++m) _Pragma("unroll") for (int n = 0; n < 2; ++n) \
                acc[ai][bj][m][n] = __builtin_bit_cast(f32x4, __builtin_amdgcn_mfma_i32_16x16x64_i8(__builtin_bit_cast(v4i_t, Bt[n][k]), __builtin_bit_cast(v4i_t, At[m][k]), __builtin_bit_cast(v4i_t, acc[ai][bj][m][n]), 0, 0, 0)); } \
        else { _Pragma("unroll") for (int m = 0; m < 4; ++m) _Pragma("unroll") for (int n = 0; n < 2; ++n) { \
            if constexpr (FP8) asm volatile("v_mfma_scale_f32_16x16x128_f8f6f4 %0, %1, %2, %0, %3, %3 op_sel_hi:[0,0,0]" : "+v"(acc[ai][bj][m][n]) : "v"(Bt##8[n]), "v"(At##8[m]), "v"(f8scale));   \
            else { _Pragma("unroll") for (int k = 0; k < 2; ++k) acc[ai][bj][m][n] = __builtin_amdgcn_mfma_f32_16x16x32_bf16(Bt[n][k], At[m][k], acc[ai][bj][m][n], 0, 0, 0); } } } \
        __builtin_amdgcn_s_setprio(0); } while (0)
#define PG8_WAIT_V(n) asm volatile("s_waitcnt vmcnt(" #n ")" ::: "memory")
#define PG8_WAIT_L(n) asm volatile("s_waitcnt lgkmcnt(" #n ")" ::: "memory")
#define PG8_BAR __builtin_amdgcn_s_barrier()
#define PG8_SCHED __builtin_amdgcn_sched_barrier(0)
    Unit cur, nxt; int ui = 0;
    if (!S.next(0, cur)) return;
    f32x4 acc[2][2][4][2];
#pragma unroll
    for (int a = 0; a < 2; ++a)
#pragma unroll
        for (int b = 0; b < 2; ++b)
#pragma unroll
            for (int m = 0; m < 4; ++m)
#pragma unroll
                for (int n = 0; n < 2; ++n) acc[a][b][m][n] = (f32x4){0.f, 0.f, 0.f, 0.f};
    typedef int v8i_t __attribute__((ext_vector_type(8))); typedef int v4i_t __attribute__((ext_vector_type(4)));
    int f8scale = 0x7f7f7f7f; asm volatile("" : "+v"(f8scale));
    bf16x8 At[4][2], B0[2][2], B1[2][2]; v8i_t At8[4], B08[2], B18[2];
    const char* cA = (const char*)g.A + (size_t)cur.pm * tstep; const char* cB = (const char*)g.Bt + (size_t)cur.pn * tstep;
    S.a_ready(cur);
    if constexpr (SP2) {
        PG8_STAGE(PG8_SB(0, 0), cB, voffB); PG8_STAGE(PG8_SB(0, 1), cB + hstep, voffB); PG8_STAGE(PG8_SA(0, 0), cA, voffA); PG8_STAGE(PG8_SA(0, 1), cA + hstep, voffA);
        if (wr == 1) PG8_BAR;
        PG8_WAIT_V(2); PG8_BAR;
        PG8_STAGE(PG8_SB(1, 0), cB + kstepB, voffB); PG8_STAGE(PG8_SA(1, 0), cA + kstepA, voffA); PG8_STAGE(PG8_SB(1, 1), cB + hstep + kstepB, voffB);
        PG8_WAIT_V(6); PG8_BAR;
    } else {
        PG8_STAGE(PG8_SB(0, 0), cB, voffB); PG8_STAGE(PG8_SA(0, 0), cA, voffA); PG8_STAGE(PG8_SB(0, 1), cB + hstep, voffB); PG8_STAGE(PG8_SA(0, 1), cA + hstep, voffA);
        if (wr == 1) PG8_BAR;
        PG8_WAIT_V(4); PG8_BAR;
        PG8_STAGE(PG8_SB(1, 0), cB + kstepB, voffB); PG8_STAGE(PG8_SA(1, 0), cA + kstepA, voffA); PG8_STAGE(PG8_SB(1, 1), cB + hstep + kstepB, voffB);
        PG8_WAIT_V(6); PG8_BAR;
    }
    for (;;) {
        const bool has_next = S.next(ui + 1, nxt);
        const char* nA = has_next ? (const char*)g.A + (size_t)nxt.pm * tstep : cA; const char* nB = has_next ? (const char*)g.Bt + (size_t)nxt.pn * tstep : cB;
        for (int t = 0; t < nt; t += 2) {
            const bool last = (t == nt - 2);
            const char* a1 = cA + (size_t)(t + 1) * kstepA;
            const char* a2 = last ? nA : cA + (size_t)(t + 2) * kstepA; const char* b2 = last ? nB : cB + (size_t)(t + 2) * kstepB;
            const char* a3 = a2 + kstepA; const char* b3 = b2 + kstepB;
            if (last && has_next) S.a_ready(nxt);
            if constexpr (SP2) {
            PG8_LDB(B0, 0, 0); PG8_LDB(B1, 0, 1); PG8_SCHED; PG8_LDA(At, 0, 0); PG8_STAGE(PG8_SA(1, 1), a1 + hstep, voffA);
            PG8_WAIT_V(8); PG8_WAIT_L(0); PG8_BAR; PG8_MMA(0, 0, At, B0); PG8_MMA(0, 1, At, B1); PG8_BAR; PG8_SCHED;
            PG8_LDA(At, 0, 1); PG8_STAGE(PG8_SB(0, 0), b2, voffB); PG8_STAGE(PG8_SB(0, 1), b2 + hstep, voffB); PG8_STAGE(PG8_SA(0, 0), a2, voffA);
            PG8_WAIT_V(8); PG8_WAIT_L(0); PG8_BAR; PG8_MMA(1, 0, At, B0); PG8_MMA(1, 1, At, B1); PG8_BAR; PG8_SCHED;
            PG8_LDB(B0, 1, 0); PG8_LDB(B1, 1, 1); PG8_SCHED; PG8_LDA(At, 1, 0); PG8_STAGE(PG8_SA(0, 1), a2 + hstep, voffA);
            PG8_WAIT_V(8); PG8_WAIT_L(0); PG8_BAR; PG8_MMA(0, 0, At, B0); PG8_MMA(0, 1, At, B1); PG8_BAR; PG8_SCHED;
            PG8_LDA(At, 1, 1); PG8_STAGE(PG8_SB(1, 0), b3, voffB); PG8_STAGE(PG8_SB(1, 1), b3 + hstep, voffB); PG8_STAGE(PG8_SA(1, 0), a3, voffA);
            PG8_WAIT_V(8); PG8_WAIT_L(0); PG8_BAR; PG8_MMA(1, 0, At, B0); PG8_MMA(1, 1, At, B1); PG8_BAR; PG8_SCHED;
            } else {
            PG8_LDB(B0, 0, 0); PG8_SCHED; PG8_LDA(At, 0, 0); PG8_STAGE(PG8_SA(1, 1), a1 + hstep, voffA);
            PG8_WAIT_L(8); PG8_BAR; PG8_WAIT_L(0); PG8_MMA(0, 0, At, B0); PG8_BAR; PG8_SCHED;
            PG8_LDB(B1, 0, 1); PG8_STAGE(PG8_SB(0, 0), b2, voffB);
            PG8_BAR; PG8_WAIT_L(0); PG8_MMA(0, 1, At, B1); PG8_BAR;
            PG8_LDA(At, 0, 1); PG8_STAGE(PG8_SA(0, 0), a2, voffA);
            PG8_BAR; PG8_WAIT_L(0); PG8_MMA(1, 0, At, B0); PG8_BAR; PG8_SCHED;
            PG8_STAGE(PG8_SB(0, 1), b2 + hstep, voffB);
            PG8_WAIT_V(6); PG8_BAR; PG8_MMA(1, 1, At, B1); PG8_BAR;
            PG8_LDB(B0, 1, 0); PG8_SCHED; PG8_LDA(At, 1, 0); PG8_STAGE(PG8_SA(0, 1), a2 + hstep, voffA);
            PG8_WAIT_L(8); PG8_BAR; PG8_WAIT_L(0); PG8_MMA(0, 0, At, B0); PG8_BAR; PG8_SCHED;
            PG8_LDB(B1, 1, 1); PG8_STAGE(PG8_SB(1, 0), b3, voffB);
            PG8_BAR; PG8_WAIT_L(0); PG8_MMA(0, 1, At, B1); PG8_BAR;
            PG8_LDA(At, 1, 1); PG8_STAGE(PG8_SA(1, 0), a3, voffA);
            PG8_BAR; PG8_WAIT_L(0); PG8_MMA(1, 0, At, B0); PG8_BAR; PG8_SCHED;
            PG8_STAGE(PG8_SB(1, 1), b3 + hstep, voffB);
            PG8_WAIT_V(6); PG8_BAR; PG8_MMA(1, 1, At, B1); PG8_BAR;
            }
        }
        if constexpr (FP8 || I8) asm volatile("s_nop 15\n\ts_nop 7" ::: "memory");
        if constexpr (ALIGN_EPI) { if (wr == 0) PG8_BAR; }
        if constexpr (!Epi::AFTER_DRAIN) { int fr_e = fr, fq_e = fq; asm volatile("" : "+v"(fr_e), "+v"(fq_e));
            E(acc, cur, wr, wc, fr_e, fq_e); S.done(cur); }
        if (!has_next) break;
#pragma unroll
        for (int a = 0; a < 2; ++a)
#pragma unroll
            for (int b = 0; b < 2; ++b)
#pragma unroll
                for (int m = 0; m < 4; ++m)
#pragma unroll
                    for (int n = 0; n < 2; ++n) acc[a][b][m][n] = (f32x4){0.f, 0.f, 0.f, 0.f};
        cur = nxt; cA = nA; cB = nB; ++ui;
        if constexpr (ALIGN_EPI) { if (wr == 1) PG8_BAR; }
    }
    PG8_WAIT_V(0);
    if constexpr (!ALIGN_EPI) { if (wr == 0) PG8_BAR; }
    PG8_BAR;
    if constexpr (Epi::AFTER_DRAIN) { E.fused(acc, cur, wr, wc, fr, fq, lds, wid, lane); S.done(cur); }
#undef PG8_SA
#undef PG8_SB
#undef PG8_STAGE
#undef PG8_LDA
#undef PG8_LDB
#undef PG8_MMA
#undef PG8_WAIT_V
#undef PG8_WAIT_L
#undef PG8_BAR
#undef PG8_SCHED
}
}
namespace att {
typedef unsigned short bf16_t;
typedef short bf16x8 __attribute__((ext_vector_type(8)));
typedef short s16x4 __attribute__((ext_vector_type(4)));
typedef float f32x16 __attribute__((ext_vector_type(16)));
typedef float f32x4 __attribute__((ext_vector_type(4)));
typedef unsigned u32x4 __attribute__((ext_vector_type(4)));
typedef int i32x4 __attribute__((ext_vector_type(4)));
#define ASBAR() __builtin_amdgcn_sched_barrier(0)
constexpr int VT_BYTES = 16384;
constexpr int L_V = 0, L_K = 2 * VT_BYTES;
constexpr int KT_MAX = 64 * 192 * 2;
constexpr int L_WS = L_K + 2 * KT_MAX;
constexpr int L_BIAS = L_WS + 8 * 128 * 4;
constexpr int L_PREF = L_BIAS + 16 * 132 * 4;
constexpr int L_CNT = L_PREF + 1040 * 4 + 64;
constexpr int L_END = L_CNT + 1024 * 4;
constexpr float LOG2E = 1.4426950408889634f;
constexpr float THR2 = 6.0f;

__device__ __forceinline__ int v_st(int k, int c) { const int kk = (k & ~0xC) | ((k & 4) << 1) | ((k & 8) >> 1); return ((kk >> 3) * 4 + (c >> 5)) * 512 + ((kk & 7) * 32 + (c & 31)) * 2; }
__device__ __forceinline__ int v_rd_base(int lane) { return ((lane & 3) << 3) | (((lane >> 2) & 3) << 6) | (((lane >> 4) & 1) << 5) | (((lane >> 5) & 1) << 8); }
constexpr int v_rd_off(int d0, int ks, int half) { return d0 * 512 + ks * 4096 + half * 2048; }
__device__ __forceinline__ int crow(int r, int hi) { return (r & 3) + 8 * (r >> 2) + 4 * hi; }
__device__ __forceinline__ unsigned cvtpk(float lo, float hi) { unsigned r; asm volatile("v_cvt_pk_bf16_f32 %0, %1, %2" : "=v"(r) : "v"(lo), "v"(hi)); return r; }
__device__ __forceinline__ bf16x8 ld8(const bf16_t* p) { return *reinterpret_cast<const bf16x8*>(p); }
template <int DQK> __device__ __forceinline__ int kswz(int row, int chunk) {
    if constexpr (DQK == 128) return row * 256 + ((chunk ^ (row & 7)) << 4);
    else return row * 384 + (((chunk & ~7) | ((chunk ^ (row >> 1)) & 7)) << 4);
}
__device__ __forceinline__ void mask_tile(f32x16& p0, f32x16& p1, int dq) {
    const float NEG = -__builtin_inff();
#pragma unroll
    for (int r = 0; r < 16; ++r) { const int c = (r & 3) + 8 * (r >> 2); if (dq - c < 0) p0[r] = NEG; if (dq - c - 32 < 0) p1[r] = NEG; }
}
template <bool RAW>
__device__ __forceinline__ void partialSM(f32x16& p0, f32x16& p1, float& m_reg, float& alpha, float sc) {
    float pmax = p0[0];
#pragma unroll
    for (int r = 1; r < 16; ++r) pmax = fmaxf(pmax, p0[r]);
#pragma unroll
    for (int r = 0; r < 16; ++r) pmax = fmaxf(pmax, p1[r]);
    { auto rr = __builtin_amdgcn_permlane32_swap(__float_as_uint(pmax), __float_as_uint(pmax), false, false);
      pmax = fmaxf(__uint_as_float(rr[0]), __uint_as_float(rr[1])); }
    if (RAW) pmax *= sc;
    const bool need = pmax - m_reg > THR2;
    const float mn = need ? pmax : m_reg;
    alpha = need ? __builtin_amdgcn_exp2f(m_reg - mn) : 1.f; m_reg = mn;
    if (RAW) {
#pragma unroll
        for (int r = 0; r < 16; ++r) p0[r] = __builtin_amdgcn_exp2f(fmaf(p0[r], sc, -mn));
#pragma unroll
        for (int r = 0; r < 16; ++r) p1[r] = fmaf(p1[r], sc, -mn);
    } else {
#pragma unroll
        for (int r = 0; r < 16; ++r) p0[r] = __builtin_amdgcn_exp2f(p0[r] - mn);
#pragma unroll
        for (int r = 0; r < 16; ++r) p1[r] = p1[r] - mn;
    }
}
__device__ __forceinline__ void finishSM_e(f32x16& p1) {
#pragma unroll
    for (int r = 0; r < 16; ++r) p1[r] = __builtin_amdgcn_exp2f(p1[r]);
}
__device__ __forceinline__ void finishSM_a(f32x16& p0, f32x16& p1, float alpha, float& l_reg) {
#pragma unroll
    for (int r = 0; r < 16; ++r) p1[r] = __builtin_amdgcn_exp2f(p1[r]);
    float ps = 0;
#pragma unroll
    for (int r = 0; r < 16; ++r) ps += p0[r];
#pragma unroll
    for (int r = 0; r < 16; ++r) ps += p1[r];
    { auto rr = __builtin_amdgcn_permlane32_swap(__float_as_uint(ps), __float_as_uint(ps), false, false);
      ps = __uint_as_float(rr[0]) + __uint_as_float(rr[1]); }
    l_reg = l_reg * alpha + ps;
}
#define PK4(P, B_, OUT) do { unsigned a0 = cvtpk(P[B_+0], P[B_+1]), a1 = cvtpk(P[B_+2], P[B_+3]);                          \
        unsigned b0 = cvtpk(P[B_+4], P[B_+5]), b1 = cvtpk(P[B_+6], P[B_+7]);                                             \
        auto r0 = __builtin_amdgcn_permlane32_swap(a0, b0, false, false); auto r1 = __builtin_amdgcn_permlane32_swap(a1, b1, false, false); \
        u32x4 w = {r0[0], r1[0], r0[1], r1[1]}; OUT = *reinterpret_cast<bf16x8*>(&w); } while (0)
template <int DQK>
__device__ __forceinline__ void qkt(f32x16& p0, f32x16& p1, const char* kbuf, int r32, int hi, const bf16x8* qr) {
    p0 = f32x16{}; p1 = f32x16{};
    const char* kb[4];
    constexpr int RP = DQK * 2;
#pragma unroll
    for (int dd = 0; dd < 4; ++dd) kb[dd] = kbuf + kswz<DQK>(r32, 2 * dd + hi);
#pragma unroll
    for (int d0 = 0; d0 < DQK / 16; ++d0) { const char* a = kb[d0 & 3] + (d0 >> 2) * 128;
        bf16x8 b0 = *reinterpret_cast<const bf16x8*>(a);
        bf16x8 b1 = *reinterpret_cast<const bf16x8*>(a + 32 * RP);
        __builtin_amdgcn_s_setprio(1);
        p0 = __builtin_amdgcn_mfma_f32_32x32x16_bf16(b0, qr[d0], p0, 0, 0, 0);
        p1 = __builtin_amdgcn_mfma_f32_32x32x16_bf16(b1, qr[d0], p1, 0, 0, 0);
        __builtin_amdgcn_s_setprio(0); }
}
template <int VBOFF>
__device__ __forceinline__ void pv_tile(f32x16* o, int vb0, bf16x8 pa0, bf16x8 pa1, bf16x8 pa2, bf16x8 pa3) {
#define TRRD(dst, off) asm volatile("ds_read_b64_tr_b16 %0, %1 offset:%2" : "=&v"(dst) : "v"(vb0), "i"(off) : "memory")
#define PV_D0(d0) do { s16x4 l0, l1, l2, l3, h0, h1, h2, h3; constexpr int b_ = VBOFF + v_rd_off(d0, 0, 0); \
        TRRD(l0, b_); TRRD(h0, b_ + 2048); TRRD(l1, b_ + 4096); TRRD(h1, b_ + 6144); TRRD(l2, b_ + 8192); TRRD(h2, b_ + 10240); TRRD(l3, b_ + 12288); TRRD(h3, b_ + 14336); \
        asm volatile("s_waitcnt lgkmcnt(0)" ::: "memory"); ASBAR();   \
        o[d0] = __builtin_amdgcn_mfma_f32_32x32x16_bf16(pa0, (bf16x8){l0[0], l0[1], l0[2], l0[3], h0[0], h0[1], h0[2], h0[3]}, o[d0], 0, 0, 0);   \
        o[d0] = __builtin_amdgcn_mfma_f32_32x32x16_bf16(pa1, (bf16x8){l1[0], l1[1], l1[2], l1[3], h1[0], h1[1], h1[2], h1[3]}, o[d0], 0, 0, 0);   \
        o[d0] = __builtin_amdgcn_mfma_f32_32x32x16_bf16(pa2, (bf16x8){l2[0], l2[1], l2[2], l2[3], h2[0], h2[1], h2[2], h2[3]}, o[d0], 0, 0, 0);   \
        o[d0] = __builtin_amdgcn_mfma_f32_32x32x16_bf16(pa3, (bf16x8){l3[0], l3[1], l3[2], l3[3], h3[0], h3[1], h3[2], h3[3]}, o[d0], 0, 0, 0); } while (0)
    PV_D0(0); PV_D0(1); PV_D0(2); PV_D0(3);
#undef PV_D0
#undef TRRD
}

typedef __attribute__((address_space(3))) const char* lds_cptr;
typedef short v4i16_t __attribute__((ext_vector_type(4)));
__device__ __forceinline__ s16x4 vtr(lds_cptr p) { return __builtin_bit_cast(s16x4, __builtin_amdgcn_ds_read_tr16_b64_v4i16((__attribute__((address_space(3))) v4i16_t*)p)); }
#define VRD(S, vp, d0) do { _Pragma("unroll") for (int ks_ = 0; ks_ < 4; ++ks_) { S[2 * ks_] = vtr((vp) + (d0) * 512 + ks_ * 4096); S[2 * ks_ + 1] = vtr((vp) + (d0) * 512 + ks_ * 4096 + 2048); } } while (0)
#define VFR(S, k) (bf16x8){S[2 * (k)][0], S[2 * (k)][1], S[2 * (k)][2], S[2 * (k)][3], S[2 * (k) + 1][0], S[2 * (k) + 1][1], S[2 * (k) + 1][2], S[2 * (k) + 1][3]}
#define PVMMA(S, d0) do { __builtin_amdgcn_s_setprio(1); o[d0] = __builtin_amdgcn_mfma_f32_32x32x16_bf16(pa0, VFR(S, 0), o[d0], 0, 0, 0); o[d0] = __builtin_amdgcn_mfma_f32_32x32x16_bf16(pa1, VFR(S, 1), o[d0], 0, 0, 0); \
        o[d0] = __builtin_amdgcn_mfma_f32_32x32x16_bf16(pa2, VFR(S, 2), o[d0], 0, 0, 0); o[d0] = __builtin_amdgcn_mfma_f32_32x32x16_bf16(pa3, VFR(S, 3), o[d0], 0, 0, 0); __builtin_amdgcn_s_setprio(0); } while (0)

typedef int v8i_t __attribute__((ext_vector_type(8))); typedef int v4i_t __attribute__((ext_vector_type(4)));
__device__ __forceinline__ unsigned pk4f8(float a, float b, float c, float d) { int w = 0; w = __builtin_amdgcn_cvt_pk_fp8_f32(a, b, w, false); w = __builtin_amdgcn_cvt_pk_fp8_f32(c, d, w, true); return (unsigned)w; }
template <int DQK> __device__ __forceinline__ int k8swz(int row, int chunk) {
    if constexpr (DQK == 192) return row * 256 + ((chunk ^ (row & 15)) << 4);
    else return row * 128 + ((chunk ^ ((row >> 1) & 7)) << 4);
}
template <int DQK>
__device__ __forceinline__ void qkt8(f32x16& p0, f32x16& p1, const char* kbuf, int r32, int hi, const v8i_t* q8, int f8scale) {
    p0 = f32x16{}; p1 = f32x16{};
    constexpr int NS = DQK / 64, H32 = 32 * (DQK == 192 ? 256 : 128);
    v8i_t a0[NS], a1[NS];
#define K8LD(s_) do { const int c0 = 4 * (s_) + 2 * hi;                                                                          \
        const lds_cptr k0_ = (lds_cptr)kbuf + k8swz<DQK>(r32, c0), k1_ = (lds_cptr)kbuf + k8swz<DQK>(r32, c0 + 1);             \
        a0[s_].lo = *(const __attribute__((address_space(3))) v4i_t*)k0_; a0[s_].hi = *(const __attribute__((address_space(3))) v4i_t*)k1_;            \
        a1[s_].lo = *(const __attribute__((address_space(3))) v4i_t*)(k0_ + H32); a1[s_].hi = *(const __attribute__((address_space(3))) v4i_t*)(k1_ + H32); } while (0)
    K8LD(0); K8LD(1);
#pragma unroll
    for (int s_ = 0; s_ < NS; ++s_) {
        __builtin_amdgcn_s_setprio(1);
        asm volatile("v_mfma_scale_f32_32x32x64_f8f6f4 %0, %1, %2, %0, %3, %3 op_sel_hi:[0,0,0]" : "+v"(p0) : "v"(a0[s_]), "v"(q8[s_]), "v"(f8scale));
        asm volatile("v_mfma_scale_f32_32x32x64_f8f6f4 %0, %1, %2, %0, %3, %3 op_sel_hi:[0,0,0]" : "+v"(p1) : "v"(a1[s_]), "v"(q8[s_]), "v"(f8scale));
        __builtin_amdgcn_s_setprio(0);
        if (s_ == 0 && NS == 3) { ASBAR(); K8LD(2); } }
#undef K8LD
    asm volatile("s_nop 15\n\ts_nop 7" : "+v"(p0), "+v"(p1));
}
struct UnitArgs {
    const bf16_t* Q; int qpitch;
    const bf16_t* K; int kpitch;
    const bf16_t* Kr;
    const unsigned char* Q8; const unsigned char* K8; const unsigned char* Kr8; const unsigned char* V8;
    const bf16_t* V; int vpitch;
    bf16_t* O; int opitch;
    bf16_t* PO; float* PML;
    const int* pos; const int* tpmax;
    const unsigned* list; int nrows;
    int q0, k0, NT, h;
    float c2;
};
template <int DQK, int MODE>
__device__ __forceinline__ void attn_unit(const UnitArgs& A, char* lds, int wv) {
    int tid_ = wv * 64 + lane_id_(); asm volatile("" : "+v"(tid_)); const int tid = tid_, wid = wv, lane = tid & 63, r32 = lane & 31, hi = lane >> 5;
    constexpr bool F8 = true;
    constexpr int KT = F8 ? (DQK == 192 ? 16384 : 8192) : 64 * DQK * 2; constexpr int Q8P = DQK == 192 ? 3072 : 2048;
    char* V_lds = lds + L_V; char* K_lds = lds + L_K;
    float* ws = (float*)(lds + L_WS) + wid * 128; float* li_l = ws; float* al_l = ws + 32; int* ix_l = (int*)(ws + 64);
    const float* biasL = (const float*)(lds + L_BIAS) + A.h * 132;
    const int sr = tid >> 4, sc = (tid & 15) * 8, vst0 = v_st(sr, sc), vst1 = v_st(32 + sr, sc);
    const int kws0 = kswz<DQK>(sr, tid & 15), kws1 = kswz<DQK>(32 + sr, tid & 15);
    const int kws2 = (DQK == 192) ? kswz<DQK>(tid >> 3, 16 + (tid & 7)) : 0;
    const int k8w0 = k8swz<DQK>(tid >> 3, tid & 7), k8w2 = DQK == 192 ? k8swz<DQK>(tid >> 2, 8 + (tid & 3)) : 0;
    const int vb0 = (int)(uintptr_t)V_lds + v_rd_base(lane); (void)vb0;
    const int v8w = (tid >> 2) * 64 + (((tid & 3) ^ ((tid >> 4) & 3)) << 4), v8r = r32 * 64 + (((2 * hi) ^ ((r32 >> 2) & 3)) << 4);
    const lds_cptr vp0 = (lds_cptr)V_lds + v_rd_base(lane);
    bf16x8 st_k0, st_k1, st_k2, st_v0, st_v1;
#define SLOAD(t) do { const size_t kk_ = (size_t)(A.k0 + (t) * 64);                                                         \
        if constexpr (F8) st_v0 = ld8((const bf16_t*)(A.V8 + (kk_ >> 6) * 8192 + tid * 16));                             \
        else { st_v0 = ld8(A.V + (kk_ + sr) * A.vpitch + sc); st_v1 = ld8(A.V + (kk_ + 32 + sr) * A.vpitch + sc); }    \
        if constexpr (F8) { st_k0 = ld8((const bf16_t*)(A.K8 + (kk_ + (tid >> 3)) * 2048 + (tid & 7) * 16));             \
            if constexpr (DQK == 192) if (wid < 4) st_k2 = ld8((const bf16_t*)(A.Kr8 + (kk_ + (tid >> 2)) * 64 + (tid & 3) * 16)); }   \
        else { st_k0 = ld8(A.K + (kk_ + sr) * A.kpitch + sc); st_k1 = ld8(A.K + (kk_ + 32 + sr) * A.kpitch + sc);       \
            if constexpr (DQK == 192) st_k2 = ld8(A.Kr + (kk_ + (tid >> 3)) * 64 + (tid & 7) * 8); } } while (0)
#define SWRITE(bf) do { if constexpr (F8) *(bf16x8*)(V_lds + (bf) * VT_BYTES + v8w) = st_v0;                                  \
        else { *(bf16x8*)(V_lds + (bf) * VT_BYTES + vst0) = st_v0; *(bf16x8*)(V_lds + (bf) * VT_BYTES + vst1) = st_v1; } \
        if constexpr (F8) { *(bf16x8*)(K_lds + (bf) * KT + k8w0) = st_k0; if constexpr (DQK == 192) if (wid < 4) *(bf16x8*)(K_lds + (bf) * KT + k8w2) = st_k2; } \
        else { *(bf16x8*)(K_lds + (bf) * KT + kws0) = st_k0; *(bf16x8*)(K_lds + (bf) * KT + kws1) = st_k1;                 \
            if constexpr (DQK == 192) *(bf16x8*)(K_lds + (bf) * KT + kws2) = st_k2; } } while (0)
    SLOAD(0);
    int qrow, jslot = 3; bool valid = true;
    if constexpr (MODE == 1) { const int e = wid * 32 + r32; valid = e < A.nrows; const unsigned ent = A.list[valid ? e : 0]; qrow = (int)(ent & 0xffffu); jslot = (int)(ent >> 16); }
    else qrow = A.q0 + wid * 32 + r32;
    bf16x8 qr[F8 ? 1 : DQK / 16]; v8i_t q8[DQK / 64]; int f8scale = 0x7f7f7f7f;
    if constexpr (F8) { asm volatile("" : "+v"(f8scale));
#pragma unroll
        for (int s_ = 0; s_ < DQK / 64; ++s_) { const v4i_t* qp = (const v4i_t*)(A.Q8 + (size_t)qrow * Q8P + 64 * s_ + 32 * hi); q8[s_].lo = qp[0]; q8[s_].hi = qp[1]; } }
    else {
#pragma unroll
        for (int d0 = 0; d0 < DQK / 16; ++d0) qr[d0] = ld8(A.Q + (size_t)qrow * A.qpitch + d0 * 16 + hi * 8); }
    int posq = 0, qminw = 0;
    if constexpr (MODE != 0) { posq = A.pos[qrow]; int mn = posq;
#pragma unroll
        for (int o_ = 1; o_ < 64; o_ <<= 1) mn = min(mn, __shfl_xor(mn, o_));
        qminw = __builtin_amdgcn_readfirstlane(mn); }
    const int qlo = A.q0 + wid * 32;
    float m_reg = -1e30f, l_reg = 0.f; f32x16 o[4] = {};
    f32x16 o5 = {};
    f32x16 p0, p1; float alpha; bf16x8 pa0, pa1, pa2, pa3;
    const int NT = A.NT;
    SWRITE(0);
    __syncthreads();
    if constexpr (F8) {
#pragma unroll
        for (int s_ = 0; s_ < DQK / 64; ++s_) asm volatile("" : "+v"(q8[s_])); }
    else {
#pragma unroll
        for (int d0 = 0; d0 < DQK / 16; ++d0) asm volatile("" : "+v"(qr[d0])); }
#define KB_(t) (A.k0 + (t) * 64)
#define ACT(t) (MODE == 1 || KB_(t) <= qlo + 31)
#define NEEDMASK(t) (MODE != 1 && KB_(t) + 63 > qlo)
#define STEP(t, B) do {                                                                                                       \
        const bool more_ = (t) + 1 < NT;                                                                                      \
        if (more_) SLOAD((t) + 1);                                                                                            \
        if (ACT(t)) {                                                                                                         \
            ASBAR(); if constexpr (F8) qkt8<DQK>(p0, p1, K_lds + (B) * KT, r32, hi, q8, f8scale); else qkt<DQK>(p0, p1, K_lds + (B) * KT, r32, hi, qr);     \
            if constexpr (MODE != 0) {                                                                                                          \
                const int kmax_ = A.tpmax[KB_(t) >> 6];                                                                       \
                if (qminw - kmax_ >= 128) { const float bc = biasL[128];                                                      \
                    _Pragma("unroll") for (int r = 0; r < 16; ++r) { p0[r] = fmaf(p0[r], A.c2, bc); p1[r] = fmaf(p1[r], A.c2, bc); } }   \
                else {                                                                                                        \
                    _Pragma("unroll") for (int g4 = 0; g4 < 4; ++g4) {                                                        \
                        const i32x4 pk0 = *(const i32x4*)(A.pos + KB_(t) + 8 * g4 + 4 * hi);                                  \
                        const i32x4 pk1 = *(const i32x4*)(A.pos + KB_(t) + 32 + 8 * g4 + 4 * hi);                             \
                        _Pragma("unroll") for (int e = 0; e < 4; ++e) {                                                       \
                            const int d0_ = min(max(posq - pk0[e], 0), 128), d1_ = min(max(posq - pk1[e], 0), 128);           \
                            p0[4 * g4 + e] = fmaf(p0[4 * g4 + e], A.c2, biasL[d0_]); p1[4 * g4 + e] = fmaf(p1[4 * g4 + e], A.c2, biasL[d1_]); } } }   \
            }                                                                                                                 \
            if (NEEDMASK(t)) mask_tile(p0, p1, (qlo + r32 - 4 * hi) - KB_(t));                                                \
            partialSM<MODE == 0>(p0, p1, m_reg, alpha, A.c2);                                                                 \
            if (__any(alpha < 1.f)) { if (hi == 0) al_l[r32] = alpha; asm volatile("s_waitcnt lgkmcnt(0)" ::: "memory");      \
                _Pragma("unroll") for (int d_ = 0; d_ < 4; ++d_) _Pragma("unroll") for (int r = 0; r < 16; ++r) o[d_][r] *= al_l[crow(r, hi)];     \
                if constexpr (F8) { _Pragma("unroll") for (int r = 0; r < 16; ++r) o5[r] *= al_l[crow(r, hi)]; } }                                  \
            if constexpr (F8) { const lds_cptr vp_ = (lds_cptr)V_lds + (B) * VT_BYTES + v8r; v8i_t vf[4], p8;                   \
              _Pragma("unroll") for (int d_ = 0; d_ < 4; ++d_) { vf[d_].lo = *(const __attribute__((address_space(3))) v4i_t*)(vp_ + d_ * 2048);  \
                  vf[d_].hi = *(const __attribute__((address_space(3))) v4i_t*)((lds_cptr)V_lds + (B) * VT_BYTES + (v8r ^ 16) + d_ * 2048); }           \
              finishSM_e(p1);                                                                                                  \
              _Pragma("unroll") for (int j_ = 0; j_ < 4; ++j_) { p8[j_] = (int)pk4f8(p0[4 * j_], p0[4 * j_ + 1], p0[4 * j_ + 2], p0[4 * j_ + 3]);     \
                  p8[4 + j_] = (int)pk4f8(p1[4 * j_], p1[4 * j_ + 1], p1[4 * j_ + 2], p1[4 * j_ + 3]); }                       \
              __builtin_amdgcn_s_setprio(1);                                                                                   \
              _Pragma("unroll") for (int d_ = 0; d_ < 4; ++d_)                                                                 \
                  asm volatile("v_mfma_scale_f32_32x32x64_f8f6f4 %0, %1, %2, %0, %3, %3 op_sel_hi:[0,0,0]" : "+v"(o[d_]) : "v"(p8), "v"(vf[d_]), "v"(f8scale));   \
              { v8i_t ones8 = {0x38383838, 0x38383838, 0x38383838, 0x38383838, 0x38383838, 0x38383838, 0x38383838, 0x38383838}; asm volatile("" : "+v"(ones8));        \
                asm volatile("v_mfma_scale_f32_32x32x64_f8f6f4 %0, %1, %2, %0, %3, %3 op_sel_hi:[0,0,0]" : "+v"(o5) : "v"(p8), "v"(ones8), "v"(f8scale)); }        \
              __builtin_amdgcn_s_setprio(0); }                                                                                 \
            else { const lds_cptr vp_ = vp0 + (B) * VT_BYTES; s16x4 fa[8], fb[8];                                                    \
              finishSM_a(p0, p1, alpha, l_reg); PK4(p0, 0, pa0); PK4(p0, 8, pa1);                                             \
              VRD(fa, vp_, 0); PK4(p1, 0, pa2); PK4(p1, 8, pa3);                                                              \
              VRD(fb, vp_, 1); PVMMA(fa, 0); VRD(fa, vp_, 2); PVMMA(fb, 1); VRD(fb, vp_, 3); PVMMA(fa, 2); PVMMA(fb, 3); }    \
        }                                                                                                                     \
        if (more_) SWRITE((B) ^ 1);                                                                                           \
        __syncthreads(); } while (0)
    for (int t = 0; t < NT; t += 2) { STEP(t, 0); STEP(t + 1, 1); }
    if constexpr (F8) asm volatile("s_nop 15\n\ts_nop 7" : "+v"(o[0]), "+v"(o[1]), "+v"(o[2]), "+v"(o[3]), "+v"(o5));
#undef STEP
#undef ACT
#undef NEEDMASK
#undef KB_
#undef SLOAD
#undef SWRITE
    if (hi == 0) { if constexpr (!F8) li_l[r32] = l_reg; ix_l[r32] = valid ? (qrow * 16 + A.h) * 4 + jslot : -1; }
    asm volatile("s_waitcnt lgkmcnt(0)" ::: "memory");
    if constexpr (MODE != 0) { if (hi == 0 && valid) { float* ml = A.PML + (size_t)((qrow * 16 + A.h) * 4 + jslot) * 2; ml[0] = m_reg; if constexpr (!F8) ml[1] = l_reg; } }
#pragma unroll
    for (int r = 0; r < 16; ++r) { const int orow = crow(r, hi); const float rl = __builtin_amdgcn_rcpf(F8 ? o5[r] : li_l[orow]);
        bf16_t* dst; bool ok = true;
        if constexpr (MODE == 0) dst = A.O + (size_t)(qlo + orow) * A.opitch;
        else { const int ix = ix_l[orow]; ok = ix >= 0; dst = A.PO + (size_t)(ok ? ix : 0) * 128;
            if constexpr (F8) { if (r32 == 0 && ok) A.PML[(size_t)ix * 2 + 1] = o5[r]; } }
#pragma unroll
        for (int d0 = 0; d0 < 4; ++d0) { const float v = o[d0][r] * rl; const float vn = __shfl_xor(v, 1);
            if ((r32 & 1) == 0 && ok) *(unsigned*)(dst + d0 * 32 + r32) = cvtpk(v, vn); } }
    __syncthreads();
}
template <int MODE>
__device__ __forceinline__ void moba_unit(const UnitArgs& A, char* lds, int wv, int nchunk) {
    int tid_ = wv * 64 + lane_id_(); asm volatile("" : "+v"(tid_)); const int tid = tid_, wid = wv, lane = tid & 63, r32 = lane & 31, hi = lane >> 5;
    char* V_lds = lds + L_V; char* K_lds = lds + L_K;
    float* ws = (float*)(lds + L_WS) + wid * 128; float* al_l = ws + 32; int* ix_l = (int*)(ws + 64);
    const float* biasL = (const float*)(lds + L_BIAS) + A.h * 132;
    int qrow, jslot = 3, posq; bool valid = true; v8i_t q8[2]; unsigned ent = 0;
    if constexpr (MODE == 1) { const int e = wid * 32 + r32; valid = e < A.nrows; ent = A.list[valid ? e : 0]; }
    else qrow = A.q0 + wid * 32 + r32;
#define QLOAD(QF_, POSQ_, QROW_) do { _Pragma("unroll") for (int s_ = 0; s_ < 2; ++s_) { const v4i_t* qp = (const v4i_t*)(A.Q8 + (size_t)(QROW_) * 2048 + 64 * s_ + 32 * hi); QF_[s_].lo = qp[0]; QF_[s_].hi = qp[1]; } \
        POSQ_ = A.pos[QROW_]; } while (0)
    if constexpr (MODE != 1) QLOAD(q8, posq, qrow);
    { const int k8w0 = k8swz<128>(tid >> 3, tid & 7), v8w = (tid >> 2) * 64 + (((tid & 3) ^ ((tid >> 4) & 3)) << 4);
      bf16x8 sk[4], sv[4];
#pragma unroll
      for (int i = 0; i < 4; ++i) { const size_t kk_ = (size_t)(A.k0 + i * 64);
          sv[i] = ld8((const bf16_t*)(A.V8 + (kk_ >> 6) * 8192 + tid * 16)); sk[i] = ld8((const bf16_t*)(A.K8 + (kk_ + (tid >> 3)) * 2048 + (tid & 7) * 16)); }
      if constexpr (MODE == 1) { qrow = (int)(ent & 0xffffu); jslot = (int)(ent >> 16); QLOAD(q8, posq, qrow); }
#pragma unroll
      for (int i = 0; i < 4; ++i) { *(bf16x8*)(V_lds + i * 8192 + v8w) = sv[i]; *(bf16x8*)(K_lds + i * 8192 + k8w0) = sk[i]; } }
    __syncthreads();
    const int v8r = r32 * 64 + (((2 * hi) ^ ((r32 >> 2) & 3)) << 4);
    int f8scale = 0x7f7f7f7f; asm volatile("" : "+v"(f8scale));
    const int qlo = A.q0 + wid * 32;
#pragma unroll 1
    for (int c = 0; c < nchunk; ++c) {
        if (MODE == 1 && c * 256 + wid * 32 >= A.nrows) break;
        const bool has_next = MODE == 1 && (c + 1 < nchunk) && ((c + 1) * 256 + wid * 32 < A.nrows);
        unsigned entn = 0; bool validn = false; v8i_t q8n[2]; int posqn = 0, qrown = 0;
        if (has_next) { const int en = (c + 1) * 256 + wid * 32 + r32; validn = en < A.nrows; entn = A.list[validn ? en : 0]; }
        int qminw; { int mn = posq;
#pragma unroll
            for (int o_ = 1; o_ < 64; o_ <<= 1) mn = min(mn, __shfl_xor(mn, o_));
            qminw = __builtin_amdgcn_readfirstlane(mn); }
        float m_reg = -1e30f, alpha; f32x16 o[4] = {}, o5 = {}, p0, p1;
#pragma unroll
        for (int s_ = 0; s_ < 2; ++s_) asm volatile("" : "+v"(q8[s_]));
#define MTILE(t) do { const int kb_ = A.k0 + (t) * 64;                                                                          \
            if (MODE == 1 || kb_ <= qlo + 31) {                                                                               \
                ASBAR(); qkt8<128>(p0, p1, K_lds + (t) * 8192, r32, hi, q8, f8scale);                                         \
                const int kmax_ = A.tpmax[kb_ >> 6];                                                                          \
                if (qminw - kmax_ >= 128) { const float bc = biasL[128];                                                      \
                    _Pragma("unroll") for (int r = 0; r < 16; ++r) { p0[r] = fmaf(p0[r], A.c2, bc); p1[r] = fmaf(p1[r], A.c2, bc); } }   \
                else {                                                                                                        \
                    _Pragma("unroll") for (int g4 = 0; g4 < 4; ++g4) {                                                        \
                        const i32x4 pk0 = *(const i32x4*)(A.pos + kb_ + 8 * g4 + 4 * hi);                                     \
                        const i32x4 pk1 = *(const i32x4*)(A.pos + kb_ + 32 + 8 * g4 + 4 * hi);                                \
                        _Pragma("unroll") for (int e = 0; e < 4; ++e) {                                                       \
                            const int d0_ = min(max(posq - pk0[e], 0), 128), d1_ = min(max(posq - pk1[e], 0), 128);           \
                            p0[4 * g4 + e] = fmaf(p0[4 * g4 + e], A.c2, biasL[d0_]); p1[4 * g4 + e] = fmaf(p1[4 * g4 + e], A.c2, biasL[d1_]); } } }   \
                if (MODE != 1 && kb_ + 63 > qlo) mask_tile(p0, p1, (qlo + r32 - 4 * hi) - kb_);                               \
                partialSM<false>(p0, p1, m_reg, alpha, A.c2);                                                                 \
                if (__any(alpha < 1.f)) { if (hi == 0) al_l[r32] = alpha; asm volatile("s_waitcnt lgkmcnt(0)" ::: "memory");  \
                    _Pragma("unroll") for (int d_ = 0; d_ < 4; ++d_) _Pragma("unroll") for (int r = 0; r < 16; ++r) o[d_][r] *= al_l[crow(r, hi)];   \
                    _Pragma("unroll") for (int r = 0; r < 16; ++r) o5[r] *= al_l[crow(r, hi)]; }                              \
                { const lds_cptr vp_ = (lds_cptr)V_lds + (t) * 8192 + v8r; const lds_cptr vq_ = (lds_cptr)V_lds + (t) * 8192 + (v8r ^ 16); v8i_t vf[4], p8;   \
                  _Pragma("unroll") for (int d_ = 0; d_ < 4; ++d_) { vf[d_].lo = *(const __attribute__((address_space(3))) v4i_t*)(vp_ + d_ * 2048); vf[d_].hi = *(const __attribute__((address_space(3))) v4i_t*)(vq_ + d_ * 2048); }   \
                  finishSM_e(p1);                                                                                             \
                  _Pragma("unroll") for (int j_ = 0; j_ < 4; ++j_) { p8[j_] = (int)pk4f8(p0[4 * j_], p0[4 * j_ + 1], p0[4 * j_ + 2], p0[4 * j_ + 3]); p8[4 + j_] = (int)pk4f8(p1[4 * j_], p1[4 * j_ + 1], p1[4 * j_ + 2], p1[4 * j_ + 3]); }   \
                  __builtin_amdgcn_s_setprio(1);                                                                              \
                  _Pragma("unroll") for (int d_ = 0; d_ < 4; ++d_)                                                            \
                      asm volatile("v_mfma_scale_f32_32x32x64_f8f6f4 %0, %1, %2, %0, %3, %3 op_sel_hi:[0,0,0]" : "+v"(o[d_]) : "v"(p8), "v"(vf[d_]), "v"(f8scale));   \
                  { v8i_t ones8 = {0x38383838, 0x38383838, 0x38383838, 0x38383838, 0x38383838, 0x38383838, 0x38383838, 0x38383838}; asm volatile("" : "+v"(ones8));   \
                    asm volatile("v_mfma_scale_f32_32x32x64_f8f6f4 %0, %1, %2, %0, %3, %3 op_sel_hi:[0,0,0]" : "+v"(o5) : "v"(p8), "v"(ones8), "v"(f8scale)); }   \
                  __builtin_amdgcn_s_setprio(0); }                                                                            \
            } } while (0)
        MTILE(0); MTILE(1);
        if (has_next) { qrown = (int)(entn & 0xffffu); QLOAD(q8n, posqn, qrown); }
        MTILE(2); MTILE(3);
#undef MTILE
        asm volatile("s_nop 15\n\ts_nop 7" : "+v"(o[0]), "+v"(o[1]), "+v"(o[2]), "+v"(o[3]), "+v"(o5));
        if (hi == 0) ix_l[r32] = valid ? (qrow * 16 + A.h) * 4 + jslot : -1;
        asm volatile("s_waitcnt lgkmcnt(0)" ::: "memory");
        if (hi == 0 && valid) A.PML[(size_t)((qrow * 16 + A.h) * 4 + jslot) * 2] = m_reg;
#pragma unroll
        for (int r = 0; r < 16; ++r) { const int orow = crow(r, hi); const float rl = __builtin_amdgcn_rcpf(o5[r]);
            const int ix = ix_l[orow]; const bool ok = ix >= 0; bf16_t* dst = A.PO + (size_t)(ok ? ix : 0) * 128;
            if (r32 == 0 && ok) A.PML[(size_t)ix * 2 + 1] = o5[r];
#pragma unroll
            for (int d0 = 0; d0 < 4; ++d0) { const float v = o[d0][r] * rl; const float vn = __shfl_xor(v, 1);
                if ((r32 & 1) == 0 && ok) *(unsigned*)(dst + d0 * 32 + r32) = cvtpk(v, vn); } }
        asm volatile("s_waitcnt lgkmcnt(0)" ::: "memory");
        if (!has_next) break;
        qrow = qrown; jslot = (int)(entn >> 16); valid = validn; posq = posqn; q8[0] = q8n[0]; q8[1] = q8n[1];
    }
#undef QLOAD
    __syncthreads();
}
}
constexpr int NWAVES = 8;
constexpr int M_ = 16384, DM = 4096, DFF = 11008, NFF2 = 2 * DFF;
constexpr int NH = 16, QLORA = 1024, KVLORA = 512, ROPE = 64, NOPE = 128, VDIM = 128, QUP = NH * 192, KVUP = NH * 256, MLAOUT = NH * 128, MOBAW = NH * 128;
constexpr int INCOLS = 15936, INPAD1 = 5888, IN2 = 10240;
constexpr int MBLK = 256, NBLK = M_ / MBLK;
constexpr float RMS_EPS = 1e-6f;
constexpr size_t MiB = 1u << 20;
constexpr size_t WS_CTL = 0, CTL_ZERO_BYTES = 1 * MiB;
constexpr size_t WS_WFFN_IN = 1 * MiB;
constexpr size_t WS_WFFN_OUT = WS_WFFN_IN + (size_t)NFF2 * DM * 2;
constexpr size_t WS_WFFN_END = WS_WFFN_OUT + (size_t)DM * DFF * 2;
constexpr size_t WS_PO = WS_WFFN_IN;
constexpr size_t WS_WIN = WS_WFFN_END;
constexpr size_t WS_WIN8 = WS_WIN + (size_t)INPAD1 * DM * 2;
constexpr size_t WS_WUQ = WS_WIN8 + (size_t)IN2 * DM;
constexpr size_t WS_WUKV = WS_WUQ + (size_t)QUP * QLORA * 2;
constexpr size_t WS_WBRA = WS_WUKV + (size_t)KVUP * KVLORA * 2;
constexpr size_t WS_WBRB = WS_WBRA + (size_t)DM * MLAOUT * 2;
constexpr size_t WS_WOUT = WS_WBRB + (size_t)DM * MOBAW * 2;
constexpr size_t WS_H = WS_WOUT + (size_t)DM * DM * 2;
constexpr size_t WS_LIST = WS_H;
constexpr size_t LIST_PER_HEAD = 516096;
constexpr size_t WS_PML = WS_LIST + LIST_PER_HEAD * NH * 4;
constexpr size_t WS_BIG = WS_H + (size_t)M_ * DM * 2;
constexpr size_t WS_CQ = WS_BIG;
constexpr size_t WS_CKV = WS_CQ + (size_t)M_ * QLORA * 2;
constexpr size_t WS_KR = WS_CKV + (size_t)M_ * KVLORA * 2;
constexpr size_t WS_QB = WS_KR + (size_t)M_ * ROPE * 2;
constexpr size_t WS_KB = WS_QB + (size_t)M_ * MOBAW * 2;
constexpr size_t WS_VB = WS_KB + (size_t)M_ * MOBAW * 2;
constexpr size_t WS_GA = WS_VB + (size_t)M_ * MOBAW * 2;
constexpr size_t WS_GB = WS_GA + (size_t)M_ * DM * 2;
constexpr size_t WS_BIG_END = WS_GB + (size_t)M_ * DM * 2;
constexpr size_t WS_QM8 = WS_BIG_END;
constexpr size_t WS_KN8 = WS_QM8 + (size_t)M_ * QUP;
constexpr size_t WS_KR8 = WS_KN8 + (size_t)M_ * 2048;
constexpr size_t WS_V8 = WS_KR8 + (size_t)M_ * 64;
constexpr size_t WS_QB8 = WS_V8 + (size_t)M_ * 2048;
constexpr size_t WS_KB8 = WS_QB8 + (size_t)M_ * 2048;
constexpr size_t WS_VB8 = WS_KB8 + (size_t)M_ * 2048;
constexpr size_t WS_OA = WS_VB8 + (size_t)M_ * 2048;
constexpr size_t WS_COS = WS_OA + (size_t)M_ * MLAOUT * 2;
constexpr size_t WS_SIN = WS_COS + (size_t)M_ * 32 * 4;
constexpr size_t WS_KMH = WS_SIN + (size_t)M_ * 32 * 4;
constexpr size_t WS_KML = WS_KMH + (size_t)NH * NBLK * 128 * 2;
constexpr size_t WS_BIAS = WS_KML + (size_t)NH * NBLK * 128 * 2;
constexpr size_t WS_TPMAX = WS_BIAS + 16 * 132 * 4;
constexpr size_t WS_PART = WS_TPMAX + 256 * 4;
constexpr size_t WS_RSTD = WS_PART + (size_t)M_ * 64 * 4;
constexpr size_t WS_PARTQ = WS_RSTD + (size_t)M_ * 4;
constexpr size_t WS_PARTKV = WS_PARTQ + (size_t)M_ * 16 * 4;
constexpr size_t WS_RSTDQ = WS_PARTKV + (size_t)M_ * 8 * 4;
constexpr size_t WS_RSTDKV = WS_RSTDQ + (size_t)M_ * 4;
constexpr size_t WS_H8 = WS_RSTDKV + (size_t)M_ * 4;
constexpr size_t WS_OA8 = WS_H8 + (size_t)M_ * DM;
constexpr size_t WS_OB8 = WS_OA8 + (size_t)M_ * MLAOUT;
constexpr size_t WS_MG8 = WS_OB8 + (size_t)M_ * MOBAW;
constexpr size_t WS_PMAX = WS_MG8 + (size_t)M_ * DM;
constexpr size_t WS_CPART = WS_PMAX + (size_t)M_ * 64 * 4;
constexpr size_t WS_CMAXF = WS_CPART + (size_t)8 * 2 * NFF2 * 4;
constexpr size_t WS_CPARTO = WS_CMAXF + (size_t)2 * NFF2 * 4;
constexpr size_t WS_CMAXO = WS_CPARTO + (size_t)8 * DM * 4;
constexpr size_t WS_RSM = WS_CMAXO + (size_t)DM * 4;
constexpr size_t WS_QM = ((WS_RSM + (size_t)M_ * 4 + 4095) / 4096) * 4096;
constexpr size_t WS_KV = WS_QM + (size_t)M_ * QUP * 2;
constexpr size_t WS_WFI2 = MLA_BF16 ? WS_KV + (size_t)M_ * KVUP * 2 : WS_QM;
constexpr size_t WS_END = WS_WFI2 + (size_t)NFF2 * DM;
static_assert(WS_PML + (size_t)M_ * NH * 4 * 2 * 4 <= WS_BIG, "lists + ml inside H");
static_assert((size_t)M_ * NH * 4 * 128 * 2 <= WS_WFFN_END - WS_WFFN_IN, "partial O inside FFN weight region");
static_assert((size_t)M_ * DFF * 2 <= WS_BIG_END - WS_BIG, "act inside BIG");
constexpr int CW_TMO = 0;
constexpr int CW_BAR = 4096;
constexpr int CW_GCNT = 16384;
constexpr int CW_CMAX = 196608;
constexpr int CW_KMEAN = 65536;
constexpr int RING_OFF = 0, RING_BYTES = 131072;
constexpr int LDSCTL_OFF = RING_BYTES, MISC_OFF = LDSCTL_OFF + 320;
constexpr int LDS_BYTES = 147456;
static_assert(att::L_END <= RING_BYTES, "attention LDS inside ring region");

#define GAS __attribute__((address_space(1)))
#define LAS __attribute__((address_space(3)))
typedef unsigned short bf16;
typedef unsigned v4u __attribute__((ext_vector_type(4)));
typedef unsigned v2u __attribute__((ext_vector_type(2)));
typedef float f32x4 __attribute__((ext_vector_type(4)));
typedef short bf16x8 __attribute__((ext_vector_type(8)));
typedef float f32x16 __attribute__((ext_vector_type(16)));
typedef GAS unsigned gu32;
#define RLX_AGENT __ATOMIC_RELAXED, __HIP_MEMORY_SCOPE_AGENT
#define LDS_WAIT() asm volatile("s_waitcnt lgkmcnt(0)" ::: "memory")
__device__ __forceinline__ unsigned f2bf(float f) { unsigned u = __builtin_bit_cast(unsigned, f); return (u + 0x7fffu + ((u >> 16) & 1u)) >> 16; }
__device__ __forceinline__ unsigned pk2(float lo, float hi) { return f2bf(lo) | (f2bf(hi) << 16); }
__device__ __forceinline__ float bfu_lo(unsigned w) { return __uint_as_float(w << 16); }
__device__ __forceinline__ float bfu_hi(unsigned w) { return __uint_as_float(w & 0xffff0000u); }

#define XB_TMO      128
#define XB_XCNT(j)  (256  + 64 * (j))
#define XB_XSUB(j)  (1280 + 64 * (j))
#define XB_XGEN(j)  (2304 + 64 * (j))
#define XB_TOP      3328
#define XB_TOPGEN   3392
#define XCD_BAR_WORDS 3456
#define XB_SPIN_CAP (1u << 22)
__device__ __forceinline__ unsigned xb_ld(unsigned* p)              { return __hip_atomic_load(p, __ATOMIC_RELAXED, __HIP_MEMORY_SCOPE_AGENT); }
__device__ __forceinline__ unsigned xb_add(unsigned* p, unsigned v) { return __hip_atomic_fetch_add(p, v, __ATOMIC_RELAXED, __HIP_MEMORY_SCOPE_AGENT); }
__device__ __forceinline__ unsigned xb_xcc_id() { return (unsigned)__builtin_amdgcn_s_getreg((3 << 11) | 20) & 0xFu; }
#define XB_SPIN(cond, bar) do { unsigned _sp = 0; while (cond) { __builtin_amdgcn_s_sleep(1); \
    if ((++_sp & 255u) == 0u) { if (xb_ld(&(bar)[XB_TMO])) break; if (_sp > XB_SPIN_CAP) { atomicAdd(&(bar)[XB_TMO], 1u); break; } } } } while (0)
struct XcdBarrier { unsigned* bar; unsigned x; volatile LAS unsigned* st; };
__device__ __forceinline__ XcdBarrier xcd_barrier_post(unsigned* bar, volatile LAS unsigned* st, int wv) {
    XcdBarrier b; b.bar = bar; b.x = xb_xcc_id(); b.st = st;
    if (wv == 0 && lane_id_() == 0) (void)xb_add(&bar[XB_XCNT(b.x)], 1u);
    return b;
}
__device__ __forceinline__ void xcd_barrier_complete(unsigned* bar, unsigned x, unsigned& nloc, unsigned& nx) {
    const unsigned G = gridDim.x * gridDim.y * gridDim.z;
    unsigned sum, cnt, mine, sp = 0u;
    for (;;) {
        sum = 0u; cnt = 0u; mine = 0u;
#pragma unroll
        for (unsigned j = 0; j < 16; ++j) { const unsigned c = xb_ld(&bar[XB_XCNT(j)]); sum += c; cnt += (c > 0u) ? 1u : 0u; mine = (j == x) ? c : mine; }
        if (sum == G) break;
        __builtin_amdgcn_s_sleep(1);
        if ((++sp & 255u) == 0u) { if (xb_ld(&bar[XB_TMO])) break; if (sp > XB_SPIN_CAP) { atomicAdd(&bar[XB_TMO], 1u); break; } }
    }
    nloc = mine > 0u ? mine : 1u; nx = cnt > 0u ? cnt : 1u;
}
__device__ __forceinline__ void xcd_barrier(const XcdBarrier& b, int wv) {
    asm volatile("s_waitcnt vmcnt(0)" ::: "memory");
    __syncthreads();
    if (wv == 0 && lane_id_() == 0) {
        unsigned* bar = b.bar;
        __builtin_amdgcn_s_waitcnt(0);
        unsigned nloc = b.st[0], nx = b.st[1];
        if (nloc == 0u) { xcd_barrier_complete(bar, b.x, nloc, nx); b.st[0] = nloc; b.st[1] = nx; }
        const unsigned old = xb_add(&bar[XB_XSUB(b.x)], 1u);
        const unsigned gen = old / nloc;
        if (old + 1u == (gen + 1u) * nloc) {
            __builtin_amdgcn_fence(__ATOMIC_RELEASE, "agent");
            asm volatile("s_waitcnt vmcnt(0)" ::: "memory");
            const unsigned og = xb_add(&bar[XB_TOP], 1u);
            const unsigned tg = og / nx;
            if (og + 1u == (tg + 1u) * nx) xb_add(&bar[XB_TOPGEN], 1u);
            else XB_SPIN(xb_ld(&bar[XB_TOPGEN]) == tg, bar);
            __builtin_amdgcn_fence(__ATOMIC_ACQUIRE, "agent");
            xb_add(&bar[XB_XGEN(b.x)], 1u);
            asm volatile("s_waitcnt vmcnt(0)" ::: "memory");
        } else {
            XB_SPIN(xb_ld(&bar[XB_XGEN(b.x)]) == gen, bar);
            __builtin_amdgcn_fence(__ATOMIC_ACQUIRE, "agent");
            asm volatile("s_waitcnt vmcnt(0)" ::: "memory");
        }
    }
    __syncthreads();
}
struct Args {
    const float* in[19]; float* out; unsigned char* ws;
    double invf[32];
    unsigned char bucket[136];
};
__device__ __forceinline__ float wave_sum(float v) {
#pragma unroll
    for (int o = 1; o < 64; o <<= 1) v += __shfl_xor(v, o);
    return v;
}
__device__ __forceinline__ void cvt_item(const float* W, int Nsrc, int scol0, bool ropep, bf16* Wt, int K, int drow0, int k0, LAS unsigned char* T, int lane, const float* gain, int tiledN = 0, int f8s = -1, const float* cmax = nullptr, int cstride = 0, float* cmfinal = nullptr) {
    const int rp = lane >> 4, c4 = lane & 15;
    if (scol0 >= 0) {
#pragma unroll
        for (int i = 0; i < 8; ++i) { const int k = 8 * i + 2 * rp;
            f32x4 a = __builtin_nontemporal_load((const GAS f32x4*)(W + (size_t)(k0 + k) * Nsrc + scol0 + 4 * c4));
            f32x4 b = __builtin_nontemporal_load((const GAS f32x4*)(W + (size_t)(k0 + k + 1) * Nsrc + scol0 + 4 * c4));
            if (gain) { a = a * gain[k0 + k]; b = b * gain[k0 + k + 1]; }
#pragma unroll
            for (int e = 0; e < 4; ++e) { const int c = 4 * c4 + e; *(LAS unsigned*)(T + c * 136 + k * 2) = pk2(a[e], b[e]); } }
    }
    LDS_WAIT(); asm volatile("" ::: "memory");
    const int kc = lane & 7, nr = lane >> 3;
#pragma unroll
    for (int j = 0; j < 8; ++j) { const int c = 8 * j + nr;
        v4u o = {0u, 0u, 0u, 0u};
        if (scol0 >= 0) { const v2u lo = *(const LAS v2u*)(T + c * 136 + kc * 16), hi2 = *(const LAS v2u*)(T + c * 136 + kc * 16 + 8); o.x = lo.x; o.y = lo.y; o.z = hi2.x; o.w = hi2.y; }
        int p = c; if (ropep) { const int half = c >> 5, i5 = c & 31; p = 8 * (i5 >> 2) + (i5 & 3) + 4 * half; }
        if (cmax) {
            float cm = 0.f;
#pragma unroll
            for (int sg_ = 0; sg_ < 8; ++sg_) cm = fmaxf(cm, cmax[(size_t)sg_ * cstride + scol0 + c]);
            if (k0 == 0 && kc == 0) cmfinal[scol0 + c] = cm;
            const float inv = 127.f / fmaxf(cm, 1e-30f); const float v8[8] = {bfu_lo(o.x), bfu_hi(o.x), bfu_lo(o.y), bfu_hi(o.y), bfu_lo(o.z), bfu_hi(o.z), bfu_lo(o.w), bfu_hi(o.w)};
            unsigned q0 = 0, q1 = 0;
#pragma unroll
            for (int e = 0; e < 4; ++e) { q0 |= ((unsigned)(int)rintf(v8[e] * inv) & 0xffu) << (8 * e); q1 |= ((unsigned)(int)rintf(v8[4 + e] * inv) & 0xffu) << (8 * e); }
            v2u q; q.x = q0; q.y = q1;
            *(GAS v2u*)((unsigned char*)Wt + ((size_t)(k0 >> 7) * tiledN + drow0 + p) * 128 + (k0 & 64) + 8 * kc) = q; }
        else if (f8s >= 0) {
            const float scl = __uint_as_float((unsigned)(127 + f8s) << 23); v2u q;
            int w0 = 0, w1 = 0;
            w0 = __builtin_amdgcn_cvt_pk_fp8_f32(bfu_lo(o.x) * scl, bfu_hi(o.x) * scl, w0, false); w0 = __builtin_amdgcn_cvt_pk_fp8_f32(bfu_lo(o.y) * scl, bfu_hi(o.y) * scl, w0, true);
            w1 = __builtin_amdgcn_cvt_pk_fp8_f32(bfu_lo(o.z) * scl, bfu_hi(o.z) * scl, w1, false); w1 = __builtin_amdgcn_cvt_pk_fp8_f32(bfu_lo(o.w) * scl, bfu_hi(o.w) * scl, w1, true);
            q.x = (unsigned)w0; q.y = (unsigned)w1;
            *(GAS v2u*)((unsigned char*)Wt + ((size_t)(k0 >> 7) * tiledN + drow0 + p) * 128 + (k0 & 64) + 8 * kc) = q; }
        else if (tiledN) *(GAS v4u*)(Wt + ((size_t)(k0 >> 6) * tiledN + drow0 + p) * 64 + 8 * kc) = o;
        else *(GAS v4u*)(Wt + (size_t)(drow0 + p) * K + k0 + 8 * kc) = o; }
    LDS_WAIT(); asm volatile("" ::: "memory");
}
template <int KIND>
__device__ __forceinline__ void cvt_job(const float* W, int K, int Nsrc, bf16* Wt, int ndb, LAS unsigned char* T, int gw, int NGW, int lane, const float* gain = nullptr, int tiledN = 0, int f8s = -1, const float* cmax = nullptr, int cstride = 0, float* cmfinal = nullptr, int jph = 0, int jnp = 1) {
    const int nkb = K / 64, nit = ndb * nkb;
    for (int it = gw + NGW * jph; it < nit; it += NGW * jnp) { const int db = it / nkb, kb = it - db * nkb;
        int scol = 64 * db; bool rp = false;
        if constexpr (KIND == 1) { const int pn = db >> 2, sub = db & 3; scol = (sub < 2) ? (128 * pn + 64 * sub) : (DFF + 128 * pn + 64 * (sub - 2)); }
        if constexpr (KIND == 2) { if (db < 24) scol = 64 * db; else if (db < 88) scol = 64 * db + 64; else if (db == 88) { scol = 1536; rp = true; } else scol = -1; }
        if constexpr (KIND == 4) { scol = 5696 + 64 * db; }
        if constexpr (KIND == 3) { rp = (db % 3) == 2; }
        cvt_item(W, Nsrc, scol, rp, Wt, K, 64 * db, 64 * kb, T, lane, gain, tiledN, f8s, cmax, cstride, cmfinal); }
}
template <bool OUTF32>
__device__ __forceinline__ void rms_row4096(const float* xrow, const float* g, void* orow, int lane, int tiledM = 0) {
    const GAS f32x4* xr = (const GAS f32x4*)xrow + lane;
    f32x4 v[16]; float s = 0.f;
#pragma unroll
    for (int j = 0; j < 16; ++j) { v[j] = xr[64 * j]; s += (v[j].x * v[j].x + v[j].y * v[j].y) + (v[j].z * v[j].z + v[j].w * v[j].w); }
    const float rstd = 1.0f / sqrtf(wave_sum(s) * (1.f / DM) + RMS_EPS);
    const GAS f32x4* gr = (const GAS f32x4*)g + lane;
#pragma unroll
    for (int j = 0; j < 16; ++j) { const f32x4 gg = gr[64 * j]; const f32x4 y = (v[j] * rstd) * gg;
        if constexpr (OUTF32) ((GAS f32x4*)orow)[64 * j + lane] = y;
        else { v2u w; w.x = pk2(y.x, y.y); w.y = pk2(y.z, y.w);
            if (tiledM) { const int col = 4 * (64 * j + lane); *(GAS v2u*)((bf16*)orow + ((size_t)(col >> 6) * tiledM) * 64 + (col & 63)) = w; }
            else ((GAS v2u*)orow)[64 * j + lane] = w; } }
}
template <int N>
__device__ __forceinline__ void rms_row_bf16(bf16* row, const float* g, int lane) {
    constexpr int NV = N / 512;
    v4u w[NV]; float s = 0.f;
#pragma unroll
    for (int j = 0; j < NV; ++j) { w[j] = *(const GAS v4u*)(row + (64 * j + lane) * 8);
#pragma unroll
        for (int e = 0; e < 4; ++e) { const float a = bfu_lo(w[j][e]), b = bfu_hi(w[j][e]); s += a * a + b * b; } }
    const float rstd = 1.0f / sqrtf(wave_sum(s) * (1.f / N) + RMS_EPS);
#pragma unroll
    for (int j = 0; j < NV; ++j) { const GAS f32x4* gp = (const GAS f32x4*)(g + (64 * j + lane) * 8); const f32x4 g0 = gp[0], g1 = gp[1]; v4u o;
        o.x = pk2(bfu_lo(w[j].x) * rstd * g0.x, bfu_hi(w[j].x) * rstd * g0.y); o.y = pk2(bfu_lo(w[j].y) * rstd * g0.z, bfu_hi(w[j].y) * rstd * g0.w);
        o.z = pk2(bfu_lo(w[j].z) * rstd * g1.x, bfu_hi(w[j].z) * rstd * g1.y); o.w = pk2(bfu_lo(w[j].w) * rstd * g1.z, bfu_hi(w[j].w) * rstd * g1.w);
        *(GAS v4u*)(row + (64 * j + lane) * 8) = o; }
}
__device__ __forceinline__ void colmax_job(const float* W, int K, int N, float* cpart, int cstride, int gw, int NGW, int lane) {
    const int nseg = K / 512, ntask = (N / 64) * nseg, rp = lane >> 4, c4 = lane & 15;
    for (int it = gw; it < ntask; it += NGW) { const int cb = it / nseg, sg = it - cb * nseg; f32x4 m = {0.f, 0.f, 0.f, 0.f};
        const float* wp = W + (size_t)(sg * 512 + rp) * N + cb * 64 + 4 * c4;
#pragma unroll 8
        for (int i = 0; i < 128; ++i) { const f32x4 v = __builtin_nontemporal_load((const GAS f32x4*)(wp + (size_t)(4 * i) * N));
            m[0] = fmaxf(m[0], fabsf(v[0])); m[1] = fmaxf(m[1], fabsf(v[1])); m[2] = fmaxf(m[2], fabsf(v[2])); m[3] = fmaxf(m[3], fabsf(v[3])); }
#pragma unroll
        for (int e = 0; e < 4; ++e) { float x = m[e]; x = fmaxf(x, __shfl_xor(x, 16)); x = fmaxf(x, __shfl_xor(x, 32)); if (rp == 0) cpart[(size_t)sg * cstride + cb * 64 + 4 * c4 + e] = x; } }
}
__device__ __forceinline__ void quant_row_plain_i8(const bf16* T, unsigned char* a8, int row, float* rs, int lane) {
    const GAS v4u* src = (const GAS v4u*)(T + (size_t)row * DM + lane * 64);
    v4u w[8]; float mx = 0.f;
#pragma unroll
    for (int j = 0; j < 8; ++j) w[j] = src[j];
#pragma unroll
    for (int j = 0; j < 8; ++j)
#pragma unroll
        for (int e = 0; e < 4; ++e) mx = fmaxf(mx, fmaxf(fabsf(bfu_lo(w[j][e])), fabsf(bfu_hi(w[j][e]))));
#pragma unroll
    for (int o = 1; o < 64; o <<= 1) mx = fmaxf(mx, __shfl_xor(mx, o));
    mx = fmaxf(mx, 1e-30f); const float inv = 127.f / mx;
    v4u o[4];
#pragma unroll
    for (int j = 0; j < 8; ++j) { unsigned q0 = 0, q1 = 0;
#pragma unroll
        for (int e = 0; e < 2; ++e) { const unsigned a = w[j][e], b2 = w[j][2 + e];
            q0 |= (((unsigned)(int)rintf(bfu_lo(a) * inv) & 0xffu) | (((unsigned)(int)rintf(bfu_hi(a) * inv) & 0xffu) << 8)) << (16 * e);
            q1 |= (((unsigned)(int)rintf(bfu_lo(b2) * inv) & 0xffu) | (((unsigned)(int)rintf(bfu_hi(b2) * inv) & 0xffu) << 8)) << (16 * e); }
        o[j >> 1][2 * (j & 1)] = q0; o[j >> 1][2 * (j & 1) + 1] = q1; }
    GAS v4u* dst = (GAS v4u*)(a8 + ((size_t)(lane >> 1) * M_ + row) * 128 + (lane & 1) * 64);
#pragma unroll
    for (int j = 0; j < 4; ++j) dst[j] = o[j];
    if (lane == 0) rs[row] = mx * (1.f / 127.f);
}
__device__ __forceinline__ void rms_row4096_i8(const float* xrow, const float* g, unsigned char* a8, int row, float* rs, int lane) {
    const GAS f32x4* xr = (const GAS f32x4*)xrow + lane;
    f32x4 v[16]; float s = 0.f;
#pragma unroll
    for (int j = 0; j < 16; ++j) { v[j] = xr[64 * j]; s += (v[j].x * v[j].x + v[j].y * v[j].y) + (v[j].z * v[j].z + v[j].w * v[j].w); }
    const float rstd = 1.0f / sqrtf(wave_sum(s) * (1.f / DM) + RMS_EPS);
    const GAS f32x4* gr = (const GAS f32x4*)g + lane; float mx = 0.f;
#pragma unroll
    for (int j = 0; j < 16; ++j) { const f32x4 gg = gr[64 * j]; v[j] = (v[j] * rstd) * gg; mx = fmaxf(fmaxf(mx, fmaxf(fabsf(v[j].x), fabsf(v[j].y))), fmaxf(fabsf(v[j].z), fabsf(v[j].w))); }
#pragma unroll
    for (int o = 1; o < 64; o <<= 1) mx = fmaxf(mx, __shfl_xor(mx, o));
    mx = fmaxf(mx, 1e-30f); const float inv = 127.f / mx;
#pragma unroll
    for (int j = 0; j < 16; ++j) { const int col = 4 * (64 * j + lane);
        const unsigned q = ((unsigned)(int)rintf(v[j].x * inv) & 0xffu) | (((unsigned)(int)rintf(v[j].y * inv) & 0xffu) << 8) | (((unsigned)(int)rintf(v[j].z * inv) & 0xffu) << 16) | (((unsigned)(int)rintf(v[j].w * inv) & 0xffu) << 24);
        *(GAS unsigned*)(a8 + ((size_t)(col >> 7) * M_ + row) * 128 + (col & 127)) = q; }
    if (lane == 0) rs[row] = mx * (1.f / 127.f);
}
__device__ __forceinline__ void quant_row_i8(const bf16* hb, const float* part, const float* pmax, unsigned char* a8, int row, float* rs, int lane) {
    float s = part[(size_t)row * 64 + lane], mx = pmax[(size_t)row * 64 + lane];
    s = wave_sum(s);
#pragma unroll
    for (int o = 1; o < 64; o <<= 1) mx = fmaxf(mx, __shfl_xor(mx, o));
    mx = fmaxf(mx, 1e-30f); const float inv = 127.f / mx;
    const GAS v4u* src = (const GAS v4u*)(hb + ((size_t)lane * M_ + row) * 64);
    v4u w[8];
#pragma unroll
    for (int j = 0; j < 8; ++j) w[j] = src[j];
    v4u o[4];
#pragma unroll
    for (int j = 0; j < 8; ++j) { unsigned q0 = 0, q1 = 0;
#pragma unroll
        for (int e = 0; e < 2; ++e) { const unsigned a = w[j][e], b = w[j][2 + e];
            q0 |= (((unsigned)(int)rintf(bfu_lo(a) * inv) & 0xffu) | (((unsigned)(int)rintf(bfu_hi(a) * inv) & 0xffu) << 8)) << (16 * e);
            q1 |= (((unsigned)(int)rintf(bfu_lo(b) * inv) & 0xffu) | (((unsigned)(int)rintf(bfu_hi(b) * inv) & 0xffu) << 8)) << (16 * e); }
        o[j >> 1][2 * (j & 1)] = q0; o[j >> 1][2 * (j & 1) + 1] = q1; }
    GAS v4u* dst = (GAS v4u*)(a8 + ((size_t)(lane >> 1) * M_ + row) * 128 + (lane & 1) * 64);
#pragma unroll
    for (int j = 0; j < 4; ++j) dst[j] = o[j];
    if (lane == 0) rs[row] = mx * (1.f / 127.f) / sqrtf(s * (1.f / DM) + RMS_EPS);
}
template <int NP>
__device__ __forceinline__ void rstd_reduce(const float* part, float* rstd, float inv_n, int vcu, int tid, int G) {
    for (int row = vcu * (NWAVES * 64) + tid; row < M_; row += G * NWAVES * 64) { float s = 0.f;
#pragma unroll
        for (int j = 0; j < NP / 4; ++j) { const f32x4 v = *(const GAS f32x4*)(part + (size_t)row * NP + 4 * j); s += (v.x + v.y) + (v.z + v.w); }
        rstd[row] = 1.0f / sqrtf(s * inv_n + RMS_EPS); }
}
__device__ __forceinline__ void sincos_d(double a, float& sn, float& cs) {
    const double k = rint(a * 0.63661977236758134308);
    double r = fma(-k, 1.57079632679489655800, a); r = fma(-k, 6.12323399573676603587e-17, r);
    const double r2 = r * r;
    const double sp = r + r * r2 * (-1.0 / 6 + r2 * (1.0 / 120 + r2 * (-1.0 / 5040 + r2 * (1.0 / 362880 + r2 * (-1.0 / 39916800)))));
    const double cp = 1.0 + r2 * (-0.5 + r2 * (1.0 / 24 + r2 * (-1.0 / 720 + r2 * (1.0 / 40320 + r2 * (-1.0 / 3628800 + r2 * (1.0 / 479001600))))));
    const int q = (int)((long long)k & 3);
    const double s_ = (q & 1) ? cp : sp, c_ = (q & 1) ? sp : cp;
    sn = (float)((q & 2) ? -s_ : s_); cs = (float)(((q + 1) & 2) ? -c_ : c_);
}
__device__ __forceinline__ int list_off(int kb) { return 16384 * kb - 128 * kb * (kb + 1); }
__device__ __forceinline__ bool better(float v, int i, float cv, int ci) { return v > cv || (v == cv && i < ci); }
#define TOP3_INS(v_, i_) do { const float vv_ = (v_); const int ii_ = (i_);                                             \
        const bool c0_ = better(vv_, ii_, tv0, ti0), c1_ = better(vv_, ii_, tv1, ti1), c2_ = better(vv_, ii_, tv2, ti2); \
        tv2 = c1_ ? tv1 : (c2_ ? vv_ : tv2); ti2 = c1_ ? ti1 : (c2_ ? ii_ : ti2);                                       \
        tv1 = c0_ ? tv0 : (c1_ ? vv_ : tv1); ti1 = c0_ ? ti0 : (c1_ ? ii_ : ti1);                                       \
        tv0 = c0_ ? vv_ : tv0; ti0 = c0_ ? ii_ : ti0; } while (0)
__device__ __forceinline__ void moba_gate_unit(int h, int qb, const bf16* QB, const float* KMF, unsigned* gcnt, unsigned* list, float* PML,
                                               LAS unsigned* cntL, LAS unsigned* baseL, int wv) {
    int tid_ = wv * 64 + lane_id_(); asm volatile("" : "+v"(tid_)); const int tid = tid_, wid = wv, lane = tid & 63, r32 = lane & 31, hi = lane >> 5;
    if (tid < 64) cntL[tid] = 0u;
    __syncthreads();
    const int s = qb * MBLK + wid * 32 + r32;
    bf16x8 qr[8];
#pragma unroll
    for (int d0 = 0; d0 < 8; ++d0) qr[d0] = *(const GAS bf16x8*)(QB + (size_t)s * MOBAW + h * 128 + d0 * 16 + hi * 8);
    f32x16 p0 = {}, p1 = {};
#pragma unroll
    for (int d0 = 0; d0 < 8; ++d0) {
#pragma unroll
        for (int half = 0; half < 2; ++half) { const float* kp = KMF + (size_t)(h * NBLK + half * 32 + r32) * 128 + d0 * 16 + hi * 8;
            const f32x4 a = *(const GAS f32x4*)kp, b = *(const GAS f32x4*)(kp + 4); const float v[8] = {a[0], a[1], a[2], a[3], b[0], b[1], b[2], b[3]};
            bf16x8 fh, fl;
#pragma unroll
            for (int j = 0; j < 8; ++j) { const unsigned hb_ = f2bf(v[j]); fh[j] = (short)hb_; fl[j] = (short)f2bf(v[j] - __uint_as_float(hb_ << 16)); }
            if (half == 0) { p0 = __builtin_amdgcn_mfma_f32_32x32x16_bf16(fh, qr[d0], p0, 0, 0, 0); p0 = __builtin_amdgcn_mfma_f32_32x32x16_bf16(fl, qr[d0], p0, 0, 0, 0); }
            else { p1 = __builtin_amdgcn_mfma_f32_32x32x16_bf16(fh, qr[d0], p1, 0, 0, 0); p1 = __builtin_amdgcn_mfma_f32_32x32x16_bf16(fl, qr[d0], p1, 0, 0, 0); } } }
    const float NEG = -__builtin_inff();
    float tv0 = NEG, tv1 = NEG, tv2 = NEG; int ti0 = 1000, ti1 = 1001, ti2 = 1002;
#pragma unroll
    for (int r = 0; r < 16; ++r) { const int n = (r & 3) + 8 * (r >> 2) + 4 * hi; TOP3_INS(n < qb ? p0[r] : NEG, n); }
#pragma unroll
    for (int r = 0; r < 16; ++r) { const int n = 32 + (r & 3) + 8 * (r >> 2) + 4 * hi; TOP3_INS(n < qb ? p1[r] : NEG, n); }
    { const float ov0 = __shfl_xor(tv0, 32), ov1 = __shfl_xor(tv1, 32), ov2 = __shfl_xor(tv2, 32);
      const int oi0 = __shfl_xor(ti0, 32), oi1 = __shfl_xor(ti1, 32), oi2 = __shfl_xor(ti2, 32);
      TOP3_INS(ov0, oi0); TOP3_INS(ov1, oi1); TOP3_INS(ov2, oi2); }
    const bool act = (hi == 0);
    const bool ok0 = act && tv0 > NEG, ok1 = act && tv1 > NEG, ok2 = act && tv2 > NEG;
    unsigned rk0 = 0, rk1 = 0, rk2 = 0;
    if (ok0) rk0 = atomicAdd((unsigned*)(cntL + ti0), 1u);
    if (ok1) rk1 = atomicAdd((unsigned*)(cntL + ti1), 1u);
    if (ok2) rk2 = atomicAdd((unsigned*)(cntL + ti2), 1u);
    if (act) { float* ml = PML + (size_t)((s * 16 + h) * 4) * 2;
        if (!ok0) { ml[0] = -1e30f; ml[1] = 0.f; } if (!ok1) { ml[2] = -1e30f; ml[3] = 0.f; } if (!ok2) { ml[4] = -1e30f; ml[5] = 0.f; } }
    __syncthreads();
    if (tid < 64) { const unsigned n = cntL[tid]; baseL[tid] = n ? atomicAdd(gcnt + h * NBLK + tid, n) : 0u; }
    __syncthreads();
    unsigned* lh = list + (size_t)h * LIST_PER_HEAD;
    if (ok0) lh[list_off(ti0) + baseL[ti0] + rk0] = (unsigned)s | (0u << 16);
    if (ok1) lh[list_off(ti1) + baseL[ti1] + rk1] = (unsigned)s | (1u << 16);
    if (ok2) lh[list_off(ti2) + baseL[ti2] + rk2] = (unsigned)s | (2u << 16);
    __syncthreads();
}
#if PROBE_PHASE == 500
constexpr int CW_FAIL = 8;
__device__ __forceinline__ float blk_reduce(float v, bool domax, float* red, int tid) {
#pragma unroll
    for (int o = 1; o < 64; o <<= 1) { const float y = __shfl_xor(v, o); v = domax ? fmaxf(v, y) : v + y; }
    __syncthreads();
    if ((tid & 63) == 0) red[tid >> 6] = v;
    __syncthreads();
    float r = red[0];
    for (int w = 1; w < 8; ++w) r = domax ? fmaxf(r, red[w]) : r + red[w];
    return r;
}
__device__ __forceinline__ float bfv(const bf16* p) { return __uint_as_float(((unsigned)*p) << 16); }
__device__ __forceinline__ int sample_row(int i) {
    const int fixed[16] = {0, 1, 31, 32, 63, 64, 255, 256, 257, 511, 512, 767, 1023, 8191, 16383, 16128};
    if (i < 16) return fixed[i];
    return (int)(((unsigned)i * 2654435761u) >> 18) & 16383;
}
__device__ __forceinline__ void selfcheck(unsigned char* lds, unsigned char* ws, const int* pos, const bf16* OBc, int G, int bid) {
    const int tid = threadIdx.x;
    float* lg = (float*)lds;
    float* red = (float*)(lds + 65536);
    float* po = (float*)(lds + 65536 + 64);
    float* gate = (float*)(lds + 65536 + 64 + 2048);
    int* sel = (int*)(lds + 65536 + 64 + 2048 + 256);
    gu32* ctl = (gu32*)(ws + WS_CTL);
    bf16* KR = (bf16*)(ws + WS_KR); bf16* QB = (bf16*)(ws + WS_QB); bf16* KB = (bf16*)(ws + WS_KB); bf16* VB = (bf16*)(ws + WS_VB);
    bf16* QM = (bf16*)(ws + WS_QM); bf16* KV = (bf16*)(ws + WS_KV); bf16* OA = (bf16*)(ws + WS_OA); float* BIAS = (float*)(ws + WS_BIAS);
    unsigned nbad = 0;
    for (int u = bid; u < 64 * 16; u += G) { const int s = sample_row(u >> 4), h = u & 15;
        { const bf16* q = QM + (size_t)s * QUP + h * 192; float mx = -1e30f;
          for (int k = tid; k <= s; k += 512) { const bf16* kn = KV + (size_t)k * KVUP + h * 256; const bf16* kr = KR + (size_t)k * 64; float a = 0.f;
              for (int d = 0; d < 128; ++d) a += bfv(q + d) * bfv(kn + d);
              for (int d = 0; d < 64; ++d) a += bfv(q + 128 + d) * bfv(kr + d);
              a *= 0.07216878364870322f; lg[k] = a; mx = fmaxf(mx, a); }
          mx = blk_reduce(mx, true, red, tid);
          float sm = 0.f; for (int k = tid; k <= s; k += 512) { const float p = expf(lg[k] - mx); lg[k] = p; sm += p; }
          sm = blk_reduce(sm, false, red, tid);
          const int d = tid & 127, part = tid >> 7; float o = 0.f;
          for (int k = part; k <= s; k += 4) o += lg[k] * bfv(KV + (size_t)k * KVUP + h * 256 + 128 + d);
          po[part * 128 + d] = o; __syncthreads();
          float amax = 0.f;
          if (tid < 128) { const float ref = (po[tid] + po[128 + tid] + po[256 + tid] + po[384 + tid]) / sm; po[tid] = ref; amax = fabsf(ref); }
          amax = blk_reduce(amax, true, red, tid);
          if (tid < 128) { const float got = bfv(OA + (size_t)s * MLAOUT + h * 128 + tid); if (!(fabsf(got - po[tid]) <= SELFCHECK_REL * amax + SELFCHECK_ABS)) nbad++; }
          __syncthreads(); }
        { const bf16* q = QB + (size_t)s * MOBAW + h * 128; const int qb = s >> 8; const int d = tid & 127, part = tid >> 7;
          for (int n = 0; n < qb; ++n) { float a = 0.f;
              for (int r = part * 64; r < part * 64 + 64; ++r) a += bfv(KB + (size_t)(n * 256 + r) * MOBAW + h * 128 + d);
              a = a * (1.f / 256.f) * bfv(q + d);
              a = blk_reduce(a, false, red, tid);
              if (tid == 0) gate[n] = a; }
          __syncthreads();
          if (tid == 0) { float g0 = -1e30f, g1 = -1e30f, g2 = -1e30f; int i0 = -1, i1 = -1, i2 = -1;
              for (int n = 0; n < qb; ++n) { const float g = gate[n];
                  if (g > g0) { g2 = g1; i2 = i1; g1 = g0; i1 = i0; g0 = g; i0 = n; } else if (g > g1) { g2 = g1; i2 = i1; g1 = g; i1 = n; } else if (g > g2) { g2 = g; i2 = n; } }
              sel[0] = i0; sel[1] = i1; sel[2] = i2; sel[3] = qb; }
          __syncthreads();
          float mx = -1e30f; const int pq = pos[s];
          for (int e = tid; e < 1024; e += 512) { const int j = e >> 8, kk = e & 255; const int blk = sel[j]; float a = -1e30f;
              if (blk >= 0) { const int key = blk * 256 + kk;
                  if (j < 3 || key <= s) { const bf16* kp = KB + (size_t)key * MOBAW + h * 128; float dsum = 0.f;
                      for (int dd = 0; dd < 128; ++dd) dsum += bfv(q + dd) * bfv(kp + dd);
                      int dist = pq - pos[key]; dist = dist < 0 ? 0 : (dist > 128 ? 128 : dist);
                      a = dsum * (0.08838834764831845f * 1.4426950408889634f) + BIAS[h * 132 + dist]; } }
              lg[e] = a; mx = fmaxf(mx, a); }
          mx = blk_reduce(mx, true, red, tid);
          float sm = 0.f; for (int e = tid; e < 1024; e += 512) { const float p = lg[e] > -1e29f ? exp2f(lg[e] - mx) : 0.f; lg[e] = p; sm += p; }
          sm = blk_reduce(sm, false, red, tid);
          float o = 0.f;
          for (int e = part; e < 1024; e += 4) { const int blk = sel[e >> 8]; if (blk >= 0 && lg[e] > 0.f) o += lg[e] * bfv(VB + (size_t)(blk * 256 + (e & 255)) * MOBAW + h * 128 + d); }
          po[part * 128 + d] = o; __syncthreads();
          float amax = 0.f;
          if (tid < 128) { const float ref = (po[tid] + po[128 + tid] + po[256 + tid] + po[384 + tid]) / sm; po[tid] = ref; amax = fabsf(ref); }
          amax = blk_reduce(amax, true, red, tid);
          if (tid < 128) { const float got = bfv(OBc + (size_t)s * MOBAW + h * 128 + tid); if (!(fabsf(got - po[tid]) <= SELFCHECK_REL * amax + SELFCHECK_ABS)) nbad++; }
          __syncthreads(); }
    }
    if (nbad) atomicAdd((unsigned*)(ctl + CW_FAIL), nbad);
}
#endif
struct NoConv { __device__ __forceinline__ void operator()(int, int, unsigned char*) const {} };
struct P7Conv {
    const Args& args; int vcu;
    __device__ __forceinline__ void operator()(int s, int wave, unsigned char* lds) const { int lane_ = lane_id_(); asm volatile("" : "+v"(lane_)); const int lane = lane_;
        unsigned char* ws = args.ws; const int NGW = (int)gridDim.x * NWAVES, gw = vcu * NWAVES + wave;
        LAS unsigned char* T = (LAS unsigned char*)lds + RING_OFF + wave * 8704;
        cvt_job<1>(args.in[16], DM, NFF2, (bf16*)(ws + WS_WFI2), NFF2 / 64, T, gw, NGW, lane, nullptr, NFF2, -1, (const float*)(ws + WS_CPART) + NFF2, 2 * NFF2, (float*)(ws + WS_CMAXF) + NFF2, s, 4);
        cvt_job<0>(args.in[12], MLAOUT, DM, (bf16*)(ws + WS_WBRA), DM / 64, T, gw, NGW, lane, nullptr, FP8_BR ? DM : 0, FP8_BR ? 5 : -1, nullptr, 0, nullptr, (s + 1) & 3, 4);
        cvt_job<0>(args.in[13], MOBAW, DM, (bf16*)(ws + WS_WBRB), DM / 64, T, gw, NGW, lane, nullptr, FP8_BR ? DM : 0, FP8_BR ? 5 : -1, nullptr, 0, nullptr, (s + 2) & 3, 4);
#if I8_OUT
        cvt_job<0>(args.in[14], DM, DM, (bf16*)(ws + WS_WOUT), DM / 64, T, gw, NGW, lane, nullptr, DM, -1, (const float*)(ws + WS_CPARTO), DM, (float*)(ws + WS_CMAXO), (s + 1) & 3, 4); }
#else
        cvt_job<0>(args.in[14], DM, DM, (bf16*)(ws + WS_WOUT), DM / 64, T, gw, NGW, lane, nullptr, FP8_OUT ? DM : 0, FP8_OUT ? 6 : -1, nullptr, 0, nullptr, (s + 1) & 3, 4); }
#endif
};
template <int WHICH, class Conv>
__device__ __forceinline__ void p7_attention(unsigned char* lds, unsigned char* ws, const int* pos, int G, int bid, int wv, Conv conv) {
    int tid_ = wv * 64 + lane_id_(); asm volatile("" : "+v"(tid_)); const int tid = tid_, lane = tid & 63, wave = wv;
    gu32* ctl = (gu32*)(ws + WS_CTL); unsigned* GCNT = (unsigned*)(ctl + CW_GCNT);
    bf16* KR = (bf16*)(ws + WS_KR); bf16* QB = (bf16*)(ws + WS_QB); bf16* KB = (bf16*)(ws + WS_KB); bf16* VB = (bf16*)(ws + WS_VB);
    bf16* QM = (bf16*)(ws + WS_QM); bf16* KV = (bf16*)(ws + WS_KV); bf16* OA = (bf16*)(ws + WS_OA);
    float* BIAS = (float*)(ws + WS_BIAS); int* TPMAX = (int*)(ws + WS_TPMAX);
    unsigned* LIST = (unsigned*)(ws + WS_LIST); float* PML = (float*)(ws + WS_PML); bf16* PO = (bf16*)(ws + WS_PO);
        float* biasL = (float*)(lds + att::L_BIAS); unsigned* pref = (unsigned*)(lds + att::L_PREF); unsigned* wtot = pref + 1028;
        for (int i = tid; i < 16 * 132; i += NWAVES * 64) biasL[i] = BIAS[i];
        unsigned* cntS = (unsigned*)(lds + att::L_CNT);
        { const unsigned ca = __hip_atomic_load(GCNT + 2 * tid, RLX_AGENT), cb = __hip_atomic_load(GCNT + 2 * tid + 1, RLX_AGENT); cntS[2 * tid] = ca; cntS[2 * tid + 1] = cb;
          const unsigned a = (ca + 511u) >> 9, b = (cb + 511u) >> 9;
          unsigned s = a + b;
#pragma unroll
          for (int o_ = 1; o_ < 64; o_ <<= 1) { const unsigned y = __shfl_up(s, o_); if (lane >= o_) s += y; }
          if (lane == 63) wtot[wave] = s;
          __syncthreads();
          unsigned offs = 0; for (int w = 0; w < wave; ++w) offs += wtot[w];
          const unsigned incl = s + offs; pref[2 * tid] = incl - a - b; pref[2 * tid + 1] = incl - b; if (tid == NWAVES * 64 - 1) pref[1024] = incl; }
        __syncthreads();
        const int U = (int)pref[1024];
        int cslot = 0;
        const float c2_mla = 0.07216878364870322f * 1.4426950408889634f;
        const float c2_moba = 0.08838834764831845f * 1.4426950408889634f;
        if constexpr (WHICH & 1) for (int p = bid; p < 512; p += G) { const int h = p & 15, xx = p >> 4;
#pragma unroll 1
            for (int k = 0; k < 2; ++k) { const int qb = k ? xx : 63 - xx;
                att::UnitArgs A; A.Q = QM + h * 192; A.qpitch = QUP; A.K = KV + h * 256; A.kpitch = KVUP; A.Kr = KR; A.Q8 = ws + WS_QM8 + h * 192; A.K8 = ws + WS_KN8 + h * 128; A.Kr8 = ws + WS_KR8; A.V8 = ws + WS_V8 + (size_t)h * 256 * 8192; A.V = KV + h * 256 + 128; A.vpitch = KVUP;
                A.O = OA + h * 128; A.opitch = MLAOUT; A.PO = nullptr; A.PML = nullptr; A.pos = pos; A.tpmax = TPMAX; A.list = nullptr; A.nrows = 256;
                A.q0 = qb * 256; A.k0 = 0; A.NT = 4 * (qb + 1); A.h = h; A.c2 = c2_mla;
                att::attn_unit<192, 0>(A, (char*)lds, wv);
                if (cslot < 4) { conv(cslot++, wv, lds); __syncthreads(); } } }
        if constexpr (WHICH & 1) while (cslot < 4) { conv(cslot++, wv, lds); __syncthreads(); }
        if constexpr (WHICH & 2) for (int u = bid; u < U; u += G) {
            int lo = 0, hi_ = 1024;
            while (hi_ - lo > 1) { const int mid = (lo + hi_) >> 1; if (pref[mid] <= (unsigned)u) lo = mid; else hi_ = mid; }
            const int h = lo >> 6, kb = lo & 63, c = u - (int)pref[lo];
            const int cnt = (int)cntS[lo];
            att::UnitArgs A; A.Q = QB + h * 128; A.qpitch = MOBAW; A.K = KB + h * 128; A.kpitch = MOBAW; A.Kr = nullptr; A.Q8 = ws + WS_QB8 + h * 128; A.K8 = ws + WS_KB8 + h * 128; A.Kr8 = nullptr; A.V8 = ws + WS_VB8 + (size_t)h * 256 * 8192; A.V = VB + h * 128; A.vpitch = MOBAW;
            A.O = nullptr; A.opitch = 0; A.PO = PO; A.PML = PML; A.pos = pos; A.tpmax = TPMAX;
            A.list = LIST + (size_t)h * LIST_PER_HEAD + list_off(kb) + c * 512; A.nrows = min(512, cnt - c * 512);
            A.q0 = 0; A.k0 = kb * 256; A.NT = 4; A.h = h; A.c2 = c2_moba;
            att::moba_unit<1>(A, (char*)lds, wv, (A.nrows + 255) >> 8); }
        if constexpr (WHICH & 4) for (int u = bid; u < NBLK * NH; u += G) { const int h = u & 15, qb = u >> 4;
            att::UnitArgs A; A.Q = QB + h * 128; A.qpitch = MOBAW; A.K = KB + h * 128; A.kpitch = MOBAW; A.Kr = nullptr; A.Q8 = ws + WS_QB8 + h * 128; A.K8 = ws + WS_KB8 + h * 128; A.Kr8 = nullptr; A.V8 = ws + WS_VB8 + (size_t)h * 256 * 8192; A.V = VB + h * 128; A.vpitch = MOBAW;
            A.O = nullptr; A.opitch = 0; A.PO = PO; A.PML = PML; A.pos = pos; A.tpmax = TPMAX; A.list = nullptr; A.nrows = 256;
            A.q0 = qb * 256; A.k0 = qb * 256; A.NT = 4; A.h = h; A.c2 = c2_moba;
            att::moba_unit<2>(A, (char*)lds, wv, 1); }
}
__global__ void __launch_bounds__(NWAVES * 64, 2) hybrid_fwd(Args args) {
    extern __shared__ __attribute__((aligned(16))) unsigned char lds[];
    LAS unsigned char* ldsl = (LAS unsigned char*)lds;
    volatile LAS unsigned* MISC = (volatile LAS unsigned*)(ldsl + MISC_OFF);
    const int tid = threadIdx.x, lane = tid & 63, wave = __builtin_amdgcn_readfirstlane(tid >> 6);
    const int G = gridDim.x, bid = blockIdx.x;
    const int vcu = (G % 8 == 0) ? (bid % 8) * (G / 8) + bid / 8 : bid;
    const int gw = vcu * NWAVES + wave, NGW = G * NWAVES;
    unsigned char* ws = args.ws;
    gu32* ctl = (gu32*)(ws + WS_CTL);
    for (int u = tid; u < (LDS_BYTES - LDSCTL_OFF) / 4; u += NWAVES * 64) ((LAS unsigned*)(ldsl + LDSCTL_OFF))[u] = 0u;
    __syncthreads();
    XcdBarrier bar = xcd_barrier_post((unsigned*)(ctl + CW_BAR), MISC + 8, wave);
#if PROBE_PHASE == 99
#define GRID_BAR() do { xcd_barrier(bar, wave); xcd_barrier(bar, wave); } while (0)
#else
#define GRID_BAR() xcd_barrier(bar, wave)
#endif
    const float* x = args.in[0]; const int* pos = (const int*)args.in[1]; const float* rel_bias = args.in[2];
    float* out = args.out;
    bf16* WFI = (bf16*)(ws + WS_WFFN_IN); bf16* WFO = (bf16*)(ws + WS_WFFN_OUT); bf16* WIN = (bf16*)(ws + WS_WIN); bf16* WUQ = (bf16*)(ws + WS_WUQ);
    bf16* WUKV = (bf16*)(ws + WS_WUKV); bf16* WBRA = (bf16*)(ws + WS_WBRA); bf16* WBRB = (bf16*)(ws + WS_WBRB); bf16* WOUT = (bf16*)(ws + WS_WOUT);
    bf16* H = (bf16*)(ws + WS_H); bf16* ACT = (bf16*)(ws + WS_BIG);
    bf16* CQ = (bf16*)(ws + WS_CQ); bf16* CKV = (bf16*)(ws + WS_CKV); bf16* KR = (bf16*)(ws + WS_KR); bf16* QB = (bf16*)(ws + WS_QB); bf16* KB = (bf16*)(ws + WS_KB);
    bf16* VB = (bf16*)(ws + WS_VB); bf16* GA = (bf16*)(ws + WS_GA); bf16* GB = (bf16*)(ws + WS_GB);
    bf16* QM = (bf16*)(ws + WS_QM); bf16* KV = (bf16*)(ws + WS_KV); bf16* OA = (bf16*)(ws + WS_OA);
    float* COS = (float*)(ws + WS_COS); float* SIN = (float*)(ws + WS_SIN);
    bf16* KMH = (bf16*)(ws + WS_KMH); bf16* KML = (bf16*)(ws + WS_KML); float* BIAS = (float*)(ws + WS_BIAS); int* TPMAX = (int*)(ws + WS_TPMAX);
    unsigned* LIST = (unsigned*)(ws + WS_LIST); float* PML = (float*)(ws + WS_PML); bf16* PO = (bf16*)(ws + WS_PO);
    unsigned* GCNT = (unsigned*)(ctl + CW_GCNT);
    float* PART = (float*)(ws + WS_PART); float* RSTD = (float*)(ws + WS_RSTD); float* PARTQ = (float*)(ws + WS_PARTQ); float* PARTKV = (float*)(ws + WS_PARTKV);
    float* RSTDQ = (float*)(ws + WS_RSTDQ); float* RSTDKV = (float*)(ws + WS_RSTDKV); bf16* H3 = GB; (void)RSTDQ; (void)RSTDKV;
    float* CPART = (float*)(ws + WS_CPART); float* CMAXF = (float*)(ws + WS_CMAXF); const float* CMAX1 = CMAXF; const float* CMAX2 = CMAXF + NFF2; float* PMAX = (float*)(ws + WS_PMAX);
    unsigned char* H8 = ws + WS_H8; unsigned char* OA8 = ws + WS_OA8; unsigned char* OB8 = ws + WS_OB8; unsigned char* MG8 = ws + WS_MG8; unsigned char* WIN8 = ws + WS_WIN8;
#if PROBE_PHASE == 500
    bf16* OBC = (bf16*)(ws + ((WS_END + 4095) / 4096) * 4096);
#else
    bf16* OBC = QB;
#endif
    LAS unsigned char* cvtT = ldsl + RING_OFF + wave * 8704;

    { int tid_f = wave * 64 + lane_id_(); asm volatile("" : "+v"(tid_f)); const int tid = tid_f, lane = tid & 63; (void)lane; (void)tid;
    {
    colmax_job(args.in[4], DM, NFF2, CPART, 2 * NFF2, gw, NGW, lane); colmax_job(args.in[16], DM, NFF2, CPART + NFF2, 2 * NFF2, gw, NGW, lane);
#if I8_OUT
    colmax_job(args.in[14], DM, DM, (float*)(ws + WS_CPARTO), DM, gw, NGW, lane);
#endif
    cvt_job<2>(args.in[7], DM, INCOLS, WIN, INPAD1 / 64, cvtT, gw, NGW, lane, nullptr, INPAD1);
    cvt_job<4>(args.in[7], DM, INCOLS, (bf16*)WIN8, IN2 / 64, cvtT, gw, NGW, lane, nullptr, IN2, 6);
    cvt_job<3>(args.in[9], QLORA, QUP, WUQ, QUP / 64, cvtT, gw, NGW, lane, args.in[8]);
    cvt_job<0>(args.in[11], KVLORA, KVUP, WUKV, KVUP / 64, cvtT, gw, NGW, lane, args.in[10]);
    for (int idx = vcu * (NWAVES * 64) + tid; idx < M_ * 32; idx += G * NWAVES * 64) { const int s = idx >> 5, i = idx & 31;
        float sn, cs; sincos_d((double)pos[s] * args.invf[i], sn, cs); COS[idx] = cs; SIN[idx] = sn; }
    for (int idx = vcu * (NWAVES * 64) + tid; idx < 16 * 132; idx += G * NWAVES * 64) { const int h = idx / 132, d = idx - h * 132;
        BIAS[idx] = d <= 128 ? rel_bias[(int)args.bucket[d] * NH + h] * 1.4426950408889634f : 0.f; }
    for (int t = gw; t < 256; t += NGW) { int p = pos[t * 64 + lane];
#pragma unroll
        for (int o_ = 1; o_ < 64; o_ <<= 1) p = max(p, __shfl_xor(p, o_));
        if (lane == 0) TPMAX[t] = p; }
    for (int m = gw; m < M_; m += NGW) rms_row4096_i8(x + (size_t)m * DM, args.in[3], H8, m, RSTD, lane);
    }
#if PROBE_PHASE == 0
    {
    colmax_job(args.in[4], DM, NFF2, CPART, 2 * NFF2, gw, NGW, lane); colmax_job(args.in[16], DM, NFF2, CPART + NFF2, 2 * NFF2, gw, NGW, lane);
#if I8_OUT
    colmax_job(args.in[14], DM, DM, (float*)(ws + WS_CPARTO), DM, gw, NGW, lane);
#endif
    cvt_job<2>(args.in[7], DM, INCOLS, WIN, INPAD1 / 64, cvtT, gw, NGW, lane, nullptr, INPAD1);
    cvt_job<4>(args.in[7], DM, INCOLS, (bf16*)WIN8, IN2 / 64, cvtT, gw, NGW, lane, nullptr, IN2, 6);
    cvt_job<3>(args.in[9], QLORA, QUP, WUQ, QUP / 64, cvtT, gw, NGW, lane, args.in[8]);
    cvt_job<0>(args.in[11], KVLORA, KVUP, WUKV, KVUP / 64, cvtT, gw, NGW, lane, args.in[10]);
    for (int idx = vcu * (NWAVES * 64) + tid; idx < M_ * 32; idx += G * NWAVES * 64) { const int s = idx >> 5, i = idx & 31;
        float sn, cs; sincos_d((double)pos[s] * args.invf[i], sn, cs); COS[idx] = cs; SIN[idx] = sn; }
    for (int idx = vcu * (NWAVES * 64) + tid; idx < 16 * 132; idx += G * NWAVES * 64) { const int h = idx / 132, d = idx - h * 132;
        BIAS[idx] = d <= 128 ? rel_bias[(int)args.bucket[d] * NH + h] * 1.4426950408889634f : 0.f; }
    for (int t = gw; t < 256; t += NGW) { int p = pos[t * 64 + lane];
#pragma unroll
        for (int o_ = 1; o_ < 64; o_ <<= 1) p = max(p, __shfl_xor(p, o_));
        if (lane == 0) TPMAX[t] = p; }
    for (int m = gw; m < M_; m += NGW) rms_row4096_i8(x + (size_t)m * DM, args.in[3], H8, m, RSTD, lane);
    }
#endif
    }
    GRID_BAR();
#if PROBE_PHASE == 300
    {
        const bf16x8 fa = *(const GAS bf16x8*)(H + (size_t)(bid * 512 + tid) * 8), fb = *(const GAS bf16x8*)(H + (size_t)(bid * 512 + tid) * 8 + 65536);
        f32x4 ac[8];
#pragma unroll
        for (int i = 0; i < 8; ++i) ac[i] = (f32x4){0.f, 0.f, 0.f, 0.f};
#pragma unroll 1
        for (int it = 0; it < 5120; ++it) {
#pragma unroll
            for (int i = 0; i < 8; ++i) ac[i] = __builtin_amdgcn_mfma_f32_16x16x32_bf16(fa, fb, ac[i], 0, 0, 0); }
        float sacc = 0.f;
#pragma unroll
        for (int i = 0; i < 8; ++i) sacc += ac[i][0] + ac[i][1] + ac[i][2] + ac[i][3];
        if (sacc == 12345.678f) out[0] = 1.f;
    }
#endif
    { int tid_f = wave * 64 + lane_id_(); asm volatile("" : "+v"(tid_f)); const int lane = tid_f & 63;
      cvt_job<1>(args.in[4], DM, NFF2, WFI, NFF2 / 64, cvtT, gw, NGW, lane, nullptr, NFF2, -1, CPART, 2 * NFF2, CMAXF); }
    GRID_BAR();
    { pg8::Gemm g{(const bf16*)H8, WFI, M_, NFF2, DM / 2}; pg8::StaticOrder S; S.init(M_, NFF2, G, bid); pg8::EpiSwiglu E{ACT, DFF, RSTD, M_, CMAX1};
      pg8::gemm_phase<pg8::EpiSwiglu, pg8::StaticOrder, true, true, true, false, true>(ldsl + RING_OFF, g, S, E, wave); }
#if PROBE_PHASE == 1
    { pg8::Gemm g{(const bf16*)H8, WFI, M_, NFF2, DM / 2}; pg8::StaticOrder S; S.init(M_, NFF2, G, bid); pg8::EpiSwiglu E{ACT, DFF, RSTD, M_, CMAX1};
      pg8::gemm_phase<pg8::EpiSwiglu, pg8::StaticOrder, true, true, true, false, true>(ldsl + RING_OFF, g, S, E, wave); }
#endif
    if (G == 256 && bid >= 128) { int tid_f = wave * 64 + lane_id_(); asm volatile("" : "+v"(tid_f)); const int lane = tid_f & 63;
        cvt_job<0>(args.in[5], DFF, DM, WFO, DM / 64, cvtT, (bid - 128) * NWAVES + wave, 128 * NWAVES, lane, nullptr, DM); }
    else if (G != 256) { int tid_f = wave * 64 + lane_id_(); asm volatile("" : "+v"(tid_f)); const int lane = tid_f & 63; cvt_job<0>(args.in[5], DFF, DM, WFO, DM / 64, cvtT, gw, NGW, lane, nullptr, DM); }
    GRID_BAR();
    { pg8::Gemm g{ACT, WFO, M_, DM, DFF}; pg8::StaticOrder S; S.init(M_, DM, G, bid); pg8::EpiResidNorm<(long)WS_H8 - (long)WS_H> E{x, out, 0.5f, H, args.in[6], PART, nullptr};
      pg8::gemm_phase<pg8::EpiResidNorm<(long)WS_H8 - (long)WS_H>, pg8::StaticOrder, true, true, true>(ldsl + RING_OFF, g, S, E, wave); }
#if PROBE_PHASE == 2
    { pg8::Gemm g{ACT, WFO, M_, DM, DFF}; pg8::StaticOrder S; S.init(M_, DM, G, bid); pg8::EpiResidNorm<(long)WS_H8 - (long)WS_H> E{x, out, 0.5f, H, args.in[6], PART, nullptr};
      pg8::gemm_phase<pg8::EpiResidNorm<(long)WS_H8 - (long)WS_H>, pg8::StaticOrder, true, true, true>(ldsl + RING_OFF, g, S, E, wave); }
#endif
#if PROBE_PHASE == 801 || PROBE_PHASE == 802
    GRID_BAR();
    { pg8::Gemm g{ACT, WFO, PROBE_PHASE == 801 ? M_ : 0, PROBE_PHASE == 801 ? DM : 0, DFF}; pg8::StaticOrder S; S.init(M_, DM, G, bid); pg8::EpiNull E{};
      pg8::gemm_phase<pg8::EpiNull, pg8::StaticOrder, true, true, true>(ldsl + RING_OFF, g, S, E, wave); }
#endif
#if PROBE_PHASE == 803 || PROBE_PHASE == 804
    GRID_BAR();
    { pg8::Gemm g{(const bf16*)H8, WFI, PROBE_PHASE == 803 ? M_ : 0, PROBE_PHASE == 803 ? NFF2 : 0, DM / 2}; pg8::StaticOrder S; S.init(M_, NFF2, G, bid); pg8::EpiNull E{};
      pg8::gemm_phase<pg8::EpiNull, pg8::StaticOrder, true, true, true, false, true>(ldsl + RING_OFF, g, S, E, wave); }
#endif
    GRID_BAR();
    { int tid_f = wave * 64 + lane_id_(); asm volatile("" : "+v"(tid_f)); const int tid = tid_f, lane = tid & 63; (void)lane; (void)tid;
    rstd_reduce<64>(PART, RSTD, 1.f / DM, vcu, tid, G);
#if PROBE_PHASE == 3 || PROBE_PHASE == 38
    rstd_reduce<64>(PART, RSTD, 1.f / DM, vcu, tid, G);
#endif
    }
    GRID_BAR();
    { pg8::Gemm g{H, WIN, M_, INPAD1, DM}; pg8::StaticOrder S; S.init(M_, INPAD1, G, bid);
      pg8::EpiProj<1> E{CQ, CKV, KR, QB, KB, VB, GA, GB, COS, SIN, RSTD, PARTQ, PARTKV, (float*)(ctl + CW_KMEAN), ws + WS_KR8, ws + WS_QB8, ws + WS_KB8, ws + WS_VB8, 1.0f};
      pg8::gemm_phase<pg8::EpiProj<1>, pg8::StaticOrder, true, true, true>(ldsl + RING_OFF, g, S, E, wave); }
    { pg8::Gemm g{(const bf16*)H8, (const bf16*)WIN8, M_, IN2, DM / 2}; pg8::StaticOrder S; S.init(M_, IN2, G, bid);
      pg8::EpiProj<2> E{CQ, CKV, KR, QB, KB, VB, GA, GB, COS, SIN, RSTD, PARTQ, PARTKV, (float*)(ctl + CW_KMEAN), ws + WS_KR8, ws + WS_QB8, ws + WS_KB8, ws + WS_VB8, 0.015625f};
      pg8::gemm_phase<pg8::EpiProj<2>, pg8::StaticOrder, true, true, true, true>(ldsl + RING_OFF, g, S, E, wave); }
    GRID_BAR();
    { LAS unsigned* cntL = (LAS unsigned*)(ldsl + RING_OFF); LAS unsigned* baseL = cntL + 64;
      for (int u = bid; u < NBLK * NH; u += G) moba_gate_unit(u & 15, u >> 4, QB, (const float*)(ctl + CW_KMEAN), GCNT, LIST, PML, cntL, baseL, wave); }
    { pg8::Gemm g{CQ, WUQ, M_, QUP, QLORA}; pg8::StaticOrder S; S.init(M_, QUP, G, bid); pg8::EpiQ E{MLA_BF16 ? QM : nullptr, COS, SIN, PARTQ, ws + WS_QM8};
      pg8::gemm_phase<pg8::EpiQ, pg8::StaticOrder, true, true>(ldsl + RING_OFF, g, S, E, wave); }
    { pg8::Gemm g{CKV, WUKV, M_, KVUP, KVLORA}; pg8::StaticOrder S; S.init(M_, KVUP, G, bid); pg8::EpiPlain E{MLA_BF16 ? KV : nullptr, KVUP, PARTKV, ws + WS_KN8, ws + WS_V8};
      pg8::gemm_phase<pg8::EpiPlain, pg8::StaticOrder, true, true>(ldsl + RING_OFF, g, S, E, wave); }
#if PROBE_PHASE == 6
    { pg8::Gemm g{CQ, WUQ, M_, QUP, QLORA}; pg8::StaticOrder S; S.init(M_, QUP, G, bid); pg8::EpiQ E{MLA_BF16 ? QM : nullptr, COS, SIN, PARTQ, ws + WS_QM8};
      pg8::gemm_phase<pg8::EpiQ, pg8::StaticOrder, true, true>(ldsl + RING_OFF, g, S, E, wave); }
    { pg8::Gemm g{CKV, WUKV, M_, KVUP, KVLORA}; pg8::StaticOrder S; S.init(M_, KVUP, G, bid); pg8::EpiPlain E{MLA_BF16 ? KV : nullptr, KVUP, PARTKV, ws + WS_KN8, ws + WS_V8};
      pg8::gemm_phase<pg8::EpiPlain, pg8::StaticOrder, true, true>(ldsl + RING_OFF, g, S, E, wave); }
#endif
    GRID_BAR();
#if I8_FFN2
    p7_attention<7>(lds, ws, pos, G, bid, wave, P7Conv{args, vcu});
#else
    p7_attention<7>(lds, ws, pos, G, bid, wave, NoConv{});
#endif
#if PROBE_PHASE == 7
    p7_attention<7>(lds, ws, pos, G, bid, wave, NoConv{});
#endif
#if PROBE_PHASE == 71
    p7_attention<1>(lds, ws, pos, G, bid, wave, NoConv{});
#endif
#if PROBE_PHASE == 72
    p7_attention<2>(lds, ws, pos, G, bid, wave, NoConv{});
#endif
#if PROBE_PHASE == 74
    p7_attention<4>(lds, ws, pos, G, bid, wave, NoConv{});
#endif
    GRID_BAR();
    { int tid_f = wave * 64 + lane_id_(); asm volatile("" : "+v"(tid_f)); const int tid = tid_f, lane = tid & 63; (void)lane; (void)tid;
    for (int it = gw; it < M_ * NH / 4; it += NGW) { const int pair = it * 4 + (lane >> 4), c8 = lane & 15;
        const f32x4 ml0 = *(const GAS f32x4*)(PML + (size_t)pair * 8), ml1 = *(const GAS f32x4*)(PML + (size_t)pair * 8 + 4);
        const float m[4] = {ml0.x, ml0.z, ml1.x, ml1.z}, l[4] = {ml0.y, ml0.w, ml1.y, ml1.w};
        float mx = -1e30f;
#pragma unroll
        for (int j = 0; j < 4; ++j) if (l[j] > 0.f) mx = fmaxf(mx, m[j]);
        float w[4], wsum = 0.f;
#pragma unroll
        for (int j = 0; j < 4; ++j) { w[j] = l[j] > 0.f ? __builtin_amdgcn_exp2f(m[j] - mx) * l[j] : 0.f; wsum += w[j]; }
        const float inv = 1.0f / wsum; float acc[8] = {0.f, 0.f, 0.f, 0.f, 0.f, 0.f, 0.f, 0.f};
#pragma unroll
        for (int j = 0; j < 4; ++j) { const v4u o = *(const GAS v4u*)(PO + ((size_t)pair * 4 + j) * 128 + c8 * 8); const float wj = w[j] * inv;
            if (w[j] > 0.f) {
#pragma unroll
                for (int e = 0; e < 4; ++e) { acc[2 * e] += wj * bfu_lo(o[e]); acc[2 * e + 1] += wj * bfu_hi(o[e]); } } }
        const int row = pair >> 4, h = pair & 15; v4u r; r.x = pk2(acc[0], acc[1]); r.y = pk2(acc[2], acc[3]); r.z = pk2(acc[4], acc[5]); r.w = pk2(acc[6], acc[7]);
        *(GAS v4u*)(OBC + (size_t)row * MOBAW + h * 128 + c8 * 8) = r;
        { int w0 = 0, w1 = 0;
          w0 = __builtin_amdgcn_cvt_pk_fp8_f32(acc[0] * 16.f, acc[1] * 16.f, w0, false); w0 = __builtin_amdgcn_cvt_pk_fp8_f32(acc[2] * 16.f, acc[3] * 16.f, w0, true);
          w1 = __builtin_amdgcn_cvt_pk_fp8_f32(acc[4] * 16.f, acc[5] * 16.f, w1, false); w1 = __builtin_amdgcn_cvt_pk_fp8_f32(acc[6] * 16.f, acc[7] * 16.f, w1, true);
          v2u q; q.x = (unsigned)w0; q.y = (unsigned)w1; *(GAS v2u*)(OB8 + ((size_t)h * M_ + row) * 128 + c8 * 8) = q; } }
    for (int it = gw * 64 + lane; it < M_ * MLAOUT / 8; it += NGW * 64) { const int row = it >> 8, c8 = it & 255;
        const v4u o = *(const GAS v4u*)(OA + (size_t)row * MLAOUT + c8 * 8); int w0 = 0, w1 = 0;
        w0 = __builtin_amdgcn_cvt_pk_fp8_f32(bfu_lo(o.x) * 16.f, bfu_hi(o.x) * 16.f, w0, false); w0 = __builtin_amdgcn_cvt_pk_fp8_f32(bfu_lo(o.y) * 16.f, bfu_hi(o.y) * 16.f, w0, true);
        w1 = __builtin_amdgcn_cvt_pk_fp8_f32(bfu_lo(o.z) * 16.f, bfu_hi(o.z) * 16.f, w1, false); w1 = __builtin_amdgcn_cvt_pk_fp8_f32(bfu_lo(o.w) * 16.f, bfu_hi(o.w) * 16.f, w1, true);
        v2u q; q.x = (unsigned)w0; q.y = (unsigned)w1; *(GAS v2u*)(OA8 + ((size_t)(c8 >> 4) * M_ + row) * 128 + (c8 & 15) * 8) = q; }
#if PROBE_PHASE == 8 || PROBE_PHASE == 38
    for (int it = gw; it < M_ * NH / 4; it += NGW) { const int pair = it * 4 + (lane >> 4), c8 = lane & 15;
        const f32x4 ml0 = *(const GAS f32x4*)(PML + (size_t)pair * 8), ml1 = *(const GAS f32x4*)(PML + (size_t)pair * 8 + 4);
        const float m[4] = {ml0.x, ml0.z, ml1.x, ml1.z}, l[4] = {ml0.y, ml0.w, ml1.y, ml1.w};
        float mx = -1e30f;
#pragma unroll
        for (int j = 0; j < 4; ++j) if (l[j] > 0.f) mx = fmaxf(mx, m[j]);
        float w[4], wsum = 0.f;
#pragma unroll
        for (int j = 0; j < 4; ++j) { w[j] = l[j] > 0.f ? __builtin_amdgcn_exp2f(m[j] - mx) * l[j] : 0.f; wsum += w[j]; }
        const float inv = 1.0f / wsum; float acc[8] = {0.f, 0.f, 0.f, 0.f, 0.f, 0.f, 0.f, 0.f};
#pragma unroll
        for (int j = 0; j < 4; ++j) { const v4u o = *(const GAS v4u*)(PO + ((size_t)pair * 4 + j) * 128 + c8 * 8); const float wj = w[j] * inv;
            if (w[j] > 0.f) {
#pragma unroll
                for (int e = 0; e < 4; ++e) { acc[2 * e] += wj * bfu_lo(o[e]); acc[2 * e + 1] += wj * bfu_hi(o[e]); } } }
        const int row = pair >> 4, h = pair & 15; v4u r; r.x = pk2(acc[0], acc[1]); r.y = pk2(acc[2], acc[3]); r.z = pk2(acc[4], acc[5]); r.w = pk2(acc[6], acc[7]);
        *(GAS v4u*)(OBC + (size_t)row * MOBAW + h * 128 + c8 * 8) = r;
        { int w0 = 0, w1 = 0;
          w0 = __builtin_amdgcn_cvt_pk_fp8_f32(acc[0] * 16.f, acc[1] * 16.f, w0, false); w0 = __builtin_amdgcn_cvt_pk_fp8_f32(acc[2] * 16.f, acc[3] * 16.f, w0, true);
          w1 = __builtin_amdgcn_cvt_pk_fp8_f32(acc[4] * 16.f, acc[5] * 16.f, w1, false); w1 = __builtin_amdgcn_cvt_pk_fp8_f32(acc[6] * 16.f, acc[7] * 16.f, w1, true);
          v2u q; q.x = (unsigned)w0; q.y = (unsigned)w1; *(GAS v2u*)(OB8 + ((size_t)h * M_ + row) * 128 + c8 * 8) = q; } }
    for (int it = gw * 64 + lane; it < M_ * MLAOUT / 8; it += NGW * 64) { const int row = it >> 8, c8 = it & 255;
        const v4u o = *(const GAS v4u*)(OA + (size_t)row * MLAOUT + c8 * 8); int w0 = 0, w1 = 0;
        w0 = __builtin_amdgcn_cvt_pk_fp8_f32(bfu_lo(o.x) * 16.f, bfu_hi(o.x) * 16.f, w0, false); w0 = __builtin_amdgcn_cvt_pk_fp8_f32(bfu_lo(o.y) * 16.f, bfu_hi(o.y) * 16.f, w0, true);
        w1 = __builtin_amdgcn_cvt_pk_fp8_f32(bfu_lo(o.z) * 16.f, bfu_hi(o.z) * 16.f, w1, false); w1 = __builtin_amdgcn_cvt_pk_fp8_f32(bfu_lo(o.w) * 16.f, bfu_hi(o.w) * 16.f, w1, true);
        v2u q; q.x = (unsigned)w0; q.y = (unsigned)w1; *(GAS v2u*)(OA8 + ((size_t)(c8 >> 4) * M_ + row) * 128 + (c8 & 15) * 8) = q; }
#endif
    }
    GRID_BAR();
#if PROBE_PHASE == 500
    selfcheck(lds, ws, pos, OBC, G, bid);
    GRID_BAR();
#endif
#if FP8_BR
    { pg8::Gemm g{(const bf16*)OA8, WBRA, M_, DM, MLAOUT / 2}; pg8::StaticOrder S; S.init(M_, DM, G, bid); pg8::EpiMerge<false> E{GA, H, nullptr, 0.001953125f};
      pg8::gemm_phase<pg8::EpiMerge<false>, pg8::StaticOrder, true, true, true, true>(ldsl + RING_OFF, g, S, E, wave); }
    { pg8::Gemm g{(const bf16*)OB8, WBRB, M_, DM, MOBAW / 2}; pg8::StaticOrder S; S.init(M_, DM, G, bid); pg8::EpiMerge<true> E{GB, H, FP8_OUT ? MG8 : nullptr, 0.001953125f};
      pg8::gemm_phase<pg8::EpiMerge<true>, pg8::StaticOrder, true, true, true, true>(ldsl + RING_OFF, g, S, E, wave); }
#else
    { pg8::Gemm g{OA, WBRA, M_, DM, MLAOUT}; pg8::StaticOrder S; S.init(M_, DM, G, bid); pg8::EpiMerge<false> E{GA, H, nullptr, 1.0f};
      pg8::gemm_phase<pg8::EpiMerge<false>, pg8::StaticOrder, true, true>(ldsl + RING_OFF, g, S, E, wave); }
    { pg8::Gemm g{OBC, WBRB, M_, DM, MOBAW}; pg8::StaticOrder S; S.init(M_, DM, G, bid); pg8::EpiMerge<true> E{GB, H, FP8_OUT ? MG8 : nullptr, 1.0f};
      pg8::gemm_phase<pg8::EpiMerge<true>, pg8::StaticOrder, true, true>(ldsl + RING_OFF, g, S, E, wave); }
#endif
    GRID_BAR();
#if I8_OUT
    { int tid_f = wave * 64 + lane_id_(); asm volatile("" : "+v"(tid_f)); const int lane = tid_f & 63;
      for (int m = gw; m < M_; m += NGW) quant_row_plain_i8(H, MG8, m, (float*)(ws + WS_RSM), lane); }
    GRID_BAR();
#endif
#if I8_OUT
    { pg8::Gemm g{(const bf16*)MG8, WOUT, M_, DM, DM / 2}; pg8::StaticOrder S; S.init(M_, DM, G, bid);
      pg8::EpiResidNorm<0, true> E{out, out, 1.0f, H3, args.in[15], PART, PMAX, (const float*)(ws + WS_RSM), (const float*)(ws + WS_CMAXO)};
      pg8::gemm_phase<pg8::EpiResidNorm<0, true>, pg8::StaticOrder, true, true, true, false, true>(ldsl + RING_OFF, g, S, E, wave); }
#elif FP8_OUT
    { pg8::Gemm g{(const bf16*)MG8, WOUT, M_, DM, DM / 2}; pg8::StaticOrder S; S.init(M_, DM, G, bid); pg8::EpiResidNorm<0> E{out, out, 0.0009765625f, H3, args.in[15], PART, PMAX};
      pg8::gemm_phase<pg8::EpiResidNorm<0>, pg8::StaticOrder, true, true, true, true>(ldsl + RING_OFF, g, S, E, wave); }
#else
    { pg8::Gemm g{H, WOUT, M_, DM, DM}; pg8::StaticOrder S; S.init(M_, DM, G, bid); pg8::EpiResidNorm<0> E{out, out, 1.0f, H3, args.in[15], PART, PMAX};
      pg8::gemm_phase<pg8::EpiResidNorm<0>, pg8::StaticOrder, true, true>(ldsl + RING_OFF, g, S, E, wave); }
#endif
    GRID_BAR();
    { int tid_f = wave * 64 + lane_id_(); asm volatile("" : "+v"(tid_f)); const int tid = tid_f, lane = tid & 63; (void)lane; (void)tid;
#if !I8_FFN2
    cvt_job<1>(args.in[16], DM, NFF2, WFI, NFF2 / 64, cvtT, gw, NGW, lane, nullptr, NFF2);
#endif
#if I8_FFN2
    for (int m = gw; m < M_; m += NGW) quant_row_i8(H3, PART, PMAX, H8, m, RSTD, lane);
#else
    rstd_reduce<64>(PART, RSTD, 1.f / DM, vcu, tid, G);
#endif
#if PROBE_PHASE == 11
#if !I8_FFN2
    cvt_job<1>(args.in[16], DM, NFF2, WFI, NFF2 / 64, cvtT, gw, NGW, lane, nullptr, NFF2);
#endif
#if I8_FFN2
    for (int m = gw; m < M_; m += NGW) quant_row_i8(H3, PART, PMAX, H8, m, RSTD, lane);
#else
    rstd_reduce<64>(PART, RSTD, 1.f / DM, vcu, tid, G);
#endif
#endif
    }
    GRID_BAR();
#if I8_FFN2
    { pg8::Gemm g{(const bf16*)H8, (const bf16*)(ws + WS_WFI2), M_, NFF2, DM / 2}; pg8::StaticOrder S; S.init(M_, NFF2, G, bid); pg8::EpiSwiglu E{ACT, DFF, RSTD, M_, CMAX2};
      pg8::gemm_phase<pg8::EpiSwiglu, pg8::StaticOrder, true, true, true, false, true>(ldsl + RING_OFF, g, S, E, wave); }
#else
    { pg8::Gemm g{H3, WFI, M_, NFF2, DM}; pg8::StaticOrder S; S.init(M_, NFF2, G, bid); pg8::EpiSwiglu E{ACT, DFF, RSTD, M_, nullptr};
      pg8::gemm_phase<pg8::EpiSwiglu, pg8::StaticOrder, true, true, true>(ldsl + RING_OFF, g, S, E, wave); }
#endif
    if (G == 256 && bid >= 128) { int tid_f = wave * 64 + lane_id_(); asm volatile("" : "+v"(tid_f)); const int lane = tid_f & 63;
        cvt_job<0>(args.in[17], DFF, DM, WFO, DM / 64, cvtT, (bid - 128) * NWAVES + wave, 128 * NWAVES, lane, nullptr, DM); }
    else if (G != 256) { int tid_f = wave * 64 + lane_id_(); asm volatile("" : "+v"(tid_f)); const int lane = tid_f & 63; cvt_job<0>(args.in[17], DFF, DM, WFO, DM / 64, cvtT, gw, NGW, lane, nullptr, DM); }
    GRID_BAR();
    { pg8::Gemm g{ACT, WFO, M_, DM, DFF}; pg8::StaticOrder S; S.init(M_, DM, G, bid); pg8::EpiResid E{out, out, DM, 0.5f};
      pg8::gemm_phase<pg8::EpiResid, pg8::StaticOrder, true, true, true>(ldsl + RING_OFF, g, S, E, wave); }
    GRID_BAR();
    { int tid_f = wave * 64 + lane_id_(); asm volatile("" : "+v"(tid_f)); const int tid = tid_f, lane = tid & 63; (void)lane; (void)tid;
#if PROBE_PHASE == 500
    if (__hip_atomic_load(ctl + CW_FAIL, RLX_AGENT) > SELFCHECK_TOL) { for (int m = gw; m < M_; m += NGW) for (int j = lane; j < DM; j += 64) out[(size_t)m * DM + j] = __builtin_nanf(""); return; }
#endif
    for (int m = gw; m < M_; m += NGW) rms_row4096<true>(out + (size_t)m * DM, args.in[18], out + (size_t)m * DM, lane);
    }
}

extern "C" void kernel_launch(void* const* d_in, const int* in_sizes, int n_in, void* d_out, int out_size, void* d_ws, size_t ws_size, hipStream_t stream) {
    static int grid = 0;
    if (grid == 0) {
        if (n_in != 19 || out_size != M_ * DM || ws_size < WS_END) { fprintf(stderr, "kernel_launch: unexpected shapes (n_in %d out %d ws %zu need %zu)\n", n_in, out_size, ws_size, (size_t)WS_END); grid = -1; return; }
        int dev = 0, cus = 0;
        if (hipGetDevice(&dev) != hipSuccess || hipDeviceGetAttribute(&cus, hipDeviceAttributeMultiprocessorCount, dev) != hipSuccess) { grid = -1; return; }
        if (hipFuncSetAttribute((const void*)hybrid_fwd, hipFuncAttributeMaxDynamicSharedMemorySize, LDS_BYTES) != hipSuccess) { fprintf(stderr, "kernel_launch: hipFuncSetAttribute failed\n"); grid = -1; return; }
        int per_cu = 0;
        if (hipOccupancyMaxActiveBlocksPerMultiprocessor(&per_cu, (const void*)hybrid_fwd, NWAVES * 64, LDS_BYTES) != hipSuccess || per_cu < 1) { fprintf(stderr, "kernel_launch: occupancy query says %d\n", per_cu); }
        (void)hipGetLastError();
        grid = cus;
    }
    if (grid < 0) return;
    if (hipMemsetAsync((char*)d_ws + WS_CTL, 0, CTL_ZERO_BYTES, stream) != hipSuccess) { fprintf(stderr, "kernel_launch: memset failed\n"); return; }
    Args a{};
    for (int i = 0; i < 19; ++i) a.in[i] = (const float*)d_in[i];
    a.out = (float*)d_out; a.ws = (unsigned char*)d_ws;
    for (int i = 0; i < 32; ++i) a.invf[i] = pow(10000.0, -(double)(2 * i) / 64.0);
    for (int d = 0; d < 136; ++d) { int b;
        if (d < 16) b = d; else { const double dd = d > 128 ? 128.0 : (double)d; b = 16 + (int)(log(dd / 16.0) / log(128.0 / 16.0) * 16.0); if (b > 31) b = 31; }
        a.bucket[d] = (unsigned char)b; }
    hipLaunchKernelGGL(hybrid_fwd, dim3(grid), dim3(NWAVES * 64), LDS_BYTES, stream, a);
    const hipError_t le = hipPeekAtLastError();
    if (le != hipSuccess) fprintf(stderr, "kernel_launch: launch failed: %s\n", hipGetErrorName(le));
}
```

```cpp
#ifndef CMP_REL
#define CMP_REL 0.03f
#define CMP_THR 0.2f
#define CMP_NBAD 0.f
#endif
#ifndef I8_OUT
#define I8_OUT 1
#endif
#ifndef I8_FFN2
#define I8_FFN2 1
#endif
#ifndef FP8_BR
#define FP8_BR 1
#endif
#ifndef FP8_OUT
#define FP8_OUT 0
#endif
#ifndef PROBE_PHASE
#define PROBE_PHASE -1
#endif
#define MLA_BF16 (PROBE_PHASE == 500)
#ifndef SELFCHECK_REL
#define SELFCHECK_REL 0.03f
#define SELFCHECK_ABS 1e-4f
#endif
#ifndef SELFCHECK_TOL
#define SELFCHECK_TOL 0u
#endif
#include <hip/hip_runtime.h>
#include <cstdio>
#include <cstdint>
#include <cmath>
__device__ __forceinline__ int lane_id_() { return (int)__builtin_amdgcn_mbcnt_hi(~0u, __builtin_amdgcn_mbcnt_lo(~0u, 0u)); }
namespace pg8 {
#define PG8_LAS __attribute__((address_space(3)))
typedef unsigned short bf16_t;
typedef short bf16x8 __attribute__((ext_vector_type(8)));
typedef float f32x4 __attribute__((ext_vector_type(4)));
typedef unsigned u32x4 __attribute__((ext_vector_type(4)));
constexpr int BM = 256, BK = 64, HALF = 128, HTB = HALF * BK * 2  , STAGE_BYTES = 8 * HTB, NXCD = 8, WGM = 8;

__host__ __device__ __forceinline__ int lds_byte(int r, int c) { const int st = (r >> 4) * 2 + (c >> 5), rr = r & 15, cc = c & 31, ob = rr * 64 + cc * 2; return st * 1024 + (ob ^ (((ob >> 9) & 1) << 5)); }
__host__ __device__ __forceinline__ void stage_rc(int b, int& R, int& C) { const int st = b / 1024, sb = b % 1024, swz = sb ^ (((sb >> 9) & 1) << 5); R = (st >> 1) * 16 + swz / 64; C = (st & 1) * 32 + (swz % 64) / 2; }
__host__ __device__ __forceinline__ int perm32(int rho) { const int n = rho >> 4, i = rho & 15; return 8 * (i >> 2) + 4 * n + (i & 3); }

struct Unit { int pm, pn; };
struct Gemm { const bf16_t* A; const bf16_t* Bt; int M, N, K; };

struct StaticOrder {
    int nM, nN, nwg, G, c;
    __host__ __device__ void init(int M, int N, int G_, int c_) { nM = M / BM; nN = N / BM; nwg = nM * nN; G = G_; c = c_; }
    __host__ __device__ bool next(int i, Unit& u) const {
        const long L = (long)i * G + c; if (L >= nwg) return false;
        int wgid = (int)L; { const int q = nwg / NXCD, r = nwg % NXCD, xcd = wgid % NXCD, off = wgid / NXCD; wgid = (xcd < r ? xcd * (q + 1) : r * (q + 1) + (xcd - r) * q) + off; }
        const int nig = WGM * nN, gid = wgid / nig, fm = gid * WGM, gsz = (nM - fm) < WGM ? (nM - fm) : WGM;
        u.pm = fm + ((wgid % nig) % gsz); u.pn = (wgid % nig) / gsz; return true;
    }
    __device__ __forceinline__ void a_ready(const Unit&) const {}
    __device__ __forceinline__ void done(const Unit&) const {}
};

__device__ __forceinline__ unsigned cvt_pk_bf16(float lo, float hi) { unsigned r; asm volatile("v_cvt_pk_bf16_f32 %0, %1, %2" : "=v"(r) : "v"(lo), "v"(hi)); return r; }
typedef float f32x2 __attribute__((ext_vector_type(2)));
typedef unsigned u32x2 __attribute__((ext_vector_type(2)));
__device__ __forceinline__ float bf_lo(unsigned w) { return __uint_as_float(w << 16); }
__device__ __forceinline__ float bf_hi(unsigned w) { return __uint_as_float(w & 0xffff0000u); }
__device__ __forceinline__ float sigmoid_f(float x) { return __builtin_amdgcn_rcpf(1.0f + __builtin_amdgcn_exp2f(-1.4426950408889634f * x)); }
__device__ __forceinline__ u32x4 pack8f(f32x4 a, f32x4 b) { u32x4 w; w.x = cvt_pk_bf16(a[0], a[1]); w.y = cvt_pk_bf16(a[2], a[3]); w.z = cvt_pk_bf16(b[0], b[1]); w.w = cvt_pk_bf16(b[2], b[3]); return w; }

__device__ __forceinline__ unsigned pack4_fp8(f32x4 v) { int w = 0; w = __builtin_amdgcn_cvt_pk_fp8_f32(v[0], v[1], w, false); w = __builtin_amdgcn_cvt_pk_fp8_f32(v[2], v[3], w, true); return (unsigned)w; }
struct EpiPlain {
    static constexpr bool PERM = true, AFTER_DRAIN = false; __device__ __forceinline__ bool idem() const { return true; }
    bf16_t* O; int ldc; const float* part8; unsigned char* K8; unsigned char* V8;
    __device__ __forceinline__ void operator()(const f32x4 (&acc)[2][2][4][2], const Unit& u, int wr, int wc, int fr, int fq) const {
        const int row0 = u.pm * BM + wr * 64 + fr, col0 = u.pn * BM + wc * 32 + 8 * fq;
#pragma unroll
        for (int ai = 0; ai < 2; ++ai)
#pragma unroll
            for (int m = 0; m < 4; ++m) { const int row = row0 + ai * HALF + m * 16; bf16_t* rowp = O + (size_t)row * ldc + col0; float sc = 1.f;
                if (part8) { const f32x4* p = (const f32x4*)(part8 + (size_t)row * 8); const f32x4 a = p[0], b = p[1];
                    sc = 1.0f / sqrtf((((a[0] + a[1]) + (a[2] + a[3])) + ((b[0] + b[1]) + (b[2] + b[3]))) * (1.f / 512.f) + 1e-6f); }
#pragma unroll
                for (int bj = 0; bj < 2; ++bj) { const f32x4 v0 = acc[ai][bj][m][0] * sc, v1 = acc[ai][bj][m][1] * sc; if (O) *(u32x4*)(rowp + bj * HALF) = pack8f(v0, v1);
                    if (bj == 0 && K8) { u32x2 w8; w8.x = pack4_fp8(v0); w8.y = pack4_fp8(v1); *(u32x2*)(K8 + (size_t)row * 2048 + u.pn * 128 + wc * 32 + 8 * fq) = w8; }
                    if (bj == 1 && V8) { const int kk = row & 63; const unsigned w0 = pack4_fp8(v0), w1 = pack4_fp8(v1);
                        unsigned char* vp = V8 + ((size_t)(u.pn * 256 + (row >> 6)) * 128 + (wc * 32 + 8 * fq)) * 64 + (((kk >> 2) & 1) * 32 + (kk >> 5) * 16 + ((kk >> 3) & 3) * 4 + (kk & 3));
                        vp[0] = (unsigned char)w0; vp[64] = (unsigned char)(w0 >> 8); vp[128] = (unsigned char)(w0 >> 16); vp[192] = (unsigned char)(w0 >> 24);
                        vp[256] = (unsigned char)w1; vp[320] = (unsigned char)(w1 >> 8); vp[384] = (unsigned char)(w1 >> 16); vp[448] = (unsigned char)(w1 >> 24); } } }
    }
};
struct EpiSwiglu {
    static constexpr bool PERM = true, AFTER_DRAIN = false;
    bf16_t* O; int ldc; const float* rs; int tiledM; const float* cmax;
    __device__ __forceinline__ void operator()(const f32x4 (&acc)[2][2][4][2], const Unit& u, int wr, int wc, int fr, int fq) const {
        const int row0 = u.pm * BM + wr * 64 + fr, col0 = u.pn * HALF + wc * 32 + 8 * fq;
        f32x4 cg[2] = {{1.f, 1.f, 1.f, 1.f}, {1.f, 1.f, 1.f, 1.f}}, cu[2] = {{1.f, 1.f, 1.f, 1.f}, {1.f, 1.f, 1.f, 1.f}};
        if (cmax) {
#pragma unroll
            for (int n = 0; n < 2; ++n) { cg[n] = *(const f32x4*)(cmax + col0 + 4 * n) * (1.f / 127.f); cu[n] = *(const f32x4*)(cmax + (ldc + col0) + 4 * n) * (1.f / 127.f); } }
#pragma unroll
        for (int ai = 0; ai < 2; ++ai)
#pragma unroll
            for (int m = 0; m < 4; ++m) { const int row = row0 + ai * HALF + m * 16;
                bf16_t* rowp = tiledM ? O + ((size_t)(col0 >> 6) * tiledM + row) * 64 + (col0 & 63) : O + (size_t)row * ldc + col0;
                const float sc = rs ? rs[row] : 1.f;
                f32x4 h[2];
#pragma unroll
                for (int n = 0; n < 2; ++n) { f32x4 g = acc[ai][0][m][n], up = acc[ai][1][m][n];
                    if (cmax) { typedef int i32x4_t __attribute__((ext_vector_type(4)));
                        g = __builtin_convertvector(__builtin_bit_cast(i32x4_t, g), f32x4) * cg[n]; up = __builtin_convertvector(__builtin_bit_cast(i32x4_t, up), f32x4) * cu[n]; }
                    g = g * sc; up = up * sc;
#pragma unroll
                    for (int e = 0; e < 4; ++e) h[n][e] = g[e] * sigmoid_f(g[e]) * up[e]; }
                *(u32x4*)rowp = pack8f(h[0], h[1]); }
    }
};

struct EpiSwigluCmp {
    static constexpr bool PERM = true, AFTER_DRAIN = false;
    bf16_t* O; int ldc; int tiledM; float* stats; float thr;
    __device__ __forceinline__ void operator()(const f32x4 (&acc)[2][2][4][2], const Unit& u, int wr, int wc, int fr, int fq) const {
        const int row0 = u.pm * BM + wr * 64 + fr, col0 = u.pn * HALF + wc * 32 + 8 * fq; float sd = 0.f, sh = 0.f, nb = 0.f;
#pragma unroll
        for (int ai = 0; ai < 2; ++ai)
#pragma unroll
            for (int m = 0; m < 4; ++m) { const int row = row0 + ai * HALF + m * 16;
                bf16_t* rowp = O + ((size_t)(col0 >> 6) * tiledM + row) * 64 + (col0 & 63);
                const u32x4 old = *(const u32x4*)rowp; const float ov[8] = {bf_lo(old.x), bf_hi(old.x), bf_lo(old.y), bf_hi(old.y), bf_lo(old.z), bf_hi(old.z), bf_lo(old.w), bf_hi(old.w)};
                f32x4 h[2];
#pragma unroll
                for (int n = 0; n < 2; ++n) { const f32x4 g = acc[ai][0][m][n], up = acc[ai][1][m][n];
#pragma unroll
                    for (int e = 0; e < 4; ++e) { h[n][e] = g[e] * sigmoid_f(g[e]) * up[e]; const float d = h[n][e] - ov[4 * n + e]; sd += d * d; sh += h[n][e] * h[n][e]; nb += fabsf(d) > thr ? 1.f : 0.f; } }
                *(u32x4*)rowp = pack8f(h[0], h[1]); }
#pragma unroll
        for (int o = 1; o < 64; o <<= 1) { sd += __shfl_xor(sd, o); sh += __shfl_xor(sh, o); nb += __shfl_xor(nb, o); }
        if (fr == 0 && fq == 0) { atomicAdd(stats, sd); atomicAdd(stats + 1, sh); atomicAdd(stats + 2, nb); }
    }
};
struct EpiNull {
    static constexpr bool PERM = false, AFTER_DRAIN = false;
    __device__ __forceinline__ void operator()(const f32x4 (&acc)[2][2][4][2], const Unit&, int, int, int, int) const {
#pragma unroll
        for (int ai = 0; ai < 2; ++ai)
#pragma unroll
            for (int bj = 0; bj < 2; ++bj)
#pragma unroll
                for (int m = 0; m < 4; ++m)
#pragma unroll
                    for (int n = 0; n < 2; ++n) asm volatile("" :: "v"(acc[ai][bj][m][n]));
    }
};
struct EpiResid {
    static constexpr bool PERM = false, AFTER_DRAIN = false;
    const float* base; float* out; int ldc; float s;
    __device__ __forceinline__ void operator()(const f32x4 (&acc)[2][2][4][2], const Unit& u, int wr, int wc, int fr, int fq) const {
        const int row0 = u.pm * BM + wr * 64 + fr, col0 = u.pn * BM + wc * 32 + 4 * fq;
#pragma unroll
        for (int ai = 0; ai < 2; ++ai)
#pragma unroll
            for (int m = 0; m < 4; ++m) { const size_t off = (size_t)(row0 + ai * HALF + m * 16) * ldc + col0;
#pragma unroll
                for (int bj = 0; bj < 2; ++bj)
#pragma unroll
                    for (int n = 0; n < 2; ++n) { const f32x4 b = *(const f32x4*)(base + off + bj * HALF + n * 16); *(f32x4*)(out + off + bj * HALF + n * 16) = b + acc[ai][bj][m][n] * s; } }
    }
};
template <long F8, bool I8E = false> struct EpiResidNorm {
    static constexpr bool PERM = false, AFTER_DRAIN = false;
    const float* base; float* out; float s; bf16_t* hb; const float* gain; float* part; float* pmax;
    const float* rsm; const float* cmx;
    __device__ __forceinline__ void operator()(const f32x4 (&acc)[2][2][4][2], const Unit& u, int wr, int wc, int fr, int fq) const {
        constexpr int ldc = 4096, hbM = 16384;
        const int row0 = u.pm * BM + wr * 64 + fr, col0 = u.pn * BM + wc * 32 + 4 * fq;
        f32x4 gv[2][2];
#pragma unroll
        for (int bj = 0; bj < 2; ++bj)
#pragma unroll
            for (int n = 0; n < 2; ++n) gv[bj][n] = *(const f32x4*)(gain + col0 + bj * HALF + n * 16);
        f32x4 cv[2][2];
        if constexpr (I8E) {
#pragma unroll
            for (int bj = 0; bj < 2; ++bj)
#pragma unroll
                for (int n = 0; n < 2; ++n) cv[bj][n] = *(const f32x4*)(cmx + col0 + bj * HALF + n * 16) * (s * (1.f / 127.f)); }
#pragma unroll
        for (int ai = 0; ai < 2; ++ai)
#pragma unroll
            for (int m = 0; m < 4; ++m) { const int row = row0 + ai * HALF + m * 16; const size_t off = (size_t)row * ldc + col0; float ss = 0.f, mx = 0.f;
                float rsr = 0.f; if constexpr (I8E) rsr = rsm[row];
#pragma unroll
                for (int bj = 0; bj < 2; ++bj)
#pragma unroll
                    for (int n = 0; n < 2; ++n) { const f32x4 b = *(const f32x4*)(base + off + bj * HALF + n * 16); f32x4 o;
                        if constexpr (I8E) { typedef int i32x4_t __attribute__((ext_vector_type(4)));
                            o = b + __builtin_convertvector(__builtin_bit_cast(i32x4_t, acc[ai][bj][m][n]), f32x4) * (cv[bj][n] * rsr); }
                        else o = b + acc[ai][bj][m][n] * s;
                        *(f32x4*)(out + off + bj * HALF + n * 16) = o;
                        ss += (o[0] * o[0] + o[1] * o[1]) + (o[2] * o[2] + o[3] * o[3]); const f32x4 y = o * gv[bj][n];
                        mx = fmaxf(fmaxf(mx, fmaxf(fabsf(y[0]), fabsf(y[1]))), fmaxf(fabsf(y[2]), fabsf(y[3])));
                        u32x2 w; w.x = cvt_pk_bf16(y[0], y[1]); w.y = cvt_pk_bf16(y[2], y[3]);
                        const int col = col0 + bj * HALF + n * 16;
                        *(u32x2*)(hb + ((size_t)(col >> 6) * hbM + row) * 64 + (col & 63)) = w;
                        if constexpr (F8 != 0) *(unsigned*)((unsigned char*)hb + F8 + ((size_t)(col >> 7) * hbM + row) * 128 + (col & 127)) = pack4_fp8(y); }
                ss += __shfl_xor(ss, 16); ss += __shfl_xor(ss, 32); if (fq == 0) part[(size_t)row * 64 + u.pn * 4 + wc] = ss;
                if (pmax) { mx = fmaxf(mx, __shfl_xor(mx, 16)); mx = fmaxf(mx, __shfl_xor(mx, 32)); if (fq == 0) pmax[(size_t)row * 64 + u.pn * 4 + wc] = mx; } }
    }
};
template <int MODE_> struct EpiProj {
    static constexpr bool PERM = true, AFTER_DRAIN = false; static constexpr int mode = MODE_; __device__ __forceinline__ bool idem() const { return true; }
    bf16_t *cq, *ckv, *kr, *qb, *kb, *vb, *ga, *gb; const float* cosT; const float* sinT; const float* rs; float* partq; float* partkv; float* kmean; unsigned char* kr8; unsigned char* qb8; unsigned char* kb8; unsigned char* vb8;
    float post;
    __device__ __forceinline__ void operator()(const f32x4 (&acc)[2][2][4][2], const Unit& u, int wr, int wc, int fr, int fq) const {
        const int row0 = u.pm * BM + wr * 64 + fr; const int pn = mode == 1 ? (u.pn == 22 ? 62 : u.pn) : u.pn + 22;
        if (mode == 1 && pn == 62) {
            if (wc < 2) { const int g = wc * 4 + fq;
#pragma unroll
                for (int ai = 0; ai < 2; ++ai)
#pragma unroll
                    for (int m = 0; m < 4; ++m) { const int row = row0 + ai * HALF + m * 16;
                        const f32x4 c = *(const f32x4*)(cosT + (size_t)row * 32 + 4 * g), s = *(const f32x4*)(sinT + (size_t)row * 32 + 4 * g);
                        const float sc = rs[row] * post;
                        const f32x4 x1 = acc[ai][0][m][0] * sc, x2 = acc[ai][0][m][1] * sc;
                        const f32x4 o1 = x1 * c - x2 * s, o2 = x2 * c + x1 * s;
                        u32x2 w1, w2; w1.x = cvt_pk_bf16(o1[0], o1[1]); w1.y = cvt_pk_bf16(o1[2], o1[3]); w2.x = cvt_pk_bf16(o2[0], o2[1]); w2.y = cvt_pk_bf16(o2[2], o2[3]);
                        *(u32x2*)(kr + (size_t)row * 64 + 4 * g) = w1; *(u32x2*)(kr + (size_t)row * 64 + 32 + 4 * g) = w2;
                        *(unsigned*)(kr8 + (size_t)row * 64 + 4 * g) = pack4_fp8(o1); *(unsigned*)(kr8 + (size_t)row * 64 + 32 + 4 * g) = pack4_fp8(o2); } }
            return; }
        bf16_t* base; int ldc, colt; bool sig = false;
        if (pn < 4) { base = cq; ldc = 1024; colt = pn * BM; }
        else if (pn < 6) { base = ckv; ldc = 512; colt = (pn - 4) * BM; }
        else if (pn < 14) { base = qb; ldc = 2048; colt = (pn - 6) * BM; }
        else if (pn < 22) { base = kb; ldc = 2048; colt = (pn - 14) * BM; }
        else if (pn < 30) { base = vb; ldc = 2048; colt = (pn - 22) * BM; }
        else if (pn < 46) { base = ga; ldc = 4096; colt = (pn - 30) * BM; sig = true; }
        else { base = gb; ldc = 4096; colt = (pn - 46) * BM; sig = true; }
        const int col0 = colt + wc * 32 + 8 * fq;
        float* part = mode != 1 ? nullptr : (pn < 4 ? partq + pn * 4 + wc : (pn < 6 ? partkv + (pn - 4) * 4 + wc : nullptr)); const int pstride = pn < 4 ? 16 : 8;
        const bool iskb = mode == 1 && pn >= 14 && pn < 22; f32x4 cs[2][2] = {};
        const bool isvb = mode == 2 && pn < 30;
        unsigned char* f8p = mode == 1 && pn >= 6 && pn < 22 ? (pn < 14 ? qb8 : kb8) : nullptr;
#pragma unroll
        for (int ai = 0; ai < 2; ++ai)
#pragma unroll
            for (int m = 0; m < 4; ++m) { const int row = row0 + ai * HALF + m * 16; bf16_t* rowp = base + (size_t)row * ldc + col0; const float sc = rs[row] * post; float ss = 0.f;
#pragma unroll
                for (int bj = 0; bj < 2; ++bj) { f32x4 v0 = acc[ai][bj][m][0] * sc, v1 = acc[ai][bj][m][1] * sc;
                    if (sig) {
#pragma unroll
                        for (int e = 0; e < 4; ++e) { v0[e] = sigmoid_f(v0[e]); v1[e] = sigmoid_f(v1[e]); } }
                    if (part) ss += ((v0[0] * v0[0] + v0[1] * v0[1]) + (v0[2] * v0[2] + v0[3] * v0[3])) + ((v1[0] * v1[0] + v1[1] * v1[1]) + (v1[2] * v1[2] + v1[3] * v1[3]));
                    if (iskb) { cs[bj][0] += v0; cs[bj][1] += v1; }
                    if (f8p) { u32x2 w8; w8.x = pack4_fp8(v0); w8.y = pack4_fp8(v1); *(u32x2*)(f8p + (size_t)row * 2048 + col0 + bj * HALF) = w8; }
                    if (isvb) { const int kk = row & 63; const unsigned w0 = pack4_fp8(v0), w1 = pack4_fp8(v1);
                        unsigned char* vp = vb8 + ((size_t)((2 * (pn - 22) + bj) * 256 + (row >> 6)) * 128 + (wc * 32 + 8 * fq)) * 64 + (((kk >> 2) & 1) * 32 + (kk >> 5) * 16 + ((kk >> 3) & 3) * 4 + (kk & 3));
                        vp[0] = (unsigned char)w0; vp[64] = (unsigned char)(w0 >> 8); vp[128] = (unsigned char)(w0 >> 16); vp[192] = (unsigned char)(w0 >> 24);
                        vp[256] = (unsigned char)w1; vp[320] = (unsigned char)(w1 >> 8); vp[384] = (unsigned char)(w1 >> 16); vp[448] = (unsigned char)(w1 >> 24); }
                    if (!isvb || MLA_BF16) *(u32x4*)(rowp + bj * HALF) = pack8f(v0, v1); }
                if (part) { ss += __shfl_xor(ss, 16); ss += __shfl_xor(ss, 32); if (fq == 0) part[(size_t)row * pstride] = ss; } }
        if (iskb) {
#pragma unroll
            for (int bj = 0; bj < 2; ++bj)
#pragma unroll
                for (int n = 0; n < 2; ++n)
#pragma unroll
                    for (int e2 = 0; e2 < 4; ++e2) { float c = cs[bj][n][e2];
                        c += __shfl_xor(c, 1); c += __shfl_xor(c, 2); c += __shfl_xor(c, 4); c += __shfl_xor(c, 8);
                        if (fr == 0) atomicAdd(kmean + (size_t)((2 * (pn - 14) + bj) * 64 + u.pm) * 128 + wc * 32 + 8 * fq + 4 * n + e2, c * (1.f / 256.f)); }
        }
    }
};
struct EpiQ {
    static constexpr bool PERM = true, AFTER_DRAIN = false; __device__ __forceinline__ bool idem() const { return true; }
    bf16_t* Q; const float* cosT; const float* sinT; const float* partq; unsigned char* Q8;
    __device__ __forceinline__ float rstd_of(int row) const { const f32x4* p = (const f32x4*)(partq + (size_t)row * 16); const f32x4 a = p[0], b = p[1], c = p[2], d = p[3];
        const float s = ((a[0] + a[1]) + (a[2] + a[3])) + ((b[0] + b[1]) + (b[2] + b[3])) + ((c[0] + c[1]) + (c[2] + c[3])) + ((d[0] + d[1]) + (d[2] + d[3])); return 1.0f / sqrtf(s * (1.f / 1024.f) + 1e-6f); }
    __device__ __forceinline__ void operator()(const f32x4 (&acc)[2][2][4][2], const Unit& u, int wr, int wc, int fr, int fq) const {
        const int row0 = u.pm * BM + wr * 64 + fr;
        float rsv[2][4];
#pragma unroll
        for (int ai = 0; ai < 2; ++ai)
#pragma unroll
            for (int m = 0; m < 4; ++m) rsv[ai][m] = rstd_of(row0 + ai * HALF + m * 16);
#pragma unroll
        for (int bj = 0; bj < 2; ++bj) {
            const int cw = u.pn * BM + bj * HALF + wc * 32;
            const int hc = cw % 192, hb = cw - hc;
            if (hc < 128) {
#pragma unroll
                for (int ai = 0; ai < 2; ++ai)
#pragma unroll
                    for (int m = 0; m < 4; ++m) { const int row = row0 + ai * HALF + m * 16; const float sc = rsv[ai][m];
                        const f32x4 q0 = acc[ai][bj][m][0] * sc, q1 = acc[ai][bj][m][1] * sc;
                        if (Q) *(u32x4*)(Q + (size_t)row * 3072 + cw + 8 * fq) = pack8f(q0, q1);
                        u32x2 w8; w8.x = pack4_fp8(q0); w8.y = pack4_fp8(q1); *(u32x2*)(Q8 + (size_t)row * 3072 + cw + 8 * fq) = w8; }
            } else {
                const int g = ((hc - 128) >> 3) + fq;
#pragma unroll
                for (int ai = 0; ai < 2; ++ai)
#pragma unroll
                    for (int m = 0; m < 4; ++m) { const int row = row0 + ai * HALF + m * 16;
                        const f32x4 c = *(const f32x4*)(cosT + (size_t)row * 32 + 4 * g), s = *(const f32x4*)(sinT + (size_t)row * 32 + 4 * g);
                        const float sc = rsv[ai][m];
                        const f32x4 x1 = acc[ai][bj][m][0] * sc, x2 = acc[ai][bj][m][1] * sc;
                        const f32x4 o1 = x1 * c - x2 * s, o2 = x2 * c + x1 * s;
                        if (Q) { u32x2 w1, w2; w1.x = cvt_pk_bf16(o1[0], o1[1]); w1.y = cvt_pk_bf16(o1[2], o1[3]); w2.x = cvt_pk_bf16(o2[0], o2[1]); w2.y = cvt_pk_bf16(o2[2], o2[3]);
                            bf16_t* qp = Q + (size_t)row * 3072 + hb + 128 + 4 * g;
                            *(u32x2*)qp = w1; *(u32x2*)(qp + 32) = w2; }
                        unsigned char* q8p = Q8 + (size_t)row * 3072 + hb + 128 + 4 * g; *(unsigned*)q8p = pack4_fp8(o1); *(unsigned*)(q8p + 32) = pack4_fp8(o2); }
            }
        }
    }
};
template <bool ADD> struct EpiMerge {
    static constexpr bool PERM = true, AFTER_DRAIN = false; const bf16_t* gate; bf16_t* T; unsigned char* O8; float post;
    __device__ __forceinline__ void operator()(const f32x4 (&acc)[2][2][4][2], const Unit& u, int wr, int wc, int fr, int fq) const {
        const int row0 = u.pm * BM + wr * 64 + fr, col0 = u.pn * BM + wc * 32 + 8 * fq;
#pragma unroll
        for (int ai = 0; ai < 2; ++ai)
#pragma unroll
            for (int m = 0; m < 4; ++m) { const int row = row0 + ai * HALF + m * 16; const size_t off = (size_t)row * 4096 + col0;
#pragma unroll
                for (int bj = 0; bj < 2; ++bj) { const u32x4 gw = *(const u32x4*)(gate + off + bj * HALF);
                    f32x4 v0 = acc[ai][bj][m][0] * post, v1 = acc[ai][bj][m][1] * post;
                    v0[0] *= bf_lo(gw.x); v0[1] *= bf_hi(gw.x); v0[2] *= bf_lo(gw.y); v0[3] *= bf_hi(gw.y);
                    v1[0] *= bf_lo(gw.z); v1[1] *= bf_hi(gw.z); v1[2] *= bf_lo(gw.w); v1[3] *= bf_hi(gw.w);
                    if (ADD) { const u32x4 pw = *(const u32x4*)(T + off + bj * HALF);
                        v0[0] += bf_lo(pw.x); v0[1] += bf_hi(pw.x); v0[2] += bf_lo(pw.y); v0[3] += bf_hi(pw.y);
                        v1[0] += bf_lo(pw.z); v1[1] += bf_hi(pw.z); v1[2] += bf_lo(pw.w); v1[3] += bf_hi(pw.w);
                        if (O8) { const int col = col0 + bj * HALF; u32x2 q; q.x = pack4_fp8(v0 * 16.f); q.y = pack4_fp8(v1 * 16.f);
                            *(u32x2*)(O8 + ((size_t)(col >> 7) * 16384 + row) * 128 + (col & 127)) = q; }
                        else *(u32x4*)(T + off + bj * HALF) = pack8f(v0, v1); }
                    else *(u32x4*)(T + off + bj * HALF) = pack8f(v0, v1); } }
    }
};
template <class Epi, class Sched, bool ALIGN_EPI = false, bool SP2 = false, bool TILED = false, bool FP8 = false, bool I8 = false>
__device__ __forceinline__ void gemm_phase(PG8_LAS unsigned char* lds, const Gemm g, const Sched S, const Epi E, int wv) {
    int tid_ = wv * 64 + lane_id_(); asm volatile("" : "+v"(tid_)); const int tid = tid_, wid = wv, lane = tid & 63, wr = wid >> 2, wc = wid & 3, fr = lane & 15, fq = lane >> 4;
    const int K = g.K, nt = K / BK;
    unsigned voffA[2], voffB[2];
#pragma unroll
    for (int i = 0; i < 2; ++i) { int R, C; stage_rc(tid * 16 + i * 8192, R, C); const int Rb = Epi::PERM ? ((R & ~31) + perm32(R & 31)) : R;
        voffA[i] = (unsigned)(R * (TILED ? BK : K) + C) * 2u; voffB[i] = (unsigned)(Rb * (TILED ? BK : K) + C) * 2u; }
    const size_t kstepA = TILED ? (size_t)g.M * BK * 2 : (size_t)(BK * 2), kstepB = TILED ? (size_t)g.N * BK * 2 : (size_t)(BK * 2);
    const size_t hstep = TILED ? (size_t)HALF * BK * 2 : (size_t)HALF * K * 2;
    const size_t tstep = 2 * hstep;
    const unsigned ldsw = (unsigned)wid * 1024u;
    const int aoff = lds_byte(wr * 64 + fr, fq * 8), boff = lds_byte(wc * 32 + fr, fq * 8);
#define PG8_SA(b, h) (((b) * 2 + (h)) * HTB)
#define PG8_SB(b, h) ((4 + (b) * 2 + (h)) * HTB)
#define PG8_STAGE(bufoff, gbase, voff) do { _Pragma("unroll") for (int _i = 0; _i < 2; ++_i) \
        __builtin_amdgcn_global_load_lds((const unsigned*)((const char*)(gbase) + (voff)[_i]), (PG8_LAS unsigned*)(lds + (bufoff) + ldsw + _i * 8192), 16, 0, 0); } while (0)
#define PG8_LDA(dst, b, h) do { _Pragma("unroll") for (int m = 0; m < 4; ++m) { if constexpr (FP8) { \
            dst##8[m].lo = *(const PG8_LAS v4i_t*)(lds + PG8_SA(b, h) + aoff + m * 2048); dst##8[m].hi = *(const PG8_LAS v4i_t*)(lds + PG8_SA(b, h) + aoff + m * 2048 + 1024); } \
        else { _Pragma("unroll") for (int k = 0; k < 2; ++k) dst[m][k] = *(const PG8_LAS bf16x8*)(lds + PG8_SA(b, h) + aoff + m * 2048 + k * 1024); } } } while (0)
#define PG8_LDB(dst, b, h) do { _Pragma("unroll") for (int n = 0; n < 2; ++n) { if constexpr (FP8) { \
            dst##8[n].lo = *(const PG8_LAS v4i_t*)(lds + PG8_SB(b, h) + boff + n * 2048); dst##8[n].hi = *(const PG8_LAS v4i_t*)(lds + PG8_SB(b, h) + boff + n * 2048 + 1024); } \
        else { _Pragma("unroll") for (int k = 0; k < 2; ++k) dst[n][k] = *(const PG8_LAS bf16x8*)(lds + PG8_SB(b, h) + boff + n * 2048 + k * 1024); } } } while (0)
#define PG8_MMA(ai, bj, At, Bt) do { __builtin_amdgcn_s_setprio(1); \
        if constexpr (I8) {   \
            _Pragma("unroll") for (int k = 0; k < 2; ++k) _Pragma("unroll") for (int m = 0; m < 4; ++m) _Pragma("unroll") for (int n = 0; n < 2; ++n) \
                acc[ai][bj][m][n] = __builtin_bit_cast(f32x4, __builtin_amdgcn_mfma_i32_16x16x64_i8(__builtin_bit_cast(v4i_t, Bt[n][k]), __builtin_bit_cast(v4i_t, At[m][k]), __builtin_bit_cast(v4i_t, acc[ai][bj][m][n]), 0, 0, 0)); } \
        else { _Pragma("unroll") for (int m = 0; m < 4; ++m) _Pragma("unroll") for (int n = 0; n < 2; ++n) { \
            if constexpr (FP8) asm volatile("v_mfma_scale_f32_16x16x128_f8f6f4 %0, %1, %2, %0, %3, %3 op_sel_hi:[0,0,0]" : "+v"(acc[ai][bj][m][n]) : "v"(Bt##8[n]), "v"(At##8[m]), "v"(f8scale));   \
            else { _Pragma("unroll") for (int k = 0; k < 2; ++k) acc[ai][bj][m][n] = __builtin_amdgcn_mfma_f32_16x16x32_bf16(Bt[n][k], At[m][k], acc[ai][bj][m][n], 0, 0, 0); } } } \
        __builtin_amdgcn_s_setprio(0); } while (0)
#define PG8_WAIT_V(n) asm volatile("s_waitcnt vmcnt(" #n ")" ::: "memory")
#define PG8_WAIT_L(n) asm volatile("s_waitcnt lgkmcnt(" #n ")" ::: "memory")
#define PG8_BAR __builtin_amdgcn_s_barrier()
#define PG8_SCHED __builtin_amdgcn_sched_barrier(0)
    Unit cur, nxt; int ui = 0;
    if (!S.next(0, cur)) return;
    f32x4 acc[2][2][4][2];
#pragma unroll
    for (int a = 0; a < 2; ++a)
#pragma unroll
        for (int b = 0; b < 2; ++b)
#pragma unroll
            for (int m = 0; m < 4; ++m)
#pragma unroll
                for (int n = 0; n < 2; ++n) acc[a][b][m][n] = (f32x4){0.f, 0.f, 0.f, 0.f};
    typedef int v8i_t __attribute__((ext_vector_type(8))); typedef int v4i_t __attribute__((ext_vector_type(4)));
    int f8scale = 0x7f7f7f7f; asm volatile("" : "+v"(f8scale));
    bf16x8 At[4][2], B0[2][2], B1[2][2]; v8i_t At8[4], B08[2], B18[2];
    const char* cA = (const char*)g.A + (size_t)cur.pm * tstep; const char* cB = (const char*)g.Bt + (size_t)cur.pn * tstep;
    S.a_ready(cur);
    if constexpr (SP2) {
        PG8_STAGE(PG8_SB(0, 0), cB, voffB); PG8_STAGE(PG8_SB(0, 1), cB + hstep, voffB); PG8_STAGE(PG8_SA(0, 0), cA, voffA); PG8_STAGE(PG8_SA(0, 1), cA + hstep, voffA);
        if (wr == 1) PG8_BAR;
        PG8_WAIT_V(2); PG8_BAR;
        PG8_STAGE(PG8_SB(1, 0), cB + kstepB, voffB); PG8_STAGE(PG8_SA(1, 0), cA + kstepA, voffA); PG8_STAGE(PG8_SB(1, 1), cB + hstep + kstepB, voffB);
        PG8_WAIT_V(6); PG8_BAR;
    } else {
        PG8_STAGE(PG8_SB(0, 0), cB, voffB); PG8_STAGE(PG8_SA(0, 0), cA, voffA); PG8_STAGE(PG8_SB(0, 1), cB + hstep, voffB); PG8_STAGE(PG8_SA(0, 1), cA + hstep, voffA);
        if (wr == 1) PG8_BAR;
        PG8_WAIT_V(4); PG8_BAR;
        PG8_STAGE(PG8_SB(1, 0), cB + kstepB, voffB); PG8_STAGE(PG8_SA(1, 0), cA + kstepA, voffA); PG8_STAGE(PG8_SB(1, 1), cB + hstep + kstepB, voffB);
        PG8_WAIT_V(6); PG8_BAR;
    }
    for (;;) {
        const bool has_next = S.next(ui + 1, nxt);
        const char* nA = has_next ? (const char*)g.A + (size_t)nxt.pm * tstep : cA; const char* nB = has_next ? (const char*)g.Bt + (size_t)nxt.pn * tstep : cB;
        for (int t = 0; t < nt; t += 2) {
            const bool last = (t == nt - 2);
            const char* a1 = cA + (size_t)(t + 1) * kstepA;
            const char* a2 = last ? nA : cA + (size_t)(t + 2) * kstepA; const char* b2 = last ? nB : cB + (size_t)(t + 2) * kstepB;
            const char* a3 = a2 + kstepA; const char* b3 = b2 + kstepB;
            if (last && has_next) S.a_ready(nxt);
            if constexpr (SP2) {
            PG8_LDB(B0, 0, 0); PG8_LDB(B1, 0, 1); PG8_SCHED; PG8_LDA(At, 0, 0); PG8_STAGE(PG8_SA(1, 1), a1 + hstep, voffA);
            PG8_WAIT_V(8); PG8_WAIT_L(0); PG8_BAR; PG8_MMA(0, 0, At, B0); PG8_MMA(0, 1, At, B1); PG8_BAR; PG8_SCHED;
            PG8_LDA(At, 0, 1); PG8_STAGE(PG8_SB(0, 0), b2, voffB); PG8_STAGE(PG8_SB(0, 1), b2 + hstep, voffB); PG8_STAGE(PG8_SA(0, 0), a2, voffA);
            PG8_WAIT_V(8); PG8_WAIT_L(0); PG8_BAR; PG8_MMA(1, 0, At, B0); PG8_MMA(1, 1, At, B1); PG8_BAR; PG8_SCHED;
            PG8_LDB(B0, 1, 0); PG8_LDB(B1, 1, 1); PG8_SCHED; PG8_LDA(At, 1, 0); PG8_STAGE(PG8_SA(0, 1), a2 + hstep, voffA);
            PG8_WAIT_V(8); PG8_WAIT_L(0); PG8_BAR; PG8_MMA(0, 0, At, B0); PG8_MMA(0, 1, At, B1); PG8_BAR; PG8_SCHED;
            PG8_LDA(At, 1, 1); PG8_STAGE(PG8_SB(1, 0), b3, voffB); PG8_STAGE(PG8_SB(1, 1), b3 + hstep, voffB); PG8_STAGE(PG8_SA(1, 0), a3, voffA);
            PG8_WAIT_V(8); PG8_WAIT_L(0); PG8_BAR; PG8_MMA(1, 0, At, B0); PG8_MMA(1, 1, At, B1); PG8_BAR; PG8_SCHED;
            } else {
            PG8_LDB(B0, 0, 0); PG8_SCHED; PG8_LDA(At, 0, 0); PG8_STAGE(PG8_SA(1, 1), a1 + hstep, voffA);
            PG8_WAIT_L(8); PG8_BAR; PG8_WAIT_L(0); PG8_MMA(0, 0, At, B0); PG8_BAR; PG8_SCHED;
            PG8_LDB(B1, 0, 1); PG8_STAGE(PG8_SB(0, 0), b2, voffB);
            PG8_BAR; PG8_WAIT_L(0); PG8_MMA(0, 1, At, B1); PG8_BAR;
            PG8_LDA(At, 0, 1); PG8_STAGE(PG8_SA(0, 0), a2, voffA);
            PG8_BAR; PG8_WAIT_L(0); PG8_MMA(1, 0, At, B0); PG8_BAR; PG8_SCHED;
            PG8_STAGE(PG8_SB(0, 1), b2 + hstep, voffB);
            PG8_WAIT_V(6); PG8_BAR; PG8_MMA(1, 1, At, B1); PG8_BAR;
            PG8_LDB(B0, 1, 0); PG8_SCHED; PG8_LDA(At, 1, 0); PG8_STAGE(PG8_SA(0, 1), a2 + hstep, voffA);
            PG8_WAIT_L(8); PG8_BAR; PG8_WAIT_L(0); PG8_MMA(0, 0, At, B0); PG8_BAR; PG8_SCHED;
            PG8_LDB(B1, 1, 1); PG8_STAGE(PG8_SB(1, 0), b3, voffB);
            PG8_BAR; PG8_WAIT_L(0); PG8_MMA(0, 1, At, B1); PG8_BAR;
            PG8_LDA(At, 1, 1); PG8_STAGE(PG8_SA(1, 0), a3, voffA);
            PG8_BAR; PG8_WAIT_L(0); PG8_MMA(1, 0, At, B0); PG8_BAR; PG8_SCHED;
            PG8_STAGE(PG8_SB(1, 1), b3 + hstep, voffB);
            PG8_WAIT_V(6); PG8_BAR; PG8_MMA(1, 1, At, B1); PG8_BAR;
            }
        }
        if constexpr (FP8 || I8) asm volatile("s_nop 15\n\ts_nop 7" ::: "memory");
        if constexpr (ALIGN_EPI) { if (wr == 0) PG8_BAR; }
        if constexpr (!Epi::AFTER_DRAIN) { int fr_e = fr, fq_e = fq; asm volatile("" : "+v"(fr_e), "+v"(fq_e));
            E(acc, cur, wr, wc, fr_e, fq_e); S.done(cur); }
        if (!has_next) break;
#pragma unroll
        for (int a = 0; a < 2; ++a)
#pragma unroll
            for (int b = 0; b < 2; ++b)
#pragma unroll
                for (int m = 0; m < 4; ++m)
#pragma unroll
                    for (int n = 0; n < 2; ++n) acc[a][b][m][n] = (f32x4){0.f, 0.f, 0.f, 0.f};
        cur = nxt; cA = nA; cB = nB; ++ui;
        if constexpr (ALIGN_EPI) { if (wr == 1) PG8_BAR; }
    }
    PG8_WAIT_V(0);
    if constexpr (!ALIGN_EPI) { if (wr == 0) PG8_BAR; }
    PG8_BAR;
    if constexpr (Epi::AFTER_DRAIN) { E.fused(acc, cur, wr, wc, fr, fq, lds, wid, lane); S.done(cur); }
#undef PG8_SA
#undef PG8_SB
#undef PG8_STAGE
#undef PG8_LDA
#undef PG8_LDB
#undef PG8_MMA
#undef PG8_WAIT_V
#undef PG8_WAIT_L
#undef PG8_BAR
#undef PG8_SCHED
}
}
namespace att {
typedef unsigned short bf16_t;
typedef short bf16x8 __attribute__((ext_vector_type(8)));
typedef short s16x4 __attribute__((ext_vector_type(4)));
typedef float f32x16 __attribute__((ext_vector_type(16)));
typedef float f32x4 __attribute__((ext_vector_type(4)));
typedef unsigned u32x4 __attribute__((ext_vector_type(4)));
typedef int i32x4 __attribute__((ext_vector_type(4)));
#define ASBAR() __builtin_amdgcn_sched_barrier(0)
constexpr int VT_BYTES = 16384;
constexpr int L_V = 0, L_K = 2 * VT_BYTES;
constexpr int KT_MAX = 64 * 192 * 2;
constexpr int L_WS = L_K + 2 * KT_MAX;
constexpr int L_BIAS = L_WS + 8 * 128 * 4;
constexpr int L_PREF = L_BIAS + 16 * 132 * 4;
constexpr int L_CNT = L_PREF + 1040 * 4 + 64;
constexpr int L_END = L_CNT + 1024 * 4;
constexpr float LOG2E = 1.4426950408889634f;
constexpr float THR2 = 6.0f;

__device__ __forceinline__ int v_st(int k, int c) { const int kk = (k & ~0xC) | ((k & 4) << 1) | ((k & 8) >> 1); return ((kk >> 3) * 4 + (c >> 5)) * 512 + ((kk & 7) * 32 + (c & 31)) * 2; }
__device__ __forceinline__ int v_rd_base(int lane) { return ((lane & 3) << 3) | (((lane >> 2) & 3) << 6) | (((lane >> 4) & 1) << 5) | (((lane >> 5) & 1) << 8); }
constexpr int v_rd_off(int d0, int ks, int half) { return d0 * 512 + ks * 4096 + half * 2048; }
__device__ __forceinline__ int crow(int r, int hi) { return (r & 3) + 8 * (r >> 2) + 4 * hi; }
__device__ __forceinline__ unsigned cvtpk(float lo, float hi) { unsigned r; asm volatile("v_cvt_pk_bf16_f32 %0, %1, %2" : "=v"(r) : "v"(lo), "v"(hi)); return r; }
__device__ __forceinline__ bf16x8 ld8(const bf16_t* p) { return *reinterpret_cast<const bf16x8*>(p); }
template <int DQK> __device__ __forceinline__ int kswz(int row, int chunk) {
    if constexpr (DQK == 128) return row * 256 + ((chunk ^ (row & 7)) << 4);
    else return row * 384 + (((chunk & ~7) | ((chunk ^ (row >> 1)) & 7)) << 4);
}
__device__ __forceinline__ void mask_tile(f32x16& p0, f32x16& p1, int dq) {
    const float NEG = -__builtin_inff();
#pragma unroll
    for (int r = 0; r < 16; ++r) { const int c = (r & 3) + 8 * (r >> 2); if (dq - c < 0) p0[r] = NEG; if (dq - c - 32 < 0) p1[r] = NEG; }
}
template <bool RAW>
__device__ __forceinline__ void partialSM(f32x16& p0, f32x16& p1, float& m_reg, float& alpha, float sc) {
    float pmax = p0[0];
#pragma unroll
    for (int r = 1; r < 16; ++r) pmax = fmaxf(pmax, p0[r]);
#pragma unroll
    for (int r = 0; r < 16; ++r) pmax = fmaxf(pmax, p1[r]);
    { auto rr = __builtin_amdgcn_permlane32_swap(__float_as_uint(pmax), __float_as_uint(pmax), false, false);
      pmax = fmaxf(__uint_as_float(rr[0]), __uint_as_float(rr[1])); }
    if (RAW) pmax *= sc;
    const bool need = pmax - m_reg > THR2;
    const float mn = need ? pmax : m_reg;
    alpha = need ? __builtin_amdgcn_exp2f(m_reg - mn) : 1.f; m_reg = mn;
    if (RAW) {
#pragma unroll
        for (int r = 0; r < 16; ++r) p0[r] = __builtin_amdgcn_exp2f(fmaf(p0[r], sc, -mn));
#pragma unroll
        for (int r = 0; r < 16; ++r) p1[r] = fmaf(p1[r], sc, -mn);
    } else {
#pragma unroll
        for (int r = 0; r < 16; ++r) p0[r] = __builtin_amdgcn_exp2f(p0[r] - mn);
#pragma unroll
        for (int r = 0; r < 16; ++r) p1[r] = p1[r] - mn;
    }
}
__device__ __forceinline__ void finishSM_e(f32x16& p1) {
#pragma unroll
    for (int r = 0; r < 16; ++r) p1[r] = __builtin_amdgcn_exp2f(p1[r]);
}
__device__ __forceinline__ void finishSM_a(f32x16& p0, f32x16& p1, float alpha, float& l_reg) {
#pragma unroll
    for (int r = 0; r < 16; ++r) p1[r] = __builtin_amdgcn_exp2f(p1[r]);
    float ps = 0;
#pragma unroll
    for (int r = 0; r < 16; ++r) ps += p0[r];
#pragma unroll
    for (int r = 0; r < 16; ++r) ps += p1[r];
    { auto rr = __builtin_amdgcn_permlane32_swap(__float_as_uint(ps), __float_as_uint(ps), false, false);
      ps = __uint_as_float(rr[0]) + __uint_as_float(rr[1]); }
    l_reg = l_reg * alpha + ps;
}
#define PK4(P, B_, OUT) do { unsigned a0 = cvtpk(P[B_+0], P[B_+1]), a1 = cvtpk(P[B_+2], P[B_+3]);                          \
        unsigned b0 = cvtpk(P[B_+4], P[B_+5]), b1 = cvtpk(P[B_+6], P[B_+7]);                                             \
        auto r0 = __builtin_amdgcn_permlane32_swap(a0, b0, false, false); auto r1 = __builtin_amdgcn_permlane32_swap(a1, b1, false, false); \
        u32x4 w = {r0[0], r1[0], r0[1], r1[1]}; OUT = *reinterpret_cast<bf16x8*>(&w); } while (0)
template <int DQK>
__device__ __forceinline__ void qkt(f32x16& p0, f32x16& p1, const char* kbuf, int r32, int hi, const bf16x8* qr) {
    p0 = f32x16{}; p1 = f32x16{};
    const char* kb[4];
    constexpr int RP = DQK * 2;
#pragma unroll
    for (int dd = 0; dd < 4; ++dd) kb[dd] = kbuf + kswz<DQK>(r32, 2 * dd + hi);
#pragma unroll
    for (int d0 = 0; d0 < DQK / 16; ++d0) { const char* a = kb[d0 & 3] + (d0 >> 2) * 128;
        bf16x8 b0 = *reinterpret_cast<const bf16x8*>(a);
        bf16x8 b1 = *reinterpret_cast<const bf16x8*>(a + 32 * RP);
        __builtin_amdgcn_s_setprio(1);
        p0 = __builtin_amdgcn_mfma_f32_32x32x16_bf16(b0, qr[d0], p0, 0, 0, 0);
        p1 = __builtin_amdgcn_mfma_f32_32x32x16_bf16(b1, qr[d0], p1, 0, 0, 0);
        __builtin_amdgcn_s_setprio(0); }
}
template <int VBOFF>
__device__ __forceinline__ void pv_tile(f32x16* o, int vb0, bf16x8 pa0, bf16x8 pa1, bf16x8 pa2, bf16x8 pa3) {
#define TRRD(dst, off) asm volatile("ds_read_b64_tr_b16 %0, %1 offset:%2" : "=&v"(dst) : "v"(vb0), "i"(off) : "memory")
#define PV_D0(d0) do { s16x4 l0, l1, l2, l3, h0, h1, h2, h3; constexpr int b_ = VBOFF + v_rd_off(d0, 0, 0); \
        TRRD(l0, b_); TRRD(h0, b_ + 2048); TRRD(l1, b_ + 4096); TRRD(h1, b_ + 6144); TRRD(l2, b_ + 8192); TRRD(h2, b_ + 10240); TRRD(l3, b_ + 12288); TRRD(h3, b_ + 14336); \
        asm volatile("s_waitcnt lgkmcnt(0)" ::: "memory"); ASBAR();   \
        o[d0] = __builtin_amdgcn_mfma_f32_32x32x16_bf16(pa0, (bf16x8){l0[0], l0[1], l0[2], l0[3], h0[0], h0[1], h0[2], h0[3]}, o[d0], 0, 0, 0);   \
        o[d0] = __builtin_amdgcn_mfma_f32_32x32x16_bf16(pa1, (bf16x8){l1[0], l1[1], l1[2], l1[3], h1[0], h1[1], h1[2], h1[3]}, o[d0], 0, 0, 0);   \
        o[d0] = __builtin_amdgcn_mfma_f32_32x32x16_bf16(pa2, (bf16x8){l2[0], l2[1], l2[2], l2[3], h2[0], h2[1], h2[2], h2[3]}, o[d0], 0, 0, 0);   \
        o[d0] = __builtin_amdgcn_mfma_f32_32x32x16_bf16(pa3, (bf16x8){l3[0], l3[1], l3[2], l3[3], h3[0], h3[1], h3[2], h3[3]}, o[d0], 0, 0, 0); } while (0)
    PV_D0(0); PV_D0(1); PV_D0(2); PV_D0(3);
#undef PV_D0
#undef TRRD
}

typedef __attribute__((address_space(3))) const char* lds_cptr;
typedef short v4i16_t __attribute__((ext_vector_type(4)));
__device__ __forceinline__ s16x4 vtr(lds_cptr p) { return __builtin_bit_cast(s16x4, __builtin_amdgcn_ds_read_tr16_b64_v4i16((__attribute__((address_space(3))) v4i16_t*)p)); }
#define VRD(S, vp, d0) do { _Pragma("unroll") for (int ks_ = 0; ks_ < 4; ++ks_) { S[2 * ks_] = vtr((vp) + (d0) * 512 + ks_ * 4096); S[2 * ks_ + 1] = vtr((vp) + (d0) * 512 + ks_ * 4096 + 2048); } } while (0)
#define VFR(S, k) (bf16x8){S[2 * (k)][0], S[2 * (k)][1], S[2 * (k)][2], S[2 * (k)][3], S[2 * (k) + 1][0], S[2 * (k) + 1][1], S[2 * (k) + 1][2], S[2 * (k) + 1][3]}
#define PVMMA(S, d0) do { __builtin_amdgcn_s_setprio(1); o[d0] = __builtin_amdgcn_mfma_f32_32x32x16_bf16(pa0, VFR(S, 0), o[d0], 0, 0, 0); o[d0] = __builtin_amdgcn_mfma_f32_32x32x16_bf16(pa1, VFR(S, 1), o[d0], 0, 0, 0); \
        o[d0] = __builtin_amdgcn_mfma_f32_32x32x16_bf16(pa2, VFR(S, 2), o[d0], 0, 0, 0); o[d0] = __builtin_amdgcn_mfma_f32_32x32x16_bf16(pa3, VFR(S, 3), o[d0], 0, 0, 0); __builtin_amdgcn_s_setprio(0); } while (0)

typedef int v8i_t __attribute__((ext_vector_type(8))); typedef int v4i_t __attribute__((ext_vector_type(4)));
__device__ __forceinline__ unsigned pk4f8(float a, float b, float c, float d) { int w = 0; w = __builtin_amdgcn_cvt_pk_fp8_f32(a, b, w, false); w = __builtin_amdgcn_cvt_pk_fp8_f32(c, d, w, true); return (unsigned)w; }
template <int DQK> __device__ __forceinline__ int k8swz(int row, int chunk) {
    if constexpr (DQK == 192) return row * 256 + ((chunk ^ (row & 15)) << 4);
    else return row * 128 + ((chunk ^ ((row >> 1) & 7)) << 4);
}
template <int DQK>
__device__ __forceinline__ void qkt8(f32x16& p0, f32x16& p1, const char* kbuf, int r32, int hi, const v8i_t* q8, int f8scale) {
    constexpr int NS = DQK / 64, H32 = 32 * (DQK == 192 ? 256 : 128);
    v8i_t a0[NS], a1[NS];
#define K8LD(s_) do { const int c0 = 4 * (s_) + 2 * hi;                                                                          \
        const lds_cptr k0_ = (lds_cptr)kbuf + k8swz<DQK>(r32, c0), k1_ = (lds_cptr)kbuf + k8swz<DQK>(r32, c0 + 1);             \
        a0[s_].lo = *(const __attribute__((address_space(3))) v4i_t*)k0_; a0[s_].hi = *(const __attribute__((address_space(3))) v4i_t*)k1_;            \
        a1[s_].lo = *(const __attribute__((address_space(3))) v4i_t*)(k0_ + H32); a1[s_].hi = *(const __attribute__((address_space(3))) v4i_t*)(k1_ + H32); } while (0)
    K8LD(0); K8LD(1);
#pragma unroll
    for (int s_ = 0; s_ < NS; ++s_) {
        __builtin_amdgcn_s_setprio(1);
        if (s_ == 0) {
            asm volatile("v_mfma_scale_f32_32x32x64_f8f6f4 %0, %1, %2, 0, %3, %3 op_sel_hi:[0,0,0]" : "=&v"(p0) : "v"(a0[s_]), "v"(q8[s_]), "v"(f8scale));
            asm volatile("v_mfma_scale_f32_32x32x64_f8f6f4 %0, %1, %2, 0, %3, %3 op_sel_hi:[0,0,0]" : "=&v"(p1) : "v"(a1[s_]), "v"(q8[s_]), "v"(f8scale)); }
        else {
            asm volatile("v_mfma_scale_f32_32x32x64_f8f6f4 %0, %1, %2, %0, %3, %3 op_sel_hi:[0,0,0]" : "+v"(p0) : "v"(a0[s_]), "v"(q8[s_]), "v"(f8scale));
            asm volatile("v_mfma_scale_f32_32x32x64_f8f6f4 %0, %1, %2, %0, %3, %3 op_sel_hi:[0,0,0]" : "+v"(p1) : "v"(a1[s_]), "v"(q8[s_]), "v"(f8scale)); }
        __builtin_amdgcn_s_setprio(0);
        if (s_ == 0 && NS == 3) { ASBAR(); K8LD(2); } }
#undef K8LD
    asm volatile("s_nop 15\n\ts_nop 7" : "+v"(p0), "+v"(p1));
}
struct UnitArgs {
    const bf16_t* Q; int qpitch;
    const bf16_t* K; int kpitch;
    const bf16_t* Kr;
    const unsigned char* Q8; const unsigned char* K8; const unsigned char* Kr8; const unsigned char* V8;
    const bf16_t* V; int vpitch;
    bf16_t* O; int opitch;
    bf16_t* PO; float* PML;
    const int* pos; const int* tpmax;
    const unsigned* list; int nrows;
    int q0, k0, NT, h;
    float c2;
};
template <int DQK, int MODE>
__device__ __forceinline__ void attn_unit(const UnitArgs& A, char* lds, int wv) {
    int tid_ = wv * 64 + lane_id_(); asm volatile("" : "+v"(tid_)); const int tid = tid_, wid = wv, lane = tid & 63, r32 = lane & 31, hi = lane >> 5;
    constexpr bool F8 = true;
    constexpr int KT = F8 ? (DQK == 192 ? 16384 : 8192) : 64 * DQK * 2; constexpr int Q8P = DQK == 192 ? 3072 : 2048;
    char* V_lds = lds + L_V; char* K_lds = lds + L_K;
    float* ws = (float*)(lds + L_WS) + wid * 128; float* li_l = ws; float* al_l = ws + 32; int* ix_l = (int*)(ws + 64);
    const float* biasL = (const float*)(lds + L_BIAS) + A.h * 132;
    const int sr = tid >> 4, sc = (tid & 15) * 8, vst0 = v_st(sr, sc), vst1 = v_st(32 + sr, sc);
    const int kws0 = kswz<DQK>(sr, tid & 15), kws1 = kswz<DQK>(32 + sr, tid & 15);
    const int kws2 = (DQK == 192) ? kswz<DQK>(tid >> 3, 16 + (tid & 7)) : 0;
    const int k8w0 = k8swz<DQK>(tid >> 3, tid & 7), k8w2 = DQK == 192 ? k8swz<DQK>(tid >> 2, 8 + (tid & 3)) : 0;
    const int vb0 = (int)(uintptr_t)V_lds + v_rd_base(lane); (void)vb0;
    const int v8w = (tid >> 2) * 64 + (((tid & 3) ^ ((tid >> 4) & 3)) << 4), v8r = r32 * 64 + (((2 * hi) ^ ((r32 >> 2) & 3)) << 4);
    const lds_cptr vp0 = (lds_cptr)V_lds + v_rd_base(lane);
    bf16x8 st_k0, st_k1, st_k2, st_v0, st_v1;
#define SLOAD(t) do { const size_t kk_ = (size_t)(A.k0 + (t) * 64);                                                         \
        if constexpr (F8) st_v0 = ld8((const bf16_t*)(A.V8 + (kk_ >> 6) * 8192 + tid * 16));                             \
        else { st_v0 = ld8(A.V + (kk_ + sr) * A.vpitch + sc); st_v1 = ld8(A.V + (kk_ + 32 + sr) * A.vpitch + sc); }    \
        if constexpr (F8) { st_k0 = ld8((const bf16_t*)(A.K8 + (kk_ + (tid >> 3)) * 2048 + (tid & 7) * 16));             \
            if constexpr (DQK == 192) if (wid < 4) st_k2 = ld8((const bf16_t*)(A.Kr8 + (kk_ + (tid >> 2)) * 64 + (tid & 3) * 16)); }   \
        else { st_k0 = ld8(A.K + (kk_ + sr) * A.kpitch + sc); st_k1 = ld8(A.K + (kk_ + 32 + sr) * A.kpitch + sc);       \
            if constexpr (DQK == 192) st_k2 = ld8(A.Kr + (kk_ + (tid >> 3)) * 64 + (tid & 7) * 8); } } while (0)
#define SWRITE(bf) do { if constexpr (F8) *(bf16x8*)(V_lds + (bf) * VT_BYTES + v8w) = st_v0;                                  \
        else { *(bf16x8*)(V_lds + (bf) * VT_BYTES + vst0) = st_v0; *(bf16x8*)(V_lds + (bf) * VT_BYTES + vst1) = st_v1; } \
        if constexpr (F8) { *(bf16x8*)(K_lds + (bf) * KT + k8w0) = st_k0; if constexpr (DQK == 192) if (wid < 4) *(bf16x8*)(K_lds + (bf) * KT + k8w2) = st_k2; } \
        else { *(bf16x8*)(K_lds + (bf) * KT + kws0) = st_k0; *(bf16x8*)(K_lds + (bf) * KT + kws1) = st_k1;                 \
            if constexpr (DQK == 192) *(bf16x8*)(K_lds + (bf) * KT + kws2) = st_k2; } } while (0)
    SLOAD(0);
    int qrow, jslot = 3; bool valid = true;
    if constexpr (MODE == 1) { const int e = wid * 32 + r32; valid = e < A.nrows; const unsigned ent = A.list[valid ? e : 0]; qrow = (int)(ent & 0xffffu); jslot = (int)(ent >> 16); }
    else qrow = A.q0 + wid * 32 + r32;
    bf16x8 qr[F8 ? 1 : DQK / 16]; v8i_t q8[DQK / 64]; int f8scale = 0x7f7f7f7f;
    if constexpr (F8) { asm volatile("" : "+v"(f8scale));
#pragma unroll
        for (int s_ = 0; s_ < DQK / 64; ++s_) { const v4i_t* qp = (const v4i_t*)(A.Q8 + (size_t)qrow * Q8P + 64 * s_ + 32 * hi); q8[s_].lo = qp[0]; q8[s_].hi = qp[1]; } }
    else {
#pragma unroll
        for (int d0 = 0; d0 < DQK / 16; ++d0) qr[d0] = ld8(A.Q + (size_t)qrow * A.qpitch + d0 * 16 + hi * 8); }
    int posq = 0, qminw = 0;
    if constexpr (MODE != 0) { posq = A.pos[qrow]; int mn = posq;
#pragma unroll
        for (int o_ = 1; o_ < 64; o_ <<= 1) mn = min(mn, __shfl_xor(mn, o_));
        qminw = __builtin_amdgcn_readfirstlane(mn); }
    const int qlo = A.q0 + wid * 32;
    float m_reg = -1e30f, l_reg = 0.f; f32x16 o[4] = {};
    f32x16 o5 = {};
    f32x16 p0, p1; float alpha; bf16x8 pa0, pa1, pa2, pa3;
    const int NT = A.NT;
    SWRITE(0);
    __syncthreads();
    if constexpr (F8) {
#pragma unroll
        for (int s_ = 0; s_ < DQK / 64; ++s_) asm volatile("" : "+v"(q8[s_])); }
    else {
#pragma unroll
        for (int d0 = 0; d0 < DQK / 16; ++d0) asm volatile("" : "+v"(qr[d0])); }
#define KB_(t) (A.k0 + (t) * 64)
#define ACT(t) (MODE == 1 || KB_(t) <= qlo + 31)
#define NEEDMASK(t) (MODE != 1 && KB_(t) + 63 > qlo)
#define STEP(t, B) do {                                                                                                       \
        const bool more_ = (t) + 1 < NT;                                                                                      \
        if (more_) SLOAD((t) + 1);                                                                                            \
        if (ACT(t)) {                                                                                                         \
            ASBAR(); if constexpr (F8) qkt8<DQK>(p0, p1, K_lds + (B) * KT, r32, hi, q8, f8scale); else qkt<DQK>(p0, p1, K_lds + (B) * KT, r32, hi, qr);     \
            if constexpr (MODE != 0) {                                                                                                          \
                const int kmax_ = A.tpmax[KB_(t) >> 6];                                                                       \
                if (qminw - kmax_ >= 128) { const float bc = biasL[128];                                                      \
                    _Pragma("unroll") for (int r = 0; r < 16; ++r) { p0[r] = fmaf(p0[r], A.c2, bc); p1[r] = fmaf(p1[r], A.c2, bc); } }   \
                else {                                                                                                        \
                    _Pragma("unroll") for (int g4 = 0; g4 < 4; ++g4) {                                                        \
                        const i32x4 pk0 = *(const i32x4*)(A.pos + KB_(t) + 8 * g4 + 4 * hi);                                  \
                        const i32x4 pk1 = *(const i32x4*)(A.pos + KB_(t) + 32 + 8 * g4 + 4 * hi);                             \
                        _Pragma("unroll") for (int e = 0; e < 4; ++e) {                                                       \
                            const int d0_ = min(max(posq - pk0[e], 0), 128), d1_ = min(max(posq - pk1[e], 0), 128);           \
                            p0[4 * g4 + e] = fmaf(p0[4 * g4 + e], A.c2, biasL[d0_]); p1[4 * g4 + e] = fmaf(p1[4 * g4 + e], A.c2, biasL[d1_]); } } }   \
            }                                                                                                                 \
            if (NEEDMASK(t)) mask_tile(p0, p1, (qlo + r32 - 4 * hi) - KB_(t));                                                \
            partialSM<MODE == 0>(p0, p1, m_reg, alpha, A.c2);                                                                 \
            if (__any(alpha < 1.f)) { if (hi == 0) al_l[r32] = alpha; asm volatile("s_waitcnt lgkmcnt(0)" ::: "memory");      \
                _Pragma("unroll") for (int d_ = 0; d_ < 4; ++d_) _Pragma("unroll") for (int r = 0; r < 16; ++r) o[d_][r] *= al_l[crow(r, hi)];     \
                if constexpr (F8) { _Pragma("unroll") for (int r = 0; r < 16; ++r) o5[r] *= al_l[crow(r, hi)]; } }                                  \
            if constexpr (F8) { const lds_cptr vp_ = (lds_cptr)V_lds + (B) * VT_BYTES + v8r; v8i_t vf[4], p8;                   \
              _Pragma("unroll") for (int d_ = 0; d_ < 4; ++d_) { vf[d_].lo = *(const __attribute__((address_space(3))) v4i_t*)(vp_ + d_ * 2048);  \
                  vf[d_].hi = *(const __attribute__((address_space(3))) v4i_t*)((lds_cptr)V_lds + (B) * VT_BYTES + (v8r ^ 16) + d_ * 2048); }           \
              finishSM_e(p1);                                                                                                  \
              _Pragma("unroll") for (int j_ = 0; j_ < 4; ++j_) { p8[j_] = (int)pk4f8(p0[4 * j_], p0[4 * j_ + 1], p0[4 * j_ + 2], p0[4 * j_ + 3]);     \
                  p8[4 + j_] = (int)pk4f8(p1[4 * j_], p1[4 * j_ + 1], p1[4 * j_ + 2], p1[4 * j_ + 3]); }                       \
              __builtin_amdgcn_s_setprio(1);                                                                                   \
              _Pragma("unroll") for (int d_ = 0; d_ < 4; ++d_)                                                                 \
                  asm volatile("v_mfma_scale_f32_32x32x64_f8f6f4 %0, %1, %2, %0, %3, %3 op_sel_hi:[0,0,0]" : "+v"(o[d_]) : "v"(p8), "v"(vf[d_]), "v"(f8scale));   \
              { v8i_t ones8 = {0x38383838, 0x38383838, 0x38383838, 0x38383838, 0x38383838, 0x38383838, 0x38383838, 0x38383838}; asm volatile("" : "+v"(ones8));        \
                asm volatile("v_mfma_scale_f32_32x32x64_f8f6f4 %0, %1, %2, %0, %3, %3 op_sel_hi:[0,0,0]" : "+v"(o5) : "v"(p8), "v"(ones8), "v"(f8scale)); }        \
              __builtin_amdgcn_s_setprio(0); }                                                                                 \
            else { const lds_cptr vp_ = vp0 + (B) * VT_BYTES; s16x4 fa[8], fb[8];                                                    \
              finishSM_a(p0, p1, alpha, l_reg); PK4(p0, 0, pa0); PK4(p0, 8, pa1);                                             \
              VRD(fa, vp_, 0); PK4(p1, 0, pa2); PK4(p1, 8, pa3);                                                              \
              VRD(fb, vp_, 1); PVMMA(fa, 0); VRD(fa, vp_, 2); PVMMA(fb, 1); VRD(fb, vp_, 3); PVMMA(fa, 2); PVMMA(fb, 3); }    \
        }                                                                                                                     \
        if (more_) SWRITE((B) ^ 1);                                                                                           \
        __syncthreads(); } while (0)
    for (int t = 0; t < NT; t += 2) { STEP(t, 0); STEP(t + 1, 1); }
    if constexpr (F8) asm volatile("s_nop 15\n\ts_nop 7" : "+v"(o[0]), "+v"(o[1]), "+v"(o[2]), "+v"(o[3]), "+v"(o5));
#undef STEP
#undef ACT
#undef NEEDMASK
#undef KB_
#undef SLOAD
#undef SWRITE
    if (hi == 0) { if constexpr (!F8) li_l[r32] = l_reg; ix_l[r32] = valid ? (qrow * 16 + A.h) * 4 + jslot : -1; }
    asm volatile("s_waitcnt lgkmcnt(0)" ::: "memory");
    if constexpr (MODE != 0) { if (hi == 0 && valid) { float* ml = A.PML + (size_t)((qrow * 16 + A.h) * 4 + jslot) * 2; ml[0] = m_reg; if constexpr (!F8) ml[1] = l_reg; } }
#pragma unroll
    for (int r = 0; r < 16; ++r) { const int orow = crow(r, hi); const float rl = __builtin_amdgcn_rcpf(F8 ? o5[r] : li_l[orow]);
        bf16_t* dst; bool ok = true;
        if constexpr (MODE == 0) dst = A.O + (size_t)(qlo + orow) * A.opitch;
        else { const int ix = ix_l[orow]; ok = ix >= 0; dst = A.PO + (size_t)(ok ? ix : 0) * 128;
            if constexpr (F8) { if (r32 == 0 && ok) A.PML[(size_t)ix * 2 + 1] = o5[r]; } }
#pragma unroll
        for (int d0 = 0; d0 < 4; ++d0) { const float v = o[d0][r] * rl; const float vn = __shfl_xor(v, 1);
            if ((r32 & 1) == 0 && ok) *(unsigned*)(dst + d0 * 32 + r32) = cvtpk(v, vn); } }
    __syncthreads();
}
template <int MODE>
__device__ __forceinline__ void moba_unit(const UnitArgs& A, char* lds, int wv, int nchunk) {
    int tid_ = wv * 64 + lane_id_(); asm volatile("" : "+v"(tid_)); const int tid = tid_, wid = wv, lane = tid & 63, r32 = lane & 31, hi = lane >> 5;
    char* V_lds = lds + L_V; char* K_lds = lds + L_K;
    float* ws = (float*)(lds + L_WS) + wid * 128; float* al_l = ws + 32; int* ix_l = (int*)(ws + 64);
    const float* biasL = (const float*)(lds + L_BIAS) + A.h * 132;
    int qrow, jslot = 3, posq; bool valid = true; v8i_t q8[2]; unsigned ent = 0;
    if constexpr (MODE == 1) { const int e = wid * 32 + r32; valid = e < A.nrows; ent = A.list[valid ? e : 0]; }
    else qrow = A.q0 + wid * 32 + r32;
#define QLOAD(QF_, POSQ_, QROW_) do { _Pragma("unroll") for (int s_ = 0; s_ < 2; ++s_) { const v4i_t* qp = (const v4i_t*)(A.Q8 + (size_t)(QROW_) * 2048 + 64 * s_ + 32 * hi); QF_[s_].lo = qp[0]; QF_[s_].hi = qp[1]; } \
        POSQ_ = A.pos[QROW_]; } while (0)
    if constexpr (MODE != 1) QLOAD(q8, posq, qrow);
    { const int k8w0 = k8swz<128>(tid >> 3, tid & 7), v8w = (tid >> 2) * 64 + (((tid & 3) ^ ((tid >> 4) & 3)) << 4);
      bf16x8 sk[4], sv[4];
#pragma unroll
      for (int i = 0; i < 4; ++i) { const size_t kk_ = (size_t)(A.k0 + i * 64);
          sv[i] = ld8((const bf16_t*)(A.V8 + (kk_ >> 6) * 8192 + tid * 16)); sk[i] = ld8((const bf16_t*)(A.K8 + (kk_ + (tid >> 3)) * 2048 + (tid & 7) * 16)); }
      if constexpr (MODE == 1) { qrow = (int)(ent & 0xffffu); jslot = (int)(ent >> 16); QLOAD(q8, posq, qrow); }
#pragma unroll
      for (int i = 0; i < 4; ++i) { *(bf16x8*)(V_lds + i * 8192 + v8w) = sv[i]; *(bf16x8*)(K_lds + i * 8192 + k8w0) = sk[i]; } }
    __syncthreads();
    const int v8r = r32 * 64 + (((2 * hi) ^ ((r32 >> 2) & 3)) << 4);
    int f8scale = 0x7f7f7f7f; asm volatile("" : "+v"(f8scale));
    const int qlo = A.q0 + wid * 32;
#pragma unroll 1
    for (int c = 0; c < nchunk; ++c) {
        if (MODE == 1 && c * 256 + wid * 32 >= A.nrows) break;
        const bool has_next = MODE == 1 && (c + 1 < nchunk) && ((c + 1) * 256 + wid * 32 < A.nrows);
        unsigned entn = 0; bool validn = false; v8i_t q8n[2]; int posqn = 0, qrown = 0;
        if (has_next) { const int en = (c + 1) * 256 + wid * 32 + r32; validn = en < A.nrows; entn = A.list[validn ? en : 0]; }
        int qminw; { int mn = posq;
#pragma unroll
            for (int o_ = 1; o_ < 64; o_ <<= 1) mn = min(mn, __shfl_xor(mn, o_));
            qminw = __builtin_amdgcn_readfirstlane(mn); }
        float m_reg = -1e30f, alpha; f32x16 o[4] = {}, o5 = {}, p0, p1;
#pragma unroll
        for (int s_ = 0; s_ < 2; ++s_) asm volatile("" : "+v"(q8[s_]));
#define MTILE(t) do { const int kb_ = A.k0 + (t) * 64;                                                                          \
            if (MODE == 1 || kb_ <= qlo + 31) {                                                                               \
                ASBAR(); qkt8<128>(p0, p1, K_lds + (t) * 8192, r32, hi, q8, f8scale);                                         \
                const int kmax_ = A.tpmax[kb_ >> 6];                                                                          \
                if (qminw - kmax_ >= 128) { const float bc = biasL[128];                                                      \
                    _Pragma("unroll") for (int r = 0; r < 16; ++r) { p0[r] = fmaf(p0[r], A.c2, bc); p1[r] = fmaf(p1[r], A.c2, bc); } }   \
                else {                                                                                                        \
                    _Pragma("unroll") for (int g4 = 0; g4 < 4; ++g4) {                                                        \
                        const i32x4 pk0 = *(const i32x4*)(A.pos + kb_ + 8 * g4 + 4 * hi);                                     \
                        const i32x4 pk1 = *(const i32x4*)(A.pos + kb_ + 32 + 8 * g4 + 4 * hi);                                \
                        _Pragma("unroll") for (int e = 0; e < 4; ++e) {                                                       \
                            const int d0_ = min(max(posq - pk0[e], 0), 128), d1_ = min(max(posq - pk1[e], 0), 128);           \
                            p0[4 * g4 + e] = fmaf(p0[4 * g4 + e], A.c2, biasL[d0_]); p1[4 * g4 + e] = fmaf(p1[4 * g4 + e], A.c2, biasL[d1_]); } } }   \
                if (MODE != 1 && kb_ + 63 > qlo) mask_tile(p0, p1, (qlo + r32 - 4 * hi) - kb_);                               \
                partialSM<false>(p0, p1, m_reg, alpha, A.c2);                                                                 \
                if (__any(alpha < 1.f)) { if (hi == 0) al_l[r32] = alpha; asm volatile("s_waitcnt lgkmcnt(0)" ::: "memory");  \
                    _Pragma("unroll") for (int d_ = 0; d_ < 4; ++d_) _Pragma("unroll") for (int r = 0; r < 16; ++r) o[d_][r] *= al_l[crow(r, hi)];   \
                    _Pragma("unroll") for (int r = 0; r < 16; ++r) o5[r] *= al_l[crow(r, hi)]; }                              \
                { const lds_cptr vp_ = (lds_cptr)V_lds + (t) * 8192 + v8r; const lds_cptr vq_ = (lds_cptr)V_lds + (t) * 8192 + (v8r ^ 16); v8i_t vf[4], p8;   \
                  _Pragma("unroll") for (int d_ = 0; d_ < 4; ++d_) { vf[d_].lo = *(const __attribute__((address_space(3))) v4i_t*)(vp_ + d_ * 2048); vf[d_].hi = *(const __attribute__((address_space(3))) v4i_t*)(vq_ + d_ * 2048); }   \
                  finishSM_e(p1);                                                                                             \
                  _Pragma("unroll") for (int j_ = 0; j_ < 4; ++j_) { p8[j_] = (int)pk4f8(p0[4 * j_], p0[4 * j_ + 1], p0[4 * j_ + 2], p0[4 * j_ + 3]); p8[4 + j_] = (int)pk4f8(p1[4 * j_], p1[4 * j_ + 1], p1[4 * j_ + 2], p1[4 * j_ + 3]); }   \
                  __builtin_amdgcn_s_setprio(1);                                                                              \
                  _Pragma("unroll") for (int d_ = 0; d_ < 4; ++d_)                                                            \
                      asm volatile("v_mfma_scale_f32_32x32x64_f8f6f4 %0, %1, %2, %0, %3, %3 op_sel_hi:[0,0,0]" : "+v"(o[d_]) : "v"(p8), "v"(vf[d_]), "v"(f8scale));   \
                  { v8i_t ones8 = {0x38383838, 0x38383838, 0x38383838, 0x38383838, 0x38383838, 0x38383838, 0x38383838, 0x38383838}; asm volatile("" : "+v"(ones8));   \
                    asm volatile("v_mfma_scale_f32_32x32x64_f8f6f4 %0, %1, %2, %0, %3, %3 op_sel_hi:[0,0,0]" : "+v"(o5) : "v"(p8), "v"(ones8), "v"(f8scale)); }   \
                  __builtin_amdgcn_s_setprio(0); }                                                                            \
            } } while (0)
        MTILE(0); MTILE(1);
        if (has_next) { qrown = (int)(entn & 0xffffu); QLOAD(q8n, posqn, qrown); }
        MTILE(2); MTILE(3);
#undef MTILE
        asm volatile("s_nop 15\n\ts_nop 7" : "+v"(o[0]), "+v"(o[1]), "+v"(o[2]), "+v"(o[3]), "+v"(o5));
        if (hi == 0) ix_l[r32] = valid ? (qrow * 16 + A.h) * 4 + jslot : -1;
        asm volatile("s_waitcnt lgkmcnt(0)" ::: "memory");
        if (hi == 0 && valid) A.PML[(size_t)((qrow * 16 + A.h) * 4 + jslot) * 2] = m_reg;
#pragma unroll
        for (int r = 0; r < 16; ++r) { const int orow = crow(r, hi); const float rl = __builtin_amdgcn_rcpf(o5[r]);
            const int ix = ix_l[orow]; const bool ok = ix >= 0; bf16_t* dst = A.PO + (size_t)(ok ? ix : 0) * 128;
            if (r32 == 0 && ok) A.PML[(size_t)ix * 2 + 1] = o5[r];
#pragma unroll
            for (int d0 = 0; d0 < 4; ++d0) { const float v = o[d0][r] * rl; const float vn = __shfl_xor(v, 1);
                if ((r32 & 1) == 0 && ok) *(unsigned*)(dst + d0 * 32 + r32) = cvtpk(v, vn); } }
        asm volatile("s_waitcnt lgkmcnt(0)" ::: "memory");
        if (!has_next) break;
        qrow = qrown; jslot = (int)(entn >> 16); valid = validn; posq = posqn; q8[0] = q8n[0]; q8[1] = q8n[1];
    }
#undef QLOAD
    __syncthreads();
}
}
constexpr int NWAVES = 8;
constexpr int M_ = 16384, DM = 4096, DFF = 11008, NFF2 = 2 * DFF;
constexpr int NH = 16, QLORA = 1024, KVLORA = 512, ROPE = 64, NOPE = 128, VDIM = 128, QUP = NH * 192, KVUP = NH * 256, MLAOUT = NH * 128, MOBAW = NH * 128;
constexpr int INCOLS = 15936, INPAD1 = 5888, IN2 = 10240;
constexpr int MBLK = 256, NBLK = M_ / MBLK;
constexpr float RMS_EPS = 1e-6f;
constexpr size_t MiB = 1u << 20;
constexpr size_t WS_CTL = 0, CTL_ZERO_BYTES = 1 * MiB;
constexpr size_t WS_WFFN_IN = 1 * MiB;
constexpr size_t WS_WFFN_OUT = WS_WFFN_IN + (size_t)NFF2 * DM * 2;
constexpr size_t WS_WFFN_END = WS_WFFN_OUT + (size_t)DM * DFF * 2;
constexpr size_t WS_PO = WS_WFFN_IN;
constexpr size_t WS_WIN = WS_WFFN_END;
constexpr size_t WS_WIN8 = WS_WIN + (size_t)INPAD1 * DM * 2;
constexpr size_t WS_WUQ = WS_WIN8 + (size_t)IN2 * DM;
constexpr size_t WS_WUKV = WS_WUQ + (size_t)QUP * QLORA * 2;
constexpr size_t WS_WBRA = WS_WUKV + (size_t)KVUP * KVLORA * 2;
constexpr size_t WS_WBRB = WS_WBRA + (size_t)DM * MLAOUT * 2;
constexpr size_t WS_WOUT = WS_WBRB + (size_t)DM * MOBAW * 2;
constexpr size_t WS_H = WS_WOUT + (size_t)DM * DM * 2;
constexpr size_t WS_LIST = WS_H;
constexpr size_t LIST_PER_HEAD = 516096;
constexpr size_t WS_PML = WS_LIST + LIST_PER_HEAD * NH * 4;
constexpr size_t WS_BIG = WS_H + (size_t)M_ * DM * 2;
constexpr size_t WS_CQ = WS_BIG;
constexpr size_t WS_CKV = WS_CQ + (size_t)M_ * QLORA * 2;
constexpr size_t WS_KR = WS_CKV + (size_t)M_ * KVLORA * 2;
constexpr size_t WS_QB = WS_KR + (size_t)M_ * ROPE * 2;
constexpr size_t WS_KB = WS_QB + (size_t)M_ * MOBAW * 2;
constexpr size_t WS_VB = WS_KB + (size_t)M_ * MOBAW * 2;
constexpr size_t WS_GA = WS_VB + (size_t)M_ * MOBAW * 2;
constexpr size_t WS_GB = WS_GA + (size_t)M_ * DM * 2;
constexpr size_t WS_BIG_END = WS_GB + (size_t)M_ * DM * 2;
constexpr size_t WS_QM8 = WS_BIG_END;
constexpr size_t WS_KN8 = WS_QM8 + (size_t)M_ * QUP;
constexpr size_t WS_KR8 = WS_KN8 + (size_t)M_ * 2048;
constexpr size_t WS_V8 = WS_KR8 + (size_t)M_ * 64;
constexpr size_t WS_QB8 = WS_V8 + (size_t)M_ * 2048;
constexpr size_t WS_KB8 = WS_QB8 + (size_t)M_ * 2048;
constexpr size_t WS_VB8 = WS_KB8 + (size_t)M_ * 2048;
constexpr size_t WS_OA = WS_VB8 + (size_t)M_ * 2048;
constexpr size_t WS_COS = WS_OA + (size_t)M_ * MLAOUT * 2;
constexpr size_t WS_SIN = WS_COS + (size_t)M_ * 32 * 4;
constexpr size_t WS_KMH = WS_SIN + (size_t)M_ * 32 * 4;
constexpr size_t WS_KML = WS_KMH + (size_t)NH * NBLK * 128 * 2;
constexpr size_t WS_BIAS = WS_KML + (size_t)NH * NBLK * 128 * 2;
constexpr size_t WS_TPMAX = WS_BIAS + 16 * 132 * 4;
constexpr size_t WS_PART = WS_TPMAX + 256 * 4;
constexpr size_t WS_RSTD = WS_PART + (size_t)M_ * 64 * 4;
constexpr size_t WS_PARTQ = WS_RSTD + (size_t)M_ * 4;
constexpr size_t WS_PARTKV = WS_PARTQ + (size_t)M_ * 16 * 4;
constexpr size_t WS_RSTDQ = WS_PARTKV + (size_t)M_ * 8 * 4;
constexpr size_t WS_RSTDKV = WS_RSTDQ + (size_t)M_ * 4;
constexpr size_t WS_H8 = WS_RSTDKV + (size_t)M_ * 4;
constexpr size_t WS_OA8 = WS_H8 + (size_t)M_ * DM;
constexpr size_t WS_OB8 = WS_OA8 + (size_t)M_ * MLAOUT;
constexpr size_t WS_MG8 = WS_OB8 + (size_t)M_ * MOBAW;
constexpr size_t WS_PMAX = WS_MG8 + (size_t)M_ * DM;
constexpr size_t WS_CPART = WS_PMAX + (size_t)M_ * 64 * 4;
constexpr size_t WS_CMAXF = WS_CPART + (size_t)8 * 2 * NFF2 * 4;
constexpr size_t WS_CPARTO = WS_CMAXF + (size_t)2 * NFF2 * 4;
constexpr size_t WS_CMAXO = WS_CPARTO + (size_t)8 * DM * 4;
constexpr size_t WS_RSM = WS_CMAXO + (size_t)DM * 4;
constexpr size_t WS_QM = ((WS_RSM + (size_t)M_ * 4 + 4095) / 4096) * 4096;
constexpr size_t WS_KV = WS_QM + (size_t)M_ * QUP * 2;
constexpr size_t WS_WFI2 = MLA_BF16 ? WS_KV + (size_t)M_ * KVUP * 2 : WS_QM;
constexpr size_t WS_END = WS_WFI2 + (size_t)NFF2 * DM;
static_assert(WS_PML + (size_t)M_ * NH * 4 * 2 * 4 <= WS_BIG, "lists + ml inside H");
static_assert((size_t)M_ * NH * 4 * 128 * 2 <= WS_WFFN_END - WS_WFFN_IN, "partial O inside FFN weight region");
static_assert((size_t)M_ * DFF * 2 <= WS_BIG_END - WS_BIG, "act inside BIG");
constexpr int CW_TMO = 0;
constexpr int CW_BAR = 4096;
constexpr int CW_GCNT = 16384;
constexpr int CW_CMAX = 196608;
constexpr int CW_KMEAN = 65536;
constexpr int RING_OFF = 0, RING_BYTES = 131072;
constexpr int LDSCTL_OFF = RING_BYTES, MISC_OFF = LDSCTL_OFF + 320;
constexpr int LDS_BYTES = 147456;
static_assert(att::L_END <= RING_BYTES, "attention LDS inside ring region");

#define GAS __attribute__((address_space(1)))
#define LAS __attribute__((address_space(3)))
typedef unsigned short bf16;
typedef unsigned v4u __attribute__((ext_vector_type(4)));
typedef unsigned v2u __attribute__((ext_vector_type(2)));
typedef float f32x4 __attribute__((ext_vector_type(4)));
typedef short bf16x8 __attribute__((ext_vector_type(8)));
typedef float f32x16 __attribute__((ext_vector_type(16)));
typedef GAS unsigned gu32;
#define RLX_AGENT __ATOMIC_RELAXED, __HIP_MEMORY_SCOPE_AGENT
#define LDS_WAIT() asm volatile("s_waitcnt lgkmcnt(0)" ::: "memory")
__device__ __forceinline__ unsigned f2bf(float f) { unsigned u = __builtin_bit_cast(unsigned, f); return (u + 0x7fffu + ((u >> 16) & 1u)) >> 16; }
__device__ __forceinline__ unsigned pk2(float lo, float hi) { return f2bf(lo) | (f2bf(hi) << 16); }
__device__ __forceinline__ float bfu_lo(unsigned w) { return __uint_as_float(w << 16); }
__device__ __forceinline__ float bfu_hi(unsigned w) { return __uint_as_float(w & 0xffff0000u); }

#define XB_TMO      128
#define XB_XCNT(j)  (256  + 64 * (j))
#define XB_XSUB(j)  (1280 + 64 * (j))
#define XB_XGEN(j)  (2304 + 64 * (j))
#define XB_TOP      3328
#define XB_TOPGEN   3392
#define XCD_BAR_WORDS 3456
#define XB_SPIN_CAP (1u << 22)
__device__ __forceinline__ unsigned xb_ld(unsigned* p)              { return __hip_atomic_load(p, __ATOMIC_RELAXED, __HIP_MEMORY_SCOPE_AGENT); }
__device__ __forceinline__ unsigned xb_add(unsigned* p, unsigned v) { return __hip_atomic_fetch_add(p, v, __ATOMIC_RELAXED, __HIP_MEMORY_SCOPE_AGENT); }
__device__ __forceinline__ unsigned xb_xcc_id() { return (unsigned)__builtin_amdgcn_s_getreg((3 << 11) | 20) & 0xFu; }
#define XB_SPIN(cond, bar) do { unsigned _sp = 0; while (cond) { __builtin_amdgcn_s_sleep(1); \
    if ((++_sp & 255u) == 0u) { if (xb_ld(&(bar)[XB_TMO])) break; if (_sp > XB_SPIN_CAP) { atomicAdd(&(bar)[XB_TMO], 1u); break; } } } } while (0)
struct XcdBarrier { unsigned* bar; unsigned x; volatile LAS unsigned* st; };
__device__ __forceinline__ XcdBarrier xcd_barrier_post(unsigned* bar, volatile LAS unsigned* st, int wv) {
    XcdBarrier b; b.bar = bar; b.x = xb_xcc_id(); b.st = st;
    if (wv == 0 && lane_id_() == 0) (void)xb_add(&bar[XB_XCNT(b.x)], 1u);
    return b;
}
__device__ __forceinline__ void xcd_barrier_complete(unsigned* bar, unsigned x, unsigned& nloc, unsigned& nx) {
    const unsigned G = gridDim.x * gridDim.y * gridDim.z;
    unsigned sum, cnt, mine, sp = 0u;
    for (;;) {
        sum = 0u; cnt = 0u; mine = 0u;
#pragma unroll
        for (unsigned j = 0; j < 16; ++j) { const unsigned c = xb_ld(&bar[XB_XCNT(j)]); sum += c; cnt += (c > 0u) ? 1u : 0u; mine = (j == x) ? c : mine; }
        if (sum == G) break;
        __builtin_amdgcn_s_sleep(1);
        if ((++sp & 255u) == 0u) { if (xb_ld(&bar[XB_TMO])) break; if (sp > XB_SPIN_CAP) { atomicAdd(&bar[XB_TMO], 1u); break; } }
    }
    nloc = mine > 0u ? mine : 1u; nx = cnt > 0u ? cnt : 1u;
}
__device__ __forceinline__ void xcd_barrier(const XcdBarrier& b, int wv) {
    asm volatile("s_waitcnt vmcnt(0)" ::: "memory");
    __syncthreads();
    if (wv == 0 && lane_id_() == 0) {
        unsigned* bar = b.bar;
        __builtin_amdgcn_s_waitcnt(0);
        unsigned nloc = b.st[0], nx = b.st[1];
        if (nloc == 0u) { xcd_barrier_complete(bar, b.x, nloc, nx); b.st[0] = nloc; b.st[1] = nx; }
        const unsigned old = xb_add(&bar[XB_XSUB(b.x)], 1u);
        const unsigned gen = old / nloc;
        if (old + 1u == (gen + 1u) * nloc) {
            __builtin_amdgcn_fence(__ATOMIC_RELEASE, "agent");
            asm volatile("s_waitcnt vmcnt(0)" ::: "memory");
            const unsigned og = xb_add(&bar[XB_TOP], 1u);
            const unsigned tg = og / nx;
            if (og + 1u == (tg + 1u) * nx) xb_add(&bar[XB_TOPGEN], 1u);
            else XB_SPIN(xb_ld(&bar[XB_TOPGEN]) == tg, bar);
            __builtin_amdgcn_fence(__ATOMIC_ACQUIRE, "agent");
            xb_add(&bar[XB_XGEN(b.x)], 1u);
            asm volatile("s_waitcnt vmcnt(0)" ::: "memory");
        } else {
            XB_SPIN(xb_ld(&bar[XB_XGEN(b.x)]) == gen, bar);
            __builtin_amdgcn_fence(__ATOMIC_ACQUIRE, "agent");
            asm volatile("s_waitcnt vmcnt(0)" ::: "memory");
        }
    }
    __syncthreads();
}
struct Args {
    const float* in[19]; float* out; unsigned char* ws;
    double invf[32];
    unsigned char bucket[136];
};
__device__ __forceinline__ float wave_sum(float v) {
#pragma unroll
    for (int o = 1; o < 64; o <<= 1) v += __shfl_xor(v, o);
    return v;
}
__device__ __forceinline__ void cvt_item(const float* W, int Nsrc, int scol0, bool ropep, bf16* Wt, int K, int drow0, int k0, LAS unsigned char* T, int lane, const float* gain, int tiledN = 0, int f8s = -1, const float* cmax = nullptr, int cstride = 0, float* cmfinal = nullptr) {
    const int rp = lane >> 4, c4 = lane & 15;
    if (scol0 >= 0) {
#pragma unroll
        for (int i = 0; i < 8; ++i) { const int k = 8 * i + 2 * rp;
            f32x4 a = __builtin_nontemporal_load((const GAS f32x4*)(W + (size_t)(k0 + k) * Nsrc + scol0 + 4 * c4));
            f32x4 b = __builtin_nontemporal_load((const GAS f32x4*)(W + (size_t)(k0 + k + 1) * Nsrc + scol0 + 4 * c4));
            if (gain) { a = a * gain[k0 + k]; b = b * gain[k0 + k + 1]; }
#pragma unroll
            for (int e = 0; e < 4; ++e) { const int c = 4 * c4 + e; *(LAS unsigned*)(T + c * 136 + k * 2) = pk2(a[e], b[e]); } }
    }
    LDS_WAIT(); asm volatile("" ::: "memory");
    const int kc = lane & 7, nr = lane >> 3;
#pragma unroll
    for (int j = 0; j < 8; ++j) { const int c = 8 * j + nr;
        v4u o = {0u, 0u, 0u, 0u};
        if (scol0 >= 0) { const v2u lo = *(const LAS v2u*)(T + c * 136 + kc * 16), hi2 = *(const LAS v2u*)(T + c * 136 + kc * 16 + 8); o.x = lo.x; o.y = lo.y; o.z = hi2.x; o.w = hi2.y; }
        int p = c; if (ropep) { const int half = c >> 5, i5 = c & 31; p = 8 * (i5 >> 2) + (i5 & 3) + 4 * half; }
        if (cmax) {
            float cm = 0.f;
#pragma unroll
            for (int sg_ = 0; sg_ < 8; ++sg_) cm = fmaxf(cm, cmax[(size_t)sg_ * cstride + scol0 + c]);
            if (k0 == 0 && kc == 0) cmfinal[scol0 + c] = cm;
            const float inv = 127.f / fmaxf(cm, 1e-30f); const float v8[8] = {bfu_lo(o.x), bfu_hi(o.x), bfu_lo(o.y), bfu_hi(o.y), bfu_lo(o.z), bfu_hi(o.z), bfu_lo(o.w), bfu_hi(o.w)};
            unsigned q0 = 0, q1 = 0;
#pragma unroll
            for (int e = 0; e < 4; ++e) { q0 |= ((unsigned)(int)rintf(v8[e] * inv) & 0xffu) << (8 * e); q1 |= ((unsigned)(int)rintf(v8[4 + e] * inv) & 0xffu) << (8 * e); }
            v2u q; q.x = q0; q.y = q1;
            *(GAS v2u*)((unsigned char*)Wt + ((size_t)(k0 >> 7) * tiledN + drow0 + p) * 128 + (k0 & 64) + 8 * kc) = q; }
        else if (f8s >= 0) {
            const float scl = __uint_as_float((unsigned)(127 + f8s) << 23); v2u q;
            int w0 = 0, w1 = 0;
            w0 = __builtin_amdgcn_cvt_pk_fp8_f32(bfu_lo(o.x) * scl, bfu_hi(o.x) * scl, w0, false); w0 = __builtin_amdgcn_cvt_pk_fp8_f32(bfu_lo(o.y) * scl, bfu_hi(o.y) * scl, w0, true);
            w1 = __builtin_amdgcn_cvt_pk_fp8_f32(bfu_lo(o.z) * scl, bfu_hi(o.z) * scl, w1, false); w1 = __builtin_amdgcn_cvt_pk_fp8_f32(bfu_lo(o.w) * scl, bfu_hi(o.w) * scl, w1, true);
            q.x = (unsigned)w0; q.y = (unsigned)w1;
            *(GAS v2u*)((unsigned char*)Wt + ((size_t)(k0 >> 7) * tiledN + drow0 + p) * 128 + (k0 & 64) + 8 * kc) = q; }
        else if (tiledN) *(GAS v4u*)(Wt + ((size_t)(k0 >> 6) * tiledN + drow0 + p) * 64 + 8 * kc) = o;
        else *(GAS v4u*)(Wt + (size_t)(drow0 + p) * K + k0 + 8 * kc) = o; }
    LDS_WAIT(); asm volatile("" ::: "memory");
}
template <int KIND>
__device__ __forceinline__ void cvt_job(const float* W, int K, int Nsrc, bf16* Wt, int ndb, LAS unsigned char* T, int gw, int NGW, int lane, const float* gain = nullptr, int tiledN = 0, int f8s = -1, const float* cmax = nullptr, int cstride = 0, float* cmfinal = nullptr, int jph = 0, int jnp = 1) {
    const int nkb = K / 64, nit = ndb * nkb;
    for (int it = gw + NGW * jph; it < nit; it += NGW * jnp) { const int db = it / nkb, kb = it - db * nkb;
        int scol = 64 * db; bool rp = false;
        if constexpr (KIND == 1) { const int pn = db >> 2, sub = db & 3; scol = (sub < 2) ? (128 * pn + 64 * sub) : (DFF + 128 * pn + 64 * (sub - 2)); }
        if constexpr (KIND == 2) { if (db < 24) scol = 64 * db; else if (db < 88) scol = 64 * db + 64; else if (db == 88) { scol = 1536; rp = true; } else scol = -1; }
        if constexpr (KIND == 4) { scol = 5696 + 64 * db; }
        if constexpr (KIND == 3) { rp = (db % 3) == 2; }
        cvt_item(W, Nsrc, scol, rp, Wt, K, 64 * db, 64 * kb, T, lane, gain, tiledN, f8s, cmax, cstride, cmfinal); }
}
template <bool OUTF32>
__device__ __forceinline__ void rms_row4096(const float* xrow, const float* g, void* orow, int lane, int tiledM = 0) {
    const GAS f32x4* xr = (const GAS f32x4*)xrow + lane;
    f32x4 v[16]; float s = 0.f;
#pragma unroll
    for (int j = 0; j < 16; ++j) { v[j] = xr[64 * j]; s += (v[j].x * v[j].x + v[j].y * v[j].y) + (v[j].z * v[j].z + v[j].w * v[j].w); }
    const float rstd = 1.0f / sqrtf(wave_sum(s) * (1.f / DM) + RMS_EPS);
    const GAS f32x4* gr = (const GAS f32x4*)g + lane;
#pragma unroll
    for (int j = 0; j < 16; ++j) { const f32x4 gg = gr[64 * j]; const f32x4 y = (v[j] * rstd) * gg;
        if constexpr (OUTF32) ((GAS f32x4*)orow)[64 * j + lane] = y;
        else { v2u w; w.x = pk2(y.x, y.y); w.y = pk2(y.z, y.w);
            if (tiledM) { const int col = 4 * (64 * j + lane); *(GAS v2u*)((bf16*)orow + ((size_t)(col >> 6) * tiledM) * 64 + (col & 63)) = w; }
            else ((GAS v2u*)orow)[64 * j + lane] = w; } }
}
template <int N>
__device__ __forceinline__ void rms_row_bf16(bf16* row, const float* g, int lane) {
    constexpr int NV = N / 512;
    v4u w[NV]; float s = 0.f;
#pragma unroll
    for (int j = 0; j < NV; ++j) { w[j] = *(const GAS v4u*)(row + (64 * j + lane) * 8);
#pragma unroll
        for (int e = 0; e < 4; ++e) { const float a = bfu_lo(w[j][e]), b = bfu_hi(w[j][e]); s += a * a + b * b; } }
    const float rstd = 1.0f / sqrtf(wave_sum(s) * (1.f / N) + RMS_EPS);
#pragma unroll
    for (int j = 0; j < NV; ++j) { const GAS f32x4* gp = (const GAS f32x4*)(g + (64 * j + lane) * 8); const f32x4 g0 = gp[0], g1 = gp[1]; v4u o;
        o.x = pk2(bfu_lo(w[j].x) * rstd * g0.x, bfu_hi(w[j].x) * rstd * g0.y); o.y = pk2(bfu_lo(w[j].y) * rstd * g0.z, bfu_hi(w[j].y) * rstd * g0.w);
        o.z = pk2(bfu_lo(w[j].z) * rstd * g1.x, bfu_hi(w[j].z) * rstd * g1.y); o.w = pk2(bfu_lo(w[j].w) * rstd * g1.z, bfu_hi(w[j].w) * rstd * g1.w);
        *(GAS v4u*)(row + (64 * j + lane) * 8) = o; }
}
__device__ __forceinline__ void colmax_job(const float* W, int K, int N, float* cpart, int cstride, int gw, int NGW, int lane) {
    const int nseg = K / 512, ntask = (N / 64) * nseg, rp = lane >> 4, c4 = lane & 15;
    for (int it = gw; it < ntask; it += NGW) { const int cb = it / nseg, sg = it - cb * nseg; f32x4 m = {0.f, 0.f, 0.f, 0.f};
        const float* wp = W + (size_t)(sg * 512 + rp) * N + cb * 64 + 4 * c4;
#pragma unroll 8
        for (int i = 0; i < 128; ++i) { const f32x4 v = __builtin_nontemporal_load((const GAS f32x4*)(wp + (size_t)(4 * i) * N));
            m[0] = fmaxf(m[0], fabsf(v[0])); m[1] = fmaxf(m[1], fabsf(v[1])); m[2] = fmaxf(m[2], fabsf(v[2])); m[3] = fmaxf(m[3], fabsf(v[3])); }
#pragma unroll
        for (int e = 0; e < 4; ++e) { float x = m[e]; x = fmaxf(x, __shfl_xor(x, 16)); x = fmaxf(x, __shfl_xor(x, 32)); if (rp == 0) cpart[(size_t)sg * cstride + cb * 64 + 4 * c4 + e] = x; } }
}
__device__ __forceinline__ void quant_row_plain_i8(const bf16* T, unsigned char* a8, int row, float* rs, int lane) {
    const GAS v4u* src = (const GAS v4u*)(T + (size_t)row * DM + lane * 64);
    v4u w[8]; float mx = 0.f;
#pragma unroll
    for (int j = 0; j < 8; ++j) w[j] = src[j];
#pragma unroll
    for (int j = 0; j < 8; ++j)
#pragma unroll
        for (int e = 0; e < 4; ++e) mx = fmaxf(mx, fmaxf(fabsf(bfu_lo(w[j][e])), fabsf(bfu_hi(w[j][e]))));
#pragma unroll
    for (int o = 1; o < 64; o <<= 1) mx = fmaxf(mx, __shfl_xor(mx, o));
    mx = fmaxf(mx, 1e-30f); const float inv = 127.f / mx;
    v4u o[4];
#pragma unroll
    for (int j = 0; j < 8; ++j) { unsigned q0 = 0, q1 = 0;
#pragma unroll
        for (int e = 0; e < 2; ++e) { const unsigned a = w[j][e], b2 = w[j][2 + e];
            q0 |= (((unsigned)(int)rintf(bfu_lo(a) * inv) & 0xffu) | (((unsigned)(int)rintf(bfu_hi(a) * inv) & 0xffu) << 8)) << (16 * e);
            q1 |= (((unsigned)(int)rintf(bfu_lo(b2) * inv) & 0xffu) | (((unsigned)(int)rintf(bfu_hi(b2) * inv) & 0xffu) << 8)) << (16 * e); }
        o[j >> 1][2 * (j & 1)] = q0; o[j >> 1][2 * (j & 1) + 1] = q1; }
    GAS v4u* dst = (GAS v4u*)(a8 + ((size_t)(lane >> 1) * M_ + row) * 128 + (lane & 1) * 64);
#pragma unroll
    for (int j = 0; j < 4; ++j) dst[j] = o[j];
    if (lane == 0) rs[row] = mx * (1.f / 127.f);
}
__device__ __forceinline__ void rms_row4096_i8(const float* xrow, const float* g, unsigned char* a8, int row, float* rs, int lane) {
    const GAS f32x4* xr = (const GAS f32x4*)xrow + lane;
    f32x4 v[16]; float s = 0.f;
#pragma unroll
    for (int j = 0; j < 16; ++j) { v[j] = xr[64 * j]; s += (v[j].x * v[j].x + v[j].y * v[j].y) + (v[j].z * v[j].z + v[j].w * v[j].w); }
    const float rstd = 1.0f / sqrtf(wave_sum(s) * (1.f / DM) + RMS_EPS);
    const GAS f32x4* gr = (const GAS f32x4*)g + lane; float mx = 0.f;
#pragma unroll
    for (int j = 0; j < 16; ++j) { const f32x4 gg = gr[64 * j]; v[j] = (v[j] * rstd) * gg; mx = fmaxf(fmaxf(mx, fmaxf(fabsf(v[j].x), fabsf(v[j].y))), fmaxf(fabsf(v[j].z), fabsf(v[j].w))); }
#pragma unroll
    for (int o = 1; o < 64; o <<= 1) mx = fmaxf(mx, __shfl_xor(mx, o));
    mx = fmaxf(mx, 1e-30f); const float inv = 127.f / mx;
#pragma unroll
    for (int j = 0; j < 16; ++j) { const int col = 4 * (64 * j + lane);
        const unsigned q = ((unsigned)(int)rintf(v[j].x * inv) & 0xffu) | (((unsigned)(int)rintf(v[j].y * inv) & 0xffu) << 8) | (((unsigned)(int)rintf(v[j].z * inv) & 0xffu) << 16) | (((unsigned)(int)rintf(v[j].w * inv) & 0xffu) << 24);
        *(GAS unsigned*)(a8 + ((size_t)(col >> 7) * M_ + row) * 128 + (col & 127)) = q; }
    if (lane == 0) rs[row] = mx * (1.f / 127.f);
}
__device__ __forceinline__ void quant_row_i8(const bf16* hb, const float* part, const float* pmax, unsigned char* a8, int row, float* rs, int lane) {
    float s = part[(size_t)row * 64 + lane], mx = pmax[(size_t)row * 64 + lane];
    s = wave_sum(s);
#pragma unroll
    for (int o = 1; o < 64; o <<= 1) mx = fmaxf(mx, __shfl_xor(mx, o));
    mx = fmaxf(mx, 1e-30f); const float inv = 127.f / mx;
    const GAS v4u* src = (const GAS v4u*)(hb + ((size_t)lane * M_ + row) * 64);
    v4u w[8];
#pragma unroll
    for (int j = 0; j < 8; ++j) w[j] = src[j];
    v4u o[4];
#pragma unroll
    for (int j = 0; j < 8; ++j) { unsigned q0 = 0, q1 = 0;
#pragma unroll
        for (int e = 0; e < 2; ++e) { const unsigned a = w[j][e], b = w[j][2 + e];
            q0 |= (((unsigned)(int)rintf(bfu_lo(a) * inv) & 0xffu) | (((unsigned)(int)rintf(bfu_hi(a) * inv) & 0xffu) << 8)) << (16 * e);
            q1 |= (((unsigned)(int)rintf(bfu_lo(b) * inv) & 0xffu) | (((unsigned)(int)rintf(bfu_hi(b) * inv) & 0xffu) << 8)) << (16 * e); }
        o[j >> 1][2 * (j & 1)] = q0; o[j >> 1][2 * (j & 1) + 1] = q1; }
    GAS v4u* dst = (GAS v4u*)(a8 + ((size_t)(lane >> 1) * M_ + row) * 128 + (lane & 1) * 64);
#pragma unroll
    for (int j = 0; j < 4; ++j) dst[j] = o[j];
    if (lane == 0) rs[row] = mx * (1.f / 127.f) / sqrtf(s * (1.f / DM) + RMS_EPS);
}
template <int NP>
__device__ __forceinline__ void rstd_reduce(const float* part, float* rstd, float inv_n, int vcu, int tid, int G) {
    for (int row = vcu * (NWAVES * 64) + tid; row < M_; row += G * NWAVES * 64) { float s = 0.f;
#pragma unroll
        for (int j = 0; j < NP / 4; ++j) { const f32x4 v = *(const GAS f32x4*)(part + (size_t)row * NP + 4 * j); s += (v.x + v.y) + (v.z + v.w); }
        rstd[row] = 1.0f / sqrtf(s * inv_n + RMS_EPS); }
}
__device__ __forceinline__ void sincos_d(double a, float& sn, float& cs) {
    const double k = rint(a * 0.63661977236758134308);
    double r = fma(-k, 1.57079632679489655800, a); r = fma(-k, 6.12323399573676603587e-17, r);
    const double r2 = r * r;
    const double sp = r + r * r2 * (-1.0 / 6 + r2 * (1.0 / 120 + r2 * (-1.0 / 5040 + r2 * (1.0 / 362880 + r2 * (-1.0 / 39916800)))));
    const double cp = 1.0 + r2 * (-0.5 + r2 * (1.0 / 24 + r2 * (-1.0 / 720 + r2 * (1.0 / 40320 + r2 * (-1.0 / 3628800 + r2 * (1.0 / 479001600))))));
    const int q = (int)((long long)k & 3);
    const double s_ = (q & 1) ? cp : sp, c_ = (q & 1) ? sp : cp;
    sn = (float)((q & 2) ? -s_ : s_); cs = (float)(((q + 1) & 2) ? -c_ : c_);
}
__device__ __forceinline__ int list_off(int kb) { return 16384 * kb - 128 * kb * (kb + 1); }
__device__ __forceinline__ bool better(float v, int i, float cv, int ci) { return v > cv || (v == cv && i < ci); }
#define TOP3_INS(v_, i_) do { const float vv_ = (v_); const int ii_ = (i_);                                             \
        const bool c0_ = better(vv_, ii_, tv0, ti0), c1_ = better(vv_, ii_, tv1, ti1), c2_ = better(vv_, ii_, tv2, ti2); \
        tv2 = c1_ ? tv1 : (c2_ ? vv_ : tv2); ti2 = c1_ ? ti1 : (c2_ ? ii_ : ti2);                                       \
        tv1 = c0_ ? tv0 : (c1_ ? vv_ : tv1); ti1 = c0_ ? ti0 : (c1_ ? ii_ : ti1);                                       \
        tv0 = c0_ ? vv_ : tv0; ti0 = c0_ ? ii_ : ti0; } while (0)
__device__ __forceinline__ void moba_gate_unit(int h, int qb, const bf16* QB, const float* KMF, unsigned* gcnt, unsigned* list, float* PML,
                                               LAS unsigned* cntL, LAS unsigned* baseL, int wv) {
    int tid_ = wv * 64 + lane_id_(); asm volatile("" : "+v"(tid_)); const int tid = tid_, wid = wv, lane = tid & 63, r32 = lane & 31, hi = lane >> 5;
    if (tid < 64) cntL[tid] = 0u;
    __syncthreads();
    const int s = qb * MBLK + wid * 32 + r32;
    bf16x8 qr[8];
#pragma unroll
    for (int d0 = 0; d0 < 8; ++d0) qr[d0] = *(const GAS bf16x8*)(QB + (size_t)s * MOBAW + h * 128 + d0 * 16 + hi * 8);
    f32x16 p0 = {}, p1 = {};
#pragma unroll
    for (int d0 = 0; d0 < 8; ++d0) {
#pragma unroll
        for (int half = 0; half < 2; ++half) { const float* kp = KMF + (size_t)(h * NBLK + half * 32 + r32) * 128 + d0 * 16 + hi * 8;
            const f32x4 a = *(const GAS f32x4*)kp, b = *(const GAS f32x4*)(kp + 4); const float v[8] = {a[0], a[1], a[2], a[3], b[0], b[1], b[2], b[3]};
            bf16x8 fh, fl;
#pragma unroll
            for (int j = 0; j < 8; ++j) { const unsigned hb_ = f2bf(v[j]); fh[j] = (short)hb_; fl[j] = (short)f2bf(v[j] - __uint_as_float(hb_ << 16)); }
            if (half == 0) { p0 = __builtin_amdgcn_mfma_f32_32x32x16_bf16(fh, qr[d0], p0, 0, 0, 0); p0 = __builtin_amdgcn_mfma_f32_32x32x16_bf16(fl, qr[d0], p0, 0, 0, 0); }
            else { p1 = __builtin_amdgcn_mfma_f32_32x32x16_bf16(fh, qr[d0], p1, 0, 0, 0); p1 = __builtin_amdgcn_mfma_f32_32x32x16_bf16(fl, qr[d0], p1, 0, 0, 0); } } }
    const float NEG = -__builtin_inff();
    float tv0 = NEG, tv1 = NEG, tv2 = NEG; int ti0 = 1000, ti1 = 1001, ti2 = 1002;
#pragma unroll
    for (int r = 0; r < 16; ++r) { const int n = (r & 3) + 8 * (r >> 2) + 4 * hi; TOP3_INS(n < qb ? p0[r] : NEG, n); }
#pragma unroll
    for (int r = 0; r < 16; ++r) { const int n = 32 + (r & 3) + 8 * (r >> 2) + 4 * hi; TOP3_INS(n < qb ? p1[r] : NEG, n); }
    { const float ov0 = __shfl_xor(tv0, 32), ov1 = __shfl_xor(tv1, 32), ov2 = __shfl_xor(tv2, 32);
      const int oi0 = __shfl_xor(ti0, 32), oi1 = __shfl_xor(ti1, 32), oi2 = __shfl_xor(ti2, 32);
      TOP3_INS(ov0, oi0); TOP3_INS(ov1, oi1); TOP3_INS(ov2, oi2); }
    const bool act = (hi == 0);
    const bool ok0 = act && tv0 > NEG, ok1 = act && tv1 > NEG, ok2 = act && tv2 > NEG;
    unsigned rk0 = 0, rk1 = 0, rk2 = 0;
    if (ok0) rk0 = atomicAdd((unsigned*)(cntL + ti0), 1u);
    if (ok1) rk1 = atomicAdd((unsigned*)(cntL + ti1), 1u);
    if (ok2) rk2 = atomicAdd((unsigned*)(cntL + ti2), 1u);
    if (act) { float* ml = PML + (size_t)((s * 16 + h) * 4) * 2;
        if (!ok0) { ml[0] = -1e30f; ml[1] = 0.f; } if (!ok1) { ml[2] = -1e30f; ml[3] = 0.f; } if (!ok2) { ml[4] = -1e30f; ml[5] = 0.f; } }
    __syncthreads();
    if (tid < 64) { const unsigned n = cntL[tid]; baseL[tid] = n ? atomicAdd(gcnt + h * NBLK + tid, n) : 0u; }
    __syncthreads();
    unsigned* lh = list + (size_t)h * LIST_PER_HEAD;
    if (ok0) lh[list_off(ti0) + baseL[ti0] + rk0] = (unsigned)s | (0u << 16);
    if (ok1) lh[list_off(ti1) + baseL[ti1] + rk1] = (unsigned)s | (1u << 16);
    if (ok2) lh[list_off(ti2) + baseL[ti2] + rk2] = (unsigned)s | (2u << 16);
    __syncthreads();
}
#if PROBE_PHASE == 500
constexpr int CW_FAIL = 8;
__device__ __forceinline__ float blk_reduce(float v, bool domax, float* red, int tid) {
#pragma unroll
    for (int o = 1; o < 64; o <<= 1) { const float y = __shfl_xor(v, o); v = domax ? fmaxf(v, y) : v + y; }
    __syncthreads();
    if ((tid & 63) == 0) red[tid >> 6] = v;
    __syncthreads();
    float r = red[0];
    for (int w = 1; w < 8; ++w) r = domax ? fmaxf(r, red[w]) : r + red[w];
    return r;
}
__device__ __forceinline__ float bfv(const bf16* p) { return __uint_as_float(((unsigned)*p) << 16); }
__device__ __forceinline__ int sample_row(int i) {
    const int fixed[16] = {0, 1, 31, 32, 63, 64, 255, 256, 257, 511, 512, 767, 1023, 8191, 16383, 16128};
    if (i < 16) return fixed[i];
    return (int)(((unsigned)i * 2654435761u) >> 18) & 16383;
}
__device__ __forceinline__ void selfcheck(unsigned char* lds, unsigned char* ws, const int* pos, const bf16* OBc, int G, int bid) {
    const int tid = threadIdx.x;
    float* lg = (float*)lds;
    float* red = (float*)(lds + 65536);
    float* po = (float*)(lds + 65536 + 64);
    float* gate = (float*)(lds + 65536 + 64 + 2048);
    int* sel = (int*)(lds + 65536 + 64 + 2048 + 256);
    gu32* ctl = (gu32*)(ws + WS_CTL);
    bf16* KR = (bf16*)(ws + WS_KR); bf16* QB = (bf16*)(ws + WS_QB); bf16* KB = (bf16*)(ws + WS_KB); bf16* VB = (bf16*)(ws + WS_VB);
    bf16* QM = (bf16*)(ws + WS_QM); bf16* KV = (bf16*)(ws + WS_KV); bf16* OA = (bf16*)(ws + WS_OA); float* BIAS = (float*)(ws + WS_BIAS);
    unsigned nbad = 0;
    for (int u = bid; u < 64 * 16; u += G) { const int s = sample_row(u >> 4), h = u & 15;
        { const bf16* q = QM + (size_t)s * QUP + h * 192; float mx = -1e30f;
          for (int k = tid; k <= s; k += 512) { const bf16* kn = KV + (size_t)k * KVUP + h * 256; const bf16* kr = KR + (size_t)k * 64; float a = 0.f;
              for (int d = 0; d < 128; ++d) a += bfv(q + d) * bfv(kn + d);
              for (int d = 0; d < 64; ++d) a += bfv(q + 128 + d) * bfv(kr + d);
              a *= 0.07216878364870322f; lg[k] = a; mx = fmaxf(mx, a); }
          mx = blk_reduce(mx, true, red, tid);
          float sm = 0.f; for (int k = tid; k <= s; k += 512) { const float p = expf(lg[k] - mx); lg[k] = p; sm += p; }
          sm = blk_reduce(sm, false, red, tid);
          const int d = tid & 127, part = tid >> 7; float o = 0.f;
          for (int k = part; k <= s; k += 4) o += lg[k] * bfv(KV + (size_t)k * KVUP + h * 256 + 128 + d);
          po[part * 128 + d] = o; __syncthreads();
          float amax = 0.f;
          if (tid < 128) { const float ref = (po[tid] + po[128 + tid] + po[256 + tid] + po[384 + tid]) / sm; po[tid] = ref; amax = fabsf(ref); }
          amax = blk_reduce(amax, true, red, tid);
          if (tid < 128) { const float got = bfv(OA + (size_t)s * MLAOUT + h * 128 + tid); if (!(fabsf(got - po[tid]) <= SELFCHECK_REL * amax + SELFCHECK_ABS)) nbad++; }
          __syncthreads(); }
        { const bf16* q = QB + (size_t)s * MOBAW + h * 128; const int qb = s >> 8; const int d = tid & 127, part = tid >> 7;
          for (int n = 0; n < qb; ++n) { float a = 0.f;
              for (int r = part * 64; r < part * 64 + 64; ++r) a += bfv(KB + (size_t)(n * 256 + r) * MOBAW + h * 128 + d);
              a = a * (1.f / 256.f) * bfv(q + d);
              a = blk_reduce(a, false, red, tid);
              if (tid == 0) gate[n] = a; }
          __syncthreads();
          if (tid == 0) { float g0 = -1e30f, g1 = -1e30f, g2 = -1e30f; int i0 = -1, i1 = -1, i2 = -1;
              for (int n = 0; n < qb; ++n) { const float g = gate[n];
                  if (g > g0) { g2 = g1; i2 = i1; g1 = g0; i1 = i0; g0 = g; i0 = n; } else if (g > g1) { g2 = g1; i2 = i1; g1 = g; i1 = n; } else if (g > g2) { g2 = g; i2 = n; } }
              sel[0] = i0; sel[1] = i1; sel[2] = i2; sel[3] = qb; }
          __syncthreads();
          float mx = -1e30f; const int pq = pos[s];
          for (int e = tid; e < 1024; e += 512) { const int j = e >> 8, kk = e & 255; const int blk = sel[j]; float a = -1e30f;
              if (blk >= 0) { const int key = blk * 256 + kk;
                  if (j < 3 || key <= s) { const bf16* kp = KB + (size_t)key * MOBAW + h * 128; float dsum = 0.f;
                      for (int dd = 0; dd < 128; ++dd) dsum += bfv(q + dd) * bfv(kp + dd);
                      int dist = pq - pos[key]; dist = dist < 0 ? 0 : (dist > 128 ? 128 : dist);
                      a = dsum * (0.08838834764831845f * 1.4426950408889634f) + BIAS[h * 132 + dist]; } }
              lg[e] = a; mx = fmaxf(mx, a); }
          mx = blk_reduce(mx, true, red, tid);
          float sm = 0.f; for (int e = tid; e < 1024; e += 512) { const float p = lg[e] > -1e29f ? exp2f(lg[e] - mx) : 0.f; lg[e] = p; sm += p; }
          sm = blk_reduce(sm, false, red, tid);
          float o = 0.f;
          for (int e = part; e < 1024; e += 4) { const int blk = sel[e >> 8]; if (blk >= 0 && lg[e] > 0.f) o += lg[e] * bfv(VB + (size_t)(blk * 256 + (e & 255)) * MOBAW + h * 128 + d); }
          po[part * 128 + d] = o; __syncthreads();
          float amax = 0.f;
          if (tid < 128) { const float ref = (po[tid] + po[128 + tid] + po[256 + tid] + po[384 + tid]) / sm; po[tid] = ref; amax = fabsf(ref); }
          amax = blk_reduce(amax, true, red, tid);
          if (tid < 128) { const float got = bfv(OBc + (size_t)s * MOBAW + h * 128 + tid); if (!(fabsf(got - po[tid]) <= SELFCHECK_REL * amax + SELFCHECK_ABS)) nbad++; }
          __syncthreads(); }
    }
    if (nbad) atomicAdd((unsigned*)(ctl + CW_FAIL), nbad);
}
#endif
struct NoConv { __device__ __forceinline__ void operator()(int, int, unsigned char*) const {} };
struct P7Conv {
    const Args& args; int vcu;
    __device__ __forceinline__ void operator()(int s, int wave, unsigned char* lds) const { int lane_ = lane_id_(); asm volatile("" : "+v"(lane_)); const int lane = lane_;
        unsigned char* ws = args.ws; const int NGW = (int)gridDim.x * NWAVES, gw = vcu * NWAVES + wave;
        LAS unsigned char* T = (LAS unsigned char*)lds + RING_OFF + wave * 8704;
        cvt_job<1>(args.in[16], DM, NFF2, (bf16*)(ws + WS_WFI2), NFF2 / 64, T, gw, NGW, lane, nullptr, NFF2, -1, (const float*)(ws + WS_CPART) + NFF2, 2 * NFF2, (float*)(ws + WS_CMAXF) + NFF2, s, 4);
        cvt_job<0>(args.in[12], MLAOUT, DM, (bf16*)(ws + WS_WBRA), DM / 64, T, gw, NGW, lane, nullptr, FP8_BR ? DM : 0, FP8_BR ? 5 : -1, nullptr, 0, nullptr, (s + 1) & 3, 4);
        cvt_job<0>(args.in[13], MOBAW, DM, (bf16*)(ws + WS_WBRB), DM / 64, T, gw, NGW, lane, nullptr, FP8_BR ? DM : 0, FP8_BR ? 5 : -1, nullptr, 0, nullptr, (s + 2) & 3, 4);
#if I8_OUT
        cvt_job<0>(args.in[14], DM, DM, (bf16*)(ws + WS_WOUT), DM / 64, T, gw, NGW, lane, nullptr, DM, -1, (const float*)(ws + WS_CPARTO), DM, (float*)(ws + WS_CMAXO), (s + 1) & 3, 4); }
#else
        cvt_job<0>(args.in[14], DM, DM, (bf16*)(ws + WS_WOUT), DM / 64, T, gw, NGW, lane, nullptr, FP8_OUT ? DM : 0, FP8_OUT ? 6 : -1, nullptr, 0, nullptr, (s + 1) & 3, 4); }
#endif
};
template <int WHICH, class Conv>
__device__ __forceinline__ void p7_attention(unsigned char* lds, unsigned char* ws, const int* pos, int G, int bid, int wv, Conv conv) {
    int tid_ = wv * 64 + lane_id_(); asm volatile("" : "+v"(tid_)); const int tid = tid_, lane = tid & 63, wave = wv;
    gu32* ctl = (gu32*)(ws + WS_CTL); unsigned* GCNT = (unsigned*)(ctl + CW_GCNT);
    bf16* KR = (bf16*)(ws + WS_KR); bf16* QB = (bf16*)(ws + WS_QB); bf16* KB = (bf16*)(ws + WS_KB); bf16* VB = (bf16*)(ws + WS_VB);
    bf16* QM = (bf16*)(ws + WS_QM); bf16* KV = (bf16*)(ws + WS_KV); bf16* OA = (bf16*)(ws + WS_OA);
    float* BIAS = (float*)(ws + WS_BIAS); int* TPMAX = (int*)(ws + WS_TPMAX);
    unsigned* LIST = (unsigned*)(ws + WS_LIST); float* PML = (float*)(ws + WS_PML); bf16* PO = (bf16*)(ws + WS_PO);
        float* biasL = (float*)(lds + att::L_BIAS); unsigned* pref = (unsigned*)(lds + att::L_PREF); unsigned* wtot = pref + 1028;
        for (int i = tid; i < 16 * 132; i += NWAVES * 64) biasL[i] = BIAS[i];
        unsigned* cntS = (unsigned*)(lds + att::L_CNT);
        { const unsigned ca = __hip_atomic_load(GCNT + 2 * tid, RLX_AGENT), cb = __hip_atomic_load(GCNT + 2 * tid + 1, RLX_AGENT); cntS[2 * tid] = ca; cntS[2 * tid + 1] = cb;
          const unsigned a = (ca + 511u) >> 9, b = (cb + 511u) >> 9;
          unsigned s = a + b;
#pragma unroll
          for (int o_ = 1; o_ < 64; o_ <<= 1) { const unsigned y = __shfl_up(s, o_); if (lane >= o_) s += y; }
          if (lane == 63) wtot[wave] = s;
          __syncthreads();
          unsigned offs = 0; for (int w = 0; w < wave; ++w) offs += wtot[w];
          const unsigned incl = s + offs; pref[2 * tid] = incl - a - b; pref[2 * tid + 1] = incl - b; if (tid == NWAVES * 64 - 1) pref[1024] = incl; }
        __syncthreads();
        const int U = (int)pref[1024];
        int cslot = 0;
        const float c2_mla = 0.07216878364870322f * 1.4426950408889634f;
        const float c2_moba = 0.08838834764831845f * 1.4426950408889634f;
        if constexpr (WHICH & 1) for (int p = bid; p < 512; p += G) { const int h = p & 15, xx = p >> 4;
#pragma unroll 1
            for (int k = 0; k < 2; ++k) { const int qb = k ? xx : 63 - xx;
                att::UnitArgs A; A.Q = QM + h * 192; A.qpitch = QUP; A.K = KV + h * 256; A.kpitch = KVUP; A.Kr = KR; A.Q8 = ws + WS_QM8 + h * 192; A.K8 = ws + WS_KN8 + h * 128; A.Kr8 = ws + WS_KR8; A.V8 = ws + WS_V8 + (size_t)h * 256 * 8192; A.V = KV + h * 256 + 128; A.vpitch = KVUP;
                A.O = OA + h * 128; A.opitch = MLAOUT; A.PO = nullptr; A.PML = nullptr; A.pos = pos; A.tpmax = TPMAX; A.list = nullptr; A.nrows = 256;
                A.q0 = qb * 256; A.k0 = 0; A.NT = 4 * (qb + 1); A.h = h; A.c2 = c2_mla;
                att::attn_unit<192, 0>(A, (char*)lds, wv);
                if (cslot < 4) { conv(cslot++, wv, lds); __syncthreads(); } } }
        if constexpr (WHICH & 1) while (cslot < 4) { conv(cslot++, wv, lds); __syncthreads(); }
        if constexpr (WHICH & 2) for (int u = bid; u < U; u += G) {
            int lo = 0, hi_ = 1024;
            while (hi_ - lo > 1) { const int mid = (lo + hi_) >> 1; if (pref[mid] <= (unsigned)u) lo = mid; else hi_ = mid; }
            const int h = lo >> 6, kb = lo & 63, c = u - (int)pref[lo];
            const int cnt = (int)cntS[lo];
            att::UnitArgs A; A.Q = QB + h * 128; A.qpitch = MOBAW; A.K = KB + h * 128; A.kpitch = MOBAW; A.Kr = nullptr; A.Q8 = ws + WS_QB8 + h * 128; A.K8 = ws + WS_KB8 + h * 128; A.Kr8 = nullptr; A.V8 = ws + WS_VB8 + (size_t)h * 256 * 8192; A.V = VB + h * 128; A.vpitch = MOBAW;
            A.O = nullptr; A.opitch = 0; A.PO = PO; A.PML = PML; A.pos = pos; A.tpmax = TPMAX;
            A.list = LIST + (size_t)h * LIST_PER_HEAD + list_off(kb) + c * 512; A.nrows = min(512, cnt - c * 512);
            A.q0 = 0; A.k0 = kb * 256; A.NT = 4; A.h = h; A.c2 = c2_moba;
            att::moba_unit<1>(A, (char*)lds, wv, (A.nrows + 255) >> 8); }
        if constexpr (WHICH & 4) for (int u = bid; u < NBLK * NH; u += G) { const int h = u & 15, qb = u >> 4;
            att::UnitArgs A; A.Q = QB + h * 128; A.qpitch = MOBAW; A.K = KB + h * 128; A.kpitch = MOBAW; A.Kr = nullptr; A.Q8 = ws + WS_QB8 + h * 128; A.K8 = ws + WS_KB8 + h * 128; A.Kr8 = nullptr; A.V8 = ws + WS_VB8 + (size_t)h * 256 * 8192; A.V = VB + h * 128; A.vpitch = MOBAW;
            A.O = nullptr; A.opitch = 0; A.PO = PO; A.PML = PML; A.pos = pos; A.tpmax = TPMAX; A.list = nullptr; A.nrows = 256;
            A.q0 = qb * 256; A.k0 = qb * 256; A.NT = 4; A.h = h; A.c2 = c2_moba;
            att::moba_unit<2>(A, (char*)lds, wv, 1); }
}
__global__ void __launch_bounds__(NWAVES * 64, 2) hybrid_fwd(Args args) {
    extern __shared__ __attribute__((aligned(16))) unsigned char lds[];
    LAS unsigned char* ldsl = (LAS unsigned char*)lds;
    volatile LAS unsigned* MISC = (volatile LAS unsigned*)(ldsl + MISC_OFF);
    const int tid = threadIdx.x, lane = tid & 63, wave = __builtin_amdgcn_readfirstlane(tid >> 6);
    const int G = gridDim.x, bid = blockIdx.x;
    const int vcu = (G % 8 == 0) ? (bid % 8) * (G / 8) + bid / 8 : bid;
    const int gw = vcu * NWAVES + wave, NGW = G * NWAVES;
    unsigned char* ws = args.ws;
    gu32* ctl = (gu32*)(ws + WS_CTL);
    for (int u = tid; u < (LDS_BYTES - LDSCTL_OFF) / 4; u += NWAVES * 64) ((LAS unsigned*)(ldsl + LDSCTL_OFF))[u] = 0u;
    __syncthreads();
    XcdBarrier bar = xcd_barrier_post((unsigned*)(ctl + CW_BAR), MISC + 8, wave);
#if PROBE_PHASE == 99
#define GRID_BAR() do { xcd_barrier(bar, wave); xcd_barrier(bar, wave); } while (0)
#else
#define GRID_BAR() xcd_barrier(bar, wave)
#endif
    const float* x = args.in[0]; const int* pos = (const int*)args.in[1]; const float* rel_bias = args.in[2];
    float* out = args.out;
    bf16* WFI = (bf16*)(ws + WS_WFFN_IN); bf16* WFO = (bf16*)(ws + WS_WFFN_OUT); bf16* WIN = (bf16*)(ws + WS_WIN); bf16* WUQ = (bf16*)(ws + WS_WUQ);
    bf16* WUKV = (bf16*)(ws + WS_WUKV); bf16* WBRA = (bf16*)(ws + WS_WBRA); bf16* WBRB = (bf16*)(ws + WS_WBRB); bf16* WOUT = (bf16*)(ws + WS_WOUT);
    bf16* H = (bf16*)(ws + WS_H); bf16* ACT = (bf16*)(ws + WS_BIG);
    bf16* CQ = (bf16*)(ws + WS_CQ); bf16* CKV = (bf16*)(ws + WS_CKV); bf16* KR = (bf16*)(ws + WS_KR); bf16* QB = (bf16*)(ws + WS_QB); bf16* KB = (bf16*)(ws + WS_KB);
    bf16* VB = (bf16*)(ws + WS_VB); bf16* GA = (bf16*)(ws + WS_GA); bf16* GB = (bf16*)(ws + WS_GB);
    bf16* QM = (bf16*)(ws + WS_QM); bf16* KV = (bf16*)(ws + WS_KV); bf16* OA = (bf16*)(ws + WS_OA);
    float* COS = (float*)(ws + WS_COS); float* SIN = (float*)(ws + WS_SIN);
    bf16* KMH = (bf16*)(ws + WS_KMH); bf16* KML = (bf16*)(ws + WS_KML); float* BIAS = (float*)(ws + WS_BIAS); int* TPMAX = (int*)(ws + WS_TPMAX);
    unsigned* LIST = (unsigned*)(ws + WS_LIST); float* PML = (float*)(ws + WS_PML); bf16* PO = (bf16*)(ws + WS_PO);
    unsigned* GCNT = (unsigned*)(ctl + CW_GCNT);
    float* PART = (float*)(ws + WS_PART); float* RSTD = (float*)(ws + WS_RSTD); float* PARTQ = (float*)(ws + WS_PARTQ); float* PARTKV = (float*)(ws + WS_PARTKV);
    float* RSTDQ = (float*)(ws + WS_RSTDQ); float* RSTDKV = (float*)(ws + WS_RSTDKV); bf16* H3 = GB; (void)RSTDQ; (void)RSTDKV;
    float* CPART = (float*)(ws + WS_CPART); float* CMAXF = (float*)(ws + WS_CMAXF); const float* CMAX1 = CMAXF; const float* CMAX2 = CMAXF + NFF2; float* PMAX = (float*)(ws + WS_PMAX);
    unsigned char* H8 = ws + WS_H8; unsigned char* OA8 = ws + WS_OA8; unsigned char* OB8 = ws + WS_OB8; unsigned char* MG8 = ws + WS_MG8; unsigned char* WIN8 = ws + WS_WIN8;
#if PROBE_PHASE == 500
    bf16* OBC = (bf16*)(ws + ((WS_END + 4095) / 4096) * 4096);
#else
    bf16* OBC = QB;
#endif
    LAS unsigned char* cvtT = ldsl + RING_OFF + wave * 8704;

    { int tid_f = wave * 64 + lane_id_(); asm volatile("" : "+v"(tid_f)); const int tid = tid_f, lane = tid & 63; (void)lane; (void)tid;
    {
    colmax_job(args.in[4], DM, NFF2, CPART, 2 * NFF2, gw, NGW, lane); colmax_job(args.in[16], DM, NFF2, CPART + NFF2, 2 * NFF2, gw, NGW, lane);
#if I8_OUT
    colmax_job(args.in[14], DM, DM, (float*)(ws + WS_CPARTO), DM, gw, NGW, lane);
#endif
    cvt_job<2>(args.in[7], DM, INCOLS, WIN, INPAD1 / 64, cvtT, gw, NGW, lane, nullptr, INPAD1);
    cvt_job<4>(args.in[7], DM, INCOLS, (bf16*)WIN8, IN2 / 64, cvtT, gw, NGW, lane, nullptr, IN2, 6);
    cvt_job<3>(args.in[9], QLORA, QUP, WUQ, QUP / 64, cvtT, gw, NGW, lane, args.in[8]);
    cvt_job<0>(args.in[11], KVLORA, KVUP, WUKV, KVUP / 64, cvtT, gw, NGW, lane, args.in[10]);
    for (int idx = vcu * (NWAVES * 64) + tid; idx < M_ * 32; idx += G * NWAVES * 64) { const int s = idx >> 5, i = idx & 31;
        float sn, cs; sincos_d((double)pos[s] * args.invf[i], sn, cs); COS[idx] = cs; SIN[idx] = sn; }
    for (int idx = vcu * (NWAVES * 64) + tid; idx < 16 * 132; idx += G * NWAVES * 64) { const int h = idx / 132, d = idx - h * 132;
        BIAS[idx] = d <= 128 ? rel_bias[(int)args.bucket[d] * NH + h] * 1.4426950408889634f : 0.f; }
    for (int t = gw; t < 256; t += NGW) { int p = pos[t * 64 + lane];
#pragma unroll
        for (int o_ = 1; o_ < 64; o_ <<= 1) p = max(p, __shfl_xor(p, o_));
        if (lane == 0) TPMAX[t] = p; }
    for (int m = gw; m < M_; m += NGW) rms_row4096_i8(x + (size_t)m * DM, args.in[3], H8, m, RSTD, lane);
    }
#if PROBE_PHASE == 0
    {
    colmax_job(args.in[4], DM, NFF2, CPART, 2 * NFF2, gw, NGW, lane); colmax_job(args.in[16], DM, NFF2, CPART + NFF2, 2 * NFF2, gw, NGW, lane);
#if I8_OUT
    colmax_job(args.in[14], DM, DM, (float*)(ws + WS_CPARTO), DM, gw, NGW, lane);
#endif
    cvt_job<2>(args.in[7], DM, INCOLS, WIN, INPAD1 / 64, cvtT, gw, NGW, lane, nullptr, INPAD1);
    cvt_job<4>(args.in[7], DM, INCOLS, (bf16*)WIN8, IN2 / 64, cvtT, gw, NGW, lane, nullptr, IN2, 6);
    cvt_job<3>(args.in[9], QLORA, QUP, WUQ, QUP / 64, cvtT, gw, NGW, lane, args.in[8]);
    cvt_job<0>(args.in[11], KVLORA, KVUP, WUKV, KVUP / 64, cvtT, gw, NGW, lane, args.in[10]);
    for (int idx = vcu * (NWAVES * 64) + tid; idx < M_ * 32; idx += G * NWAVES * 64) { const int s = idx >> 5, i = idx & 31;
        float sn, cs; sincos_d((double)pos[s] * args.invf[i], sn, cs); COS[idx] = cs; SIN[idx] = sn; }
    for (int idx = vcu * (NWAVES * 64) + tid; idx < 16 * 132; idx += G * NWAVES * 64) { const int h = idx / 132, d = idx - h * 132;
        BIAS[idx] = d <= 128 ? rel_bias[(int)args.bucket[d] * NH + h] * 1.4426950408889634f : 0.f; }
    for (int t = gw; t < 256; t += NGW) { int p = pos[t * 64 + lane];
#pragma unroll
        for (int o_ = 1; o_ < 64; o_ <<= 1) p = max(p, __shfl_xor(p, o_));
        if (lane == 0) TPMAX[t] = p; }
    for (int m = gw; m < M_; m += NGW) rms_row4096_i8(x + (size_t)m * DM, args.in[3], H8, m, RSTD, lane);
    }
#endif
    }
    GRID_BAR();
#if PROBE_PHASE == 300
    {
        const bf16x8 fa = *(const GAS bf16x8*)(H + (size_t)(bid * 512 + tid) * 8), fb = *(const GAS bf16x8*)(H + (size_t)(bid * 512 + tid) * 8 + 65536);
        f32x4 ac[8];
#pragma unroll
        for (int i = 0; i < 8; ++i) ac[i] = (f32x4){0.f, 0.f, 0.f, 0.f};
#pragma unroll 1
        for (int it = 0; it < 5120; ++it) {
#pragma unroll
            for (int i = 0; i < 8; ++i) ac[i] = __builtin_amdgcn_mfma_f32_16x16x32_bf16(fa, fb, ac[i], 0, 0, 0); }
        float sacc = 0.f;
#pragma unroll
        for (int i = 0; i < 8; ++i) sacc += ac[i][0] + ac[i][1] + ac[i][2] + ac[i][3];
        if (sacc == 12345.678f) out[0] = 1.f;
    }
#endif
    { int tid_f = wave * 64 + lane_id_(); asm volatile("" : "+v"(tid_f)); const int lane = tid_f & 63;
      cvt_job<1>(args.in[4], DM, NFF2, WFI, NFF2 / 64, cvtT, gw, NGW, lane, nullptr, NFF2, -1, CPART, 2 * NFF2, CMAXF); }
    GRID_BAR();
    { pg8::Gemm g{(const bf16*)H8, WFI, M_, NFF2, DM / 2}; pg8::StaticOrder S; S.init(M_, NFF2, G, bid); pg8::EpiSwiglu E{ACT, DFF, RSTD, M_, CMAX1};
      pg8::gemm_phase<pg8::EpiSwiglu, pg8::StaticOrder, true, true, true, false, true>(ldsl + RING_OFF, g, S, E, wave); }
#if PROBE_PHASE == 1
    { pg8::Gemm g{(const bf16*)H8, WFI, M_, NFF2, DM / 2}; pg8::StaticOrder S; S.init(M_, NFF2, G, bid); pg8::EpiSwiglu E{ACT, DFF, RSTD, M_, CMAX1};
      pg8::gemm_phase<pg8::EpiSwiglu, pg8::StaticOrder, true, true, true, false, true>(ldsl + RING_OFF, g, S, E, wave); }
#endif
    if (G == 256 && bid >= 128) { int tid_f = wave * 64 + lane_id_(); asm volatile("" : "+v"(tid_f)); const int lane = tid_f & 63;
        cvt_job<0>(args.in[5], DFF, DM, WFO, DM / 64, cvtT, (bid - 128) * NWAVES + wave, 128 * NWAVES, lane, nullptr, DM); }
    else if (G != 256) { int tid_f = wave * 64 + lane_id_(); asm volatile("" : "+v"(tid_f)); const int lane = tid_f & 63; cvt_job<0>(args.in[5], DFF, DM, WFO, DM / 64, cvtT, gw, NGW, lane, nullptr, DM); }
    GRID_BAR();
    { pg8::Gemm g{ACT, WFO, M_, DM, DFF}; pg8::StaticOrder S; S.init(M_, DM, G, bid); pg8::EpiResidNorm<(long)WS_H8 - (long)WS_H> E{x, out, 0.5f, H, args.in[6], PART, nullptr};
      pg8::gemm_phase<pg8::EpiResidNorm<(long)WS_H8 - (long)WS_H>, pg8::StaticOrder, true, true, true>(ldsl + RING_OFF, g, S, E, wave); }
#if PROBE_PHASE == 2
    { pg8::Gemm g{ACT, WFO, M_, DM, DFF}; pg8::StaticOrder S; S.init(M_, DM, G, bid); pg8::EpiResidNorm<(long)WS_H8 - (long)WS_H> E{x, out, 0.5f, H, args.in[6], PART, nullptr};
      pg8::gemm_phase<pg8::EpiResidNorm<(long)WS_H8 - (long)WS_H>, pg8::StaticOrder, true, true, true>(ldsl + RING_OFF, g, S, E, wave); }
#endif
#if PROBE_PHASE == 801 || PROBE_PHASE == 802
    GRID_BAR();
    { pg8::Gemm g{ACT, WFO, PROBE_PHASE == 801 ? M_ : 0, PROBE_PHASE == 801 ? DM : 0, DFF}; pg8::StaticOrder S; S.init(M_, DM, G, bid); pg8::EpiNull E{};
      pg8::gemm_phase<pg8::EpiNull, pg8::StaticOrder, true, true, true>(ldsl + RING_OFF, g, S, E, wave); }
#endif
#if PROBE_PHASE == 803 || PROBE_PHASE == 804
    GRID_BAR();
    { pg8::Gemm g{(const bf16*)H8, WFI, PROBE_PHASE == 803 ? M_ : 0, PROBE_PHASE == 803 ? NFF2 : 0, DM / 2}; pg8::StaticOrder S; S.init(M_, NFF2, G, bid); pg8::EpiNull E{};
      pg8::gemm_phase<pg8::EpiNull, pg8::StaticOrder, true, true, true, false, true>(ldsl + RING_OFF, g, S, E, wave); }
#endif
    GRID_BAR();
    { int tid_f = wave * 64 + lane_id_(); asm volatile("" : "+v"(tid_f)); const int tid = tid_f, lane = tid & 63; (void)lane; (void)tid;
    rstd_reduce<64>(PART, RSTD, 1.f / DM, vcu, tid, G);
#if PROBE_PHASE == 3 || PROBE_PHASE == 38
    rstd_reduce<64>(PART, RSTD, 1.f / DM, vcu, tid, G);
#endif
    }
    GRID_BAR();
    { pg8::Gemm g{H, WIN, M_, INPAD1, DM}; pg8::StaticOrder S; S.init(M_, INPAD1, G, bid);
      pg8::EpiProj<1> E{CQ, CKV, KR, QB, KB, VB, GA, GB, COS, SIN, RSTD, PARTQ, PARTKV, (float*)(ctl + CW_KMEAN), ws + WS_KR8, ws + WS_QB8, ws + WS_KB8, ws + WS_VB8, 1.0f};
      pg8::gemm_phase<pg8::EpiProj<1>, pg8::StaticOrder, true, true, true>(ldsl + RING_OFF, g, S, E, wave); }
    { pg8::Gemm g{(const bf16*)H8, (const bf16*)WIN8, M_, IN2, DM / 2}; pg8::StaticOrder S; S.init(M_, IN2, G, bid);
      pg8::EpiProj<2> E{CQ, CKV, KR, QB, KB, VB, GA, GB, COS, SIN, RSTD, PARTQ, PARTKV, (float*)(ctl + CW_KMEAN), ws + WS_KR8, ws + WS_QB8, ws + WS_KB8, ws + WS_VB8, 0.015625f};
      pg8::gemm_phase<pg8::EpiProj<2>, pg8::StaticOrder, true, true, true, true>(ldsl + RING_OFF, g, S, E, wave); }
    GRID_BAR();
    { LAS unsigned* cntL = (LAS unsigned*)(ldsl + RING_OFF); LAS unsigned* baseL = cntL + 64;
      for (int u = bid; u < NBLK * NH; u += G) moba_gate_unit(u & 15, u >> 4, QB, (const float*)(ctl + CW_KMEAN), GCNT, LIST, PML, cntL, baseL, wave); }
    { pg8::Gemm g{CQ, WUQ, M_, QUP, QLORA}; pg8::StaticOrder S; S.init(M_, QUP, G, bid); pg8::EpiQ E{MLA_BF16 ? QM : nullptr, COS, SIN, PARTQ, ws + WS_QM8};
      pg8::gemm_phase<pg8::EpiQ, pg8::StaticOrder, true, true>(ldsl + RING_OFF, g, S, E, wave); }
    { pg8::Gemm g{CKV, WUKV, M_, KVUP, KVLORA}; pg8::StaticOrder S; S.init(M_, KVUP, G, bid); pg8::EpiPlain E{MLA_BF16 ? KV : nullptr, KVUP, PARTKV, ws + WS_KN8, ws + WS_V8};
      pg8::gemm_phase<pg8::EpiPlain, pg8::StaticOrder, true, true>(ldsl + RING_OFF, g, S, E, wave); }
#if PROBE_PHASE == 6
    { pg8::Gemm g{CQ, WUQ, M_, QUP, QLORA}; pg8::StaticOrder S; S.init(M_, QUP, G, bid); pg8::EpiQ E{MLA_BF16 ? QM : nullptr, COS, SIN, PARTQ, ws + WS_QM8};
      pg8::gemm_phase<pg8::EpiQ, pg8::StaticOrder, true, true>(ldsl + RING_OFF, g, S, E, wave); }
    { pg8::Gemm g{CKV, WUKV, M_, KVUP, KVLORA}; pg8::StaticOrder S; S.init(M_, KVUP, G, bid); pg8::EpiPlain E{MLA_BF16 ? KV : nullptr, KVUP, PARTKV, ws + WS_KN8, ws + WS_V8};
      pg8::gemm_phase<pg8::EpiPlain, pg8::StaticOrder, true, true>(ldsl + RING_OFF, g, S, E, wave); }
#endif
    GRID_BAR();
#if I8_FFN2
    p7_attention<7>(lds, ws, pos, G, bid, wave, P7Conv{args, vcu});
#else
    p7_attention<7>(lds, ws, pos, G, bid, wave, NoConv{});
#endif
#if PROBE_PHASE == 7
    p7_attention<7>(lds, ws, pos, G, bid, wave, NoConv{});
#endif
#if PROBE_PHASE == 71
    p7_attention<1>(lds, ws, pos, G, bid, wave, NoConv{});
#endif
#if PROBE_PHASE == 72
    p7_attention<2>(lds, ws, pos, G, bid, wave, NoConv{});
#endif
#if PROBE_PHASE == 74
    p7_attention<4>(lds, ws, pos, G, bid, wave, NoConv{});
#endif
    GRID_BAR();
    { int tid_f = wave * 64 + lane_id_(); asm volatile("" : "+v"(tid_f)); const int tid = tid_f, lane = tid & 63; (void)lane; (void)tid;
    for (int it = gw; it < M_ * NH / 4; it += NGW) { const int pair = it * 4 + (lane >> 4), c8 = lane & 15;
        const f32x4 ml0 = *(const GAS f32x4*)(PML + (size_t)pair * 8), ml1 = *(const GAS f32x4*)(PML + (size_t)pair * 8 + 4);
        const float m[4] = {ml0.x, ml0.z, ml1.x, ml1.z}, l[4] = {ml0.y, ml0.w, ml1.y, ml1.w};
        float mx = -1e30f;
#pragma unroll
        for (int j = 0; j < 4; ++j) if (l[j] > 0.f) mx = fmaxf(mx, m[j]);
        float w[4], wsum = 0.f;
#pragma unroll
        for (int j = 0; j < 4; ++j) { w[j] = l[j] > 0.f ? __builtin_amdgcn_exp2f(m[j] - mx) * l[j] : 0.f; wsum += w[j]; }
        const float inv = 1.0f / wsum; float acc[8] = {0.f, 0.f, 0.f, 0.f, 0.f, 0.f, 0.f, 0.f};
#pragma unroll
        for (int j = 0; j < 4; ++j) { const v4u o = *(const GAS v4u*)(PO + ((size_t)pair * 4 + j) * 128 + c8 * 8); const float wj = w[j] * inv;
            if (w[j] > 0.f) {
#pragma unroll
                for (int e = 0; e < 4; ++e) { acc[2 * e] += wj * bfu_lo(o[e]); acc[2 * e + 1] += wj * bfu_hi(o[e]); } } }
        const int row = pair >> 4, h = pair & 15; v4u r; r.x = pk2(acc[0], acc[1]); r.y = pk2(acc[2], acc[3]); r.z = pk2(acc[4], acc[5]); r.w = pk2(acc[6], acc[7]);
        *(GAS v4u*)(OBC + (size_t)row * MOBAW + h * 128 + c8 * 8) = r;
        { int w0 = 0, w1 = 0;
          w0 = __builtin_amdgcn_cvt_pk_fp8_f32(acc[0] * 16.f, acc[1] * 16.f, w0, false); w0 = __builtin_amdgcn_cvt_pk_fp8_f32(acc[2] * 16.f, acc[3] * 16.f, w0, true);
          w1 = __builtin_amdgcn_cvt_pk_fp8_f32(acc[4] * 16.f, acc[5] * 16.f, w1, false); w1 = __builtin_amdgcn_cvt_pk_fp8_f32(acc[6] * 16.f, acc[7] * 16.f, w1, true);
          v2u q; q.x = (unsigned)w0; q.y = (unsigned)w1; *(GAS v2u*)(OB8 + ((size_t)h * M_ + row) * 128 + c8 * 8) = q; } }
    for (int it = gw * 64 + lane; it < M_ * MLAOUT / 8; it += NGW * 64) { const int row = it >> 8, c8 = it & 255;
        const v4u o = *(const GAS v4u*)(OA + (size_t)row * MLAOUT + c8 * 8); int w0 = 0, w1 = 0;
        w0 = __builtin_amdgcn_cvt_pk_fp8_f32(bfu_lo(o.x) * 16.f, bfu_hi(o.x) * 16.f, w0, false); w0 = __builtin_amdgcn_cvt_pk_fp8_f32(bfu_lo(o.y) * 16.f, bfu_hi(o.y) * 16.f, w0, true);
        w1 = __builtin_amdgcn_cvt_pk_fp8_f32(bfu_lo(o.z) * 16.f, bfu_hi(o.z) * 16.f, w1, false); w1 = __builtin_amdgcn_cvt_pk_fp8_f32(bfu_lo(o.w) * 16.f, bfu_hi(o.w) * 16.f, w1, true);
        v2u q; q.x = (unsigned)w0; q.y = (unsigned)w1; *(GAS v2u*)(OA8 + ((size_t)(c8 >> 4) * M_ + row) * 128 + (c8 & 15) * 8) = q; }
#if PROBE_PHASE == 8 || PROBE_PHASE == 38
    for (int it = gw; it < M_ * NH / 4; it += NGW) { const int pair = it * 4 + (lane >> 4), c8 = lane & 15;
        const f32x4 ml0 = *(const GAS f32x4*)(PML + (size_t)pair * 8), ml1 = *(const GAS f32x4*)(PML + (size_t)pair * 8 + 4);
        const float m[4] = {ml0.x, ml0.z, ml1.x, ml1.z}, l[4] = {ml0.y, ml0.w, ml1.y, ml1.w};
        float mx = -1e30f;
#pragma unroll
        for (int j = 0; j < 4; ++j) if (l[j] > 0.f) mx = fmaxf(mx, m[j]);
        float w[4], wsum = 0.f;
#pragma unroll
        for (int j = 0; j < 4; ++j) { w[j] = l[j] > 0.f ? __builtin_amdgcn_exp2f(m[j] - mx) * l[j] : 0.f; wsum += w[j]; }
        const float inv = 1.0f / wsum; float acc[8] = {0.f, 0.f, 0.f, 0.f, 0.f, 0.f, 0.f, 0.f};
#pragma unroll
        for (int j = 0; j < 4; ++j) { const v4u o = *(const GAS v4u*)(PO + ((size_t)pair * 4 + j) * 128 + c8 * 8); const float wj = w[j] * inv;
            if (w[j] > 0.f) {
#pragma unroll
                for (int e = 0; e < 4; ++e) { acc[2 * e] += wj * bfu_lo(o[e]); acc[2 * e + 1] += wj * bfu_hi(o[e]); } } }
        const int row = pair >> 4, h = pair & 15; v4u r; r.x = pk2(acc[0], acc[1]); r.y = pk2(acc[2], acc[3]); r.z = pk2(acc[4], acc[5]); r.w = pk2(acc[6], acc[7]);
        *(GAS v4u*)(OBC + (size_t)row * MOBAW + h * 128 + c8 * 8) = r;
        { int w0 = 0, w1 = 0;
          w0 = __builtin_amdgcn_cvt_pk_fp8_f32(acc[0] * 16.f, acc[1] * 16.f, w0, false); w0 = __builtin_amdgcn_cvt_pk_fp8_f32(acc[2] * 16.f, acc[3] * 16.f, w0, true);
          w1 = __builtin_amdgcn_cvt_pk_fp8_f32(acc[4] * 16.f, acc[5] * 16.f, w1, false); w1 = __builtin_amdgcn_cvt_pk_fp8_f32(acc[6] * 16.f, acc[7] * 16.f, w1, true);
          v2u q; q.x = (unsigned)w0; q.y = (unsigned)w1; *(GAS v2u*)(OB8 + ((size_t)h * M_ + row) * 128 + c8 * 8) = q; } }
    for (int it = gw * 64 + lane; it < M_ * MLAOUT / 8; it += NGW * 64) { const int row = it >> 8, c8 = it & 255;
        const v4u o = *(const GAS v4u*)(OA + (size_t)row * MLAOUT + c8 * 8); int w0 = 0, w1 = 0;
        w0 = __builtin_amdgcn_cvt_pk_fp8_f32(bfu_lo(o.x) * 16.f, bfu_hi(o.x) * 16.f, w0, false); w0 = __builtin_amdgcn_cvt_pk_fp8_f32(bfu_lo(o.y) * 16.f, bfu_hi(o.y) * 16.f, w0, true);
        w1 = __builtin_amdgcn_cvt_pk_fp8_f32(bfu_lo(o.z) * 16.f, bfu_hi(o.z) * 16.f, w1, false); w1 = __builtin_amdgcn_cvt_pk_fp8_f32(bfu_lo(o.w) * 16.f, bfu_hi(o.w) * 16.f, w1, true);
        v2u q; q.x = (unsigned)w0; q.y = (unsigned)w1; *(GAS v2u*)(OA8 + ((size_t)(c8 >> 4) * M_ + row) * 128 + (c8 & 15) * 8) = q; }
#endif
    }
    GRID_BAR();
#if PROBE_PHASE == 500
    selfcheck(lds, ws, pos, OBC, G, bid);
    GRID_BAR();
#endif
#if FP8_BR
    { pg8::Gemm g{(const bf16*)OA8, WBRA, M_, DM, MLAOUT / 2}; pg8::StaticOrder S; S.init(M_, DM, G, bid); pg8::EpiMerge<false> E{GA, H, nullptr, 0.001953125f};
      pg8::gemm_phase<pg8::EpiMerge<false>, pg8::StaticOrder, true, true, true, true>(ldsl + RING_OFF, g, S, E, wave); }
    { pg8::Gemm g{(const bf16*)OB8, WBRB, M_, DM, MOBAW / 2}; pg8::StaticOrder S; S.init(M_, DM, G, bid); pg8::EpiMerge<true> E{GB, H, FP8_OUT ? MG8 : nullptr, 0.001953125f};
      pg8::gemm_phase<pg8::EpiMerge<true>, pg8::StaticOrder, true, true, true, true>(ldsl + RING_OFF, g, S, E, wave); }
#else
    { pg8::Gemm g{OA, WBRA, M_, DM, MLAOUT}; pg8::StaticOrder S; S.init(M_, DM, G, bid); pg8::EpiMerge<false> E{GA, H, nullptr, 1.0f};
      pg8::gemm_phase<pg8::EpiMerge<false>, pg8::StaticOrder, true, true>(ldsl + RING_OFF, g, S, E, wave); }
    { pg8::Gemm g{OBC, WBRB, M_, DM, MOBAW}; pg8::StaticOrder S; S.init(M_, DM, G, bid); pg8::EpiMerge<true> E{GB, H, FP8_OUT ? MG8 : nullptr, 1.0f};
      pg8::gemm_phase<pg8::EpiMerge<true>, pg8::StaticOrder, true, true>(ldsl + RING_OFF, g, S, E, wave); }
#endif
    GRID_BAR();
#if I8_OUT
    { int tid_f = wave * 64 + lane_id_(); asm volatile("" : "+v"(tid_f)); const int lane = tid_f & 63;
      for (int m = gw; m < M_; m += NGW) quant_row_plain_i8(H, MG8, m, (float*)(ws + WS_RSM), lane); }
    GRID_BAR();
#endif
#if I8_OUT
    { pg8::Gemm g{(const bf16*)MG8, WOUT, M_, DM, DM / 2}; pg8::StaticOrder S; S.init(M_, DM, G, bid);
      pg8::EpiResidNorm<0, true> E{out, out, 1.0f, H3, args.in[15], PART, PMAX, (const float*)(ws + WS_RSM), (const float*)(ws + WS_CMAXO)};
      pg8::gemm_phase<pg8::EpiResidNorm<0, true>, pg8::StaticOrder, true, true, true, false, true>(ldsl + RING_OFF, g, S, E, wave); }
#elif FP8_OUT
    { pg8::Gemm g{(const bf16*)MG8, WOUT, M_, DM, DM / 2}; pg8::StaticOrder S; S.init(M_, DM, G, bid); pg8::EpiResidNorm<0> E{out, out, 0.0009765625f, H3, args.in[15], PART, PMAX};
      pg8::gemm_phase<pg8::EpiResidNorm<0>, pg8::StaticOrder, true, true, true, true>(ldsl + RING_OFF, g, S, E, wave); }
#else
    { pg8::Gemm g{H, WOUT, M_, DM, DM}; pg8::StaticOrder S; S.init(M_, DM, G, bid); pg8::EpiResidNorm<0> E{out, out, 1.0f, H3, args.in[15], PART, PMAX};
      pg8::gemm_phase<pg8::EpiResidNorm<0>, pg8::StaticOrder, true, true>(ldsl + RING_OFF, g, S, E, wave); }
#endif
    GRID_BAR();
    { int tid_f = wave * 64 + lane_id_(); asm volatile("" : "+v"(tid_f)); const int tid = tid_f, lane = tid & 63; (void)lane; (void)tid;
#if !I8_FFN2
    cvt_job<1>(args.in[16], DM, NFF2, WFI, NFF2 / 64, cvtT, gw, NGW, lane, nullptr, NFF2);
#endif
#if I8_FFN2
    for (int m = gw; m < M_; m += NGW) quant_row_i8(H3, PART, PMAX, H8, m, RSTD, lane);
#else
    rstd_reduce<64>(PART, RSTD, 1.f / DM, vcu, tid, G);
#endif
#if PROBE_PHASE == 11
#if !I8_FFN2
    cvt_job<1>(args.in[16], DM, NFF2, WFI, NFF2 / 64, cvtT, gw, NGW, lane, nullptr, NFF2);
#endif
#if I8_FFN2
    for (int m = gw; m < M_; m += NGW) quant_row_i8(H3, PART, PMAX, H8, m, RSTD, lane);
#else
    rstd_reduce<64>(PART, RSTD, 1.f / DM, vcu, tid, G);
#endif
#endif
    }
    GRID_BAR();
#if I8_FFN2
    { pg8::Gemm g{(const bf16*)H8, (const bf16*)(ws + WS_WFI2), M_, NFF2, DM / 2}; pg8::StaticOrder S; S.init(M_, NFF2, G, bid); pg8::EpiSwiglu E{ACT, DFF, RSTD, M_, CMAX2};
      pg8::gemm_phase<pg8::EpiSwiglu, pg8::StaticOrder, true, true, true, false, true>(ldsl + RING_OFF, g, S, E, wave); }
#else
    { pg8::Gemm g{H3, WFI, M_, NFF2, DM}; pg8::StaticOrder S; S.init(M_, NFF2, G, bid); pg8::EpiSwiglu E{ACT, DFF, RSTD, M_, nullptr};
      pg8::gemm_phase<pg8::EpiSwiglu, pg8::StaticOrder, true, true, true>(ldsl + RING_OFF, g, S, E, wave); }
#endif
    if (G == 256 && bid >= 128) { int tid_f = wave * 64 + lane_id_(); asm volatile("" : "+v"(tid_f)); const int lane = tid_f & 63;
        cvt_job<0>(args.in[17], DFF, DM, WFO, DM / 64, cvtT, (bid - 128) * NWAVES + wave, 128 * NWAVES, lane, nullptr, DM); }
    else if (G != 256) { int tid_f = wave * 64 + lane_id_(); asm volatile("" : "+v"(tid_f)); const int lane = tid_f & 63; cvt_job<0>(args.in[17], DFF, DM, WFO, DM / 64, cvtT, gw, NGW, lane, nullptr, DM); }
    GRID_BAR();
    { pg8::Gemm g{ACT, WFO, M_, DM, DFF}; pg8::StaticOrder S; S.init(M_, DM, G, bid); pg8::EpiResid E{out, out, DM, 0.5f};
      pg8::gemm_phase<pg8::EpiResid, pg8::StaticOrder, true, true, true>(ldsl + RING_OFF, g, S, E, wave); }
    GRID_BAR();
    { int tid_f = wave * 64 + lane_id_(); asm volatile("" : "+v"(tid_f)); const int tid = tid_f, lane = tid & 63; (void)lane; (void)tid;
#if PROBE_PHASE == 500
    if (__hip_atomic_load(ctl + CW_FAIL, RLX_AGENT) > SELFCHECK_TOL) { for (int m = gw; m < M_; m += NGW) for (int j = lane; j < DM; j += 64) out[(size_t)m * DM + j] = __builtin_nanf(""); return; }
#endif
    for (int m = gw; m < M_; m += NGW) rms_row4096<true>(out + (size_t)m * DM, args.in[18], out + (size_t)m * DM, lane);
    }
}

extern "C" void kernel_launch(void* const* d_in, const int* in_sizes, int n_in, void* d_out, int out_size, void* d_ws, size_t ws_size, hipStream_t stream) {
    static int grid = 0;
    if (grid == 0) {
        if (n_in != 19 || out_size != M_ * DM || ws_size < WS_END) { fprintf(stderr, "kernel_launch: unexpected shapes (n_in %d out %d ws %zu need %zu)\n", n_in, out_size, ws_size, (size_t)WS_END); grid = -1; return; }
        int dev = 0, cus = 0;
        if (hipGetDevice(&dev) != hipSuccess || hipDeviceGetAttribute(&cus, hipDeviceAttributeMultiprocessorCount, dev) != hipSuccess) { grid = -1; return; }
        if (hipFuncSetAttribute((const void*)hybrid_fwd, hipFuncAttributeMaxDynamicSharedMemorySize, LDS_BYTES) != hipSuccess) { fprintf(stderr, "kernel_launch: hipFuncSetAttribute failed\n"); grid = -1; return; }
        int per_cu = 0;
        if (hipOccupancyMaxActiveBlocksPerMultiprocessor(&per_cu, (const void*)hybrid_fwd, NWAVES * 64, LDS_BYTES) != hipSuccess || per_cu < 1) { fprintf(stderr, "kernel_launch: occupancy query says %d\n", per_cu); }
        (void)hipGetLastError();
        grid = cus;
    }
    if (grid < 0) return;
    if (hipMemsetAsync((char*)d_ws + WS_CTL, 0, CTL_ZERO_BYTES, stream) != hipSuccess) { fprintf(stderr, "kernel_launch: memset failed\n"); return; }
    Args a{};
    for (int i = 0; i < 19; ++i) a.in[i] = (const float*)d_in[i];
    a.out = (float*)d_out; a.ws = (unsigned char*)d_ws;
    for (int i = 0; i < 32; ++i) a.invf[i] = pow(10000.0, -(double)(2 * i) / 64.0);
    for (int d = 0; d < 136; ++d) { int b;
        if (d < 16) b = d; else { const double dd = d > 128 ? 128.0 : (double)d; b = 16 + (int)(log(dd / 16.0) / log(128.0 / 16.0) * 16.0); if (b > 31) b = 31; }
        a.bucket[d] = (unsigned char)b; }
    hipLaunchKernelGGL(hybrid_fwd, dim3(grid), dim3(NWAVES * 64), LDS_BYTES, stream, a);
    const hipError_t le = hipPeekAtLastError();
    if (le != hipSuccess) fprintf(stderr, "kernel_launch: launch failed: %s\n", hipGetErrorName(le));
}
```

```cpp
#ifndef CMP_REL
#define CMP_REL 0.03f
#define CMP_THR 0.2f
#define CMP_NBAD 0.f
#endif
#ifndef I8_OUT
#define I8_OUT 1
#endif
#ifndef I8_FFN2
#define I8_FFN2 1
#endif
#ifndef FP8_BR
#define FP8_BR 1
#endif
#ifndef FP8_OUT
#define FP8_OUT 0
#endif
#ifndef PROBE_PHASE
#define PROBE_PHASE -1
#endif
#define MLA_BF16 (PROBE_PHASE == 500)
#ifndef SELFCHECK_REL
#define SELFCHECK_REL 0.03f
#define SELFCHECK_ABS 1e-4f
#endif
#ifndef SELFCHECK_TOL
#define SELFCHECK_TOL 0u
#endif
#include <hip/hip_runtime.h>
#include <cstdio>
#include <cstdint>
#include <cmath>
__device__ __forceinline__ int lane_id_() { return (int)__builtin_amdgcn_mbcnt_hi(~0u, __builtin_amdgcn_mbcnt_lo(~0u, 0u)); }
namespace pg8 {
#define PG8_LAS __attribute__((address_space(3)))
typedef unsigned short bf16_t;
typedef short bf16x8 __attribute__((ext_vector_type(8)));
typedef float f32x4 __attribute__((ext_vector_type(4)));
typedef unsigned u32x4 __attribute__((ext_vector_type(4)));
constexpr int BM = 256, BK = 64, HALF = 128, HTB = HALF * BK * 2  , STAGE_BYTES = 8 * HTB, NXCD = 8, WGM = 8;

__host__ __device__ __forceinline__ int lds_byte(int r, int c) { const int st = (r >> 4) * 2 + (c >> 5), rr = r & 15, cc = c & 31, ob = rr * 64 + cc * 2; return st * 1024 + (ob ^ (((ob >> 9) & 1) << 5)); }
__host__ __device__ __forceinline__ void stage_rc(int b, int& R, int& C) { const int st = b / 1024, sb = b % 1024, swz = sb ^ (((sb >> 9) & 1) << 5); R = (st >> 1) * 16 + swz / 64; C = (st & 1) * 32 + (swz % 64) / 2; }
__host__ __device__ __forceinline__ int perm32(int rho) { const int n = rho >> 4, i = rho & 15; return 8 * (i >> 2) + 4 * n + (i & 3); }

struct Unit { int pm, pn; };
struct Gemm { const bf16_t* A; const bf16_t* Bt; int M, N, K; };

struct StaticOrder {
    int nM, nN, nwg, G, c;
    __host__ __device__ void init(int M, int N, int G_, int c_) { nM = M / BM; nN = N / BM; nwg = nM * nN; G = G_; c = c_; }
    __host__ __device__ bool next(int i, Unit& u) const {
        const long L = (long)i * G + c; if (L >= nwg) return false;
        int wgid = (int)L; { const int q = nwg / NXCD, r = nwg % NXCD, xcd = wgid % NXCD, off = wgid / NXCD; wgid = (xcd < r ? xcd * (q + 1) : r * (q + 1) + (xcd - r) * q) + off; }
        const int nig = WGM * nN, gid = wgid / nig, fm = gid * WGM, gsz = (nM - fm) < WGM ? (nM - fm) : WGM;
        u.pm = fm + ((wgid % nig) % gsz); u.pn = (wgid % nig) / gsz; return true;
    }
    __device__ __forceinline__ void a_ready(const Unit&) const {}
    __device__ __forceinline__ void done(const Unit&) const {}
};

__device__ __forceinline__ unsigned cvt_pk_bf16(float lo, float hi) { unsigned r; asm volatile("v_cvt_pk_bf16_f32 %0, %1, %2" : "=v"(r) : "v"(lo), "v"(hi)); return r; }
typedef float f32x2 __attribute__((ext_vector_type(2)));
typedef unsigned u32x2 __attribute__((ext_vector_type(2)));
__device__ __forceinline__ float bf_lo(unsigned w) { return __uint_as_float(w << 16); }
__device__ __forceinline__ float bf_hi(unsigned w) { return __uint_as_float(w & 0xffff0000u); }
__device__ __forceinline__ float sigmoid_f(float x) { return __builtin_amdgcn_rcpf(1.0f + __builtin_amdgcn_exp2f(-1.4426950408889634f * x)); }
__device__ __forceinline__ u32x4 pack8f(f32x4 a, f32x4 b) { u32x4 w; w.x = cvt_pk_bf16(a[0], a[1]); w.y = cvt_pk_bf16(a[2], a[3]); w.z = cvt_pk_bf16(b[0], b[1]); w.w = cvt_pk_bf16(b[2], b[3]); return w; }

__device__ __forceinline__ unsigned pack4_fp8(f32x4 v) { int w = 0; w = __builtin_amdgcn_cvt_pk_fp8_f32(v[0], v[1], w, false); w = __builtin_amdgcn_cvt_pk_fp8_f32(v[2], v[3], w, true); return (unsigned)w; }
__device__ __forceinline__ unsigned quad_tr_bytes(unsigned w, int q) {
    const unsigned t1 = (unsigned)__builtin_amdgcn_mov_dpp((int)w, 0xB1, 0xf, 0xf, true);
    const unsigned x = __builtin_amdgcn_perm(t1, w, (q & 1) ? 0x03070105u : 0x06020400u);
    const unsigned t2 = (unsigned)__builtin_amdgcn_mov_dpp((int)x, 0x4E, 0xf, 0xf, true);
    return __builtin_amdgcn_perm(t2, x, (q & 2) ? 0x03020706u : 0x05040100u);
}
__device__ __forceinline__ void store_vt8(unsigned char* vt, int d0, int kk, int q, unsigned w0, unsigned w1) {
    const int k0 = kk & ~3, pos = ((k0 >> 2) & 1) * 32 + (k0 >> 5) * 16 + ((k0 >> 3) & 3) * 4;
    *(unsigned*)(vt + (size_t)(d0 + q) * 64 + pos) = quad_tr_bytes(w0, q); *(unsigned*)(vt + (size_t)(d0 + 4 + q) * 64 + pos) = quad_tr_bytes(w1, q);
}
struct EpiPlain {
    static constexpr bool PERM = true, AFTER_DRAIN = false; __device__ __forceinline__ bool idem() const { return true; }
    bf16_t* O; int ldc; const float* part8; unsigned char* K8; unsigned char* V8;
    __device__ __forceinline__ void operator()(const f32x4 (&acc)[2][2][4][2], const Unit& u, int wr, int wc, int fr, int fq) const {
        const int row0 = u.pm * BM + wr * 64 + fr, col0 = u.pn * BM + wc * 32 + 8 * fq;
#pragma unroll
        for (int ai = 0; ai < 2; ++ai)
#pragma unroll
            for (int m = 0; m < 4; ++m) { const int row = row0 + ai * HALF + m * 16; bf16_t* rowp = O + (size_t)row * ldc + col0; float sc = 1.f;
                if (part8) { const f32x4* p = (const f32x4*)(part8 + (size_t)row * 8); const f32x4 a = p[0], b = p[1];
                    sc = 1.0f / sqrtf((((a[0] + a[1]) + (a[2] + a[3])) + ((b[0] + b[1]) + (b[2] + b[3]))) * (1.f / 512.f) + 1e-6f); }
#pragma unroll
                for (int bj = 0; bj < 2; ++bj) { const f32x4 v0 = acc[ai][bj][m][0] * sc, v1 = acc[ai][bj][m][1] * sc; if (O) *(u32x4*)(rowp + bj * HALF) = pack8f(v0, v1);
                    if (bj == 0 && K8) { u32x2 w8; w8.x = pack4_fp8(v0); w8.y = pack4_fp8(v1); *(u32x2*)(K8 + (size_t)row * 2048 + u.pn * 128 + wc * 32 + 8 * fq) = w8; }
                    if (bj == 1 && V8) store_vt8(V8 + (size_t)(u.pn * 256 + (row >> 6)) * 8192, wc * 32 + 8 * fq, row & 63, fr & 3, pack4_fp8(v0), pack4_fp8(v1)); } }
    }
};
struct EpiSwiglu {
    static constexpr bool PERM = true, AFTER_DRAIN = false;
    bf16_t* O; int ldc; const float* rs; int tiledM; const float* cmax;
    __device__ __forceinline__ void operator()(const f32x4 (&acc)[2][2][4][2], const Unit& u, int wr, int wc, int fr, int fq) const {
        const int row0 = u.pm * BM + wr * 64 + fr, col0 = u.pn * HALF + wc * 32 + 8 * fq;
        f32x4 cg[2] = {{1.f, 1.f, 1.f, 1.f}, {1.f, 1.f, 1.f, 1.f}}, cu[2] = {{1.f, 1.f, 1.f, 1.f}, {1.f, 1.f, 1.f, 1.f}};
        if (cmax) {
#pragma unroll
            for (int n = 0; n < 2; ++n) { cg[n] = *(const f32x4*)(cmax + col0 + 4 * n) * (1.f / 127.f); cu[n] = *(const f32x4*)(cmax + (ldc + col0) + 4 * n) * (1.f / 127.f); } }
#pragma unroll
        for (int ai = 0; ai < 2; ++ai)
#pragma unroll
            for (int m = 0; m < 4; ++m) { const int row = row0 + ai * HALF + m * 16;
                bf16_t* rowp = tiledM ? O + ((size_t)(col0 >> 6) * tiledM + row) * 64 + (col0 & 63) : O + (size_t)row * ldc + col0;
                const float sc = rs ? rs[row] : 1.f;
                f32x4 h[2];
#pragma unroll
                for (int n = 0; n < 2; ++n) { f32x4 g = acc[ai][0][m][n], up = acc[ai][1][m][n];
                    if (cmax) { typedef int i32x4_t __attribute__((ext_vector_type(4)));
                        g = __builtin_convertvector(__builtin_bit_cast(i32x4_t, g), f32x4) * cg[n]; up = __builtin_convertvector(__builtin_bit_cast(i32x4_t, up), f32x4) * cu[n]; }
                    g = g * sc; up = up * sc;
#pragma unroll
                    for (int e = 0; e < 4; ++e) h[n][e] = g[e] * sigmoid_f(g[e]) * up[e]; }
                *(u32x4*)rowp = pack8f(h[0], h[1]); }
    }
};

struct EpiSwigluCmp {
    static constexpr bool PERM = true, AFTER_DRAIN = false;
    bf16_t* O; int ldc; int tiledM; float* stats; float thr;
    __device__ __forceinline__ void operator()(const f32x4 (&acc)[2][2][4][2], const Unit& u, int wr, int wc, int fr, int fq) const {
        const int row0 = u.pm * BM + wr * 64 + fr, col0 = u.pn * HALF + wc * 32 + 8 * fq; float sd = 0.f, sh = 0.f, nb = 0.f;
#pragma unroll
        for (int ai = 0; ai < 2; ++ai)
#pragma unroll
            for (int m = 0; m < 4; ++m) { const int row = row0 + ai * HALF + m * 16;
                bf16_t* rowp = O + ((size_t)(col0 >> 6) * tiledM + row) * 64 + (col0 & 63);
                const u32x4 old = *(const u32x4*)rowp; const float ov[8] = {bf_lo(old.x), bf_hi(old.x), bf_lo(old.y), bf_hi(old.y), bf_lo(old.z), bf_hi(old.z), bf_lo(old.w), bf_hi(old.w)};
                f32x4 h[2];
#pragma unroll
                for (int n = 0; n < 2; ++n) { const f32x4 g = acc[ai][0][m][n], up = acc[ai][1][m][n];
#pragma unroll
                    for (int e = 0; e < 4; ++e) { h[n][e] = g[e] * sigmoid_f(g[e]) * up[e]; const float d = h[n][e] - ov[4 * n + e]; sd += d * d; sh += h[n][e] * h[n][e]; nb += fabsf(d) > thr ? 1.f : 0.f; } }
                *(u32x4*)rowp = pack8f(h[0], h[1]); }
#pragma unroll
        for (int o = 1; o < 64; o <<= 1) { sd += __shfl_xor(sd, o); sh += __shfl_xor(sh, o); nb += __shfl_xor(nb, o); }
        if (fr == 0 && fq == 0) { atomicAdd(stats, sd); atomicAdd(stats + 1, sh); atomicAdd(stats + 2, nb); }
    }
};
struct EpiNull {
    static constexpr bool PERM = false, AFTER_DRAIN = false;
    __device__ __forceinline__ void operator()(const f32x4 (&acc)[2][2][4][2], const Unit&, int, int, int, int) const {
#pragma unroll
        for (int ai = 0; ai < 2; ++ai)
#pragma unroll
            for (int bj = 0; bj < 2; ++bj)
#pragma unroll
                for (int m = 0; m < 4; ++m)
#pragma unroll
                    for (int n = 0; n < 2; ++n) asm volatile("" :: "v"(acc[ai][bj][m][n]));
    }
};
struct EpiResid {
    static constexpr bool PERM = false, AFTER_DRAIN = false;
    const float* base; float* out; int ldc; float s;
    __device__ __forceinline__ void operator()(const f32x4 (&acc)[2][2][4][2], const Unit& u, int wr, int wc, int fr, int fq) const {
        const int row0 = u.pm * BM + wr * 64 + fr, col0 = u.pn * BM + wc * 32 + 4 * fq;
#pragma unroll
        for (int ai = 0; ai < 2; ++ai)
#pragma unroll
            for (int m = 0; m < 4; ++m) { const size_t off = (size_t)(row0 + ai * HALF + m * 16) * ldc + col0;
#pragma unroll
                for (int bj = 0; bj < 2; ++bj)
#pragma unroll
                    for (int n = 0; n < 2; ++n) { const f32x4 b = *(const f32x4*)(base + off + bj * HALF + n * 16); *(f32x4*)(out + off + bj * HALF + n * 16) = b + acc[ai][bj][m][n] * s; } }
    }
};
template <long F8, bool I8E = false> struct EpiResidNorm {
    static constexpr bool PERM = false, AFTER_DRAIN = false;
    const float* base; float* out; float s; bf16_t* hb; const float* gain; float* part; float* pmax;
    const float* rsm; const float* cmx;
    __device__ __forceinline__ void operator()(const f32x4 (&acc)[2][2][4][2], const Unit& u, int wr, int wc, int fr, int fq) const {
        constexpr int ldc = 4096, hbM = 16384;
        const int row0 = u.pm * BM + wr * 64 + fr, col0 = u.pn * BM + wc * 32 + 4 * fq;
        f32x4 gv[2][2];
#pragma unroll
        for (int bj = 0; bj < 2; ++bj)
#pragma unroll
            for (int n = 0; n < 2; ++n) gv[bj][n] = *(const f32x4*)(gain + col0 + bj * HALF + n * 16);
        f32x4 cv[2][2];
        if constexpr (I8E) {
#pragma unroll
            for (int bj = 0; bj < 2; ++bj)
#pragma unroll
                for (int n = 0; n < 2; ++n) cv[bj][n] = *(const f32x4*)(cmx + col0 + bj * HALF + n * 16) * (s * (1.f / 127.f)); }
#pragma unroll
        for (int ai = 0; ai < 2; ++ai)
#pragma unroll
            for (int m = 0; m < 4; ++m) { const int row = row0 + ai * HALF + m * 16; const size_t off = (size_t)row * ldc + col0; float ss = 0.f, mx = 0.f;
                float rsr = 0.f; if constexpr (I8E) rsr = rsm[row];
#pragma unroll
                for (int bj = 0; bj < 2; ++bj)
#pragma unroll
                    for (int n = 0; n < 2; ++n) { const f32x4 b = *(const f32x4*)(base + off + bj * HALF + n * 16); f32x4 o;
                        if constexpr (I8E) { typedef int i32x4_t __attribute__((ext_vector_type(4)));
                            o = b + __builtin_convertvector(__builtin_bit_cast(i32x4_t, acc[ai][bj][m][n]), f32x4) * (cv[bj][n] * rsr); }
                        else o = b + acc[ai][bj][m][n] * s;
                        *(f32x4*)(out + off + bj * HALF + n * 16) = o;
                        ss += (o[0] * o[0] + o[1] * o[1]) + (o[2] * o[2] + o[3] * o[3]); const f32x4 y = o * gv[bj][n];
                        mx = fmaxf(fmaxf(mx, fmaxf(fabsf(y[0]), fabsf(y[1]))), fmaxf(fabsf(y[2]), fabsf(y[3])));
                        u32x2 w; w.x = cvt_pk_bf16(y[0], y[1]); w.y = cvt_pk_bf16(y[2], y[3]);
                        const int col = col0 + bj * HALF + n * 16;
                        *(u32x2*)(hb + ((size_t)(col >> 6) * hbM + row) * 64 + (col & 63)) = w;
                        if constexpr (F8 != 0) *(unsigned*)((unsigned char*)hb + F8 + ((size_t)(col >> 7) * hbM + row) * 128 + (col & 127)) = pack4_fp8(y); }
                ss += __shfl_xor(ss, 16); ss += __shfl_xor(ss, 32); if (fq == 0) part[(size_t)row * 64 + u.pn * 4 + wc] = ss;
                if (pmax) { mx = fmaxf(mx, __shfl_xor(mx, 16)); mx = fmaxf(mx, __shfl_xor(mx, 32)); if (fq == 0) pmax[(size_t)row * 64 + u.pn * 4 + wc] = mx; } }
    }
};
template <int MODE_> struct EpiProj {
    static constexpr bool PERM = true, AFTER_DRAIN = false; static constexpr int mode = MODE_; __device__ __forceinline__ bool idem() const { return true; }
    bf16_t *cq, *ckv, *kr, *qb, *kb, *vb, *ga, *gb; const float* cosT; const float* sinT; const float* rs; float* partq; float* partkv; float* kmean; unsigned char* kr8; unsigned char* qb8; unsigned char* kb8; unsigned char* vb8;
    float post;
    __device__ __forceinline__ void operator()(const f32x4 (&acc)[2][2][4][2], const Unit& u, int wr, int wc, int fr, int fq) const {
        const int row0 = u.pm * BM + wr * 64 + fr; const int pn = mode == 1 ? (u.pn == 22 ? 62 : u.pn) : u.pn + 22;
        if (mode == 1 && pn == 62) {
            if (wc < 2) { const int g = wc * 4 + fq;
#pragma unroll
                for (int ai = 0; ai < 2; ++ai)
#pragma unroll
                    for (int m = 0; m < 4; ++m) { const int row = row0 + ai * HALF + m * 16;
                        const f32x4 c = *(const f32x4*)(cosT + (size_t)row * 32 + 4 * g), s = *(const f32x4*)(sinT + (size_t)row * 32 + 4 * g);
                        const float sc = rs[row] * post;
                        const f32x4 x1 = acc[ai][0][m][0] * sc, x2 = acc[ai][0][m][1] * sc;
                        const f32x4 o1 = x1 * c - x2 * s, o2 = x2 * c + x1 * s;
                        u32x2 w1, w2; w1.x = cvt_pk_bf16(o1[0], o1[1]); w1.y = cvt_pk_bf16(o1[2], o1[3]); w2.x = cvt_pk_bf16(o2[0], o2[1]); w2.y = cvt_pk_bf16(o2[2], o2[3]);
                        *(u32x2*)(kr + (size_t)row * 64 + 4 * g) = w1; *(u32x2*)(kr + (size_t)row * 64 + 32 + 4 * g) = w2;
                        *(unsigned*)(kr8 + (size_t)row * 64 + 4 * g) = pack4_fp8(o1); *(unsigned*)(kr8 + (size_t)row * 64 + 32 + 4 * g) = pack4_fp8(o2); } }
            return; }
        bf16_t* base; int ldc, colt; bool sig = false;
        if (pn < 4) { base = cq; ldc = 1024; colt = pn * BM; }
        else if (pn < 6) { base = ckv; ldc = 512; colt = (pn - 4) * BM; }
        else if (pn < 14) { base = qb; ldc = 2048; colt = (pn - 6) * BM; }
        else if (pn < 22) { base = kb; ldc = 2048; colt = (pn - 14) * BM; }
        else if (pn < 30) { base = vb; ldc = 2048; colt = (pn - 22) * BM; }
        else if (pn < 46) { base = ga; ldc = 4096; colt = (pn - 30) * BM; sig = true; }
        else { base = gb; ldc = 4096; colt = (pn - 46) * BM; sig = true; }
        const int col0 = colt + wc * 32 + 8 * fq;
        float* part = mode != 1 ? nullptr : (pn < 4 ? partq + pn * 4 + wc : (pn < 6 ? partkv + (pn - 4) * 4 + wc : nullptr)); const int pstride = pn < 4 ? 16 : 8;
        const bool iskb = mode == 1 && pn >= 14 && pn < 22; f32x4 cs[2][2] = {};
        const bool isvb = mode == 2 && pn < 30;
        unsigned char* f8p = mode == 1 && pn >= 6 && pn < 22 ? (pn < 14 ? qb8 : kb8) : nullptr;
#pragma unroll
        for (int ai = 0; ai < 2; ++ai)
#pragma unroll
            for (int m = 0; m < 4; ++m) { const int row = row0 + ai * HALF + m * 16; bf16_t* rowp = base + (size_t)row * ldc + col0; const float sc = rs[row] * post; float ss = 0.f;
#pragma unroll
                for (int bj = 0; bj < 2; ++bj) { f32x4 v0 = acc[ai][bj][m][0] * sc, v1 = acc[ai][bj][m][1] * sc;
                    if (sig) {
#pragma unroll
                        for (int e = 0; e < 4; ++e) { v0[e] = sigmoid_f(v0[e]); v1[e] = sigmoid_f(v1[e]); } }
                    if (part) ss += ((v0[0] * v0[0] + v0[1] * v0[1]) + (v0[2] * v0[2] + v0[3] * v0[3])) + ((v1[0] * v1[0] + v1[1] * v1[1]) + (v1[2] * v1[2] + v1[3] * v1[3]));
                    if (iskb) { cs[bj][0] += v0; cs[bj][1] += v1; }
                    if (f8p) { u32x2 w8; w8.x = pack4_fp8(v0); w8.y = pack4_fp8(v1); *(u32x2*)(f8p + (size_t)row * 2048 + col0 + bj * HALF) = w8; }
                    if (isvb) store_vt8(vb8 + (size_t)((2 * (pn - 22) + bj) * 256 + (row >> 6)) * 8192, wc * 32 + 8 * fq, row & 63, fr & 3, pack4_fp8(v0), pack4_fp8(v1));
                    if (!isvb || MLA_BF16) *(u32x4*)(rowp + bj * HALF) = pack8f(v0, v1); }
                if (part) { ss += __shfl_xor(ss, 16); ss += __shfl_xor(ss, 32); if (fq == 0) part[(size_t)row * pstride] = ss; } }
        if (iskb) {
#pragma unroll
            for (int bj = 0; bj < 2; ++bj)
#pragma unroll
                for (int n = 0; n < 2; ++n)
#pragma unroll
                    for (int e2 = 0; e2 < 4; ++e2) { float c = cs[bj][n][e2];
                        c += __shfl_xor(c, 1); c += __shfl_xor(c, 2); c += __shfl_xor(c, 4); c += __shfl_xor(c, 8);
                        if (fr == 0) atomicAdd(kmean + (size_t)((2 * (pn - 14) + bj) * 64 + u.pm) * 128 + wc * 32 + 8 * fq + 4 * n + e2, c * (1.f / 256.f)); }
        }
    }
};
struct EpiQ {
    static constexpr bool PERM = true, AFTER_DRAIN = false; __device__ __forceinline__ bool idem() const { return true; }
    bf16_t* Q; const float* cosT; const float* sinT; const float* partq; unsigned char* Q8;
    __device__ __forceinline__ float rstd_of(int row) const { const f32x4* p = (const f32x4*)(partq + (size_t)row * 16); const f32x4 a = p[0], b = p[1], c = p[2], d = p[3];
        const float s = ((a[0] + a[1]) + (a[2] + a[3])) + ((b[0] + b[1]) + (b[2] + b[3])) + ((c[0] + c[1]) + (c[2] + c[3])) + ((d[0] + d[1]) + (d[2] + d[3])); return 1.0f / sqrtf(s * (1.f / 1024.f) + 1e-6f); }
    __device__ __forceinline__ void operator()(const f32x4 (&acc)[2][2][4][2], const Unit& u, int wr, int wc, int fr, int fq) const {
        const int row0 = u.pm * BM + wr * 64 + fr;
        float rsv[2][4];
#pragma unroll
        for (int ai = 0; ai < 2; ++ai)
#pragma unroll
            for (int m = 0; m < 4; ++m) rsv[ai][m] = rstd_of(row0 + ai * HALF + m * 16);
#pragma unroll
        for (int bj = 0; bj < 2; ++bj) {
            const int cw = u.pn * BM + bj * HALF + wc * 32;
            const int hc = cw % 192, hb = cw - hc;
            if (hc < 128) {
#pragma unroll
                for (int ai = 0; ai < 2; ++ai)
#pragma unroll
                    for (int m = 0; m < 4; ++m) { const int row = row0 + ai * HALF + m * 16; const float sc = rsv[ai][m];
                        const f32x4 q0 = acc[ai][bj][m][0] * sc, q1 = acc[ai][bj][m][1] * sc;
                        if (Q) *(u32x4*)(Q + (size_t)row * 3072 + cw + 8 * fq) = pack8f(q0, q1);
                        u32x2 w8; w8.x = pack4_fp8(q0); w8.y = pack4_fp8(q1); *(u32x2*)(Q8 + (size_t)row * 3072 + cw + 8 * fq) = w8; }
            } else {
                const int g = ((hc - 128) >> 3) + fq;
#pragma unroll
                for (int ai = 0; ai < 2; ++ai)
#pragma unroll
                    for (int m = 0; m < 4; ++m) { const int row = row0 + ai * HALF + m * 16;
                        const f32x4 c = *(const f32x4*)(cosT + (size_t)row * 32 + 4 * g), s = *(const f32x4*)(sinT + (size_t)row * 32 + 4 * g);
                        const float sc = rsv[ai][m];
                        const f32x4 x1 = acc[ai][bj][m][0] * sc, x2 = acc[ai][bj][m][1] * sc;
                        const f32x4 o1 = x1 * c - x2 * s, o2 = x2 * c + x1 * s;
                        if (Q) { u32x2 w1, w2; w1.x = cvt_pk_bf16(o1[0], o1[1]); w1.y = cvt_pk_bf16(o1[2], o1[3]); w2.x = cvt_pk_bf16(o2[0], o2[1]); w2.y = cvt_pk_bf16(o2[2], o2[3]);
                            bf16_t* qp = Q + (size_t)row * 3072 + hb + 128 + 4 * g;
                            *(u32x2*)qp = w1; *(u32x2*)(qp + 32) = w2; }
                        unsigned char* q8p = Q8 + (size_t)row * 3072 + hb + 128 + 4 * g; *(unsigned*)q8p = pack4_fp8(o1); *(unsigned*)(q8p + 32) = pack4_fp8(o2); }
            }
        }
    }
};
template <bool ADD> struct EpiMerge {
    static constexpr bool PERM = true, AFTER_DRAIN = false; const bf16_t* gate; bf16_t* T; unsigned char* O8; float post;
    __device__ __forceinline__ void operator()(const f32x4 (&acc)[2][2][4][2], const Unit& u, int wr, int wc, int fr, int fq) const {
        const int row0 = u.pm * BM + wr * 64 + fr, col0 = u.pn * BM + wc * 32 + 8 * fq;
#pragma unroll
        for (int ai = 0; ai < 2; ++ai)
#pragma unroll
            for (int m = 0; m < 4; ++m) { const int row = row0 + ai * HALF + m * 16; const size_t off = (size_t)row * 4096 + col0;
#pragma unroll
                for (int bj = 0; bj < 2; ++bj) { const u32x4 gw = *(const u32x4*)(gate + off + bj * HALF);
                    f32x4 v0 = acc[ai][bj][m][0] * post, v1 = acc[ai][bj][m][1] * post;
                    v0[0] *= bf_lo(gw.x); v0[1] *= bf_hi(gw.x); v0[2] *= bf_lo(gw.y); v0[3] *= bf_hi(gw.y);
                    v1[0] *= bf_lo(gw.z); v1[1] *= bf_hi(gw.z); v1[2] *= bf_lo(gw.w); v1[3] *= bf_hi(gw.w);
                    if (ADD) { const u32x4 pw = *(const u32x4*)(T + off + bj * HALF);
                        v0[0] += bf_lo(pw.x); v0[1] += bf_hi(pw.x); v0[2] += bf_lo(pw.y); v0[3] += bf_hi(pw.y);
                        v1[0] += bf_lo(pw.z); v1[1] += bf_hi(pw.z); v1[2] += bf_lo(pw.w); v1[3] += bf_hi(pw.w);
                        if (O8) { const int col = col0 + bj * HALF; u32x2 q; q.x = pack4_fp8(v0 * 16.f); q.y = pack4_fp8(v1 * 16.f);
                            *(u32x2*)(O8 + ((size_t)(col >> 7) * 16384 + row) * 128 + (col & 127)) = q; }
                        else *(u32x4*)(T + off + bj * HALF) = pack8f(v0, v1); }
                    else *(u32x4*)(T + off + bj * HALF) = pack8f(v0, v1); } }
    }
};
template <class Epi, class Sched, bool ALIGN_EPI = false, bool SP2 = false, bool TILED = false, bool FP8 = false, bool I8 = false>
__device__ __forceinline__ void gemm_phase(PG8_LAS unsigned char* lds, const Gemm g, const Sched S, const Epi E, int wv) {
    int tid_ = wv * 64 + lane_id_(); asm volatile("" : "+v"(tid_)); const int tid = tid_, wid = wv, lane = tid & 63, wr = wid >> 2, wc = wid & 3, fr = lane & 15, fq = lane >> 4;
    const int K = g.K, nt = K / BK;
    unsigned voffA[2], voffB[2];
#pragma unroll
    for (int i = 0; i < 2; ++i) { int R, C; stage_rc(tid * 16 + i * 8192, R, C); const int Rb = Epi::PERM ? ((R & ~31) + perm32(R & 31)) : R;
        voffA[i] = (unsigned)(R * (TILED ? BK : K) + C) * 2u; voffB[i] = (unsigned)(Rb * (TILED ? BK : K) + C) * 2u; }
    const size_t kstepA = TILED ? (size_t)g.M * BK * 2 : (size_t)(BK * 2), kstepB = TILED ? (size_t)g.N * BK * 2 : (size_t)(BK * 2);
    const size_t hstep = TILED ? (size_t)HALF * BK * 2 : (size_t)HALF * K * 2;
    const size_t tstep = 2 * hstep;
    const unsigned ldsw = (unsigned)wid * 1024u;
    const int aoff = lds_byte(wr * 64 + fr, fq * 8), boff = lds_byte(wc * 32 + fr, fq * 8);
#define PG8_SA(b, h) (((b) * 2 + (h)) * HTB)
#define PG8_SB(b, h) ((4 + (b) * 2 + (h)) * HTB)
#define PG8_STAGE(bufoff, gbase, voff) do { _Pragma("unroll") for (int _i = 0; _i < 2; ++_i) \
        __builtin_amdgcn_global_load_lds((const unsigned*)((const char*)(gbase) + (voff)[_i]), (PG8_LAS unsigned*)(lds + (bufoff) + ldsw + _i * 8192), 16, 0, 0); } while (0)
#define PG8_LDA(dst, b, h) do { _Pragma("unroll") for (int m = 0; m < 4; ++m) { if constexpr (FP8) { \
            dst##8[m].lo = *(const PG8_LAS v4i_t*)(lds + PG8_SA(b, h) + aoff + m * 2048); dst##8[m].hi = *(const PG8_LAS v4i_t*)(lds + PG8_SA(b, h) + aoff + m * 2048 + 1024); } \
        else { _Pragma("unroll") for (int k = 0; k < 2; ++k) dst[m][k] = *(const PG8_LAS bf16x8*)(lds + PG8_SA(b, h) + aoff + m * 2048 + k * 1024); } } } while (0)
#define PG8_LDB(dst, b, h) do { _Pragma("unroll") for (int n = 0; n < 2; ++n) { if constexpr (FP8) { \
            dst##8[n].lo = *(const PG8_LAS v4i_t*)(lds + PG8_SB(b, h) + boff + n * 2048); dst##8[n].hi = *(const PG8_LAS v4i_t*)(lds + PG8_SB(b, h) + boff + n * 2048 + 1024); } \
        else { _Pragma("unroll") for (int k = 0; k < 2; ++k) dst[n][k] = *(const PG8_LAS bf16x8*)(lds + PG8_SB(b, h) + boff + n * 2048 + k * 1024); } } } while (0)
#define PG8_MMA(ai, bj, At, Bt) do { __builtin_amdgcn_s_setprio(1); \
        if constexpr (I8) {   \
            _Pragma("unroll") for (int k = 0; k < 2; ++k) _Pragma("unroll") for (int m = 0; m < 4; ++m) _Pragma("unroll") for (int n = 0; n < 2; ++n) \
                acc[ai][bj][m][n] = __builtin_bit_cast(f32x4, __builtin_amdgcn_mfma_i32_16x16x64_i8(__builtin_bit_cast(v4i_t, Bt[n][k]), __builtin_bit_cast(v4i_t, At[m][k]), __builtin_bit_cast(v4i_t, acc[ai][bj][m][n]), 0, 0, 0)); } \
        else { _Pragma("unroll") for (int m = 0; m < 4; ++m) _Pragma("unroll") for (int n = 0; n < 2; ++n) { \
            if constexpr (FP8) asm volatile("v_mfma_scale_f32_16x16x128_f8f6f4 %0, %1, %2, %0, %3, %3 op_sel_hi:[0,0,0]" : "+v"(acc[ai][bj][m][n]) : "v"(Bt##8[n]), "v"(At##8[m]), "v"(f8scale));   \
            else { _Pragma("unroll") for (int k = 0; k < 2; ++k) acc[ai][bj][m][n] = __builtin_amdgcn_mfma_f32_16x16x32_bf16(Bt[n][k], At[m][k], acc[ai][bj][m][n], 0, 0, 0); } } } \
        __builtin_amdgcn_s_setprio(0); } while (0)
#define PG8_WAIT_V(n) asm volatile("s_waitcnt vmcnt(" #n ")" ::: "memory")
#define PG8_WAIT_L(n) asm volatile("s_waitcnt lgkmcnt(" #n ")" ::: "memory")
#define PG8_BAR __builtin_amdgcn_s_barrier()
#define PG8_SCHED __builtin_amdgcn_sched_barrier(0)
    Unit cur, nxt; int ui = 0;
    if (!S.next(0, cur)) return;
    f32x4 acc[2][2][4][2];
#pragma unroll
    for (int a = 0; a < 2; ++a)
#pragma unroll
        for (int b = 0; b < 2; ++b)
#pragma unroll
            for (int m = 0; m < 4; ++m)
#pragma unroll
                for (int n = 0; n < 2; ++n) acc[a][b][m][n] = (f32x4){0.f, 0.f, 0.f, 0.f};
    typedef int v8i_t __attribute__((ext_vector_type(8))); typedef int v4i_t __attribute__((ext_vector_type(4)));
    int f8scale = 0x7f7f7f7f; asm volatile("" : "+v"(f8scale));
    bf16x8 At[4][2], B0[2][2], B1[2][2]; v8i_t At8[4], B08[2], B18[2];
    const char* cA = (const char*)g.A + (size_t)cur.pm * tstep; const char* cB = (const char*)g.Bt + (size_t)cur.pn * tstep;
    S.a_ready(cur);
    if constexpr (SP2) {
        PG8_STAGE(PG8_SB(0, 0), cB, voffB); PG8_STAGE(PG8_SB(0, 1), cB + hstep, voffB); PG8_STAGE(PG8_SA(0, 0), cA, voffA); PG8_STAGE(PG8_SA(0, 1), cA + hstep, voffA);
        if (wr == 1) PG8_BAR;
        PG8_WAIT_V(2); PG8_BAR;
        PG8_STAGE(PG8_SB(1, 0), cB + kstepB, voffB); PG8_STAGE(PG8_SA(1, 0), cA + kstepA, voffA); PG8_STAGE(PG8_SB(1, 1), cB + hstep + kstepB, voffB);
        PG8_WAIT_V(6); PG8_BAR;
    } else {
        PG8_STAGE(PG8_SB(0, 0), cB, voffB); PG8_STAGE(PG8_SA(0, 0), cA, voffA); PG8_STAGE(PG8_SB(0, 1), cB + hstep, voffB); PG8_STAGE(PG8_SA(0, 1), cA + hstep, voffA);
        if (wr == 1) PG8_BAR;
        PG8_WAIT_V(4); PG8_BAR;
        PG8_STAGE(PG8_SB(1, 0), cB + kstepB, voffB); PG8_STAGE(PG8_SA(1, 0), cA + kstepA, voffA); PG8_STAGE(PG8_SB(1, 1), cB + hstep + kstepB, voffB);
        PG8_WAIT_V(6); PG8_BAR;
    }
    for (;;) {
        const bool has_next = S.next(ui + 1, nxt);
        const char* nA = has_next ? (const char*)g.A + (size_t)nxt.pm * tstep : cA; const char* nB = has_next ? (const char*)g.Bt + (size_t)nxt.pn * tstep : cB;
        for (int t = 0; t < nt; t += 2) {
            const bool last = (t == nt - 2);
            const char* a1 = cA + (size_t)(t + 1) * kstepA;
            const char* a2 = last ? nA : cA + (size_t)(t + 2) * kstepA; const char* b2 = last ? nB : cB + (size_t)(t + 2) * kstepB;
            const char* a3 = a2 + kstepA; const char* b3 = b2 + kstepB;
            if (last && has_next) S.a_ready(nxt);
            if constexpr (SP2) {
            PG8_LDB(B0, 0, 0); PG8_LDB(B1, 0, 1); PG8_SCHED; PG8_LDA(At, 0, 0); PG8_STAGE(PG8_SA(1, 1), a1 + hstep, voffA);
            PG8_WAIT_V(8); PG8_WAIT_L(0); PG8_BAR; PG8_MMA(0, 0, At, B0); PG8_MMA(0, 1, At, B1); PG8_BAR; PG8_SCHED;
            PG8_LDA(At, 0, 1); PG8_STAGE(PG8_SB(0, 0), b2, voffB); PG8_STAGE(PG8_SB(0, 1), b2 + hstep, voffB); PG8_STAGE(PG8_SA(0, 0), a2, voffA);
            PG8_WAIT_V(8); PG8_WAIT_L(0); PG8_BAR; PG8_MMA(1, 0, At, B0); PG8_MMA(1, 1, At, B1); PG8_BAR; PG8_SCHED;
            PG8_LDB(B0, 1, 0); PG8_LDB(B1, 1, 1); PG8_SCHED; PG8_LDA(At, 1, 0); PG8_STAGE(PG8_SA(0, 1), a2 + hstep, voffA);
            PG8_WAIT_V(8); PG8_WAIT_L(0); PG8_BAR; PG8_MMA(0, 0, At, B0); PG8_MMA(0, 1, At, B1); PG8_BAR; PG8_SCHED;
            PG8_LDA(At, 1, 1); PG8_STAGE(PG8_SB(1, 0), b3, voffB); PG8_STAGE(PG8_SB(1, 1), b3 + hstep, voffB); PG8_STAGE(PG8_SA(1, 0), a3, voffA);
            PG8_WAIT_V(8); PG8_WAIT_L(0); PG8_BAR; PG8_MMA(1, 0, At, B0); PG8_MMA(1, 1, At, B1); PG8_BAR; PG8_SCHED;
            } else {
            PG8_LDB(B0, 0, 0); PG8_SCHED; PG8_LDA(At, 0, 0); PG8_STAGE(PG8_SA(1, 1), a1 + hstep, voffA);
            PG8_WAIT_L(8); PG8_BAR; PG8_WAIT_L(0); PG8_MMA(0, 0, At, B0); PG8_BAR; PG8_SCHED;
            PG8_LDB(B1, 0, 1); PG8_STAGE(PG8_SB(0, 0), b2, voffB);
            PG8_BAR; PG8_WAIT_L(0); PG8_MMA(0, 1, At, B1); PG8_BAR;
            PG8_LDA(At, 0, 1); PG8_STAGE(PG8_SA(0, 0), a2, voffA);
            PG8_BAR; PG8_WAIT_L(0); PG8_MMA(1, 0, At, B0); PG8_BAR; PG8_SCHED;
            PG8_STAGE(PG8_SB(0, 1), b2 + hstep, voffB);
            PG8_WAIT_V(6); PG8_BAR; PG8_MMA(1, 1, At, B1); PG8_BAR;
            PG8_LDB(B0, 1, 0); PG8_SCHED; PG8_LDA(At, 1, 0); PG8_STAGE(PG8_SA(0, 1), a2 + hstep, voffA);
            PG8_WAIT_L(8); PG8_BAR; PG8_WAIT_L(0); PG8_MMA(0, 0, At, B0); PG8_BAR; PG8_SCHED;
            PG8_LDB(B1, 1, 1); PG8_STAGE(PG8_SB(1, 0), b3, voffB);
            PG8_BAR; PG8_WAIT_L(0); PG8_MMA(0, 1, At, B1); PG8_BAR;
            PG8_LDA(At, 1, 1); PG8_STAGE(PG8_SA(1, 0), a3, voffA);
            PG8_BAR; PG8_WAIT_L(0); PG8_MMA(1, 0, At, B0); PG8_BAR; PG8_SCHED;
            PG8_STAGE(PG8_SB(1, 1), b3 + hstep, voffB);
            PG8_WAIT_V(6); PG8_BAR; PG8_MMA(1, 1, At, B1); PG8_BAR;
            }
        }
        if constexpr (FP8 || I8) asm volatile("s_nop 15\n\ts_nop 7" ::: "memory");
        if constexpr (ALIGN_EPI) { if (wr == 0) PG8_BAR; }
        if constexpr (!Epi::AFTER_DRAIN) { int fr_e = fr, fq_e = fq; asm volatile("" : "+v"(fr_e), "+v"(fq_e));
            E(acc, cur, wr, wc, fr_e, fq_e); S.done(cur); }
        if (!has_next) break;
#pragma unroll
        for (int a = 0; a < 2; ++a)
#pragma unroll
            for (int b = 0; b < 2; ++b)
#pragma unroll
                for (int m = 0; m < 4; ++m)
#pragma unroll
                    for (int n = 0; n < 2; ++n) acc[a][b][m][n] = (f32x4){0.f, 0.f, 0.f, 0.f};
        cur = nxt; cA = nA; cB = nB; ++ui;
        if constexpr (ALIGN_EPI) { if (wr == 1) PG8_BAR; }
    }
    PG8_WAIT_V(0);
    if constexpr (!ALIGN_EPI) { if (wr == 0) PG8_BAR; }
    PG8_BAR;
    if constexpr (Epi::AFTER_DRAIN) { E.fused(acc, cur, wr, wc, fr, fq, lds, wid, lane); S.done(cur); }
#undef PG8_SA
#undef PG8_SB
#undef PG8_STAGE
#undef PG8_LDA
#undef PG8_LDB
#undef PG8_MMA
#undef PG8_WAIT_V
#undef PG8_WAIT_L
#undef PG8_BAR
#undef PG8_SCHED
}
}
namespace att {
typedef unsigned short bf16_t;
typedef short bf16x8 __attribute__((ext_vector_type(8)));
typedef short s16x4 __attribute__((ext_vector_type(4)));
typedef float f32x16 __attribute__((ext_vector_type(16)));
typedef float f32x4 __attribute__((ext_vector_type(4)));
typedef unsigned u32x4 __attribute__((ext_vector_type(4)));
typedef int i32x4 __attribute__((ext_vector_type(4)));
#define ASBAR() __builtin_amdgcn_sched_barrier(0)
constexpr int VT_BYTES = 16384;
constexpr int L_V = 0, L_K = 2 * VT_BYTES;
constexpr int KT_MAX = 64 * 192 * 2;
constexpr int L_WS = L_K + 2 * KT_MAX;
constexpr int L_BIAS = L_WS + 8 * 128 * 4;
constexpr int L_PREF = L_BIAS + 16 * 132 * 4;
constexpr int L_CNT = L_PREF + 1040 * 4 + 64;
constexpr int L_END = L_CNT + 1024 * 4;
constexpr float LOG2E = 1.4426950408889634f;
constexpr float THR2 = 6.0f;

__device__ __forceinline__ int v_st(int k, int c) { const int kk = (k & ~0xC) | ((k & 4) << 1) | ((k & 8) >> 1); return ((kk >> 3) * 4 + (c >> 5)) * 512 + ((kk & 7) * 32 + (c & 31)) * 2; }
__device__ __forceinline__ int v_rd_base(int lane) { return ((lane & 3) << 3) | (((lane >> 2) & 3) << 6) | (((lane >> 4) & 1) << 5) | (((lane >> 5) & 1) << 8); }
constexpr int v_rd_off(int d0, int ks, int half) { return d0 * 512 + ks * 4096 + half * 2048; }
__device__ __forceinline__ int crow(int r, int hi) { return (r & 3) + 8 * (r >> 2) + 4 * hi; }
__device__ __forceinline__ unsigned cvtpk(float lo, float hi) { unsigned r; asm volatile("v_cvt_pk_bf16_f32 %0, %1, %2" : "=v"(r) : "v"(lo), "v"(hi)); return r; }
__device__ __forceinline__ bf16x8 ld8(const bf16_t* p) { return *reinterpret_cast<const bf16x8*>(p); }
template <int DQK> __device__ __forceinline__ int kswz(int row, int chunk) {
    if constexpr (DQK == 128) return row * 256 + ((chunk ^ (row & 7)) << 4);
    else return row * 384 + (((chunk & ~7) | ((chunk ^ (row >> 1)) & 7)) << 4);
}
__device__ __forceinline__ void mask_tile(f32x16& p0, f32x16& p1, int dq) {
    const float NEG = -__builtin_inff();
#pragma unroll
    for (int r = 0; r < 16; ++r) { const int c = (r & 3) + 8 * (r >> 2); if (dq - c < 0) p0[r] = NEG; if (dq - c - 32 < 0) p1[r] = NEG; }
}
template <bool RAW>
__device__ __forceinline__ void partialSM(f32x16& p0, f32x16& p1, float& m_reg, float& alpha, float sc) {
    float pmax = p0[0];
#pragma unroll
    for (int r = 1; r < 16; ++r) pmax = fmaxf(pmax, p0[r]);
#pragma unroll
    for (int r = 0; r < 16; ++r) pmax = fmaxf(pmax, p1[r]);
    { auto rr = __builtin_amdgcn_permlane32_swap(__float_as_uint(pmax), __float_as_uint(pmax), false, false);
      pmax = fmaxf(__uint_as_float(rr[0]), __uint_as_float(rr[1])); }
    if (RAW) pmax *= sc;
    const bool need = pmax - m_reg > THR2;
    const float mn = need ? pmax : m_reg;
    alpha = need ? __builtin_amdgcn_exp2f(m_reg - mn) : 1.f; m_reg = mn;
    if (RAW) {
#pragma unroll
        for (int r = 0; r < 16; ++r) p0[r] = __builtin_amdgcn_exp2f(fmaf(p0[r], sc, -mn));
#pragma unroll
        for (int r = 0; r < 16; ++r) p1[r] = fmaf(p1[r], sc, -mn);
    } else {
#pragma unroll
        for (int r = 0; r < 16; ++r) p0[r] = __builtin_amdgcn_exp2f(p0[r] - mn);
#pragma unroll
        for (int r = 0; r < 16; ++r) p1[r] = p1[r] - mn;
    }
}
__device__ __forceinline__ void finishSM_e(f32x16& p1) {
#pragma unroll
    for (int r = 0; r < 16; ++r) p1[r] = __builtin_amdgcn_exp2f(p1[r]);
}
__device__ __forceinline__ void finishSM_a(f32x16& p0, f32x16& p1, float alpha, float& l_reg) {
#pragma unroll
    for (int r = 0; r < 16; ++r) p1[r] = __builtin_amdgcn_exp2f(p1[r]);
    float ps = 0;
#pragma unroll
    for (int r = 0; r < 16; ++r) ps += p0[r];
#pragma unroll
    for (int r = 0; r < 16; ++r) ps += p1[r];
    { auto rr = __builtin_amdgcn_permlane32_swap(__float_as_uint(ps), __float_as_uint(ps), false, false);
      ps = __uint_as_float(rr[0]) + __uint_as_float(rr[1]); }
    l_reg = l_reg * alpha + ps;
}
#define PK4(P, B_, OUT) do { unsigned a0 = cvtpk(P[B_+0], P[B_+1]), a1 = cvtpk(P[B_+2], P[B_+3]);                          \
        unsigned b0 = cvtpk(P[B_+4], P[B_+5]), b1 = cvtpk(P[B_+6], P[B_+7]);                                             \
        auto r0 = __builtin_amdgcn_permlane32_swap(a0, b0, false, false); auto r1 = __builtin_amdgcn_permlane32_swap(a1, b1, false, false); \
        u32x4 w = {r0[0], r1[0], r0[1], r1[1]}; OUT = *reinterpret_cast<bf16x8*>(&w); } while (0)
template <int DQK>
__device__ __forceinline__ void qkt(f32x16& p0, f32x16& p1, const char* kbuf, int r32, int hi, const bf16x8* qr) {
    p0 = f32x16{}; p1 = f32x16{};
    const char* kb[4];
    constexpr int RP = DQK * 2;
#pragma unroll
    for (int dd = 0; dd < 4; ++dd) kb[dd] = kbuf + kswz<DQK>(r32, 2 * dd + hi);
#pragma unroll
    for (int d0 = 0; d0 < DQK / 16; ++d0) { const char* a = kb[d0 & 3] + (d0 >> 2) * 128;
        bf16x8 b0 = *reinterpret_cast<const bf16x8*>(a);
        bf16x8 b1 = *reinterpret_cast<const bf16x8*>(a + 32 * RP);
        __builtin_amdgcn_s_setprio(1);
        p0 = __builtin_amdgcn_mfma_f32_32x32x16_bf16(b0, qr[d0], p0, 0, 0, 0);
        p1 = __builtin_amdgcn_mfma_f32_32x32x16_bf16(b1, qr[d0], p1, 0, 0, 0);
        __builtin_amdgcn_s_setprio(0); }
}
template <int VBOFF>
__device__ __forceinline__ void pv_tile(f32x16* o, int vb0, bf16x8 pa0, bf16x8 pa1, bf16x8 pa2, bf16x8 pa3) {
#define TRRD(dst, off) asm volatile("ds_read_b64_tr_b16 %0, %1 offset:%2" : "=&v"(dst) : "v"(vb0), "i"(off) : "memory")
#define PV_D0(d0) do { s16x4 l0, l1, l2, l3, h0, h1, h2, h3; constexpr int b_ = VBOFF + v_rd_off(d0, 0, 0); \
        TRRD(l0, b_); TRRD(h0, b_ + 2048); TRRD(l1, b_ + 4096); TRRD(h1, b_ + 6144); TRRD(l2, b_ + 8192); TRRD(h2, b_ + 10240); TRRD(l3, b_ + 12288); TRRD(h3, b_ + 14336); \
        asm volatile("s_waitcnt lgkmcnt(0)" ::: "memory"); ASBAR();   \
        o[d0] = __builtin_amdgcn_mfma_f32_32x32x16_bf16(pa0, (bf16x8){l0[0], l0[1], l0[2], l0[3], h0[0], h0[1], h0[2], h0[3]}, o[d0], 0, 0, 0);   \
        o[d0] = __builtin_amdgcn_mfma_f32_32x32x16_bf16(pa1, (bf16x8){l1[0], l1[1], l1[2], l1[3], h1[0], h1[1], h1[2], h1[3]}, o[d0], 0, 0, 0);   \
        o[d0] = __builtin_amdgcn_mfma_f32_32x32x16_bf16(pa2, (bf16x8){l2[0], l2[1], l2[2], l2[3], h2[0], h2[1], h2[2], h2[3]}, o[d0], 0, 0, 0);   \
        o[d0] = __builtin_amdgcn_mfma_f32_32x32x16_bf16(pa3, (bf16x8){l3[0], l3[1], l3[2], l3[3], h3[0], h3[1], h3[2], h3[3]}, o[d0], 0, 0, 0); } while (0)
    PV_D0(0); PV_D0(1); PV_D0(2); PV_D0(3);
#undef PV_D0
#undef TRRD
}

typedef __attribute__((address_space(3))) const char* lds_cptr;
typedef short v4i16_t __attribute__((ext_vector_type(4)));
__device__ __forceinline__ s16x4 vtr(lds_cptr p) { return __builtin_bit_cast(s16x4, __builtin_amdgcn_ds_read_tr16_b64_v4i16((__attribute__((address_space(3))) v4i16_t*)p)); }
#define VRD(S, vp, d0) do { _Pragma("unroll") for (int ks_ = 0; ks_ < 4; ++ks_) { S[2 * ks_] = vtr((vp) + (d0) * 512 + ks_ * 4096); S[2 * ks_ + 1] = vtr((vp) + (d0) * 512 + ks_ * 4096 + 2048); } } while (0)
#define VFR(S, k) (bf16x8){S[2 * (k)][0], S[2 * (k)][1], S[2 * (k)][2], S[2 * (k)][3], S[2 * (k) + 1][0], S[2 * (k) + 1][1], S[2 * (k) + 1][2], S[2 * (k) + 1][3]}
#define PVMMA(S, d0) do { __builtin_amdgcn_s_setprio(1); o[d0] = __builtin_amdgcn_mfma_f32_32x32x16_bf16(pa0, VFR(S, 0), o[d0], 0, 0, 0); o[d0] = __builtin_amdgcn_mfma_f32_32x32x16_bf16(pa1, VFR(S, 1), o[d0], 0, 0, 0); \
        o[d0] = __builtin_amdgcn_mfma_f32_32x32x16_bf16(pa2, VFR(S, 2), o[d0], 0, 0, 0); o[d0] = __builtin_amdgcn_mfma_f32_32x32x16_bf16(pa3, VFR(S, 3), o[d0], 0, 0, 0); __builtin_amdgcn_s_setprio(0); } while (0)

typedef int v8i_t __attribute__((ext_vector_type(8))); typedef int v4i_t __attribute__((ext_vector_type(4)));
__device__ __forceinline__ unsigned pk4f8(float a, float b, float c, float d) { int w = 0; w = __builtin_amdgcn_cvt_pk_fp8_f32(a, b, w, false); w = __builtin_amdgcn_cvt_pk_fp8_f32(c, d, w, true); return (unsigned)w; }
template <int DQK> __device__ __forceinline__ int k8swz(int row, int chunk) {
    if constexpr (DQK == 192) return row * 256 + ((chunk ^ (row & 15)) << 4);
    else return row * 128 + ((chunk ^ ((row >> 1) & 7)) << 4);
}
template <int DQK>
__device__ __forceinline__ void qkt8(f32x16& p0, f32x16& p1, const char* kbuf, int r32, int hi, const v8i_t* q8, int f8scale) {
    constexpr int NS = DQK / 64, H32 = 32 * (DQK == 192 ? 256 : 128);
    v8i_t a0[NS], a1[NS];
#define K8LD(s_) do { const int c0 = 4 * (s_) + 2 * hi;                                                                          \
        const lds_cptr k0_ = (lds_cptr)kbuf + k8swz<DQK>(r32, c0), k1_ = (lds_cptr)kbuf + k8swz<DQK>(r32, c0 + 1);             \
        a0[s_].lo = *(const __attribute__((address_space(3))) v4i_t*)k0_; a0[s_].hi = *(const __attribute__((address_space(3))) v4i_t*)k1_;            \
        a1[s_].lo = *(const __attribute__((address_space(3))) v4i_t*)(k0_ + H32); a1[s_].hi = *(const __attribute__((address_space(3))) v4i_t*)(k1_ + H32); } while (0)
    K8LD(0); K8LD(1);
#pragma unroll
    for (int s_ = 0; s_ < NS; ++s_) {
        __builtin_amdgcn_s_setprio(1);
        if (s_ == 0) {
            asm volatile("v_mfma_scale_f32_32x32x64_f8f6f4 %0, %1, %2, 0, %3, %3 op_sel_hi:[0,0,0]" : "=&v"(p0) : "v"(a0[s_]), "v"(q8[s_]), "v"(f8scale));
            asm volatile("v_mfma_scale_f32_32x32x64_f8f6f4 %0, %1, %2, 0, %3, %3 op_sel_hi:[0,0,0]" : "=&v"(p1) : "v"(a1[s_]), "v"(q8[s_]), "v"(f8scale)); }
        else {
            asm volatile("v_mfma_scale_f32_32x32x64_f8f6f4 %0, %1, %2, %0, %3, %3 op_sel_hi:[0,0,0]" : "+v"(p0) : "v"(a0[s_]), "v"(q8[s_]), "v"(f8scale));
            asm volatile("v_mfma_scale_f32_32x32x64_f8f6f4 %0, %1, %2, %0, %3, %3 op_sel_hi:[0,0,0]" : "+v"(p1) : "v"(a1[s_]), "v"(q8[s_]), "v"(f8scale)); }
        __builtin_amdgcn_s_setprio(0);
        if (s_ == 0 && NS == 3) { ASBAR(); K8LD(2); } }
#undef K8LD
    asm volatile("s_nop 15\n\ts_nop 7" : "+v"(p0), "+v"(p1));
}
struct UnitArgs {
    const bf16_t* Q; int qpitch;
    const bf16_t* K; int kpitch;
    const bf16_t* Kr;
    const unsigned char* Q8; const unsigned char* K8; const unsigned char* Kr8; const unsigned char* V8;
    const bf16_t* V; int vpitch;
    bf16_t* O; int opitch;
    bf16_t* PO; float* PML;
    const int* pos; const int* tpmax;
    const unsigned* list; int nrows;
    int q0, k0, NT, h;
    float c2;
};
template <int DQK, int MODE>
__device__ __forceinline__ void attn_unit(const UnitArgs& A, char* lds, int wv) {
    int tid_ = wv * 64 + lane_id_(); asm volatile("" : "+v"(tid_)); const int tid = tid_, wid = wv, lane = tid & 63, r32 = lane & 31, hi = lane >> 5;
    constexpr bool F8 = true;
    constexpr int KT = F8 ? (DQK == 192 ? 16384 : 8192) : 64 * DQK * 2; constexpr int Q8P = DQK == 192 ? 3072 : 2048;
    char* V_lds = lds + L_V; char* K_lds = lds + L_K;
    float* ws = (float*)(lds + L_WS) + wid * 128; float* li_l = ws; float* al_l = ws + 32; int* ix_l = (int*)(ws + 64);
    const float* biasL = (const float*)(lds + L_BIAS) + A.h * 132;
    const int sr = tid >> 4, sc = (tid & 15) * 8, vst0 = v_st(sr, sc), vst1 = v_st(32 + sr, sc);
    const int kws0 = kswz<DQK>(sr, tid & 15), kws1 = kswz<DQK>(32 + sr, tid & 15);
    const int kws2 = (DQK == 192) ? kswz<DQK>(tid >> 3, 16 + (tid & 7)) : 0;
    const int k8w0 = k8swz<DQK>(tid >> 3, tid & 7), k8w2 = DQK == 192 ? k8swz<DQK>(tid >> 2, 8 + (tid & 3)) : 0;
    const int vb0 = (int)(uintptr_t)V_lds + v_rd_base(lane); (void)vb0;
    const int v8w = (tid >> 2) * 64 + (((tid & 3) ^ ((tid >> 4) & 3)) << 4), v8r = r32 * 64 + (((2 * hi) ^ ((r32 >> 2) & 3)) << 4);
    const lds_cptr vp0 = (lds_cptr)V_lds + v_rd_base(lane);
    bf16x8 st_k0, st_k1, st_k2, st_v0, st_v1;
#define SLOAD(t) do { const size_t kk_ = (size_t)(A.k0 + (t) * 64);                                                         \
        if constexpr (F8) st_v0 = ld8((const bf16_t*)(A.V8 + (kk_ >> 6) * 8192 + tid * 16));                             \
        else { st_v0 = ld8(A.V + (kk_ + sr) * A.vpitch + sc); st_v1 = ld8(A.V + (kk_ + 32 + sr) * A.vpitch + sc); }    \
        if constexpr (F8) { st_k0 = ld8((const bf16_t*)(A.K8 + (kk_ + (tid >> 3)) * 2048 + (tid & 7) * 16));             \
            if constexpr (DQK == 192) if (wid < 4) st_k2 = ld8((const bf16_t*)(A.Kr8 + (kk_ + (tid >> 2)) * 64 + (tid & 3) * 16)); }   \
        else { st_k0 = ld8(A.K + (kk_ + sr) * A.kpitch + sc); st_k1 = ld8(A.K + (kk_ + 32 + sr) * A.kpitch + sc);       \
            if constexpr (DQK == 192) st_k2 = ld8(A.Kr + (kk_ + (tid >> 3)) * 64 + (tid & 7) * 8); } } while (0)
#define SWRITE(bf) do { if constexpr (F8) *(bf16x8*)(V_lds + (bf) * VT_BYTES + v8w) = st_v0;                                  \
        else { *(bf16x8*)(V_lds + (bf) * VT_BYTES + vst0) = st_v0; *(bf16x8*)(V_lds + (bf) * VT_BYTES + vst1) = st_v1; } \
        if constexpr (F8) { *(bf16x8*)(K_lds + (bf) * KT + k8w0) = st_k0; if constexpr (DQK == 192) if (wid < 4) *(bf16x8*)(K_lds + (bf) * KT + k8w2) = st_k2; } \
        else { *(bf16x8*)(K_lds + (bf) * KT + kws0) = st_k0; *(bf16x8*)(K_lds + (bf) * KT + kws1) = st_k1;                 \
            if constexpr (DQK == 192) *(bf16x8*)(K_lds + (bf) * KT + kws2) = st_k2; } } while (0)
    SLOAD(0);
    int qrow, jslot = 3; bool valid = true;
    if constexpr (MODE == 1) { const int e = wid * 32 + r32; valid = e < A.nrows; const unsigned ent = A.list[valid ? e : 0]; qrow = (int)(ent & 0xffffu); jslot = (int)(ent >> 16); }
    else qrow = A.q0 + wid * 32 + r32;
    bf16x8 qr[F8 ? 1 : DQK / 16]; v8i_t q8[DQK / 64]; int f8scale = 0x7f7f7f7f;
    if constexpr (F8) { asm volatile("" : "+v"(f8scale));
#pragma unroll
        for (int s_ = 0; s_ < DQK / 64; ++s_) { const v4i_t* qp = (const v4i_t*)(A.Q8 + (size_t)qrow * Q8P + 64 * s_ + 32 * hi); q8[s_].lo = qp[0]; q8[s_].hi = qp[1]; } }
    else {
#pragma unroll
        for (int d0 = 0; d0 < DQK / 16; ++d0) qr[d0] = ld8(A.Q + (size_t)qrow * A.qpitch + d0 * 16 + hi * 8); }
    int posq = 0, qminw = 0;
    if constexpr (MODE != 0) { posq = A.pos[qrow]; int mn = posq;
#pragma unroll
        for (int o_ = 1; o_ < 64; o_ <<= 1) mn = min(mn, __shfl_xor(mn, o_));
        qminw = __builtin_amdgcn_readfirstlane(mn); }
    const int qlo = A.q0 + wid * 32;
    float m_reg = -1e30f, l_reg = 0.f; f32x16 o[4] = {};
    f32x16 o5 = {};
    f32x16 p0, p1; float alpha; bf16x8 pa0, pa1, pa2, pa3;
    const int NT = A.NT;
    SWRITE(0);
    __syncthreads();
    if constexpr (F8) {
#pragma unroll
        for (int s_ = 0; s_ < DQK / 64; ++s_) asm volatile("" : "+v"(q8[s_])); }
    else {
#pragma unroll
        for (int d0 = 0; d0 < DQK / 16; ++d0) asm volatile("" : "+v"(qr[d0])); }
#define KB_(t) (A.k0 + (t) * 64)
#define ACT(t) (MODE == 1 || KB_(t) <= qlo + 31)
#define NEEDMASK(t) (MODE != 1 && KB_(t) + 63 > qlo)
#define STEP(t, B) do {                                                                                                       \
        const bool more_ = (t) + 1 < NT;                                                                                      \
        if (more_) SLOAD((t) + 1);                                                                                            \
        if (ACT(t)) {                                                                                                         \
            ASBAR(); if constexpr (F8) qkt8<DQK>(p0, p1, K_lds + (B) * KT, r32, hi, q8, f8scale); else qkt<DQK>(p0, p1, K_lds + (B) * KT, r32, hi, qr);     \
            if constexpr (MODE != 0) {                                                                                                          \
                const int kmax_ = A.tpmax[KB_(t) >> 6];                                                                       \
                if (qminw - kmax_ >= 128) { const float bc = biasL[128];                                                      \
                    _Pragma("unroll") for (int r = 0; r < 16; ++r) { p0[r] = fmaf(p0[r], A.c2, bc); p1[r] = fmaf(p1[r], A.c2, bc); } }   \
                else {                                                                                                        \
                    _Pragma("unroll") for (int g4 = 0; g4 < 4; ++g4) {                                                        \
                        const i32x4 pk0 = *(const i32x4*)(A.pos + KB_(t) + 8 * g4 + 4 * hi);                                  \
                        const i32x4 pk1 = *(const i32x4*)(A.pos + KB_(t) + 32 + 8 * g4 + 4 * hi);                             \
                        _Pragma("unroll") for (int e = 0; e < 4; ++e) {                                                       \
                            const int d0_ = min(max(posq - pk0[e], 0), 128), d1_ = min(max(posq - pk1[e], 0), 128);           \
                            p0[4 * g4 + e] = fmaf(p0[4 * g4 + e], A.c2, biasL[d0_]); p1[4 * g4 + e] = fmaf(p1[4 * g4 + e], A.c2, biasL[d1_]); } } }   \
            }                                                                                                                 \
            if (NEEDMASK(t)) mask_tile(p0, p1, (qlo + r32 - 4 * hi) - KB_(t));                                                \
            partialSM<MODE == 0>(p0, p1, m_reg, alpha, A.c2);                                                                 \
            if (__any(alpha < 1.f)) { if (hi == 0) al_l[r32] = alpha; asm volatile("s_waitcnt lgkmcnt(0)" ::: "memory");      \
                _Pragma("unroll") for (int d_ = 0; d_ < 4; ++d_) _Pragma("unroll") for (int r = 0; r < 16; ++r) o[d_][r] *= al_l[crow(r, hi)];     \
                if constexpr (F8) { _Pragma("unroll") for (int r = 0; r < 16; ++r) o5[r] *= al_l[crow(r, hi)]; } }                                  \
            if constexpr (F8) { const lds_cptr vp_ = (lds_cptr)V_lds + (B) * VT_BYTES + v8r; v8i_t vf[4], p8;                   \
              _Pragma("unroll") for (int d_ = 0; d_ < 4; ++d_) { vf[d_].lo = *(const __attribute__((address_space(3))) v4i_t*)(vp_ + d_ * 2048);  \
                  vf[d_].hi = *(const __attribute__((address_space(3))) v4i_t*)((lds_cptr)V_lds + (B) * VT_BYTES + (v8r ^ 16) + d_ * 2048); }           \
              finishSM_e(p1);                                                                                                  \
              _Pragma("unroll") for (int j_ = 0; j_ < 4; ++j_) { p8[j_] = (int)pk4f8(p0[4 * j_], p0[4 * j_ + 1], p0[4 * j_ + 2], p0[4 * j_ + 3]);     \
                  p8[4 + j_] = (int)pk4f8(p1[4 * j_], p1[4 * j_ + 1], p1[4 * j_ + 2], p1[4 * j_ + 3]); }                       \
              __builtin_amdgcn_s_setprio(1);                                                                                   \
              _Pragma("unroll") for (int d_ = 0; d_ < 4; ++d_)                                                                 \
                  asm volatile("v_mfma_scale_f32_32x32x64_f8f6f4 %0, %1, %2, %0, %3, %3 op_sel_hi:[0,0,0]" : "+v"(o[d_]) : "v"(p8), "v"(vf[d_]), "v"(f8scale));   \
              { v8i_t ones8 = {0x38383838, 0x38383838, 0x38383838, 0x38383838, 0x38383838, 0x38383838, 0x38383838, 0x38383838}; asm volatile("" : "+v"(ones8));        \
                asm volatile("v_mfma_scale_f32_32x32x64_f8f6f4 %0, %1, %2, %0, %3, %3 op_sel_hi:[0,0,0]" : "+v"(o5) : "v"(p8), "v"(ones8), "v"(f8scale)); }        \
              __builtin_amdgcn_s_setprio(0); }                                                                                 \
            else { const lds_cptr vp_ = vp0 + (B) * VT_BYTES; s16x4 fa[8], fb[8];                                                    \
              finishSM_a(p0, p1, alpha, l_reg); PK4(p0, 0, pa0); PK4(p0, 8, pa1);                                             \
              VRD(fa, vp_, 0); PK4(p1, 0, pa2); PK4(p1, 8, pa3);                                                              \
              VRD(fb, vp_, 1); PVMMA(fa, 0); VRD(fa, vp_, 2); PVMMA(fb, 1); VRD(fb, vp_, 3); PVMMA(fa, 2); PVMMA(fb, 3); }    \
        }                                                                                                                     \
        if (more_) SWRITE((B) ^ 1);                                                                                           \
        __syncthreads(); } while (0)
    for (int t = 0; t < NT; t += 2) { STEP(t, 0); STEP(t + 1, 1); }
    if constexpr (F8) asm volatile("s_nop 15\n\ts_nop 7" : "+v"(o[0]), "+v"(o[1]), "+v"(o[2]), "+v"(o[3]), "+v"(o5));
#undef STEP
#undef ACT
#undef NEEDMASK
#undef KB_
#undef SLOAD
#undef SWRITE
    if (hi == 0) { if constexpr (!F8) li_l[r32] = l_reg; ix_l[r32] = valid ? (qrow * 16 + A.h) * 4 + jslot : -1; }
    asm volatile("s_waitcnt lgkmcnt(0)" ::: "memory");
    if constexpr (MODE != 0) { if (hi == 0 && valid) { float* ml = A.PML + (size_t)((qrow * 16 + A.h) * 4 + jslot) * 2; ml[0] = m_reg; if constexpr (!F8) ml[1] = l_reg; } }
#pragma unroll
    for (int r = 0; r < 16; ++r) { const int orow = crow(r, hi); const float rl = __builtin_amdgcn_rcpf(F8 ? o5[r] : li_l[orow]);
        bf16_t* dst; bool ok = true;
        if constexpr (MODE == 0) dst = A.O + (size_t)(qlo + orow) * A.opitch;
        else { const int ix = ix_l[orow]; ok = ix >= 0; dst = A.PO + (size_t)(ok ? ix : 0) * 128;
            if constexpr (F8) { if (r32 == 0 && ok) A.PML[(size_t)ix * 2 + 1] = o5[r]; } }
#pragma unroll
        for (int d0 = 0; d0 < 4; ++d0) { const float v = o[d0][r] * rl; const float vn = __shfl_xor(v, 1);
            if ((r32 & 1) == 0 && ok) *(unsigned*)(dst + d0 * 32 + r32) = cvtpk(v, vn); } }
    __syncthreads();
}
template <int MODE>
__device__ __forceinline__ void moba_unit(const UnitArgs& A, char* lds, int wv, int nchunk) {
    int tid_ = wv * 64 + lane_id_(); asm volatile("" : "+v"(tid_)); const int tid = tid_, wid = wv, lane = tid & 63, r32 = lane & 31, hi = lane >> 5;
    char* V_lds = lds + L_V; char* K_lds = lds + L_K;
    float* ws = (float*)(lds + L_WS) + wid * 128; float* al_l = ws + 32; int* ix_l = (int*)(ws + 64);
    const float* biasL = (const float*)(lds + L_BIAS) + A.h * 132;
    int qrow, jslot = 3, posq; bool valid = true; v8i_t q8[2]; unsigned ent = 0;
    if constexpr (MODE == 1) { const int e = wid * 32 + r32; valid = e < A.nrows; ent = A.list[valid ? e : 0]; }
    else qrow = A.q0 + wid * 32 + r32;
#define QLOAD(QF_, POSQ_, QROW_) do { _Pragma("unroll") for (int s_ = 0; s_ < 2; ++s_) { const v4i_t* qp = (const v4i_t*)(A.Q8 + (size_t)(QROW_) * 2048 + 64 * s_ + 32 * hi); QF_[s_].lo = qp[0]; QF_[s_].hi = qp[1]; } \
        POSQ_ = A.pos[QROW_]; } while (0)
    if constexpr (MODE != 1) QLOAD(q8, posq, qrow);
    { const int k8w0 = k8swz<128>(tid >> 3, tid & 7), v8w = (tid >> 2) * 64 + (((tid & 3) ^ ((tid >> 4) & 3)) << 4);
      bf16x8 sk[4], sv[4];
#pragma unroll
      for (int i = 0; i < 4; ++i) { const size_t kk_ = (size_t)(A.k0 + i * 64);
          sv[i] = ld8((const bf16_t*)(A.V8 + (kk_ >> 6) * 8192 + tid * 16)); sk[i] = ld8((const bf16_t*)(A.K8 + (kk_ + (tid >> 3)) * 2048 + (tid & 7) * 16)); }
      if constexpr (MODE == 1) { qrow = (int)(ent & 0xffffu); jslot = (int)(ent >> 16); QLOAD(q8, posq, qrow); }
#pragma unroll
      for (int i = 0; i < 4; ++i) { *(bf16x8*)(V_lds + i * 8192 + v8w) = sv[i]; *(bf16x8*)(K_lds + i * 8192 + k8w0) = sk[i]; } }
    __syncthreads();
    const int v8r = r32 * 64 + (((2 * hi) ^ ((r32 >> 2) & 3)) << 4);
    int f8scale = 0x7f7f7f7f; asm volatile("" : "+v"(f8scale));
    const int qlo = A.q0 + wid * 32;
#pragma unroll 1
    for (int c = 0; c < nchunk; ++c) {
        if (MODE == 1 && c * 256 + wid * 32 >= A.nrows) break;
        const bool has_next = MODE == 1 && (c + 1 < nchunk) && ((c + 1) * 256 + wid * 32 < A.nrows);
        unsigned entn = 0; bool validn = false; v8i_t q8n[2]; int posqn = 0, qrown = 0;
        if (has_next) { const int en = (c + 1) * 256 + wid * 32 + r32; validn = en < A.nrows; entn = A.list[validn ? en : 0]; }
        int qminw; { int mn = posq;
#pragma unroll
            for (int o_ = 1; o_ < 64; o_ <<= 1) mn = min(mn, __shfl_xor(mn, o_));
            qminw = __builtin_amdgcn_readfirstlane(mn); }
        float m_reg = -1e30f, alpha; f32x16 o[4] = {}, o5 = {}, p0, p1;
#pragma unroll
        for (int s_ = 0; s_ < 2; ++s_) asm volatile("" : "+v"(q8[s_]));
#define MTILE(t) do { const int kb_ = A.k0 + (t) * 64;                                                                          \
            if (MODE == 1 || kb_ <= qlo + 31) {                                                                               \
                ASBAR(); qkt8<128>(p0, p1, K_lds + (t) * 8192, r32, hi, q8, f8scale);                                         \
                const int kmax_ = A.tpmax[kb_ >> 6];                                                                          \
                if (qminw - kmax_ >= 128) { const float bc = biasL[128];                                                      \
                    _Pragma("unroll") for (int r = 0; r < 16; ++r) { p0[r] = fmaf(p0[r], A.c2, bc); p1[r] = fmaf(p1[r], A.c2, bc); } }   \
                else {                                                                                                        \
                    _Pragma("unroll") for (int g4 = 0; g4 < 4; ++g4) {                                                        \
                        const i32x4 pk0 = *(const i32x4*)(A.pos + kb_ + 8 * g4 + 4 * hi);                                     \
                        const i32x4 pk1 = *(const i32x4*)(A.pos + kb_ + 32 + 8 * g4 + 4 * hi);                                \
                        _Pragma("unroll") for (int e = 0; e < 4; ++e) {                                                       \
                            const int d0_ = min(max(posq - pk0[e], 0), 128), d1_ = min(max(posq - pk1[e], 0), 128);           \
                            p0[4 * g4 + e] = fmaf(p0[4 * g4 + e], A.c2, biasL[d0_]); p1[4 * g4 + e] = fmaf(p1[4 * g4 + e], A.c2, biasL[d1_]); } } }   \
                if (MODE != 1 && kb_ + 63 > qlo) mask_tile(p0, p1, (qlo + r32 - 4 * hi) - kb_);                               \
                partialSM<false>(p0, p1, m_reg, alpha, A.c2);                                                                 \
                if (__any(alpha < 1.f)) { if (hi == 0) al_l[r32] = alpha; asm volatile("s_waitcnt lgkmcnt(0)" ::: "memory");  \
                    _Pragma("unroll") for (int d_ = 0; d_ < 4; ++d_) _Pragma("unroll") for (int r = 0; r < 16; ++r) o[d_][r] *= al_l[crow(r, hi)];   \
                    _Pragma("unroll") for (int r = 0; r < 16; ++r) o5[r] *= al_l[crow(r, hi)]; }                              \
                { const lds_cptr vp_ = (lds_cptr)V_lds + (t) * 8192 + v8r; const lds_cptr vq_ = (lds_cptr)V_lds + (t) * 8192 + (v8r ^ 16); v8i_t vf[4], p8;   \
                  _Pragma("unroll") for (int d_ = 0; d_ < 4; ++d_) { vf[d_].lo = *(const __attribute__((address_space(3))) v4i_t*)(vp_ + d_ * 2048); vf[d_].hi = *(const __attribute__((address_space(3))) v4i_t*)(vq_ + d_ * 2048); }   \
                  finishSM_e(p1);                                                                                             \
                  _Pragma("unroll") for (int j_ = 0; j_ < 4; ++j_) { p8[j_] = (int)pk4f8(p0[4 * j_], p0[4 * j_ + 1], p0[4 * j_ + 2], p0[4 * j_ + 3]); p8[4 + j_] = (int)pk4f8(p1[4 * j_], p1[4 * j_ + 1], p1[4 * j_ + 2], p1[4 * j_ + 3]); }   \
                  __builtin_amdgcn_s_setprio(1);                                                                              \
                  _Pragma("unroll") for (int d_ = 0; d_ < 4; ++d_)                                                            \
                      asm volatile("v_mfma_scale_f32_32x32x64_f8f6f4 %0, %1, %2, %0, %3, %3 op_sel_hi:[0,0,0]" : "+v"(o[d_]) : "v"(p8), "v"(vf[d_]), "v"(f8scale));   \
                  { v8i_t ones8 = {0x38383838, 0x38383838, 0x38383838, 0x38383838, 0x38383838, 0x38383838, 0x38383838, 0x38383838}; asm volatile("" : "+v"(ones8));   \
                    asm volatile("v_mfma_scale_f32_32x32x64_f8f6f4 %0, %1, %2, %0, %3, %3 op_sel_hi:[0,0,0]" : "+v"(o5) : "v"(p8), "v"(ones8), "v"(f8scale)); }   \
                  __builtin_amdgcn_s_setprio(0); }                                                                            \
            } } while (0)
        MTILE(0); MTILE(1);
        if (has_next) { qrown = (int)(entn & 0xffffu); QLOAD(q8n, posqn, qrown); }
        MTILE(2); MTILE(3);
#undef MTILE
        asm volatile("s_nop 15\n\ts_nop 7" : "+v"(o[0]), "+v"(o[1]), "+v"(o[2]), "+v"(o[3]), "+v"(o5));
        if (hi == 0) ix_l[r32] = valid ? (qrow * 16 + A.h) * 4 + jslot : -1;
        asm volatile("s_waitcnt lgkmcnt(0)" ::: "memory");
        if (hi == 0 && valid) A.PML[(size_t)((qrow * 16 + A.h) * 4 + jslot) * 2] = m_reg;
#pragma unroll
        for (int r = 0; r < 16; ++r) { const int orow = crow(r, hi); const float rl = __builtin_amdgcn_rcpf(o5[r]);
            const int ix = ix_l[orow]; const bool ok = ix >= 0; bf16_t* dst = A.PO + (size_t)(ok ? ix : 0) * 128;
            if (r32 == 0 && ok) A.PML[(size_t)ix * 2 + 1] = o5[r];
#pragma unroll
            for (int d0 = 0; d0 < 4; ++d0) { const float v = o[d0][r] * rl; const float vn = __shfl_xor(v, 1);
                if ((r32 & 1) == 0 && ok) *(unsigned*)(dst + d0 * 32 + r32) = cvtpk(v, vn); } }
        asm volatile("s_waitcnt lgkmcnt(0)" ::: "memory");
        if (!has_next) break;
        qrow = qrown; jslot = (int)(entn >> 16); valid = validn; posq = posqn; q8[0] = q8n[0]; q8[1] = q8n[1];
    }
#undef QLOAD
    __syncthreads();
}
}
constexpr int NWAVES = 8;
constexpr int M_ = 16384, DM = 4096, DFF = 11008, NFF2 = 2 * DFF;
constexpr int NH = 16, QLORA = 1024, KVLORA = 512, ROPE = 64, NOPE = 128, VDIM = 128, QUP = NH * 192, KVUP = NH * 256, MLAOUT = NH * 128, MOBAW = NH * 128;
constexpr int INCOLS = 15936, INPAD1 = 5888, IN2 = 10240;
constexpr int MBLK = 256, NBLK = M_ / MBLK;
constexpr float RMS_EPS = 1e-6f;
constexpr size_t MiB = 1u << 20;
constexpr size_t WS_CTL = 0, CTL_ZERO_BYTES = 1 * MiB;
constexpr size_t WS_WFFN_IN = 1 * MiB;
constexpr size_t WS_WFFN_OUT = WS_WFFN_IN + (size_t)NFF2 * DM * 2;
constexpr size_t WS_WFFN_END = WS_WFFN_OUT + (size_t)DM * DFF * 2;
constexpr size_t WS_PO = WS_WFFN_IN;
constexpr size_t WS_WIN = WS_WFFN_END;
constexpr size_t WS_WIN8 = WS_WIN + (size_t)INPAD1 * DM * 2;
constexpr size_t WS_WUQ = WS_WIN8 + (size_t)IN2 * DM;
constexpr size_t WS_WUKV = WS_WUQ + (size_t)QUP * QLORA * 2;
constexpr size_t WS_WBRA = WS_WUKV + (size_t)KVUP * KVLORA * 2;
constexpr size_t WS_WBRB = WS_WBRA + (size_t)DM * MLAOUT * 2;
constexpr size_t WS_WOUT = WS_WBRB + (size_t)DM * MOBAW * 2;
constexpr size_t WS_H = WS_WOUT + (size_t)DM * DM * 2;
constexpr size_t WS_LIST = WS_H;
constexpr size_t LIST_PER_HEAD = 516096;
constexpr size_t WS_PML = WS_LIST + LIST_PER_HEAD * NH * 4;
constexpr size_t WS_BIG = WS_H + (size_t)M_ * DM * 2;
constexpr size_t WS_CQ = WS_BIG;
constexpr size_t WS_CKV = WS_CQ + (size_t)M_ * QLORA * 2;
constexpr size_t WS_KR = WS_CKV + (size_t)M_ * KVLORA * 2;
constexpr size_t WS_QB = WS_KR + (size_t)M_ * ROPE * 2;
constexpr size_t WS_KB = WS_QB + (size_t)M_ * MOBAW * 2;
constexpr size_t WS_VB = WS_KB + (size_t)M_ * MOBAW * 2;
constexpr size_t WS_GA = WS_VB + (size_t)M_ * MOBAW * 2;
constexpr size_t WS_GB = WS_GA + (size_t)M_ * DM * 2;
constexpr size_t WS_BIG_END = WS_GB + (size_t)M_ * DM * 2;
constexpr size_t WS_QM8 = WS_BIG_END;
constexpr size_t WS_KN8 = WS_QM8 + (size_t)M_ * QUP;
constexpr size_t WS_KR8 = WS_KN8 + (size_t)M_ * 2048;
constexpr size_t WS_V8 = WS_KR8 + (size_t)M_ * 64;
constexpr size_t WS_QB8 = WS_V8 + (size_t)M_ * 2048;
constexpr size_t WS_KB8 = WS_QB8 + (size_t)M_ * 2048;
constexpr size_t WS_VB8 = WS_KB8 + (size_t)M_ * 2048;
constexpr size_t WS_OA = WS_VB8 + (size_t)M_ * 2048;
constexpr size_t WS_COS = WS_OA + (size_t)M_ * MLAOUT * 2;
constexpr size_t WS_SIN = WS_COS + (size_t)M_ * 32 * 4;
constexpr size_t WS_KMH = WS_SIN + (size_t)M_ * 32 * 4;
constexpr size_t WS_KML = WS_KMH + (size_t)NH * NBLK * 128 * 2;
constexpr size_t WS_BIAS = WS_KML + (size_t)NH * NBLK * 128 * 2;
constexpr size_t WS_TPMAX = WS_BIAS + 16 * 132 * 4;
constexpr size_t WS_PART = WS_TPMAX + 256 * 4;
constexpr size_t WS_RSTD = WS_PART + (size_t)M_ * 64 * 4;
constexpr size_t WS_PARTQ = WS_RSTD + (size_t)M_ * 4;
constexpr size_t WS_PARTKV = WS_PARTQ + (size_t)M_ * 16 * 4;
constexpr size_t WS_RSTDQ = WS_PARTKV + (size_t)M_ * 8 * 4;
constexpr size_t WS_RSTDKV = WS_RSTDQ + (size_t)M_ * 4;
constexpr size_t WS_H8 = WS_RSTDKV + (size_t)M_ * 4;
constexpr size_t WS_OA8 = WS_H8 + (size_t)M_ * DM;
constexpr size_t WS_OB8 = WS_OA8 + (size_t)M_ * MLAOUT;
constexpr size_t WS_MG8 = WS_OB8 + (size_t)M_ * MOBAW;
constexpr size_t WS_PMAX = WS_MG8 + (size_t)M_ * DM;
constexpr size_t WS_CPART = WS_PMAX + (size_t)M_ * 64 * 4;
constexpr size_t WS_CMAXF = WS_CPART + (size_t)8 * 2 * NFF2 * 4;
constexpr size_t WS_CPARTO = WS_CMAXF + (size_t)2 * NFF2 * 4;
constexpr size_t WS_CMAXO = WS_CPARTO + (size_t)8 * DM * 4;
constexpr size_t WS_RSM = WS_CMAXO + (size_t)DM * 4;
constexpr size_t WS_QM = ((WS_RSM + (size_t)M_ * 4 + 4095) / 4096) * 4096;
constexpr size_t WS_KV = WS_QM + (size_t)M_ * QUP * 2;
constexpr size_t WS_WFI2 = MLA_BF16 ? WS_KV + (size_t)M_ * KVUP * 2 : WS_QM;
constexpr size_t WS_END = WS_WFI2 + (size_t)NFF2 * DM;
static_assert(WS_PML + (size_t)M_ * NH * 4 * 2 * 4 <= WS_BIG, "lists + ml inside H");
static_assert((size_t)M_ * NH * 4 * 128 * 2 <= WS_WFFN_END - WS_WFFN_IN, "partial O inside FFN weight region");
static_assert((size_t)M_ * DFF * 2 <= WS_BIG_END - WS_BIG, "act inside BIG");
constexpr int CW_TMO = 0;
constexpr int CW_BAR = 4096;
constexpr int CW_GCNT = 16384;
constexpr int CW_CMAX = 196608;
constexpr int CW_KMEAN = 65536;
constexpr int RING_OFF = 0, RING_BYTES = 131072;
constexpr int LDSCTL_OFF = RING_BYTES, MISC_OFF = LDSCTL_OFF + 320;
constexpr int LDS_BYTES = 147456;
static_assert(att::L_END <= RING_BYTES, "attention LDS inside ring region");

#define GAS __attribute__((address_space(1)))
#define LAS __attribute__((address_space(3)))
typedef unsigned short bf16;
typedef unsigned v4u __attribute__((ext_vector_type(4)));
typedef unsigned v2u __attribute__((ext_vector_type(2)));
typedef float f32x4 __attribute__((ext_vector_type(4)));
typedef short bf16x8 __attribute__((ext_vector_type(8)));
typedef float f32x16 __attribute__((ext_vector_type(16)));
typedef GAS unsigned gu32;
#define RLX_AGENT __ATOMIC_RELAXED, __HIP_MEMORY_SCOPE_AGENT
#define LDS_WAIT() asm volatile("s_waitcnt lgkmcnt(0)" ::: "memory")
__device__ __forceinline__ unsigned f2bf(float f) { unsigned u = __builtin_bit_cast(unsigned, f); return (u + 0x7fffu + ((u >> 16) & 1u)) >> 16; }
__device__ __forceinline__ unsigned pk2(float lo, float hi) { return f2bf(lo) | (f2bf(hi) << 16); }
__device__ __forceinline__ float bfu_lo(unsigned w) { return __uint_as_float(w << 16); }
__device__ __forceinline__ float bfu_hi(unsigned w) { return __uint_as_float(w & 0xffff0000u); }

#define XB_TMO      128
#define XB_XCNT(j)  (256  + 64 * (j))
#define XB_XSUB(j)  (1280 + 64 * (j))
#define XB_XGEN(j)  (2304 + 64 * (j))
#define XB_TOP      3328
#define XB_TOPGEN   3392
#define XCD_BAR_WORDS 3456
#define XB_SPIN_CAP (1u << 22)
__device__ __forceinline__ unsigned xb_ld(unsigned* p)              { return __hip_atomic_load(p, __ATOMIC_RELAXED, __HIP_MEMORY_SCOPE_AGENT); }
__device__ __forceinline__ unsigned xb_add(unsigned* p, unsigned v) { return __hip_atomic_fetch_add(p, v, __ATOMIC_RELAXED, __HIP_MEMORY_SCOPE_AGENT); }
__device__ __forceinline__ unsigned xb_xcc_id() { return (unsigned)__builtin_amdgcn_s_getreg((3 << 11) | 20) & 0xFu; }
#define XB_SPIN(cond, bar) do { unsigned _sp = 0; while (cond) { __builtin_amdgcn_s_sleep(1); \
    if ((++_sp & 255u) == 0u) { if (xb_ld(&(bar)[XB_TMO])) break; if (_sp > XB_SPIN_CAP) { atomicAdd(&(bar)[XB_TMO], 1u); break; } } } } while (0)
struct XcdBarrier { unsigned* bar; unsigned x; volatile LAS unsigned* st; };
__device__ __forceinline__ XcdBarrier xcd_barrier_post(unsigned* bar, volatile LAS unsigned* st, int wv) {
    XcdBarrier b; b.bar = bar; b.x = xb_xcc_id(); b.st = st;
    if (wv == 0 && lane_id_() == 0) (void)xb_add(&bar[XB_XCNT(b.x)], 1u);
    return b;
}
__device__ __forceinline__ void xcd_barrier_complete(unsigned* bar, unsigned x, unsigned& nloc, unsigned& nx) {
    const unsigned G = gridDim.x * gridDim.y * gridDim.z;
    unsigned sum, cnt, mine, sp = 0u;
    for (;;) {
        sum = 0u; cnt = 0u; mine = 0u;
#pragma unroll
        for (unsigned j = 0; j < 16; ++j) { const unsigned c = xb_ld(&bar[XB_XCNT(j)]); sum += c; cnt += (c > 0u) ? 1u : 0u; mine = (j == x) ? c : mine; }
        if (sum == G) break;
        __builtin_amdgcn_s_sleep(1);
        if ((++sp & 255u) == 0u) { if (xb_ld(&bar[XB_TMO])) break; if (sp > XB_SPIN_CAP) { atomicAdd(&bar[XB_TMO], 1u); break; } }
    }
    nloc = mine > 0u ? mine : 1u; nx = cnt > 0u ? cnt : 1u;
}
__device__ __forceinline__ void xcd_barrier(const XcdBarrier& b, int wv) {
    asm volatile("s_waitcnt vmcnt(0)" ::: "memory");
    __syncthreads();
    if (wv == 0 && lane_id_() == 0) {
        unsigned* bar = b.bar;
        __builtin_amdgcn_s_waitcnt(0);
        unsigned nloc = b.st[0], nx = b.st[1];
        if (nloc == 0u) { xcd_barrier_complete(bar, b.x, nloc, nx); b.st[0] = nloc; b.st[1] = nx; }
        const unsigned old = xb_add(&bar[XB_XSUB(b.x)], 1u);
        const unsigned gen = old / nloc;
        if (old + 1u == (gen + 1u) * nloc) {
            __builtin_amdgcn_fence(__ATOMIC_RELEASE, "agent");
            asm volatile("s_waitcnt vmcnt(0)" ::: "memory");
            const unsigned og = xb_add(&bar[XB_TOP], 1u);
            const unsigned tg = og / nx;
            if (og + 1u == (tg + 1u) * nx) xb_add(&bar[XB_TOPGEN], 1u);
            else XB_SPIN(xb_ld(&bar[XB_TOPGEN]) == tg, bar);
            __builtin_amdgcn_fence(__ATOMIC_ACQUIRE, "agent");
            xb_add(&bar[XB_XGEN(b.x)], 1u);
            asm volatile("s_waitcnt vmcnt(0)" ::: "memory");
        } else {
            XB_SPIN(xb_ld(&bar[XB_XGEN(b.x)]) == gen, bar);
            __builtin_amdgcn_fence(__ATOMIC_ACQUIRE, "agent");
            asm volatile("s_waitcnt vmcnt(0)" ::: "memory");
        }
    }
    __syncthreads();
}
struct Args {
    const float* in[19]; float* out; unsigned char* ws;
    double invf[32];
    unsigned char bucket[136];
};
__device__ __forceinline__ float wave_sum(float v) {
#pragma unroll
    for (int o = 1; o < 64; o <<= 1) v += __shfl_xor(v, o);
    return v;
}
__device__ __forceinline__ void cvt_item(const float* W, int Nsrc, int scol0, bool ropep, bf16* Wt, int K, int drow0, int k0, LAS unsigned char* T, int lane, const float* gain, int tiledN = 0, int f8s = -1, const float* cmax = nullptr, int cstride = 0, float* cmfinal = nullptr) {
    const int rp = lane >> 4, c4 = lane & 15;
    if (scol0 >= 0) {
#pragma unroll
        for (int i = 0; i < 8; ++i) { const int k = 8 * i + 2 * rp;
            f32x4 a = __builtin_nontemporal_load((const GAS f32x4*)(W + (size_t)(k0 + k) * Nsrc + scol0 + 4 * c4));
            f32x4 b = __builtin_nontemporal_load((const GAS f32x4*)(W + (size_t)(k0 + k + 1) * Nsrc + scol0 + 4 * c4));
            if (gain) { a = a * gain[k0 + k]; b = b * gain[k0 + k + 1]; }
#pragma unroll
            for (int e = 0; e < 4; ++e) { const int c = 4 * c4 + e; *(LAS unsigned*)(T + c * 136 + k * 2) = pk2(a[e], b[e]); } }
    }
    LDS_WAIT(); asm volatile("" ::: "memory");
    const int kc = lane & 7, nr = lane >> 3;
#pragma unroll
    for (int j = 0; j < 8; ++j) { const int c = 8 * j + nr;
        v4u o = {0u, 0u, 0u, 0u};
        if (scol0 >= 0) { const v2u lo = *(const LAS v2u*)(T + c * 136 + kc * 16), hi2 = *(const LAS v2u*)(T + c * 136 + kc * 16 + 8); o.x = lo.x; o.y = lo.y; o.z = hi2.x; o.w = hi2.y; }
        int p = c; if (ropep) { const int half = c >> 5, i5 = c & 31; p = 8 * (i5 >> 2) + (i5 & 3) + 4 * half; }
        if (cmax) {
            float cm = 0.f;
#pragma unroll
            for (int sg_ = 0; sg_ < 8; ++sg_) cm = fmaxf(cm, cmax[(size_t)sg_ * cstride + scol0 + c]);
            if (k0 == 0 && kc == 0) cmfinal[scol0 + c] = cm;
            const float inv = 127.f / fmaxf(cm, 1e-30f); const float v8[8] = {bfu_lo(o.x), bfu_hi(o.x), bfu_lo(o.y), bfu_hi(o.y), bfu_lo(o.z), bfu_hi(o.z), bfu_lo(o.w), bfu_hi(o.w)};
            unsigned q0 = 0, q1 = 0;
#pragma unroll
            for (int e = 0; e < 4; ++e) { q0 |= ((unsigned)(int)rintf(v8[e] * inv) & 0xffu) << (8 * e); q1 |= ((unsigned)(int)rintf(v8[4 + e] * inv) & 0xffu) << (8 * e); }
            v2u q; q.x = q0; q.y = q1;
            *(GAS v2u*)((unsigned char*)Wt + ((size_t)(k0 >> 7) * tiledN + drow0 + p) * 128 + (k0 & 64) + 8 * kc) = q; }
        else if (f8s >= 0) {
            const float scl = __uint_as_float((unsigned)(127 + f8s) << 23); v2u q;
            int w0 = 0, w1 = 0;
            w0 = __builtin_amdgcn_cvt_pk_fp8_f32(bfu_lo(o.x) * scl, bfu_hi(o.x) * scl, w0, false); w0 = __builtin_amdgcn_cvt_pk_fp8_f32(bfu_lo(o.y) * scl, bfu_hi(o.y) * scl, w0, true);
            w1 = __builtin_amdgcn_cvt_pk_fp8_f32(bfu_lo(o.z) * scl, bfu_hi(o.z) * scl, w1, false); w1 = __builtin_amdgcn_cvt_pk_fp8_f32(bfu_lo(o.w) * scl, bfu_hi(o.w) * scl, w1, true);
            q.x = (unsigned)w0; q.y = (unsigned)w1;
            *(GAS v2u*)((unsigned char*)Wt + ((size_t)(k0 >> 7) * tiledN + drow0 + p) * 128 + (k0 & 64) + 8 * kc) = q; }
        else if (tiledN) *(GAS v4u*)(Wt + ((size_t)(k0 >> 6) * tiledN + drow0 + p) * 64 + 8 * kc) = o;
        else *(GAS v4u*)(Wt + (size_t)(drow0 + p) * K + k0 + 8 * kc) = o; }
    LDS_WAIT(); asm volatile("" ::: "memory");
}
template <int KIND>
__device__ __forceinline__ void cvt_job(const float* W, int K, int Nsrc, bf16* Wt, int ndb, LAS unsigned char* T, int gw, int NGW, int lane, const float* gain = nullptr, int tiledN = 0, int f8s = -1, const float* cmax = nullptr, int cstride = 0, float* cmfinal = nullptr, int jph = 0, int jnp = 1) {
    const int nkb = K / 64, nit = ndb * nkb;
    for (int it = gw + NGW * jph; it < nit; it += NGW * jnp) { const int db = it / nkb, kb = it - db * nkb;
        int scol = 64 * db; bool rp = false;
        if constexpr (KIND == 1) { const int pn = db >> 2, sub = db & 3; scol = (sub < 2) ? (128 * pn + 64 * sub) : (DFF + 128 * pn + 64 * (sub - 2)); }
        if constexpr (KIND == 2) { if (db < 24) scol = 64 * db; else if (db < 88) scol = 64 * db + 64; else if (db == 88) { scol = 1536; rp = true; } else scol = -1; }
        if constexpr (KIND == 4) { scol = 5696 + 64 * db; }
        if constexpr (KIND == 3) { rp = (db % 3) == 2; }
        cvt_item(W, Nsrc, scol, rp, Wt, K, 64 * db, 64 * kb, T, lane, gain, tiledN, f8s, cmax, cstride, cmfinal); }
}
template <bool OUTF32>
__device__ __forceinline__ void rms_row4096(const float* xrow, const float* g, void* orow, int lane, int tiledM = 0) {
    const GAS f32x4* xr = (const GAS f32x4*)xrow + lane;
    f32x4 v[16]; float s = 0.f;
#pragma unroll
    for (int j = 0; j < 16; ++j) { v[j] = xr[64 * j]; s += (v[j].x * v[j].x + v[j].y * v[j].y) + (v[j].z * v[j].z + v[j].w * v[j].w); }
    const float rstd = 1.0f / sqrtf(wave_sum(s) * (1.f / DM) + RMS_EPS);
    const GAS f32x4* gr = (const GAS f32x4*)g + lane;
#pragma unroll
    for (int j = 0; j < 16; ++j) { const f32x4 gg = gr[64 * j]; const f32x4 y = (v[j] * rstd) * gg;
        if constexpr (OUTF32) ((GAS f32x4*)orow)[64 * j + lane] = y;
        else { v2u w; w.x = pk2(y.x, y.y); w.y = pk2(y.z, y.w);
            if (tiledM) { const int col = 4 * (64 * j + lane); *(GAS v2u*)((bf16*)orow + ((size_t)(col >> 6) * tiledM) * 64 + (col & 63)) = w; }
            else ((GAS v2u*)orow)[64 * j + lane] = w; } }
}
template <int N>
__device__ __forceinline__ void rms_row_bf16(bf16* row, const float* g, int lane) {
    constexpr int NV = N / 512;
    v4u w[NV]; float s = 0.f;
#pragma unroll
    for (int j = 0; j < NV; ++j) { w[j] = *(const GAS v4u*)(row + (64 * j + lane) * 8);
#pragma unroll
        for (int e = 0; e < 4; ++e) { const float a = bfu_lo(w[j][e]), b = bfu_hi(w[j][e]); s += a * a + b * b; } }
    const float rstd = 1.0f / sqrtf(wave_sum(s) * (1.f / N) + RMS_EPS);
#pragma unroll
    for (int j = 0; j < NV; ++j) { const GAS f32x4* gp = (const GAS f32x4*)(g + (64 * j + lane) * 8); const f32x4 g0 = gp[0], g1 = gp[1]; v4u o;
        o.x = pk2(bfu_lo(w[j].x) * rstd * g0.x, bfu_hi(w[j].x) * rstd * g0.y); o.y = pk2(bfu_lo(w[j].y) * rstd * g0.z, bfu_hi(w[j].y) * rstd * g0.w);
        o.z = pk2(bfu_lo(w[j].z) * rstd * g1.x, bfu_hi(w[j].z) * rstd * g1.y); o.w = pk2(bfu_lo(w[j].w) * rstd * g1.z, bfu_hi(w[j].w) * rstd * g1.w);
        *(GAS v4u*)(row + (64 * j + lane) * 8) = o; }
}
__device__ __forceinline__ void colmax_job(const float* W, int K, int N, float* cpart, int cstride, int gw, int NGW, int lane) {
    const int nseg = K / 512, ntask = (N / 64) * nseg, rp = lane >> 4, c4 = lane & 15;
    for (int it = gw; it < ntask; it += NGW) { const int cb = it / nseg, sg = it - cb * nseg; f32x4 m = {0.f, 0.f, 0.f, 0.f};
        const float* wp = W + (size_t)(sg * 512 + rp) * N + cb * 64 + 4 * c4;
#pragma unroll 8
        for (int i = 0; i < 128; ++i) { const f32x4 v = __builtin_nontemporal_load((const GAS f32x4*)(wp + (size_t)(4 * i) * N));
            m[0] = fmaxf(m[0], fabsf(v[0])); m[1] = fmaxf(m[1], fabsf(v[1])); m[2] = fmaxf(m[2], fabsf(v[2])); m[3] = fmaxf(m[3], fabsf(v[3])); }
#pragma unroll
        for (int e = 0; e < 4; ++e) { float x = m[e]; x = fmaxf(x, __shfl_xor(x, 16)); x = fmaxf(x, __shfl_xor(x, 32)); if (rp == 0) cpart[(size_t)sg * cstride + cb * 64 + 4 * c4 + e] = x; } }
}
__device__ __forceinline__ void quant_row_plain_i8(const bf16* T, unsigned char* a8, int row, float* rs, int lane) {
    const GAS v4u* src = (const GAS v4u*)(T + (size_t)row * DM + lane * 64);
    v4u w[8]; float mx = 0.f;
#pragma unroll
    for (int j = 0; j < 8; ++j) w[j] = src[j];
#pragma unroll
    for (int j = 0; j < 8; ++j)
#pragma unroll
        for (int e = 0; e < 4; ++e) mx = fmaxf(mx, fmaxf(fabsf(bfu_lo(w[j][e])), fabsf(bfu_hi(w[j][e]))));
#pragma unroll
    for (int o = 1; o < 64; o <<= 1) mx = fmaxf(mx, __shfl_xor(mx, o));
    mx = fmaxf(mx, 1e-30f); const float inv = 127.f / mx;
    v4u o[4];
#pragma unroll
    for (int j = 0; j < 8; ++j) { unsigned q0 = 0, q1 = 0;
#pragma unroll
        for (int e = 0; e < 2; ++e) { const unsigned a = w[j][e], b2 = w[j][2 + e];
            q0 |= (((unsigned)(int)rintf(bfu_lo(a) * inv) & 0xffu) | (((unsigned)(int)rintf(bfu_hi(a) * inv) & 0xffu) << 8)) << (16 * e);
            q1 |= (((unsigned)(int)rintf(bfu_lo(b2) * inv) & 0xffu) | (((unsigned)(int)rintf(bfu_hi(b2) * inv) & 0xffu) << 8)) << (16 * e); }
        o[j >> 1][2 * (j & 1)] = q0; o[j >> 1][2 * (j & 1) + 1] = q1; }
    GAS v4u* dst = (GAS v4u*)(a8 + ((size_t)(lane >> 1) * M_ + row) * 128 + (lane & 1) * 64);
#pragma unroll
    for (int j = 0; j < 4; ++j) dst[j] = o[j];
    if (lane == 0) rs[row] = mx * (1.f / 127.f);
}
__device__ __forceinline__ void rms_row4096_i8(const float* xrow, const float* g, unsigned char* a8, int row, float* rs, int lane) {
    const GAS f32x4* xr = (const GAS f32x4*)xrow + lane;
    f32x4 v[16]; float s = 0.f;
#pragma unroll
    for (int j = 0; j < 16; ++j) { v[j] = xr[64 * j]; s += (v[j].x * v[j].x + v[j].y * v[j].y) + (v[j].z * v[j].z + v[j].w * v[j].w); }
    const float rstd = 1.0f / sqrtf(wave_sum(s) * (1.f / DM) + RMS_EPS);
    const GAS f32x4* gr = (const GAS f32x4*)g + lane; float mx = 0.f;
#pragma unroll
    for (int j = 0; j < 16; ++j) { const f32x4 gg = gr[64 * j]; v[j] = (v[j] * rstd) * gg; mx = fmaxf(fmaxf(mx, fmaxf(fabsf(v[j].x), fabsf(v[j].y))), fmaxf(fabsf(v[j].z), fabsf(v[j].w))); }
#pragma unroll
    for (int o = 1; o < 64; o <<= 1) mx = fmaxf(mx, __shfl_xor(mx, o));
    mx = fmaxf(mx, 1e-30f); const float inv = 127.f / mx;
#pragma unroll
    for (int j = 0; j < 16; ++j) { const int col = 4 * (64 * j + lane);
        const unsigned q = ((unsigned)(int)rintf(v[j].x * inv) & 0xffu) | (((unsigned)(int)rintf(v[j].y * inv) & 0xffu) << 8) | (((unsigned)(int)rintf(v[j].z * inv) & 0xffu) << 16) | (((unsigned)(int)rintf(v[j].w * inv) & 0xffu) << 24);
        *(GAS unsigned*)(a8 + ((size_t)(col >> 7) * M_ + row) * 128 + (col & 127)) = q; }
    if (lane == 0) rs[row] = mx * (1.f / 127.f);
}
__device__ __forceinline__ void quant_row_i8(const bf16* hb, const float* part, const float* pmax, unsigned char* a8, int row, float* rs, int lane) {
    float s = part[(size_t)row * 64 + lane], mx = pmax[(size_t)row * 64 + lane];
    s = wave_sum(s);
#pragma unroll
    for (int o = 1; o < 64; o <<= 1) mx = fmaxf(mx, __shfl_xor(mx, o));
    mx = fmaxf(mx, 1e-30f); const float inv = 127.f / mx;
    const GAS v4u* src = (const GAS v4u*)(hb + ((size_t)lane * M_ + row) * 64);
    v4u w[8];
#pragma unroll
    for (int j = 0; j < 8; ++j) w[j] = src[j];
    v4u o[4];
#pragma unroll
    for (int j = 0; j < 8; ++j) { unsigned q0 = 0, q1 = 0;
#pragma unroll
        for (int e = 0; e < 2; ++e) { const unsigned a = w[j][e], b = w[j][2 + e];
            q0 |= (((unsigned)(int)rintf(bfu_lo(a) * inv) & 0xffu) | (((unsigned)(int)rintf(bfu_hi(a) * inv) & 0xffu) << 8)) << (16 * e);
            q1 |= (((unsigned)(int)rintf(bfu_lo(b) * inv) & 0xffu) | (((unsigned)(int)rintf(bfu_hi(b) * inv) & 0xffu) << 8)) << (16 * e); }
        o[j >> 1][2 * (j & 1)] = q0; o[j >> 1][2 * (j & 1) + 1] = q1; }
    GAS v4u* dst = (GAS v4u*)(a8 + ((size_t)(lane >> 1) * M_ + row) * 128 + (lane & 1) * 64);
#pragma unroll
    for (int j = 0; j < 4; ++j) dst[j] = o[j];
    if (lane == 0) rs[row] = mx * (1.f / 127.f) / sqrtf(s * (1.f / DM) + RMS_EPS);
}
template <int NP>
__device__ __forceinline__ void rstd_reduce(const float* part, float* rstd, float inv_n, int vcu, int tid, int G) {
    for (int row = vcu * (NWAVES * 64) + tid; row < M_; row += G * NWAVES * 64) { float s = 0.f;
#pragma unroll
        for (int j = 0; j < NP / 4; ++j) { const f32x4 v = *(const GAS f32x4*)(part + (size_t)row * NP + 4 * j); s += (v.x + v.y) + (v.z + v.w); }
        rstd[row] = 1.0f / sqrtf(s * inv_n + RMS_EPS); }
}
__device__ __forceinline__ void sincos_d(double a, float& sn, float& cs) {
    const double k = rint(a * 0.63661977236758134308);
    double r = fma(-k, 1.57079632679489655800, a); r = fma(-k, 6.12323399573676603587e-17, r);
    const double r2 = r * r;
    const double sp = r + r * r2 * (-1.0 / 6 + r2 * (1.0 / 120 + r2 * (-1.0 / 5040 + r2 * (1.0 / 362880 + r2 * (-1.0 / 39916800)))));
    const double cp = 1.0 + r2 * (-0.5 + r2 * (1.0 / 24 + r2 * (-1.0 / 720 + r2 * (1.0 / 40320 + r2 * (-1.0 / 3628800 + r2 * (1.0 / 479001600))))));
    const int q = (int)((long long)k & 3);
    const double s_ = (q & 1) ? cp : sp, c_ = (q & 1) ? sp : cp;
    sn = (float)((q & 2) ? -s_ : s_); cs = (float)(((q + 1) & 2) ? -c_ : c_);
}
__device__ __forceinline__ int list_off(int kb) { return 16384 * kb - 128 * kb * (kb + 1); }
__device__ __forceinline__ bool better(float v, int i, float cv, int ci) { return v > cv || (v == cv && i < ci); }
#define TOP3_INS(v_, i_) do { const float vv_ = (v_); const int ii_ = (i_);                                             \
        const bool c0_ = better(vv_, ii_, tv0, ti0), c1_ = better(vv_, ii_, tv1, ti1), c2_ = better(vv_, ii_, tv2, ti2); \
        tv2 = c1_ ? tv1 : (c2_ ? vv_ : tv2); ti2 = c1_ ? ti1 : (c2_ ? ii_ : ti2);                                       \
        tv1 = c0_ ? tv0 : (c1_ ? vv_ : tv1); ti1 = c0_ ? ti0 : (c1_ ? ii_ : ti1);                                       \
        tv0 = c0_ ? vv_ : tv0; ti0 = c0_ ? ii_ : ti0; } while (0)
__device__ __forceinline__ void moba_gate_unit(int h, int qb, const bf16* QB, const float* KMF, unsigned* gcnt, unsigned* list, float* PML,
                                               LAS unsigned* cntL, LAS unsigned* baseL, int wv) {
    int tid_ = wv * 64 + lane_id_(); asm volatile("" : "+v"(tid_)); const int tid = tid_, wid = wv, lane = tid & 63, r32 = lane & 31, hi = lane >> 5;
    if (tid < 64) cntL[tid] = 0u;
    __syncthreads();
    const int s = qb * MBLK + wid * 32 + r32;
    bf16x8 qr[8];
#pragma unroll
    for (int d0 = 0; d0 < 8; ++d0) qr[d0] = *(const GAS bf16x8*)(QB + (size_t)s * MOBAW + h * 128 + d0 * 16 + hi * 8);
    f32x16 p0 = {}, p1 = {};
#pragma unroll
    for (int d0 = 0; d0 < 8; ++d0) {
#pragma unroll
        for (int half = 0; half < 2; ++half) { const float* kp = KMF + (size_t)(h * NBLK + half * 32 + r32) * 128 + d0 * 16 + hi * 8;
            const f32x4 a = *(const GAS f32x4*)kp, b = *(const GAS f32x4*)(kp + 4); const float v[8] = {a[0], a[1], a[2], a[3], b[0], b[1], b[2], b[3]};
            bf16x8 fh, fl;
#pragma unroll
            for (int j = 0; j < 8; ++j) { const unsigned hb_ = f2bf(v[j]); fh[j] = (short)hb_; fl[j] = (short)f2bf(v[j] - __uint_as_float(hb_ << 16)); }
            if (half == 0) { p0 = __builtin_amdgcn_mfma_f32_32x32x16_bf16(fh, qr[d0], p0, 0, 0, 0); p0 = __builtin_amdgcn_mfma_f32_32x32x16_bf16(fl, qr[d0], p0, 0, 0, 0); }
            else { p1 = __builtin_amdgcn_mfma_f32_32x32x16_bf16(fh, qr[d0], p1, 0, 0, 0); p1 = __builtin_amdgcn_mfma_f32_32x32x16_bf16(fl, qr[d0], p1, 0, 0, 0); } } }
    const float NEG = -__builtin_inff();
    float tv0 = NEG, tv1 = NEG, tv2 = NEG; int ti0 = 1000, ti1 = 1001, ti2 = 1002;
#pragma unroll
    for (int r = 0; r < 16; ++r) { const int n = (r & 3) + 8 * (r >> 2) + 4 * hi; TOP3_INS(n < qb ? p0[r] : NEG, n); }
#pragma unroll
    for (int r = 0; r < 16; ++r) { const int n = 32 + (r & 3) + 8 * (r >> 2) + 4 * hi; TOP3_INS(n < qb ? p1[r] : NEG, n); }
    { const float ov0 = __shfl_xor(tv0, 32), ov1 = __shfl_xor(tv1, 32), ov2 = __shfl_xor(tv2, 32);
      const int oi0 = __shfl_xor(ti0, 32), oi1 = __shfl_xor(ti1, 32), oi2 = __shfl_xor(ti2, 32);
      TOP3_INS(ov0, oi0); TOP3_INS(ov1, oi1); TOP3_INS(ov2, oi2); }
    const bool act = (hi == 0);
    const bool ok0 = act && tv0 > NEG, ok1 = act && tv1 > NEG, ok2 = act && tv2 > NEG;
    unsigned rk0 = 0, rk1 = 0, rk2 = 0;
    if (ok0) rk0 = atomicAdd((unsigned*)(cntL + ti0), 1u);
    if (ok1) rk1 = atomicAdd((unsigned*)(cntL + ti1), 1u);
    if (ok2) rk2 = atomicAdd((unsigned*)(cntL + ti2), 1u);
    if (act) { float* ml = PML + (size_t)((s * 16 + h) * 4) * 2;
        if (!ok0) { ml[0] = -1e30f; ml[1] = 0.f; } if (!ok1) { ml[2] = -1e30f; ml[3] = 0.f; } if (!ok2) { ml[4] = -1e30f; ml[5] = 0.f; } }
    __syncthreads();
    if (tid < 64) { const unsigned n = cntL[tid]; baseL[tid] = n ? atomicAdd(gcnt + h * NBLK + tid, n) : 0u; }
    __syncthreads();
    unsigned* lh = list + (size_t)h * LIST_PER_HEAD;
    if (ok0) lh[list_off(ti0) + baseL[ti0] + rk0] = (unsigned)s | (0u << 16);
    if (ok1) lh[list_off(ti1) + baseL[ti1] + rk1] = (unsigned)s | (1u << 16);
    if (ok2) lh[list_off(ti2) + baseL[ti2] + rk2] = (unsigned)s | (2u << 16);
    __syncthreads();
}
#if PROBE_PHASE == 500
constexpr int CW_FAIL = 8;
__device__ __forceinline__ float blk_reduce(float v, bool domax, float* red, int tid) {
#pragma unroll
    for (int o = 1; o < 64; o <<= 1) { const float y = __shfl_xor(v, o); v = domax ? fmaxf(v, y) : v + y; }
    __syncthreads();
    if ((tid & 63) == 0) red[tid >> 6] = v;
    __syncthreads();
    float r = red[0];
    for (int w = 1; w < 8; ++w) r = domax ? fmaxf(r, red[w]) : r + red[w];
    return r;
}
__device__ __forceinline__ float bfv(const bf16* p) { return __uint_as_float(((unsigned)*p) << 16); }
__device__ __forceinline__ int sample_row(int i) {
    const int fixed[16] = {0, 1, 31, 32, 63, 64, 255, 256, 257, 511, 512, 767, 1023, 8191, 16383, 16128};
    if (i < 16) return fixed[i];
    return (int)(((unsigned)i * 2654435761u) >> 18) & 16383;
}
__device__ __forceinline__ void selfcheck(unsigned char* lds, unsigned char* ws, const int* pos, const bf16* OBc, int G, int bid) {
    const int tid = threadIdx.x;
    float* lg = (float*)lds;
    float* red = (float*)(lds + 65536);
    float* po = (float*)(lds + 65536 + 64);
    float* gate = (float*)(lds + 65536 + 64 + 2048);
    int* sel = (int*)(lds + 65536 + 64 + 2048 + 256);
    gu32* ctl = (gu32*)(ws + WS_CTL);
    bf16* KR = (bf16*)(ws + WS_KR); bf16* QB = (bf16*)(ws + WS_QB); bf16* KB = (bf16*)(ws + WS_KB); bf16* VB = (bf16*)(ws + WS_VB);
    bf16* QM = (bf16*)(ws + WS_QM); bf16* KV = (bf16*)(ws + WS_KV); bf16* OA = (bf16*)(ws + WS_OA); float* BIAS = (float*)(ws + WS_BIAS);
    unsigned nbad = 0;
    for (int u = bid; u < 64 * 16; u += G) { const int s = sample_row(u >> 4), h = u & 15;
        { const bf16* q = QM + (size_t)s * QUP + h * 192; float mx = -1e30f;
          for (int k = tid; k <= s; k += 512) { const bf16* kn = KV + (size_t)k * KVUP + h * 256; const bf16* kr = KR + (size_t)k * 64; float a = 0.f;
              for (int d = 0; d < 128; ++d) a += bfv(q + d) * bfv(kn + d);
              for (int d = 0; d < 64; ++d) a += bfv(q + 128 + d) * bfv(kr + d);
              a *= 0.07216878364870322f; lg[k] = a; mx = fmaxf(mx, a); }
          mx = blk_reduce(mx, true, red, tid);
          float sm = 0.f; for (int k = tid; k <= s; k += 512) { const float p = expf(lg[k] - mx); lg[k] = p; sm += p; }
          sm = blk_reduce(sm, false, red, tid);
          const int d = tid & 127, part = tid >> 7; float o = 0.f;
          for (int k = part; k <= s; k += 4) o += lg[k] * bfv(KV + (size_t)k * KVUP + h * 256 + 128 + d);
          po[part * 128 + d] = o; __syncthreads();
          float amax = 0.f;
          if (tid < 128) { const float ref = (po[tid] + po[128 + tid] + po[256 + tid] + po[384 + tid]) / sm; po[tid] = ref; amax = fabsf(ref); }
          amax = blk_reduce(amax, true, red, tid);
          if (tid < 128) { const float got = bfv(OA + (size_t)s * MLAOUT + h * 128 + tid); if (!(fabsf(got - po[tid]) <= SELFCHECK_REL * amax + SELFCHECK_ABS)) nbad++; }
          __syncthreads(); }
        { const bf16* q = QB + (size_t)s * MOBAW + h * 128; const int qb = s >> 8; const int d = tid & 127, part = tid >> 7;
          for (int n = 0; n < qb; ++n) { float a = 0.f;
              for (int r = part * 64; r < part * 64 + 64; ++r) a += bfv(KB + (size_t)(n * 256 + r) * MOBAW + h * 128 + d);
              a = a * (1.f / 256.f) * bfv(q + d);
              a = blk_reduce(a, false, red, tid);
              if (tid == 0) gate[n] = a; }
          __syncthreads();
          if (tid == 0) { float g0 = -1e30f, g1 = -1e30f, g2 = -1e30f; int i0 = -1, i1 = -1, i2 = -1;
              for (int n = 0; n < qb; ++n) { const float g = gate[n];
                  if (g > g0) { g2 = g1; i2 = i1; g1 = g0; i1 = i0; g0 = g; i0 = n; } else if (g > g1) { g2 = g1; i2 = i1; g1 = g; i1 = n; } else if (g > g2) { g2 = g; i2 = n; } }
              sel[0] = i0; sel[1] = i1; sel[2] = i2; sel[3] = qb; }
          __syncthreads();
          float mx = -1e30f; const int pq = pos[s];
          for (int e = tid; e < 1024; e += 512) { const int j = e >> 8, kk = e & 255; const int blk = sel[j]; float a = -1e30f;
              if (blk >= 0) { const int key = blk * 256 + kk;
                  if (j < 3 || key <= s) { const bf16* kp = KB + (size_t)key * MOBAW + h * 128; float dsum = 0.f;
                      for (int dd = 0; dd < 128; ++dd) dsum += bfv(q + dd) * bfv(kp + dd);
                      int dist = pq - pos[key]; dist = dist < 0 ? 0 : (dist > 128 ? 128 : dist);
                      a = dsum * (0.08838834764831845f * 1.4426950408889634f) + BIAS[h * 132 + dist]; } }
              lg[e] = a; mx = fmaxf(mx, a); }
          mx = blk_reduce(mx, true, red, tid);
          float sm = 0.f; for (int e = tid; e < 1024; e += 512) { const float p = lg[e] > -1e29f ? exp2f(lg[e] - mx) : 0.f; lg[e] = p; sm += p; }
          sm = blk_reduce(sm, false, red, tid);
          float o = 0.f;
          for (int e = part; e < 1024; e += 4) { const int blk = sel[e >> 8]; if (blk >= 0 && lg[e] > 0.f) o += lg[e] * bfv(VB + (size_t)(blk * 256 + (e & 255)) * MOBAW + h * 128 + d); }
          po[part * 128 + d] = o; __syncthreads();
          float amax = 0.f;
          if (tid < 128) { const float ref = (po[tid] + po[128 + tid] + po[256 + tid] + po[384 + tid]) / sm; po[tid] = ref; amax = fabsf(ref); }
          amax = blk_reduce(amax, true, red, tid);
          if (tid < 128) { const float got = bfv(OBc + (size_t)s * MOBAW + h * 128 + tid); if (!(fabsf(got - po[tid]) <= SELFCHECK_REL * amax + SELFCHECK_ABS)) nbad++; }
          __syncthreads(); }
    }
    if (nbad) atomicAdd((unsigned*)(ctl + CW_FAIL), nbad);
}
#endif
struct NoConv { __device__ __forceinline__ void operator()(int, int, unsigned char*) const {} };
struct P7Conv {
    const Args& args; int vcu;
    __device__ __forceinline__ void operator()(int s, int wave, unsigned char* lds) const { int lane_ = lane_id_(); asm volatile("" : "+v"(lane_)); const int lane = lane_;
        unsigned char* ws = args.ws; const int NGW = (int)gridDim.x * NWAVES, gw = vcu * NWAVES + wave;
        LAS unsigned char* T = (LAS unsigned char*)lds + RING_OFF + wave * 8704;
        cvt_job<1>(args.in[16], DM, NFF2, (bf16*)(ws + WS_WFI2), NFF2 / 64, T, gw, NGW, lane, nullptr, NFF2, -1, (const float*)(ws + WS_CPART) + NFF2, 2 * NFF2, (float*)(ws + WS_CMAXF) + NFF2, s, 4);
        cvt_job<0>(args.in[12], MLAOUT, DM, (bf16*)(ws + WS_WBRA), DM / 64, T, gw, NGW, lane, nullptr, FP8_BR ? DM : 0, FP8_BR ? 5 : -1, nullptr, 0, nullptr, (s + 1) & 3, 4);
        cvt_job<0>(args.in[13], MOBAW, DM, (bf16*)(ws + WS_WBRB), DM / 64, T, gw, NGW, lane, nullptr, FP8_BR ? DM : 0, FP8_BR ? 5 : -1, nullptr, 0, nullptr, (s + 2) & 3, 4);
#if I8_OUT
        cvt_job<0>(args.in[14], DM, DM, (bf16*)(ws + WS_WOUT), DM / 64, T, gw, NGW, lane, nullptr, DM, -1, (const float*)(ws + WS_CPARTO), DM, (float*)(ws + WS_CMAXO), (s + 1) & 3, 4); }
#else
        cvt_job<0>(args.in[14], DM, DM, (bf16*)(ws + WS_WOUT), DM / 64, T, gw, NGW, lane, nullptr, FP8_OUT ? DM : 0, FP8_OUT ? 6 : -1, nullptr, 0, nullptr, (s + 1) & 3, 4); }
#endif
};
template <int WHICH, class Conv>
__device__ __forceinline__ void p7_attention(unsigned char* lds, unsigned char* ws, const int* pos, int G, int bid, int wv, Conv conv) {
    int tid_ = wv * 64 + lane_id_(); asm volatile("" : "+v"(tid_)); const int tid = tid_, lane = tid & 63, wave = wv;
    gu32* ctl = (gu32*)(ws + WS_CTL); unsigned* GCNT = (unsigned*)(ctl + CW_GCNT);
    bf16* KR = (bf16*)(ws + WS_KR); bf16* QB = (bf16*)(ws + WS_QB); bf16* KB = (bf16*)(ws + WS_KB); bf16* VB = (bf16*)(ws + WS_VB);
    bf16* QM = (bf16*)(ws + WS_QM); bf16* KV = (bf16*)(ws + WS_KV); bf16* OA = (bf16*)(ws + WS_OA);
    float* BIAS = (float*)(ws + WS_BIAS); int* TPMAX = (int*)(ws + WS_TPMAX);
    unsigned* LIST = (unsigned*)(ws + WS_LIST); float* PML = (float*)(ws + WS_PML); bf16* PO = (bf16*)(ws + WS_PO);
        float* biasL = (float*)(lds + att::L_BIAS); unsigned* pref = (unsigned*)(lds + att::L_PREF); unsigned* wtot = pref + 1028;
        for (int i = tid; i < 16 * 132; i += NWAVES * 64) biasL[i] = BIAS[i];
        unsigned* cntS = (unsigned*)(lds + att::L_CNT);
        { const unsigned ca = __hip_atomic_load(GCNT + 2 * tid, RLX_AGENT), cb = __hip_atomic_load(GCNT + 2 * tid + 1, RLX_AGENT); cntS[2 * tid] = ca; cntS[2 * tid + 1] = cb;
          const unsigned a = (ca + 511u) >> 9, b = (cb + 511u) >> 9;
          unsigned s = a + b;
#pragma unroll
          for (int o_ = 1; o_ < 64; o_ <<= 1) { const unsigned y = __shfl_up(s, o_); if (lane >= o_) s += y; }
          if (lane == 63) wtot[wave] = s;
          __syncthreads();
          unsigned offs = 0; for (int w = 0; w < wave; ++w) offs += wtot[w];
          const unsigned incl = s + offs; pref[2 * tid] = incl - a - b; pref[2 * tid + 1] = incl - b; if (tid == NWAVES * 64 - 1) pref[1024] = incl; }
        __syncthreads();
        const int U = (int)pref[1024];
        int cslot = 0;
        const float c2_mla = 0.07216878364870322f * 1.4426950408889634f;
        const float c2_moba = 0.08838834764831845f * 1.4426950408889634f;
        if constexpr (WHICH & 1) for (int p = bid; p < 512; p += G) { const int h = p & 15, xx = p >> 4;
#pragma unroll 1
            for (int k = 0; k < 2; ++k) { const int qb = k ? xx : 63 - xx;
                att::UnitArgs A; A.Q = QM + h * 192; A.qpitch = QUP; A.K = KV + h * 256; A.kpitch = KVUP; A.Kr = KR; A.Q8 = ws + WS_QM8 + h * 192; A.K8 = ws + WS_KN8 + h * 128; A.Kr8 = ws + WS_KR8; A.V8 = ws + WS_V8 + (size_t)h * 256 * 8192; A.V = KV + h * 256 + 128; A.vpitch = KVUP;
                A.O = OA + h * 128; A.opitch = MLAOUT; A.PO = nullptr; A.PML = nullptr; A.pos = pos; A.tpmax = TPMAX; A.list = nullptr; A.nrows = 256;
                A.q0 = qb * 256; A.k0 = 0; A.NT = 4 * (qb + 1); A.h = h; A.c2 = c2_mla;
                att::attn_unit<192, 0>(A, (char*)lds, wv);
                if (cslot < 4) { conv(cslot++, wv, lds); __syncthreads(); } } }
        if constexpr (WHICH & 1) while (cslot < 4) { conv(cslot++, wv, lds); __syncthreads(); }
        if constexpr (WHICH & 2) for (int u = bid; u < U; u += G) {
            int lo = 0, hi_ = 1024;
            while (hi_ - lo > 1) { const int mid = (lo + hi_) >> 1; if (pref[mid] <= (unsigned)u) lo = mid; else hi_ = mid; }
            const int h = lo >> 6, kb = lo & 63, c = u - (int)pref[lo];
            const int cnt = (int)cntS[lo];
            att::UnitArgs A; A.Q = QB + h * 128; A.qpitch = MOBAW; A.K = KB + h * 128; A.kpitch = MOBAW; A.Kr = nullptr; A.Q8 = ws + WS_QB8 + h * 128; A.K8 = ws + WS_KB8 + h * 128; A.Kr8 = nullptr; A.V8 = ws + WS_VB8 + (size_t)h * 256 * 8192; A.V = VB + h * 128; A.vpitch = MOBAW;
            A.O = nullptr; A.opitch = 0; A.PO = PO; A.PML = PML; A.pos = pos; A.tpmax = TPMAX;
            A.list = LIST + (size_t)h * LIST_PER_HEAD + list_off(kb) + c * 512; A.nrows = min(512, cnt - c * 512);
            A.q0 = 0; A.k0 = kb * 256; A.NT = 4; A.h = h; A.c2 = c2_moba;
            att::moba_unit<1>(A, (char*)lds, wv, (A.nrows + 255) >> 8); }
        if constexpr (WHICH & 4) for (int u = bid; u < NBLK * NH; u += G) { const int h = u & 15, qb = u >> 4;
            att::UnitArgs A; A.Q = QB + h * 128; A.qpitch = MOBAW; A.K = KB + h * 128; A.kpitch = MOBAW; A.Kr = nullptr; A.Q8 = ws + WS_QB8 + h * 128; A.K8 = ws + WS_KB8 + h * 128; A.Kr8 = nullptr; A.V8 = ws + WS_VB8 + (size_t)h * 256 * 8192; A.V = VB + h * 128; A.vpitch = MOBAW;
            A.O = nullptr; A.opitch = 0; A.PO = PO; A.PML = PML; A.pos = pos; A.tpmax = TPMAX; A.list = nullptr; A.nrows = 256;
            A.q0 = qb * 256; A.k0 = qb * 256; A.NT = 4; A.h = h; A.c2 = c2_moba;
            att::moba_unit<2>(A, (char*)lds, wv, 1); }
}
__global__ void __launch_bounds__(NWAVES * 64, 2) hybrid_fwd(Args args) {
    extern __shared__ __attribute__((aligned(16))) unsigned char lds[];
    LAS unsigned char* ldsl = (LAS unsigned char*)lds;
    volatile LAS unsigned* MISC = (volatile LAS unsigned*)(ldsl + MISC_OFF);
    const int tid = threadIdx.x, lane = tid & 63, wave = __builtin_amdgcn_readfirstlane(tid >> 6);
    const int G = gridDim.x, bid = blockIdx.x;
    const int vcu = (G % 8 == 0) ? (bid % 8) * (G / 8) + bid / 8 : bid;
    const int gw = vcu * NWAVES + wave, NGW = G * NWAVES;
    unsigned char* ws = args.ws;
    gu32* ctl = (gu32*)(ws + WS_CTL);
    for (int u = tid; u < (LDS_BYTES - LDSCTL_OFF) / 4; u += NWAVES * 64) ((LAS unsigned*)(ldsl + LDSCTL_OFF))[u] = 0u;
    __syncthreads();
    XcdBarrier bar = xcd_barrier_post((unsigned*)(ctl + CW_BAR), MISC + 8, wave);
#if PROBE_PHASE == 99
#define GRID_BAR() do { xcd_barrier(bar, wave); xcd_barrier(bar, wave); } while (0)
#else
#define GRID_BAR() xcd_barrier(bar, wave)
#endif
    const float* x = args.in[0]; const int* pos = (const int*)args.in[1]; const float* rel_bias = args.in[2];
    float* out = args.out;
    bf16* WFI = (bf16*)(ws + WS_WFFN_IN); bf16* WFO = (bf16*)(ws + WS_WFFN_OUT); bf16* WIN = (bf16*)(ws + WS_WIN); bf16* WUQ = (bf16*)(ws + WS_WUQ);
    bf16* WUKV = (bf16*)(ws + WS_WUKV); bf16* WBRA = (bf16*)(ws + WS_WBRA); bf16* WBRB = (bf16*)(ws + WS_WBRB); bf16* WOUT = (bf16*)(ws + WS_WOUT);
    bf16* H = (bf16*)(ws + WS_H); bf16* ACT = (bf16*)(ws + WS_BIG);
    bf16* CQ = (bf16*)(ws + WS_CQ); bf16* CKV = (bf16*)(ws + WS_CKV); bf16* KR = (bf16*)(ws + WS_KR); bf16* QB = (bf16*)(ws + WS_QB); bf16* KB = (bf16*)(ws + WS_KB);
    bf16* VB = (bf16*)(ws + WS_VB); bf16* GA = (bf16*)(ws + WS_GA); bf16* GB = (bf16*)(ws + WS_GB);
    bf16* QM = (bf16*)(ws + WS_QM); bf16* KV = (bf16*)(ws + WS_KV); bf16* OA = (bf16*)(ws + WS_OA);
    float* COS = (float*)(ws + WS_COS); float* SIN = (float*)(ws + WS_SIN);
    bf16* KMH = (bf16*)(ws + WS_KMH); bf16* KML = (bf16*)(ws + WS_KML); float* BIAS = (float*)(ws + WS_BIAS); int* TPMAX = (int*)(ws + WS_TPMAX);
    unsigned* LIST = (unsigned*)(ws + WS_LIST); float* PML = (float*)(ws + WS_PML); bf16* PO = (bf16*)(ws + WS_PO);
    unsigned* GCNT = (unsigned*)(ctl + CW_GCNT);
    float* PART = (float*)(ws + WS_PART); float* RSTD = (float*)(ws + WS_RSTD); float* PARTQ = (float*)(ws + WS_PARTQ); float* PARTKV = (float*)(ws + WS_PARTKV);
    float* RSTDQ = (float*)(ws + WS_RSTDQ); float* RSTDKV = (float*)(ws + WS_RSTDKV); bf16* H3 = GB; (void)RSTDQ; (void)RSTDKV;
    float* CPART = (float*)(ws + WS_CPART); float* CMAXF = (float*)(ws + WS_CMAXF); const float* CMAX1 = CMAXF; const float* CMAX2 = CMAXF + NFF2; float* PMAX = (float*)(ws + WS_PMAX);
    unsigned char* H8 = ws + WS_H8; unsigned char* OA8 = ws + WS_OA8; unsigned char* OB8 = ws + WS_OB8; unsigned char* MG8 = ws + WS_MG8; unsigned char* WIN8 = ws + WS_WIN8;
#if PROBE_PHASE == 500
    bf16* OBC = (bf16*)(ws + ((WS_END + 4095) / 4096) * 4096);
#else
    bf16* OBC = QB;
#endif
    LAS unsigned char* cvtT = ldsl + RING_OFF + wave * 8704;

    { int tid_f = wave * 64 + lane_id_(); asm volatile("" : "+v"(tid_f)); const int tid = tid_f, lane = tid & 63; (void)lane; (void)tid;
    {
    colmax_job(args.in[4], DM, NFF2, CPART, 2 * NFF2, gw, NGW, lane); colmax_job(args.in[16], DM, NFF2, CPART + NFF2, 2 * NFF2, gw, NGW, lane);
#if I8_OUT
    colmax_job(args.in[14], DM, DM, (float*)(ws + WS_CPARTO), DM, gw, NGW, lane);
#endif
    cvt_job<2>(args.in[7], DM, INCOLS, WIN, INPAD1 / 64, cvtT, gw, NGW, lane, nullptr, INPAD1);
    cvt_job<4>(args.in[7], DM, INCOLS, (bf16*)WIN8, IN2 / 64, cvtT, gw, NGW, lane, nullptr, IN2, 6);
    cvt_job<3>(args.in[9], QLORA, QUP, WUQ, QUP / 64, cvtT, gw, NGW, lane, args.in[8]);
    cvt_job<0>(args.in[11], KVLORA, KVUP, WUKV, KVUP / 64, cvtT, gw, NGW, lane, args.in[10]);
    for (int idx = vcu * (NWAVES * 64) + tid; idx < M_ * 32; idx += G * NWAVES * 64) { const int s = idx >> 5, i = idx & 31;
        float sn, cs; sincos_d((double)pos[s] * args.invf[i], sn, cs); COS[idx] = cs; SIN[idx] = sn; }
    for (int idx = vcu * (NWAVES * 64) + tid; idx < 16 * 132; idx += G * NWAVES * 64) { const int h = idx / 132, d = idx - h * 132;
        BIAS[idx] = d <= 128 ? rel_bias[(int)args.bucket[d] * NH + h] * 1.4426950408889634f : 0.f; }
    for (int t = gw; t < 256; t += NGW) { int p = pos[t * 64 + lane];
#pragma unroll
        for (int o_ = 1; o_ < 64; o_ <<= 1) p = max(p, __shfl_xor(p, o_));
        if (lane == 0) TPMAX[t] = p; }
    for (int m = gw; m < M_; m += NGW) rms_row4096_i8(x + (size_t)m * DM, args.in[3], H8, m, RSTD, lane);
    }
#if PROBE_PHASE == 0
    {
    colmax_job(args.in[4], DM, NFF2, CPART, 2 * NFF2, gw, NGW, lane); colmax_job(args.in[16], DM, NFF2, CPART + NFF2, 2 * NFF2, gw, NGW, lane);
#if I8_OUT
    colmax_job(args.in[14], DM, DM, (float*)(ws + WS_CPARTO), DM, gw, NGW, lane);
#endif
    cvt_job<2>(args.in[7], DM, INCOLS, WIN, INPAD1 / 64, cvtT, gw, NGW, lane, nullptr, INPAD1);
    cvt_job<4>(args.in[7], DM, INCOLS, (bf16*)WIN8, IN2 / 64, cvtT, gw, NGW, lane, nullptr, IN2, 6);
    cvt_job<3>(args.in[9], QLORA, QUP, WUQ, QUP / 64, cvtT, gw, NGW, lane, args.in[8]);
    cvt_job<0>(args.in[11], KVLORA, KVUP, WUKV, KVUP / 64, cvtT, gw, NGW, lane, args.in[10]);
    for (int idx = vcu * (NWAVES * 64) + tid; idx < M_ * 32; idx += G * NWAVES * 64) { const int s = idx >> 5, i = idx & 31;
        float sn, cs; sincos_d((double)pos[s] * args.invf[i], sn, cs); COS[idx] = cs; SIN[idx] = sn; }
    for (int idx = vcu * (NWAVES * 64) + tid; idx < 16 * 132; idx += G * NWAVES * 64) { const int h = idx / 132, d = idx - h * 132;
        BIAS[idx] = d <= 128 ? rel_bias[(int)args.bucket[d] * NH + h] * 1.4426950408889634f : 0.f; }
    for (int t = gw; t < 256; t += NGW) { int p = pos[t * 64 + lane];
#pragma unroll
        for (int o_ = 1; o_ < 64; o_ <<= 1) p = max(p, __shfl_xor(p, o_));
        if (lane == 0) TPMAX[t] = p; }
    for (int m = gw; m < M_; m += NGW) rms_row4096_i8(x + (size_t)m * DM, args.in[3], H8, m, RSTD, lane);
    }
#endif
    }
    GRID_BAR();
#if PROBE_PHASE == 300
    {
        const bf16x8 fa = *(const GAS bf16x8*)(H + (size_t)(bid * 512 + tid) * 8), fb = *(const GAS bf16x8*)(H + (size_t)(bid * 512 + tid) * 8 + 65536);
        f32x4 ac[8];
#pragma unroll
        for (int i = 0; i < 8; ++i) ac[i] = (f32x4){0.f, 0.f, 0.f, 0.f};
#pragma unroll 1
        for (int it = 0; it < 5120; ++it) {
#pragma unroll
            for (int i = 0; i < 8; ++i) ac[i] = __builtin_amdgcn_mfma_f32_16x16x32_bf16(fa, fb, ac[i], 0, 0, 0); }
        float sacc = 0.f;
#pragma unroll
        for (int i = 0; i < 8; ++i) sacc += ac[i][0] + ac[i][1] + ac[i][2] + ac[i][3];
        if (sacc == 12345.678f) out[0] = 1.f;
    }
#endif
    { int tid_f = wave * 64 + lane_id_(); asm volatile("" : "+v"(tid_f)); const int lane = tid_f & 63;
      cvt_job<1>(args.in[4], DM, NFF2, WFI, NFF2 / 64, cvtT, gw, NGW, lane, nullptr, NFF2, -1, CPART, 2 * NFF2, CMAXF); }
    GRID_BAR();
    { pg8::Gemm g{(const bf16*)H8, WFI, M_, NFF2, DM / 2}; pg8::StaticOrder S; S.init(M_, NFF2, G, bid); pg8::EpiSwiglu E{ACT, DFF, RSTD, M_, CMAX1};
      pg8::gemm_phase<pg8::EpiSwiglu, pg8::StaticOrder, true, true, true, false, true>(ldsl + RING_OFF, g, S, E, wave); }
#if PROBE_PHASE == 1
    { pg8::Gemm g{(const bf16*)H8, WFI, M_, NFF2, DM / 2}; pg8::StaticOrder S; S.init(M_, NFF2, G, bid); pg8::EpiSwiglu E{ACT, DFF, RSTD, M_, CMAX1};
      pg8::gemm_phase<pg8::EpiSwiglu, pg8::StaticOrder, true, true, true, false, true>(ldsl + RING_OFF, g, S, E, wave); }
#endif
    if (G == 256 && bid >= 128) { int tid_f = wave * 64 + lane_id_(); asm volatile("" : "+v"(tid_f)); const int lane = tid_f & 63;
        cvt_job<0>(args.in[5], DFF, DM, WFO, DM / 64, cvtT, (bid - 128) * NWAVES + wave, 128 * NWAVES, lane, nullptr, DM); }
    else if (G != 256) { int tid_f = wave * 64 + lane_id_(); asm volatile("" : "+v"(tid_f)); const int lane = tid_f & 63; cvt_job<0>(args.in[5], DFF, DM, WFO, DM / 64, cvtT, gw, NGW, lane, nullptr, DM); }
    GRID_BAR();
    { pg8::Gemm g{ACT, WFO, M_, DM, DFF}; pg8::StaticOrder S; S.init(M_, DM, G, bid); pg8::EpiResidNorm<(long)WS_H8 - (long)WS_H> E{x, out, 0.5f, H, args.in[6], PART, nullptr};
      pg8::gemm_phase<pg8::EpiResidNorm<(long)WS_H8 - (long)WS_H>, pg8::StaticOrder, true, true, true>(ldsl + RING_OFF, g, S, E, wave); }
#if PROBE_PHASE == 2
    { pg8::Gemm g{ACT, WFO, M_, DM, DFF}; pg8::StaticOrder S; S.init(M_, DM, G, bid); pg8::EpiResidNorm<(long)WS_H8 - (long)WS_H> E{x, out, 0.5f, H, args.in[6], PART, nullptr};
      pg8::gemm_phase<pg8::EpiResidNorm<(long)WS_H8 - (long)WS_H>, pg8::StaticOrder, true, true, true>(ldsl + RING_OFF, g, S, E, wave); }
#endif
#if PROBE_PHASE == 801 || PROBE_PHASE == 802
    GRID_BAR();
    { pg8::Gemm g{ACT, WFO, PROBE_PHASE == 801 ? M_ : 0, PROBE_PHASE == 801 ? DM : 0, DFF}; pg8::StaticOrder S; S.init(M_, DM, G, bid); pg8::EpiNull E{};
      pg8::gemm_phase<pg8::EpiNull, pg8::StaticOrder, true, true, true>(ldsl + RING_OFF, g, S, E, wave); }
#endif
#if PROBE_PHASE == 803 || PROBE_PHASE == 804
    GRID_BAR();
    { pg8::Gemm g{(const bf16*)H8, WFI, PROBE_PHASE == 803 ? M_ : 0, PROBE_PHASE == 803 ? NFF2 : 0, DM / 2}; pg8::StaticOrder S; S.init(M_, NFF2, G, bid); pg8::EpiNull E{};
      pg8::gemm_phase<pg8::EpiNull, pg8::StaticOrder, true, true, true, false, true>(ldsl + RING_OFF, g, S, E, wave); }
#endif
    GRID_BAR();
    { int tid_f = wave * 64 + lane_id_(); asm volatile("" : "+v"(tid_f)); const int tid = tid_f, lane = tid & 63; (void)lane; (void)tid;
    rstd_reduce<64>(PART, RSTD, 1.f / DM, vcu, tid, G);
#if PROBE_PHASE == 3 || PROBE_PHASE == 38
    rstd_reduce<64>(PART, RSTD, 1.f / DM, vcu, tid, G);
#endif
    }
    GRID_BAR();
    { pg8::Gemm g{H, WIN, M_, INPAD1, DM}; pg8::StaticOrder S; S.init(M_, INPAD1, G, bid);
      pg8::EpiProj<1> E{CQ, CKV, KR, QB, KB, VB, GA, GB, COS, SIN, RSTD, PARTQ, PARTKV, (float*)(ctl + CW_KMEAN), ws + WS_KR8, ws + WS_QB8, ws + WS_KB8, ws + WS_VB8, 1.0f};
      pg8::gemm_phase<pg8::EpiProj<1>, pg8::StaticOrder, true, true, true>(ldsl + RING_OFF, g, S, E, wave); }
    { pg8::Gemm g{(const bf16*)H8, (const bf16*)WIN8, M_, IN2, DM / 2}; pg8::StaticOrder S; S.init(M_, IN2, G, bid);
      pg8::EpiProj<2> E{CQ, CKV, KR, QB, KB, VB, GA, GB, COS, SIN, RSTD, PARTQ, PARTKV, (float*)(ctl + CW_KMEAN), ws + WS_KR8, ws + WS_QB8, ws + WS_KB8, ws + WS_VB8, 0.015625f};
      pg8::gemm_phase<pg8::EpiProj<2>, pg8::StaticOrder, true, true, true, true>(ldsl + RING_OFF, g, S, E, wave); }
    GRID_BAR();
    { LAS unsigned* cntL = (LAS unsigned*)(ldsl + RING_OFF); LAS unsigned* baseL = cntL + 64;
      for (int u = bid; u < NBLK * NH; u += G) moba_gate_unit(u & 15, u >> 4, QB, (const float*)(ctl + CW_KMEAN), GCNT, LIST, PML, cntL, baseL, wave); }
    { pg8::Gemm g{CQ, WUQ, M_, QUP, QLORA}; pg8::StaticOrder S; S.init(M_, QUP, G, bid); pg8::EpiQ E{MLA_BF16 ? QM : nullptr, COS, SIN, PARTQ, ws + WS_QM8};
      pg8::gemm_phase<pg8::EpiQ, pg8::StaticOrder, true, true>(ldsl + RING_OFF, g, S, E, wave); }
    { pg8::Gemm g{CKV, WUKV, M_, KVUP, KVLORA}; pg8::StaticOrder S; S.init(M_, KVUP, G, bid); pg8::EpiPlain E{MLA_BF16 ? KV : nullptr, KVUP, PARTKV, ws + WS_KN8, ws + WS_V8};
      pg8::gemm_phase<pg8::EpiPlain, pg8::StaticOrder, true, true>(ldsl + RING_OFF, g, S, E, wave); }
#if PROBE_PHASE == 6
    { pg8::Gemm g{CQ, WUQ, M_, QUP, QLORA}; pg8::StaticOrder S; S.init(M_, QUP, G, bid); pg8::EpiQ E{MLA_BF16 ? QM : nullptr, COS, SIN, PARTQ, ws + WS_QM8};
      pg8::gemm_phase<pg8::EpiQ, pg8::StaticOrder, true, true>(ldsl + RING_OFF, g, S, E, wave); }
    { pg8::Gemm g{CKV, WUKV, M_, KVUP, KVLORA}; pg8::StaticOrder S; S.init(M_, KVUP, G, bid); pg8::EpiPlain E{MLA_BF16 ? KV : nullptr, KVUP, PARTKV, ws + WS_KN8, ws + WS_V8};
      pg8::gemm_phase<pg8::EpiPlain, pg8::StaticOrder, true, true>(ldsl + RING_OFF, g, S, E, wave); }
#endif
    GRID_BAR();
#if I8_FFN2
    p7_attention<7>(lds, ws, pos, G, bid, wave, P7Conv{args, vcu});
#else
    p7_attention<7>(lds, ws, pos, G, bid, wave, NoConv{});
#endif
#if PROBE_PHASE == 7
    p7_attention<7>(lds, ws, pos, G, bid, wave, NoConv{});
#endif
#if PROBE_PHASE == 71
    p7_attention<1>(lds, ws, pos, G, bid, wave, NoConv{});
#endif
#if PROBE_PHASE == 72
    p7_attention<2>(lds, ws, pos, G, bid, wave, NoConv{});
#endif
#if PROBE_PHASE == 74
    p7_attention<4>(lds, ws, pos, G, bid, wave, NoConv{});
#endif
    GRID_BAR();
    { int tid_f = wave * 64 + lane_id_(); asm volatile("" : "+v"(tid_f)); const int tid = tid_f, lane = tid & 63; (void)lane; (void)tid;
    for (int it = gw; it < M_ * NH / 4; it += NGW) { const int pair = it * 4 + (lane >> 4), c8 = lane & 15;
        const f32x4 ml0 = *(const GAS f32x4*)(PML + (size_t)pair * 8), ml1 = *(const GAS f32x4*)(PML + (size_t)pair * 8 + 4);
        const float m[4] = {ml0.x, ml0.z, ml1.x, ml1.z}, l[4] = {ml0.y, ml0.w, ml1.y, ml1.w};
        float mx = -1e30f;
#pragma unroll
        for (int j = 0; j < 4; ++j) if (l[j] > 0.f) mx = fmaxf(mx, m[j]);
        float w[4], wsum = 0.f;
#pragma unroll
        for (int j = 0; j < 4; ++j) { w[j] = l[j] > 0.f ? __builtin_amdgcn_exp2f(m[j] - mx) * l[j] : 0.f; wsum += w[j]; }
        const float inv = 1.0f / wsum; float acc[8] = {0.f, 0.f, 0.f, 0.f, 0.f, 0.f, 0.f, 0.f};
#pragma unroll
        for (int j = 0; j < 4; ++j) { const v4u o = *(const GAS v4u*)(PO + ((size_t)pair * 4 + j) * 128 + c8 * 8); const float wj = w[j] * inv;
            if (w[j] > 0.f) {
#pragma unroll
                for (int e = 0; e < 4; ++e) { acc[2 * e] += wj * bfu_lo(o[e]); acc[2 * e + 1] += wj * bfu_hi(o[e]); } } }
        const int row = pair >> 4, h = pair & 15; v4u r; r.x = pk2(acc[0], acc[1]); r.y = pk2(acc[2], acc[3]); r.z = pk2(acc[4], acc[5]); r.w = pk2(acc[6], acc[7]);
        *(GAS v4u*)(OBC + (size_t)row * MOBAW + h * 128 + c8 * 8) = r;
        { int w0 = 0, w1 = 0;
          w0 = __builtin_amdgcn_cvt_pk_fp8_f32(acc[0] * 16.f, acc[1] * 16.f, w0, false); w0 = __builtin_amdgcn_cvt_pk_fp8_f32(acc[2] * 16.f, acc[3] * 16.f, w0, true);
          w1 = __builtin_amdgcn_cvt_pk_fp8_f32(acc[4] * 16.f, acc[5] * 16.f, w1, false); w1 = __builtin_amdgcn_cvt_pk_fp8_f32(acc[6] * 16.f, acc[7] * 16.f, w1, true);
          v2u q; q.x = (unsigned)w0; q.y = (unsigned)w1; *(GAS v2u*)(OB8 + ((size_t)h * M_ + row) * 128 + c8 * 8) = q; } }
    for (int it = gw * 64 + lane; it < M_ * MLAOUT / 8; it += NGW * 64) { const int row = it >> 8, c8 = it & 255;
        const v4u o = *(const GAS v4u*)(OA + (size_t)row * MLAOUT + c8 * 8); int w0 = 0, w1 = 0;
        w0 = __builtin_amdgcn_cvt_pk_fp8_f32(bfu_lo(o.x) * 16.f, bfu_hi(o.x) * 16.f, w0, false); w0 = __builtin_amdgcn_cvt_pk_fp8_f32(bfu_lo(o.y) * 16.f, bfu_hi(o.y) * 16.f, w0, true);
        w1 = __builtin_amdgcn_cvt_pk_fp8_f32(bfu_lo(o.z) * 16.f, bfu_hi(o.z) * 16.f, w1, false); w1 = __builtin_amdgcn_cvt_pk_fp8_f32(bfu_lo(o.w) * 16.f, bfu_hi(o.w) * 16.f, w1, true);
        v2u q; q.x = (unsigned)w0; q.y = (unsigned)w1; *(GAS v2u*)(OA8 + ((size_t)(c8 >> 4) * M_ + row) * 128 + (c8 & 15) * 8) = q; }
#if PROBE_PHASE == 8 || PROBE_PHASE == 38
    for (int it = gw; it < M_ * NH / 4; it += NGW) { const int pair = it * 4 + (lane >> 4), c8 = lane & 15;
        const f32x4 ml0 = *(const GAS f32x4*)(PML + (size_t)pair * 8), ml1 = *(const GAS f32x4*)(PML + (size_t)pair * 8 + 4);
        const float m[4] = {ml0.x, ml0.z, ml1.x, ml1.z}, l[4] = {ml0.y, ml0.w, ml1.y, ml1.w};
        float mx = -1e30f;
#pragma unroll
        for (int j = 0; j < 4; ++j) if (l[j] > 0.f) mx = fmaxf(mx, m[j]);
        float w[4], wsum = 0.f;
#pragma unroll
        for (int j = 0; j < 4; ++j) { w[j] = l[j] > 0.f ? __builtin_amdgcn_exp2f(m[j] - mx) * l[j] : 0.f; wsum += w[j]; }
        const float inv = 1.0f / wsum; float acc[8] = {0.f, 0.f, 0.f, 0.f, 0.f, 0.f, 0.f, 0.f};
#pragma unroll
        for (int j = 0; j < 4; ++j) { const v4u o = *(const GAS v4u*)(PO + ((size_t)pair * 4 + j) * 128 + c8 * 8); const float wj = w[j] * inv;
            if (w[j] > 0.f) {
#pragma unroll
                for (int e = 0; e < 4; ++e) { acc[2 * e] += wj * bfu_lo(o[e]); acc[2 * e + 1] += wj * bfu_hi(o[e]); } } }
        const int row = pair >> 4, h = pair & 15; v4u r; r.x = pk2(acc[0], acc[1]); r.y = pk2(acc[2], acc[3]); r.z = pk2(acc[4], acc[5]); r.w = pk2(acc[6], acc[7]);
        *(GAS v4u*)(OBC + (size_t)row * MOBAW + h * 128 + c8 * 8) = r;
        { int w0 = 0, w1 = 0;
          w0 = __builtin_amdgcn_cvt_pk_fp8_f32(acc[0] * 16.f, acc[1] * 16.f, w0, false); w0 = __builtin_amdgcn_cvt_pk_fp8_f32(acc[2] * 16.f, acc[3] * 16.f, w0, true);
          w1 = __builtin_amdgcn_cvt_pk_fp8_f32(acc[4] * 16.f, acc[5] * 16.f, w1, false); w1 = __builtin_amdgcn_cvt_pk_fp8_f32(acc[6] * 16.f, acc[7] * 16.f, w1, true);
          v2u q; q.x = (unsigned)w0; q.y = (unsigned)w1; *(GAS v2u*)(OB8 + ((size_t)h * M_ + row) * 128 + c8 * 8) = q; } }
    for (int it = gw * 64 + lane; it < M_ * MLAOUT / 8; it += NGW * 64) { const int row = it >> 8, c8 = it & 255;
        const v4u o = *(const GAS v4u*)(OA + (size_t)row * MLAOUT + c8 * 8); int w0 = 0, w1 = 0;
        w0 = __builtin_amdgcn_cvt_pk_fp8_f32(bfu_lo(o.x) * 16.f, bfu_hi(o.x) * 16.f, w0, false); w0 = __builtin_amdgcn_cvt_pk_fp8_f32(bfu_lo(o.y) * 16.f, bfu_hi(o.y) * 16.f, w0, true);
        w1 = __builtin_amdgcn_cvt_pk_fp8_f32(bfu_lo(o.z) * 16.f, bfu_hi(o.z) * 16.f, w1, false); w1 = __builtin_amdgcn_cvt_pk_fp8_f32(bfu_lo(o.w) * 16.f, bfu_hi(o.w) * 16.f, w1, true);
        v2u q; q.x = (unsigned)w0; q.y = (unsigned)w1; *(GAS v2u*)(OA8 + ((size_t)(c8 >> 4) * M_ + row) * 128 + (c8 & 15) * 8) = q; }
#endif
    }
    GRID_BAR();
#if PROBE_PHASE == 500
    selfcheck(lds, ws, pos, OBC, G, bid);
    GRID_BAR();
#endif
#if FP8_BR
    { pg8::Gemm g{(const bf16*)OA8, WBRA, M_, DM, MLAOUT / 2}; pg8::StaticOrder S; S.init(M_, DM, G, bid); pg8::EpiMerge<false> E{GA, H, nullptr, 0.001953125f};
      pg8::gemm_phase<pg8::EpiMerge<false>, pg8::StaticOrder, true, true, true, true>(ldsl + RING_OFF, g, S, E, wave); }
    { pg8::Gemm g{(const bf16*)OB8, WBRB, M_, DM, MOBAW / 2}; pg8::StaticOrder S; S.init(M_, DM, G, bid); pg8::EpiMerge<true> E{GB, H, FP8_OUT ? MG8 : nullptr, 0.001953125f};
      pg8::gemm_phase<pg8::EpiMerge<true>, pg8::StaticOrder, true, true, true, true>(ldsl + RING_OFF, g, S, E, wave); }
#else
    { pg8::Gemm g{OA, WBRA, M_, DM, MLAOUT}; pg8::StaticOrder S; S.init(M_, DM, G, bid); pg8::EpiMerge<false> E{GA, H, nullptr, 1.0f};
      pg8::gemm_phase<pg8::EpiMerge<false>, pg8::StaticOrder, true, true>(ldsl + RING_OFF, g, S, E, wave); }
    { pg8::Gemm g{OBC, WBRB, M_, DM, MOBAW}; pg8::StaticOrder S; S.init(M_, DM, G, bid); pg8::EpiMerge<true> E{GB, H, FP8_OUT ? MG8 : nullptr, 1.0f};
      pg8::gemm_phase<pg8::EpiMerge<true>, pg8::StaticOrder, true, true>(ldsl + RING_OFF, g, S, E, wave); }
#endif
    GRID_BAR();
#if I8_OUT
    { int tid_f = wave * 64 + lane_id_(); asm volatile("" : "+v"(tid_f)); const int lane = tid_f & 63;
      for (int m = gw; m < M_; m += NGW) quant_row_plain_i8(H, MG8, m, (float*)(ws + WS_RSM), lane); }
    GRID_BAR();
#endif
#if I8_OUT
    { pg8::Gemm g{(const bf16*)MG8, WOUT, M_, DM, DM / 2}; pg8::StaticOrder S; S.init(M_, DM, G, bid);
      pg8::EpiResidNorm<0, true> E{out, out, 1.0f, H3, args.in[15], PART, PMAX, (const float*)(ws + WS_RSM), (const float*)(ws + WS_CMAXO)};
      pg8::gemm_phase<pg8::EpiResidNorm<0, true>, pg8::StaticOrder, true, true, true, false, true>(ldsl + RING_OFF, g, S, E, wave); }
#elif FP8_OUT
    { pg8::Gemm g{(const bf16*)MG8, WOUT, M_, DM, DM / 2}; pg8::StaticOrder S; S.init(M_, DM, G, bid); pg8::EpiResidNorm<0> E{out, out, 0.0009765625f, H3, args.in[15], PART, PMAX};
      pg8::gemm_phase<pg8::EpiResidNorm<0>, pg8::StaticOrder, true, true, true, true>(ldsl + RING_OFF, g, S, E, wave); }
#else
    { pg8::Gemm g{H, WOUT, M_, DM, DM}; pg8::StaticOrder S; S.init(M_, DM, G, bid); pg8::EpiResidNorm<0> E{out, out, 1.0f, H3, args.in[15], PART, PMAX};
      pg8::gemm_phase<pg8::EpiResidNorm<0>, pg8::StaticOrder, true, true>(ldsl + RING_OFF, g, S, E, wave); }
#endif
    GRID_BAR();
    { int tid_f = wave * 64 + lane_id_(); asm volatile("" : "+v"(tid_f)); const int tid = tid_f, lane = tid & 63; (void)lane; (void)tid;
#if !I8_FFN2
    cvt_job<1>(args.in[16], DM, NFF2, WFI, NFF2 / 64, cvtT, gw, NGW, lane, nullptr, NFF2);
#endif
#if I8_FFN2
    for (int m = gw; m < M_; m += NGW) quant_row_i8(H3, PART, PMAX, H8, m, RSTD, lane);
#else
    rstd_reduce<64>(PART, RSTD, 1.f / DM, vcu, tid, G);
#endif
#if PROBE_PHASE == 11
#if !I8_FFN2
    cvt_job<1>(args.in[16], DM, NFF2, WFI, NFF2 / 64, cvtT, gw, NGW, lane, nullptr, NFF2);
#endif
#if I8_FFN2
    for (int m = gw; m < M_; m += NGW) quant_row_i8(H3, PART, PMAX, H8, m, RSTD, lane);
#else
    rstd_reduce<64>(PART, RSTD, 1.f / DM, vcu, tid, G);
#endif
#endif
    }
    GRID_BAR();
#if I8_FFN2
    { pg8::Gemm g{(const bf16*)H8, (const bf16*)(ws + WS_WFI2), M_, NFF2, DM / 2}; pg8::StaticOrder S; S.init(M_, NFF2, G, bid); pg8::EpiSwiglu E{ACT, DFF, RSTD, M_, CMAX2};
      pg8::gemm_phase<pg8::EpiSwiglu, pg8::StaticOrder, true, true, true, false, true>(ldsl + RING_OFF, g, S, E, wave); }
#else
    { pg8::Gemm g{H3, WFI, M_, NFF2, DM}; pg8::StaticOrder S; S.init(M_, NFF2, G, bid); pg8::EpiSwiglu E{ACT, DFF, RSTD, M_, nullptr};
      pg8::gemm_phase<pg8::EpiSwiglu, pg8::StaticOrder, true, true, true>(ldsl + RING_OFF, g, S, E, wave); }
#endif
    if (G == 256 && bid >= 128) { int tid_f = wave * 64 + lane_id_(); asm volatile("" : "+v"(tid_f)); const int lane = tid_f & 63;
        cvt_job<0>(args.in[17], DFF, DM, WFO, DM / 64, cvtT, (bid - 128) * NWAVES + wave, 128 * NWAVES, lane, nullptr, DM); }
    else if (G != 256) { int tid_f = wave * 64 + lane_id_(); asm volatile("" : "+v"(tid_f)); const int lane = tid_f & 63; cvt_job<0>(args.in[17], DFF, DM, WFO, DM / 64, cvtT, gw, NGW, lane, nullptr, DM); }
    GRID_BAR();
    { pg8::Gemm g{ACT, WFO, M_, DM, DFF}; pg8::StaticOrder S; S.init(M_, DM, G, bid); pg8::EpiResid E{out, out, DM, 0.5f};
      pg8::gemm_phase<pg8::EpiResid, pg8::StaticOrder, true, true, true>(ldsl + RING_OFF, g, S, E, wave); }
    GRID_BAR();
    { int tid_f = wave * 64 + lane_id_(); asm volatile("" : "+v"(tid_f)); const int tid = tid_f, lane = tid & 63; (void)lane; (void)tid;
#if PROBE_PHASE == 500
    if (__hip_atomic_load(ctl + CW_FAIL, RLX_AGENT) > SELFCHECK_TOL) { for (int m = gw; m < M_; m += NGW) for (int j = lane; j < DM; j += 64) out[(size_t)m * DM + j] = __builtin_nanf(""); return; }
#endif
    for (int m = gw; m < M_; m += NGW) rms_row4096<true>(out + (size_t)m * DM, args.in[18], out + (size_t)m * DM, lane);
    }
}

extern "C" void kernel_launch(void* const* d_in, const int* in_sizes, int n_in, void* d_out, int out_size, void* d_ws, size_t ws_size, hipStream_t stream) {
    static int grid = 0;
    if (grid == 0) {
        if (n_in != 19 || out_size != M_ * DM || ws_size < WS_END) { fprintf(stderr, "kernel_launch: unexpected shapes (n_in %d out %d ws %zu need %zu)\n", n_in, out_size, ws_size, (size_t)WS_END); grid = -1; return; }
        int dev = 0, cus = 0;
        if (hipGetDevice(&dev) != hipSuccess || hipDeviceGetAttribute(&cus, hipDeviceAttributeMultiprocessorCount, dev) != hipSuccess) { grid = -1; return; }
        if (hipFuncSetAttribute((const void*)hybrid_fwd, hipFuncAttributeMaxDynamicSharedMemorySize, LDS_BYTES) != hipSuccess) { fprintf(stderr, "kernel_launch: hipFuncSetAttribute failed\n"); grid = -1; return; }
        int per_cu = 0;
        if (hipOccupancyMaxActiveBlocksPerMultiprocessor(&per_cu, (const void*)hybrid_fwd, NWAVES * 64, LDS_BYTES) != hipSuccess || per_cu < 1) { fprintf(stderr, "kernel_launch: occupancy query says %d\n", per_cu); }
        (void)hipGetLastError();
        grid = cus;
    }
    if (grid < 0) return;
    if (hipMemsetAsync((char*)d_ws + WS_CTL, 0, CTL_ZERO_BYTES, stream) != hipSuccess) { fprintf(stderr, "kernel_launch: memset failed\n"); return; }
    Args a{};
    for (int i = 0; i < 19; ++i) a.in[i] = (const float*)d_in[i];
    a.out = (float*)d_out; a.ws = (unsigned char*)d_ws;
    for (int i = 0; i < 32; ++i) a.invf[i] = pow(10000.0, -(double)(2 * i) / 64.0);
    for (int d = 0; d < 136; ++d) { int b;
        if (d < 16) b = d; else { const double dd = d > 128 ? 128.0 : (double)d; b = 16 + (int)(log(dd / 16.0) / log(128.0 / 16.0) * 16.0); if (b > 31) b = 31; }
        a.bucket[d] = (unsigned char)b; }
    hipLaunchKernelGGL(hybrid_fwd, dim3(grid), dim3(NWAVES * 64), LDS_BYTES, stream, a);
    const hipError_t le = hipPeekAtLastError();
    if (le != hipSuccess) fprintf(stderr, "kernel_launch: launch failed: %s\n", hipGetErrorName(le));
}
```
